# Optimizing an MI355X kernel written in HIP

```python
import math
import jax, jax.numpy as jnp
from jax import lax
import numpy as np

D_MODEL = 1024
BATCH = 2
SEQ = 16384
DEPTH = 2

CHUNK = 64
N_MIXERS = 2
N_A_LAYERS = (DEPTH + 1) // 2
N_B_LAYERS = DEPTH // 2
RMS_EPS = 1e-6
LN_EPS = 1e-5

A_HEADS = 8
A_HEAD_DIM = 128
A_WIDTH = A_HEADS * A_HEAD_DIM
IDX_HEADS = 8
IDX_DIM = 64
TOPK_MAX = 256
Q_BLOCK = 128
A_IN_COLS = 4 * A_WIDTH + IDX_HEADS * IDX_DIM + IDX_DIM + IDX_HEADS

REL_BUCKETS = 32
REL_MAX_DIST = 128

SGU_CHUNK = 128
B_WIDTH = 2 * D_MODEL
B_GROUPS = 8
B_GROUP_DIM = B_WIDTH // B_GROUPS
B_IN_COLS = 3 * B_WIDTH

kernel_name = "hybrid_dsa_sgu_streaming_encoder"


def rmsnorm(x, g):
    x32 = x.astype(jnp.float32)
    y = x32 * lax.rsqrt(jnp.mean(x32 * x32, axis=-1, keepdims=True) + RMS_EPS)
    return y.astype(x.dtype) * g


def layernorm(x, g, b):
    x32 = x.astype(jnp.float32)
    mu = jnp.mean(x32, axis=-1, keepdims=True)
    var = jnp.mean(jnp.square(x32 - mu), axis=-1, keepdims=True)
    return ((x32 - mu) * lax.rsqrt(var + LN_EPS)).astype(x.dtype) * g + b


def t5_bucket(rel):
    half = REL_BUCKETS // 2
    max_exact = half // 2
    ret = jnp.where(rel < 0, half, 0)
    n = jnp.abs(rel)
    nf = jnp.maximum(n, 1).astype(jnp.float32)
    large = max_exact + (jnp.log(nf / max_exact) / math.log(REL_MAX_DIST / max_exact)
                         * (half - max_exact)).astype(jnp.int32)
    large = jnp.minimum(large, half - 1)
    return ret + jnp.where(n < max_exact, n, large)


def dsa_mixer(h, w_in, w_out, rel_bias):
    bsz, seq, _ = h.shape
    offs = np.cumsum([A_WIDTH, A_WIDTH, A_WIDTH, A_WIDTH,
                      IDX_HEADS * IDX_DIM, IDX_DIM]).tolist()
    q, k, v, z, qi, ki, wi = jnp.split(h @ w_in, offs, axis=-1)
    q = q.reshape(bsz, seq, A_HEADS, A_HEAD_DIM)
    k = k.reshape(bsz, seq, A_HEADS, A_HEAD_DIM)
    v = v.reshape(bsz, seq, A_HEADS, A_HEAD_DIM)
    qi = qi.reshape(bsz, seq, IDX_HEADS, IDX_DIM).astype(jnp.float32)
    ki = ki.astype(jnp.float32)
    wi = wi.astype(jnp.float32) * (IDX_HEADS ** -0.5)

    topk = min(TOPK_MAX, seq // 4)
    n_blk = seq // Q_BLOCK
    key_chunk = jnp.arange(seq, dtype=jnp.int32) // CHUNK
    attn_scale = A_HEAD_DIM ** -0.5
    idx_scale = IDX_DIM ** -0.5

    def gather_rows(arr, idx):
        return arr[idx]

    def block(i):
        start = i * Q_BLOCK
        qb = lax.dynamic_slice_in_dim(q, start, Q_BLOCK, axis=1)
        qib = lax.dynamic_slice_in_dim(qi, start, Q_BLOCK, axis=1)
        wib = lax.dynamic_slice_in_dim(wi, start, Q_BLOCK, axis=1)
        tpos = start + jnp.arange(Q_BLOCK, dtype=jnp.int32)
        tchunk = tpos // CHUNK
        dots = jnp.einsum('bqhd,bsd->bqhs', qib, ki) * idx_scale
        iscore = jnp.einsum('bqhs,bqh->bqs', jax.nn.relu(dots), wib)
        admissible = key_chunk[None, :] <= tchunk[:, None]
        iscore = jnp.where(admissible[None], iscore, -jnp.inf)
        _, idx = lax.top_k(iscore, topk)
        kg = jax.vmap(gather_rows)(k, idx)
        vg = jax.vmap(gather_rows)(v, idx)
        logits = jnp.einsum('bqhd,bqkhd->bhqk', qb, kg).astype(jnp.float32) * attn_scale
        bias = rel_bias[t5_bucket(tpos[None, :, None] - idx)]
        logits = logits + jnp.transpose(bias, (0, 3, 1, 2)).astype(jnp.float32)
        valid = (idx // CHUNK) <= tchunk[None, :, None]
        logits = jnp.where(valid[:, None], logits, -jnp.inf)
        p = jax.nn.softmax(logits, axis=-1).astype(vg.dtype)
        return jnp.einsum('bhqk,bqkhd->bqhd', p, vg)

    out = lax.map(block, jnp.arange(n_blk, dtype=jnp.int32))
    out = jnp.moveaxis(out, 0, 1).reshape(bsz, seq, A_WIDTH)
    return (out * jax.nn.silu(z)) @ w_out


def sgu_mixer(h, w_in, ln_g, ln_b, w_s, b_s, w_out):
    bsz, seq, _ = h.shape
    u, v, z = jnp.split(h @ w_in, 3, axis=-1)
    v = layernorm(v, ln_g, ln_b)
    n_c = seq // SGU_CHUNK
    vc = v.reshape(bsz, n_c, SGU_CHUNK, B_GROUPS, B_GROUP_DIM)
    tri = jnp.tril(jnp.ones((SGU_CHUNK, SGU_CHUNK), dtype=w_s.dtype))
    ws = w_s * tri[None]
    mixed = jnp.einsum('gts,bcsge->bctge', ws, vc) + jnp.transpose(b_s)[None, None, :, :, None]
    y = u * mixed.reshape(bsz, seq, B_WIDTH)
    return (y * jax.nn.silu(z)) @ w_out


def setup_inputs(seed: int = 0) -> dict:
    key = jax.random.key(seed)
    ks = jax.random.split(key, 14)
    f32 = jnp.float32
    x = jax.random.normal(ks[0], (BATCH, SEQ, D_MODEL), f32)
    norm_g = 1.0 + 0.05 * jax.random.normal(ks[1], (DEPTH, D_MODEL), f32)
    final_g = 1.0 + 0.05 * jax.random.normal(ks[2], (D_MODEL,), f32)
    rel_bias = 0.5 * jax.random.normal(ks[3], (REL_BUCKETS, A_HEADS), f32)
    a_w_in = jax.random.normal(ks[4], (N_A_LAYERS, D_MODEL, A_IN_COLS), f32) * D_MODEL ** -0.5
    a_w_out = jax.random.normal(ks[5], (N_A_LAYERS, A_WIDTH, D_MODEL), f32) * A_WIDTH ** -0.5
    b_w_in = jax.random.normal(ks[6], (N_B_LAYERS, D_MODEL, B_IN_COLS), f32) * D_MODEL ** -0.5
    b_ln_g = 1.0 + 0.05 * jax.random.normal(ks[7], (N_B_LAYERS, B_WIDTH), f32)
    b_ln_b = 0.02 * jax.random.normal(ks[8], (N_B_LAYERS, B_WIDTH), f32)
    b_w_s = jax.random.normal(ks[9], (N_B_LAYERS, B_GROUPS, SGU_CHUNK, SGU_CHUNK), f32) * SGU_CHUNK ** -0.5
    b_b_s = 1.0 + 0.1 * jax.random.normal(ks[10], (N_B_LAYERS, B_GROUPS, SGU_CHUNK), f32)
    b_w_out = jax.random.normal(ks[11], (N_B_LAYERS, B_WIDTH, D_MODEL), f32) * B_WIDTH ** -0.5
    return {"x": x, "norm_g": norm_g, "final_g": final_g, "rel_bias": rel_bias,
            "a_w_in": a_w_in, "a_w_out": a_w_out,
            "b_w_in": b_w_in, "b_ln_g": b_ln_g, "b_ln_b": b_ln_b,
            "b_w_s": b_w_s, "b_b_s": b_b_s, "b_w_out": b_w_out}


def reference(x, norm_g, final_g, rel_bias, a_w_in, a_w_out,
              b_w_in, b_ln_g, b_ln_b, b_w_s, b_b_s, b_w_out):
    for i in range(DEPTH):
        h = rmsnorm(x, norm_g[i])
        j = i // N_MIXERS
        if i % N_MIXERS == 0:
            x = x + dsa_mixer(h, a_w_in[j], a_w_out[j], rel_bias)
        else:
            x = x + sgu_mixer(h, b_w_in[j], b_ln_g[j], b_ln_b[j],
                              b_w_s[j], b_b_s[j], b_w_out[j])
    return rmsnorm(x, final_g)
```

```cpp
#include <hip/hip_runtime.h>
#include <cstdio>
#include <cstdint>

constexpr int NB = 2, S = 16384, DM = 1024, M = NB * S;
constexpr int A_COLS = 4680, A_NPAD = 4864;
constexpr int BW = 2048, B_COLS = 3 * BW;
constexpr float RMS_EPS = 1e-6f, LN_EPS = 1e-5f;
constexpr float LOG2E = 1.4426950408889634f;
constexpr float QSCALE = 0.08838834764831845f * LOG2E;
constexpr float WI_SCALE = 0.35355339059327373f;
constexpr float QI_SCALE = 0.125f;
constexpr int TOPK = 256;

namespace pg8 {
#define PG8_LAS __attribute__((address_space(3)))
typedef unsigned short bf16_t;
typedef short bf16x8 __attribute__((ext_vector_type(8)));
typedef float f32x4 __attribute__((ext_vector_type(4)));
typedef unsigned u32x4 __attribute__((ext_vector_type(4)));
constexpr int BM = 256, BK = 64, HALF = 128, HTB = HALF * BK * 2  , STAGE_BYTES = 8 * HTB, NXCD = 8, WGM = 8;

__host__ __device__ __forceinline__ int lds_byte(int r, int c) { const int st = (r >> 4) * 2 + (c >> 5), rr = r & 15, cc = c & 31, ob = rr * 64 + cc * 2; return st * 1024 + (ob ^ (((ob >> 9) & 1) << 5)); }
__host__ __device__ __forceinline__ void stage_rc(int b, int& R, int& C) { const int st = b / 1024, sb = b % 1024, swz = sb ^ (((sb >> 9) & 1) << 5); R = (st >> 1) * 16 + swz / 64; C = (st & 1) * 32 + (swz % 64) / 2; }
__host__ __device__ __forceinline__ int perm32(int rho) { const int n = rho >> 4, i = rho & 15; return 8 * (i >> 2) + 4 * n + (i & 3); }

struct Unit { int pm, pn; };
struct Gemm { const bf16_t* A; const bf16_t* Bt; int M, N, K; };

struct StaticOrder {
    int nM, nN, nwg, G, c;
    __host__ __device__ void init(int M, int N, int G_, int c_) { nM = M / BM; nN = N / BM; nwg = nM * nN; G = G_; c = c_; }
    __host__ __device__ bool next(int i, Unit& u) const {
        const long L = (long)i * G + c; if (L >= nwg) return false;
        int wgid = (int)L; { const int q = nwg / NXCD, r = nwg % NXCD, xcd = wgid % NXCD, off = wgid / NXCD; wgid = (xcd < r ? xcd * (q + 1) : r * (q + 1) + (xcd - r) * q) + off; }
        const int nig = WGM * nN, gid = wgid / nig, fm = gid * WGM, gsz = (nM - fm) < WGM ? (nM - fm) : WGM;
        u.pm = fm + ((wgid % nig) % gsz); u.pn = (wgid % nig) / gsz; return true;
    }
    __device__ __forceinline__ void a_ready(const Unit&) const {}
    __device__ __forceinline__ void done(const Unit&) const {}
};

__device__ __forceinline__ unsigned cvt_pk_bf16(float lo, float hi) { unsigned r; asm volatile("v_cvt_pk_bf16_f32 %0, %1, %2" : "=v"(r) : "v"(lo), "v"(hi)); return r; }
typedef float f32x2 __attribute__((ext_vector_type(2)));
__device__ __forceinline__ float silu_f(float z) { return z * __builtin_amdgcn_rcpf(1.0f + __builtin_amdgcn_exp2f(-z * 1.4426950408889634f)); }

struct EpiA {
    static constexpr bool PERM = true, AFTER_DRAIN = false;
    bf16_t *Q, *K, *V, *ZS, *QI, *KI; float* WI;
    __device__ __forceinline__ void operator()(const f32x4 (&acc)[2][2][4][2], const Unit& u, int wr, int wc, int fr, int fq) const {
        const int pn = u.pn, row0 = u.pm * BM + wr * 64 + fr;
        if (pn < 18) {
            bf16_t* base; int ldc, colt; float sc = 1.f; bool act = false;
            if (pn < 4) { base = Q; ldc = 1024; colt = pn * 256; sc = 0.08838834764831845f * 1.4426950408889634f; }
            else if (pn < 8) { base = K; ldc = 1024; colt = (pn - 4) * 256; }
            else if (pn < 12) { base = V; ldc = 1024; colt = (pn - 8) * 256; }
            else if (pn < 16) { base = ZS; ldc = 1024; colt = (pn - 12) * 256; act = true; }
            else { base = QI; ldc = 512; colt = (pn - 16) * 256; sc = 0.125f; }
            const int col0 = colt + wc * 32 + 8 * fq;
#pragma unroll
            for (int ai = 0; ai < 2; ++ai)
#pragma unroll
                for (int m = 0; m < 4; ++m) { bf16_t* rowp = base + (size_t)(row0 + ai * HALF + m * 16) * ldc + col0;
#pragma unroll
                    for (int bj = 0; bj < 2; ++bj) { f32x4 v0 = acc[ai][bj][m][0], v1 = acc[ai][bj][m][1];
                        if (act) { v0 = (f32x4){silu_f(v0[0]), silu_f(v0[1]), silu_f(v0[2]), silu_f(v0[3])}; v1 = (f32x4){silu_f(v1[0]), silu_f(v1[1]), silu_f(v1[2]), silu_f(v1[3])}; }
                        v0 = v0 * sc; v1 = v1 * sc; u32x4 w; w.x = cvt_pk_bf16(v0[0], v0[1]); w.y = cvt_pk_bf16(v0[2], v0[3]); w.z = cvt_pk_bf16(v1[0], v1[1]); w.w = cvt_pk_bf16(v1[2], v1[3]);
                        *(u32x4*)(rowp + bj * HALF) = w; } }
        } else {
#pragma unroll
            for (int ai = 0; ai < 2; ++ai)
#pragma unroll
                for (int m = 0; m < 4; ++m) { const size_t row = (size_t)(row0 + ai * HALF + m * 16);
                    const f32x4 v0 = acc[ai][0][m][0], v1 = acc[ai][0][m][1];
                    if (wc < 2) { u32x4 w; w.x = cvt_pk_bf16(v0[0], v0[1]); w.y = cvt_pk_bf16(v0[2], v0[3]); w.z = cvt_pk_bf16(v1[0], v1[1]); w.w = cvt_pk_bf16(v1[2], v1[3]);
                        *(u32x4*)(KI + row * 64 + wc * 32 + 8 * fq) = w; }
                    else if (wc == 2 && fq == 0) { const float s = 0.35355339059327373f; *(f32x4*)(WI + row * 8) = v0 * s; *(f32x4*)(WI + row * 8 + 4) = v1 * s; } }
        }
    }
};

struct EpiB {
    static constexpr bool PERM = true, AFTER_DRAIN = false;
    bf16_t* U; size_t stride;
    template <bool ACT> __device__ __forceinline__ void run(const f32x4 (&acc)[2][2][4][2], bf16_t* p) const {
#pragma unroll
        for (int ai = 0; ai < 2; ++ai)
#pragma unroll
            for (int m = 0; m < 4; ++m) { bf16_t* rowp = p + (size_t)(ai * HALF + m * 16) * 2048;
#pragma unroll
                for (int bj = 0; bj < 2; ++bj) { f32x4 v0 = acc[ai][bj][m][0], v1 = acc[ai][bj][m][1];
                    if (ACT) { v0 = (f32x4){silu_f(v0[0]), silu_f(v0[1]), silu_f(v0[2]), silu_f(v0[3])}; v1 = (f32x4){silu_f(v1[0]), silu_f(v1[1]), silu_f(v1[2]), silu_f(v1[3])}; }
                    u32x4 w; w.x = cvt_pk_bf16(v0[0], v0[1]); w.y = cvt_pk_bf16(v0[2], v0[3]); w.z = cvt_pk_bf16(v1[0], v1[1]); w.w = cvt_pk_bf16(v1[2], v1[3]);
                    *(u32x4*)(rowp + bj * HALF) = w; } }
    }
    __device__ __forceinline__ void operator()(const f32x4 (&acc)[2][2][4][2], const Unit& u, int wr, int wc, int fr, int fq) const {
        const int pn = u.pn, row0 = u.pm * BM + wr * 64 + fr;
        bf16_t* base = U + (size_t)(pn >> 3) * stride;
        bf16_t* p = base + (size_t)row0 * 2048 + (pn & 7) * 256 + wc * 32 + 8 * fq;
        if (pn >= 16) run<true>(acc, p); else run<false>(acc, p);
    }
};

struct EpiRes {
    static constexpr bool PERM = false, AFTER_DRAIN = false;
    const float* base; float* out;
    __device__ __forceinline__ void operator()(const f32x4 (&acc)[2][2][4][2], const Unit& u, int wr, int wc, int fr, int fq) const {
        const int row0 = u.pm * BM + wr * 64 + fr, col0 = u.pn * BM + wc * 32 + 4 * fq;
#pragma unroll
        for (int ai = 0; ai < 2; ++ai)
#pragma unroll
            for (int m = 0; m < 4; ++m) { const size_t ro = (size_t)(row0 + ai * HALF + m * 16) * 1024 + col0;
#pragma unroll
                for (int bj = 0; bj < 2; ++bj)
#pragma unroll
                    for (int n = 0; n < 2; ++n) { const size_t o = ro + bj * HALF + n * 16; const f32x4 b = *(const f32x4*)(base + o); *(f32x4*)(out + o) = b + acc[ai][bj][m][n]; } }
    }
};


template <class Epi, class Sched, bool ALIGN_EPI = false, bool SP2 = false>
__device__ __forceinline__ void gemm_phase(PG8_LAS unsigned char* lds, const Gemm g, const Sched& S, const Epi& E) {
    const int tid = threadIdx.x, wid = __builtin_amdgcn_readfirstlane(tid >> 6), lane = tid & 63, wr = wid >> 2, wc = wid & 3, fr = lane & 15, fq = lane >> 4;
    const int K = g.K, nt = K / BK;
    unsigned voffA[2], voffB[2];
#pragma unroll
    for (int i = 0; i < 2; ++i) { int R, C; stage_rc(tid * 16 + i * 8192, R, C); const int Rb = Epi::PERM ? ((R & ~31) + perm32(R & 31)) : R;
        voffA[i] = (unsigned)(R * K + C) * 2u; voffB[i] = (unsigned)(Rb * K + C) * 2u; }
    const size_t kstep = (size_t)(BK * 2);
    const size_t hstep = (size_t)HALF * K * 2;
    const size_t tstep = 2 * hstep;
    const unsigned ldsw = (unsigned)wid * 1024u;
    const int aoff = lds_byte(wr * 64 + fr, fq * 8), boff = lds_byte(wc * 32 + fr, fq * 8);
#define PG8_SA(b, h) (((b) * 2 + (h)) * HTB)
#define PG8_SB(b, h) ((4 + (b) * 2 + (h)) * HTB)
#define PG8_STAGE(bufoff, gbase, voff) do { _Pragma("unroll") for (int _i = 0; _i < 2; ++_i) \
        __builtin_amdgcn_global_load_lds((const unsigned*)((const char*)(gbase) + (voff)[_i]), (PG8_LAS unsigned*)(lds + (bufoff) + ldsw + _i * 8192), 16, 0, 0); } while (0)
#define PG8_LDA(dst, b, h) do { _Pragma("unroll") for (int m = 0; m < 4; ++m) _Pragma("unroll") for (int k = 0; k < 2; ++k) dst[m][k] = *(const PG8_LAS bf16x8*)(lds + PG8_SA(b, h) + aoff + m * 2048 + k * 1024); } while (0)
#define PG8_LDB(dst, b, h) do { _Pragma("unroll") for (int n = 0; n < 2; ++n) _Pragma("unroll") for (int k = 0; k < 2; ++k) dst[n][k] = *(const PG8_LAS bf16x8*)(lds + PG8_SB(b, h) + boff + n * 2048 + k * 1024); } while (0)
#define PG8_MMA(ai, bj, At, Bt) do { __builtin_amdgcn_s_setprio(1); _Pragma("unroll") for (int m = 0; m < 4; ++m) _Pragma("unroll") for (int n = 0; n < 2; ++n) _Pragma("unroll") for (int k = 0; k < 2; ++k) \
        acc[ai][bj][m][n] = __builtin_amdgcn_mfma_f32_16x16x32_bf16(Bt[n][k], At[m][k], acc[ai][bj][m][n], 0, 0, 0); __builtin_amdgcn_s_setprio(0); } while (0)
#define PG8_WAIT_V(n) asm volatile("s_waitcnt vmcnt(" #n ")" ::: "memory")
#define PG8_WAIT_L(n) asm volatile("s_waitcnt lgkmcnt(" #n ")" ::: "memory")
#define PG8_BAR __builtin_amdgcn_s_barrier()
#define PG8_SCHED __builtin_amdgcn_sched_barrier(0)
    Unit cur, nxt; int ui = 0;
    if (!S.next(0, cur)) return;
    f32x4 acc[2][2][4][2];
#pragma unroll
    for (int a = 0; a < 2; ++a)
#pragma unroll
        for (int b = 0; b < 2; ++b)
#pragma unroll
            for (int m = 0; m < 4; ++m)
#pragma unroll
                for (int n = 0; n < 2; ++n) acc[a][b][m][n] = (f32x4){0.f, 0.f, 0.f, 0.f};
    bf16x8 At[4][2], B0[2][2], B1[2][2];
    const char* cA = (const char*)g.A + (size_t)cur.pm * tstep; const char* cB = (const char*)g.Bt + (size_t)cur.pn * tstep;
    S.a_ready(cur);
    if constexpr (SP2) {
        PG8_STAGE(PG8_SB(0, 0), cB, voffB); PG8_STAGE(PG8_SB(0, 1), cB + hstep, voffB); PG8_STAGE(PG8_SA(0, 0), cA, voffA); PG8_STAGE(PG8_SA(0, 1), cA + hstep, voffA);
        if (wr == 1) PG8_BAR;
        PG8_WAIT_V(2); PG8_BAR;
        PG8_STAGE(PG8_SB(1, 0), cB + kstep, voffB); PG8_STAGE(PG8_SA(1, 0), cA + kstep, voffA); PG8_STAGE(PG8_SB(1, 1), cB + hstep + kstep, voffB);
        PG8_WAIT_V(6); PG8_BAR;
    } else {
        PG8_STAGE(PG8_SB(0, 0), cB, voffB); PG8_STAGE(PG8_SA(0, 0), cA, voffA); PG8_STAGE(PG8_SB(0, 1), cB + hstep, voffB); PG8_STAGE(PG8_SA(0, 1), cA + hstep, voffA);
        if (wr == 1) PG8_BAR;
        PG8_WAIT_V(4); PG8_BAR;
        PG8_STAGE(PG8_SB(1, 0), cB + kstep, voffB); PG8_STAGE(PG8_SA(1, 0), cA + kstep, voffA); PG8_STAGE(PG8_SB(1, 1), cB + hstep + kstep, voffB);
        PG8_WAIT_V(6); PG8_BAR;
    }
    for (;;) {
        const bool has_next = S.next(ui + 1, nxt);
        const char* nA = has_next ? (const char*)g.A + (size_t)nxt.pm * tstep : cA; const char* nB = has_next ? (const char*)g.Bt + (size_t)nxt.pn * tstep : cB;
        for (int t = 0; t < nt; t += 2) {
            const bool last = (t == nt - 2);
            const char* a1 = cA + (size_t)(t + 1) * kstep;
            const char* a2 = last ? nA : cA + (size_t)(t + 2) * kstep; const char* b2 = last ? nB : cB + (size_t)(t + 2) * kstep;
            const char* a3 = a2 + kstep; const char* b3 = b2 + kstep;
            if (last && has_next) S.a_ready(nxt);
            if constexpr (SP2) {
            PG8_LDB(B0, 0, 0); PG8_LDB(B1, 0, 1); PG8_SCHED; PG8_LDA(At, 0, 0); PG8_STAGE(PG8_SA(1, 1), a1 + hstep, voffA);
            PG8_WAIT_V(8); PG8_WAIT_L(0); PG8_BAR; PG8_MMA(0, 0, At, B0); PG8_MMA(0, 1, At, B1); PG8_BAR; PG8_SCHED;
            PG8_LDA(At, 0, 1); PG8_STAGE(PG8_SB(0, 0), b2, voffB); PG8_STAGE(PG8_SB(0, 1), b2 + hstep, voffB); PG8_STAGE(PG8_SA(0, 0), a2, voffA);
            PG8_WAIT_V(8); PG8_WAIT_L(0); PG8_BAR; PG8_MMA(1, 0, At, B0); PG8_MMA(1, 1, At, B1); PG8_BAR; PG8_SCHED;
            PG8_LDB(B0, 1, 0); PG8_LDB(B1, 1, 1); PG8_SCHED; PG8_LDA(At, 1, 0); PG8_STAGE(PG8_SA(0, 1), a2 + hstep, voffA);
            PG8_WAIT_V(8); PG8_WAIT_L(0); PG8_BAR; PG8_MMA(0, 0, At, B0); PG8_MMA(0, 1, At, B1); PG8_BAR; PG8_SCHED;
            PG8_LDA(At, 1, 1); PG8_STAGE(PG8_SB(1, 0), b3, voffB); PG8_STAGE(PG8_SB(1, 1), b3 + hstep, voffB); PG8_STAGE(PG8_SA(1, 0), a3, voffA);
            PG8_WAIT_V(8); PG8_WAIT_L(0); PG8_BAR; PG8_MMA(1, 0, At, B0); PG8_MMA(1, 1, At, B1); PG8_BAR; PG8_SCHED;
            } else {
            PG8_LDB(B0, 0, 0); PG8_SCHED; PG8_LDA(At, 0, 0); PG8_STAGE(PG8_SA(1, 1), a1 + hstep, voffA);
            PG8_WAIT_L(8); PG8_BAR; PG8_WAIT_L(0); PG8_MMA(0, 0, At, B0); PG8_BAR; PG8_SCHED;
            PG8_LDB(B1, 0, 1); PG8_STAGE(PG8_SB(0, 0), b2, voffB);
            PG8_BAR; PG8_WAIT_L(0); PG8_MMA(0, 1, At, B1); PG8_BAR;
            PG8_LDA(At, 0, 1); PG8_STAGE(PG8_SA(0, 0), a2, voffA);
            PG8_BAR; PG8_WAIT_L(0); PG8_MMA(1, 0, At, B0); PG8_BAR; PG8_SCHED;
            PG8_STAGE(PG8_SB(0, 1), b2 + hstep, voffB);
            PG8_WAIT_V(6); PG8_BAR; PG8_MMA(1, 1, At, B1); PG8_BAR;
            PG8_LDB(B0, 1, 0); PG8_SCHED; PG8_LDA(At, 1, 0); PG8_STAGE(PG8_SA(0, 1), a2 + hstep, voffA);
            PG8_WAIT_L(8); PG8_BAR; PG8_WAIT_L(0); PG8_MMA(0, 0, At, B0); PG8_BAR; PG8_SCHED;
            PG8_LDB(B1, 1, 1); PG8_STAGE(PG8_SB(1, 0), b3, voffB);
            PG8_BAR; PG8_WAIT_L(0); PG8_MMA(0, 1, At, B1); PG8_BAR;
            PG8_LDA(At, 1, 1); PG8_STAGE(PG8_SA(1, 0), a3, voffA);
            PG8_BAR; PG8_WAIT_L(0); PG8_MMA(1, 0, At, B0); PG8_BAR; PG8_SCHED;
            PG8_STAGE(PG8_SB(1, 1), b3 + hstep, voffB);
            PG8_WAIT_V(6); PG8_BAR; PG8_MMA(1, 1, At, B1); PG8_BAR;
            }
        }
        if constexpr (ALIGN_EPI) { if (wr == 0) PG8_BAR; }
        if constexpr (!Epi::AFTER_DRAIN) { E(acc, cur, wr, wc, fr, fq); S.done(cur); }
        if (!has_next) break;
#pragma unroll
        for (int a = 0; a < 2; ++a)
#pragma unroll
            for (int b = 0; b < 2; ++b)
#pragma unroll
                for (int m = 0; m < 4; ++m)
#pragma unroll
                    for (int n = 0; n < 2; ++n) acc[a][b][m][n] = (f32x4){0.f, 0.f, 0.f, 0.f};
        cur = nxt; cA = nA; cB = nB; ++ui;
        if constexpr (ALIGN_EPI) { if (wr == 1) PG8_BAR; }
    }
    PG8_WAIT_V(0);
    if constexpr (!ALIGN_EPI) { if (wr == 0) PG8_BAR; }
    PG8_BAR;
    if constexpr (Epi::AFTER_DRAIN) { E.fused(acc, cur, wr, wc, fr, fq, lds, wid, lane); S.done(cur); }
#undef PG8_SA
#undef PG8_SB
#undef PG8_STAGE
#undef PG8_LDA
#undef PG8_LDB
#undef PG8_MMA
#undef PG8_WAIT_V
#undef PG8_WAIT_L
#undef PG8_BAR
#undef PG8_SCHED
}
}
#define LAS __attribute__((address_space(3)))
typedef unsigned short bf16;
typedef float f32x4 __attribute__((ext_vector_type(4)));
typedef unsigned v4u __attribute__((ext_vector_type(4)));
typedef unsigned v2u __attribute__((ext_vector_type(2)));
__device__ __forceinline__ unsigned f2bf(float f) { unsigned u = __builtin_bit_cast(unsigned, f); return (u + 0x7fffu + ((u >> 16) & 1u)) >> 16; }
__device__ __forceinline__ unsigned pk2(float lo, float hi) { return f2bf(lo) | (f2bf(hi) << 16); }
__device__ __forceinline__ float bflo(unsigned w) { return __builtin_bit_cast(float, w << 16); }
__device__ __forceinline__ float bfhi(unsigned w) { return __builtin_bit_cast(float, w & 0xffff0000u); }
__device__ __forceinline__ float wave_sum(float v) {
#pragma unroll
    for (int o = 1; o < 64; o <<= 1) v += __shfl_xor(v, o);
    return v;
}
__device__ __forceinline__ float wave_max(float v) {
#pragma unroll
    for (int o = 1; o < 64; o <<= 1) v = fmaxf(v, __shfl_xor(v, o));
    return v;
}
__device__ __forceinline__ int t5_bucket(int rel) {
    const int ret = rel < 0 ? 16 : 0; const int n = rel < 0 ? -rel : rel;
    int v;
    if (n < 8) v = n; else if (n < 12) v = 8; else if (n < 16) v = 9; else if (n < 23) v = 10; else if (n < 32) v = 11; else if (n < 46) v = 12; else if (n < 64) v = 13; else if (n < 91) v = 14; else v = 15;
    return ret + v;
}

__device__ __forceinline__ void transpose_item(const float* W, int K, int N, int Npad, bf16* WT, LAS float* scr, int item, int lane) {
    const int nblk = Npad / 32, kb = item / nblk, nb = item % nblk, k0 = 64 * kb, n0 = 32 * nb;
    const int nn = n0 + (lane & 31);
#pragma unroll 8
    for (int i = 0; i < 32; ++i) { const int kk = 2 * i + (lane >> 5); scr[kk * 33 + (lane & 31)] = nn < N ? W[(size_t)(k0 + kk) * N + nn] : 0.f; }
    asm volatile("s_waitcnt lgkmcnt(0)" ::: "memory");
    const int c = lane & 7;
#pragma unroll
    for (int j = 0; j < 4; ++j) { const int n = (lane >> 3) + 8 * j; const LAS float* s = scr + (8 * c) * 33 + n;
        v4u o; o.x = pk2(s[0 * 33], s[1 * 33]); o.y = pk2(s[2 * 33], s[3 * 33]); o.z = pk2(s[4 * 33], s[5 * 33]); o.w = pk2(s[6 * 33], s[7 * 33]);
        *(v4u*)(WT + (size_t)(n0 + n) * K + k0 + 8 * c) = o; }
    asm volatile("s_waitcnt lgkmcnt(0)" ::: "memory");
}
__device__ __forceinline__ void rms_row_to_bf16(const float* xrow, const float* g, bf16* orow, int lane) {
    const f32x4* xr = (const f32x4*)xrow + lane; const f32x4* gr = (const f32x4*)g + lane;
    f32x4 v[4]; float s = 0.f;
#pragma unroll
    for (int j = 0; j < 4; ++j) { v[j] = xr[64 * j]; s += (v[j].x * v[j].x + v[j].y * v[j].y) + (v[j].z * v[j].z + v[j].w * v[j].w); }
    const float rs = 1.0f / sqrtf(wave_sum(s) * (1.f / 1024.f) + RMS_EPS);
    v2u* o8 = (v2u*)orow + lane;
#pragma unroll
    for (int j = 0; j < 4; ++j) { const f32x4 gg = gr[64 * j]; v2u o; o.x = pk2(v[j].x * rs * gg.x, v[j].y * rs * gg.y); o.y = pk2(v[j].z * rs * gg.z, v[j].w * rs * gg.w); o8[64 * j] = o; }
}
__device__ __forceinline__ void rms_row_f32(const float* xrow, const float* g, float* orow, int lane) {
    const f32x4* xr = (const f32x4*)xrow + lane; const f32x4* gr = (const f32x4*)g + lane;
    f32x4 v[4]; float s = 0.f;
#pragma unroll
    for (int j = 0; j < 4; ++j) { v[j] = xr[64 * j]; s += (v[j].x * v[j].x + v[j].y * v[j].y) + (v[j].z * v[j].z + v[j].w * v[j].w); }
    const float rs = 1.0f / sqrtf(wave_sum(s) * (1.f / 1024.f) + RMS_EPS);
    f32x4* o = (f32x4*)orow + lane;
#pragma unroll
    for (int j = 0; j < 4; ++j) { const f32x4 gg = gr[64 * j]; o[64 * j] = v[j] * rs * gg; }
}

__global__ void __launch_bounds__(512) k_prep(const float* x, const float* norm_g, const float* a_w_in, const float* a_w_out, const float* b_w_in, const float* b_w_out,
                                              bf16* WAI, bf16* WAO, bf16* WBI, bf16* WBO, bf16* H) {
    __shared__ float scr_all[8 * 64 * 33];
    const int tid = threadIdx.x, lane = tid & 63, wave = tid >> 6;
    LAS float* scr = (LAS float*)scr_all + wave * 64 * 33;
    const int gw = blockIdx.x * 8 + wave, NGW = gridDim.x * 8;
    constexpr int I_AI = 16 * (A_NPAD / 32), I_AO = 16 * 32, I_BI = 16 * (B_COLS / 32), I_BO = 32 * 32;
    for (int it = gw; it < I_AI + I_AO + I_BI + I_BO; it += NGW) {
        int r = it;
        if (r < I_AI) { transpose_item(a_w_in, 1024, A_COLS, A_NPAD, WAI, scr, r, lane); continue; } r -= I_AI;
        if (r < I_AO) { transpose_item(a_w_out, 1024, 1024, 1024, WAO, scr, r, lane); continue; } r -= I_AO;
        if (r < I_BI) { transpose_item(b_w_in, 1024, B_COLS, B_COLS, WBI, scr, r, lane); continue; } r -= I_BI;
        transpose_item(b_w_out, 2048, 1024, 1024, WBO, scr, r, lane);
    }
    for (int m = gw; m < M; m += NGW) rms_row_to_bf16(x + (size_t)m * DM, norm_g, H + (size_t)m * DM, lane);
}
__global__ void __launch_bounds__(512) k_norm_bf16(const float* x, const float* g, bf16* H) {
    const int lane = threadIdx.x & 63, gw = blockIdx.x * 8 + (threadIdx.x >> 6), NGW = gridDim.x * 8;
    for (int m = gw; m < M; m += NGW) rms_row_to_bf16(x + (size_t)m * DM, g, H + (size_t)m * DM, lane);
}
__global__ void __launch_bounds__(512) k_norm_f32(float* x, const float* g) {
    const int lane = threadIdx.x & 63, gw = blockIdx.x * 8 + (threadIdx.x >> 6), NGW = gridDim.x * 8;
    for (int m = gw; m < M; m += NGW) rms_row_f32(x + (size_t)m * DM, g, x + (size_t)m * DM, lane);
}

constexpr int NAIVE_DSA_LDS = 65536 + 4096 + 8192 + 1024 + 1024 + 64;
__global__ void __launch_bounds__(256) k_naive_dsa(const bf16* Q, const bf16* K, const bf16* V, const bf16* ZS, const bf16* QI, const bf16* KI, const float* WI, const float* rel_bias, bf16* OG) {
    extern __shared__ __attribute__((aligned(16))) unsigned char smem[];
    float* sc = (float*)smem;
    float* qf = sc + 16384;
    float* lg = qf + 1024;
    int* sel = (int*)(lg + 2048);
    unsigned* hist = (unsigned*)(sel + 256);
    unsigned* misc = hist + 256;
    const int tid = threadIdx.x, lane = tid & 63, wave = tid >> 6;
    const int tg = blockIdx.x, b = tg / S, t = tg % S;
    const int n = (t / 64 + 1) * 64;
    const size_t rowb = (size_t)b * S;
    { const unsigned w = ((const unsigned*)(QI + (size_t)tg * 512))[tid]; qf[2 * tid] = bflo(w); qf[2 * tid + 1] = bfhi(w); }
    float wi[8];
#pragma unroll
    for (int h = 0; h < 8; ++h) wi[h] = WI[(size_t)tg * 8 + h];
    __syncthreads();
    for (int s = tid; s < n; s += 256) {
        const v4u* kp = (const v4u*)(KI + (rowb + s) * 64);
        float kf[64];
#pragma unroll
        for (int c = 0; c < 8; ++c) { const v4u w = kp[c]; kf[8 * c] = bflo(w.x); kf[8 * c + 1] = bfhi(w.x); kf[8 * c + 2] = bflo(w.y); kf[8 * c + 3] = bfhi(w.y); kf[8 * c + 4] = bflo(w.z); kf[8 * c + 5] = bfhi(w.z); kf[8 * c + 6] = bflo(w.w); kf[8 * c + 7] = bfhi(w.w); }
        float score = 0.f;
#pragma unroll
        for (int h = 0; h < 8; ++h) { float d = 0.f;
#pragma unroll
            for (int j = 0; j < 64; ++j) d = fmaf(qf[h * 64 + j], kf[j], d);
            score = fmaf(wi[h], fmaxf(d, 0.f), score); }
        sc[s] = score;
    }
    __syncthreads();
    int count;
    if (n <= TOPK) { if (tid < n) sel[tid] = tid; count = n; }
    else {
        count = TOPK;
        unsigned prefix = 0u, need = TOPK, eq_total = 0u;
        for (int pass = 0; pass < 4; ++pass) {
            const int shift = 24 - 8 * pass; const unsigned mask = pass == 0 ? 0u : (0xFFFFFFFFu << (shift + 8));
            hist[tid] = 0u; __syncthreads();
            for (int s = tid; s < n; s += 256) { const unsigned u = __builtin_bit_cast(unsigned, sc[s]); const unsigned k = (u & 0x80000000u) ? ~u : (u | 0x80000000u);
                if ((k & mask) == (prefix & mask)) atomicAdd(&hist[(k >> shift) & 255u], 1u); }
            __syncthreads();
            if (tid == 0) { unsigned c = 0u; int bin = 255; for (; bin > 0; --bin) { if (c + hist[bin] >= need) break; c += hist[bin]; }
                misc[0] = (unsigned)bin; misc[1] = need - c; misc[2] = hist[bin]; }
            __syncthreads();
            prefix |= misc[0] << shift; need = misc[1]; eq_total = misc[2];
            __syncthreads();
        }
        if (tid == 0) misc[3] = 0u;
        __syncthreads();
        const bool take_all_eq = (eq_total == need);
        for (int s = tid; s < n; s += 256) { const unsigned u = __builtin_bit_cast(unsigned, sc[s]); const unsigned k = (u & 0x80000000u) ? ~u : (u | 0x80000000u);
            if (k > prefix || (take_all_eq && k == prefix)) { const unsigned pos = atomicAdd(&misc[3], 1u); if (pos < TOPK) sel[pos] = s; } }
        __syncthreads();
        if (!take_all_eq && tid == 0) { unsigned pos = misc[3], got = 0u;
            for (int s = 0; s < n && got < need; ++s) { const unsigned u = __builtin_bit_cast(unsigned, sc[s]); const unsigned k = (u & 0x80000000u) ? ~u : (u | 0x80000000u);
                if (k == prefix) { if (pos < TOPK) sel[pos] = s; ++pos; ++got; } } }
    }
    __syncthreads();
    { const v2u w = ((const v2u*)(Q + (size_t)tg * 1024))[tid]; qf[4 * tid] = bflo(w.x); qf[4 * tid + 1] = bfhi(w.x); qf[4 * tid + 2] = bflo(w.y); qf[4 * tid + 3] = bfhi(w.y); }
    __syncthreads();
    if (tid < count) {
        const int idx = sel[tid]; const v4u* kp = (const v4u*)(K + (rowb + idx) * 1024);
        const int bk = t5_bucket(t - idx);
#pragma unroll 1
        for (int h = 0; h < 8; ++h) { float d = 0.f;
#pragma unroll
            for (int c = 0; c < 16; ++c) { const v4u w = kp[h * 16 + c]; const float* q = qf + h * 128 + c * 8;
                d = fmaf(q[0], bflo(w.x), d); d = fmaf(q[1], bfhi(w.x), d); d = fmaf(q[2], bflo(w.y), d); d = fmaf(q[3], bfhi(w.y), d);
                d = fmaf(q[4], bflo(w.z), d); d = fmaf(q[5], bfhi(w.z), d); d = fmaf(q[6], bflo(w.w), d); d = fmaf(q[7], bfhi(w.w), d); }
            lg[h * 256 + tid] = d + rel_bias[bk * 8 + h] * LOG2E; }
    } else {
#pragma unroll
        for (int h = 0; h < 8; ++h) lg[h * 256 + tid] = -__builtin_inff();
    }
    __syncthreads();
#pragma unroll
    for (int hh = 0; hh < 2; ++hh) { float* row = lg + (wave * 2 + hh) * 256; float v[4]; float mx = -__builtin_inff();
#pragma unroll
        for (int j = 0; j < 4; ++j) { v[j] = row[lane + 64 * j]; mx = fmaxf(mx, v[j]); }
        mx = wave_max(mx); float sm = 0.f;
#pragma unroll
        for (int j = 0; j < 4; ++j) { v[j] = __builtin_amdgcn_exp2f(v[j] - mx); sm += v[j]; }
        sm = wave_sum(sm); const float inv = 1.0f / sm;
#pragma unroll
        for (int j = 0; j < 4; ++j) row[lane + 64 * j] = v[j] * inv; }
    __syncthreads();
    { float a0 = 0.f, a1 = 0.f, a2 = 0.f, a3 = 0.f; const float* prow = lg + (tid >> 5) * 256;
        for (int j = 0; j < count; ++j) { const int idx = sel[j]; const float p = prow[j]; const v2u w = ((const v2u*)(V + (rowb + idx) * 1024))[tid];
            a0 = fmaf(p, bflo(w.x), a0); a1 = fmaf(p, bfhi(w.x), a1); a2 = fmaf(p, bflo(w.y), a2); a3 = fmaf(p, bfhi(w.y), a3); }
        const v2u z = ((const v2u*)(ZS + (size_t)tg * 1024))[tid];
        v2u o; o.x = pk2(a0 * bflo(z.x), a1 * bfhi(z.x)); o.y = pk2(a2 * bflo(z.y), a3 * bfhi(z.y));
        ((v2u*)(OG + (size_t)tg * 1024))[tid] = o; }
}

__global__ void __launch_bounds__(512) k_lnstats(const bf16* Vb, float* stats) {
    const int lane = threadIdx.x & 63, gw = blockIdx.x * 8 + (threadIdx.x >> 6), NGW = gridDim.x * 8;
    for (int m = gw; m < M; m += NGW) {
        const v4u* vr = (const v4u*)(Vb + (size_t)m * BW) + lane; float f[32]; float s = 0.f;
#pragma unroll
        for (int j = 0; j < 4; ++j) { const v4u w = vr[64 * j]; f[8 * j] = bflo(w.x); f[8 * j + 1] = bfhi(w.x); f[8 * j + 2] = bflo(w.y); f[8 * j + 3] = bfhi(w.y); f[8 * j + 4] = bflo(w.z); f[8 * j + 5] = bfhi(w.z); f[8 * j + 6] = bflo(w.w); f[8 * j + 7] = bfhi(w.w); }
#pragma unroll
        for (int j = 0; j < 32; ++j) s += f[j];
        const float mean = wave_sum(s) * (1.f / BW); float q = 0.f;
#pragma unroll
        for (int j = 0; j < 32; ++j) { const float d = f[j] - mean; q += d * d; }
        const float rstd = 1.0f / sqrtf(wave_sum(q) * (1.f / BW) + LN_EPS);
        if (lane == 0) { stats[2 * m] = mean; stats[2 * m + 1] = rstd; }
    }
}
__global__ void __launch_bounds__(256) k_naive_sgu(bf16* U, const bf16* Vb, const bf16* ZS, const float* stats, const float* ln_g, const float* ln_b, const float* w_s, const float* b_s) {
    const int chunk = blockIdx.x >> 3, g = blockIdx.x & 7, e = threadIdx.x, ch = g * 256 + e;
    const size_t row0 = (size_t)chunk * 128;
    const float lg_ = ln_g[ch], lb_ = ln_b[ch];
    float vn[128];
#pragma unroll
    for (int s = 0; s < 128; ++s) { const float v = __builtin_bit_cast(float, (unsigned)Vb[(row0 + s) * BW + ch] << 16); vn[s] = (v - stats[2 * (row0 + s)]) * stats[2 * (row0 + s) + 1] * lg_ + lb_; }
    const float* wg = w_s + (size_t)g * 128 * 128;
#pragma unroll 1
    for (int t = 0; t < 128; ++t) { float acc = b_s[g * 128 + t]; const float* wr = wg + t * 128;
#pragma unroll
        for (int s = 0; s < 128; ++s) { const float w = s <= t ? wr[s] : 0.f; acc = fmaf(w, vn[s], acc); }
        const size_t o = (row0 + t) * BW + ch;
        const float u = __builtin_bit_cast(float, (unsigned)U[o] << 16), z = __builtin_bit_cast(float, (unsigned)ZS[o] << 16);
        U[o] = (bf16)f2bf(u * acc * z); }
}

constexpr int GEMM_LDS = pg8::STAGE_BYTES;
struct GArgs { const bf16* A; const bf16* Bt; int Mr, N, K, which; void* p0; void* p1; void* p2; void* p3; void* p4; void* p5; void* p6; };
template <int WHICH>
__global__ void __launch_bounds__(512, 2) k_gemm(GArgs a) {
    extern __shared__ __attribute__((aligned(16))) unsigned char lds[];
    pg8::Gemm g{a.A, a.Bt, a.Mr, a.N, a.K}; pg8::StaticOrder So; So.init(a.Mr, a.N, (int)gridDim.x, (int)blockIdx.x);
    if constexpr (WHICH == 0) { pg8::EpiA E{(bf16*)a.p0, (bf16*)a.p1, (bf16*)a.p2, (bf16*)a.p3, (bf16*)a.p4, (bf16*)a.p5, (float*)a.p6};
        pg8::gemm_phase<pg8::EpiA, pg8::StaticOrder, true, true>((PG8_LAS unsigned char*)lds, g, So, E); }
    else if constexpr (WHICH == 1) { pg8::EpiB E{(bf16*)a.p0, (size_t)((bf16*)a.p1 - (bf16*)a.p0)};
        pg8::gemm_phase<pg8::EpiB, pg8::StaticOrder, true, true>((PG8_LAS unsigned char*)lds, g, So, E); }
    else { pg8::EpiRes E{(const float*)a.p0, (float*)a.p1};
        pg8::gemm_phase<pg8::EpiRes, pg8::StaticOrder, true, true>((PG8_LAS unsigned char*)lds, g, So, E); }
}

constexpr size_t MiB = 1u << 20;
constexpr size_t WS_CTL = 0;
constexpr size_t WS_WAI = 2 * MiB, WS_WAO = 12 * MiB, WS_WBI = 14 * MiB, WS_WBO = 26 * MiB;
constexpr size_t WS_STATS = 30 * MiB;
constexpr size_t WS_H = 32 * MiB;
constexpr size_t WS_Q = 96 * MiB, WS_K = 160 * MiB, WS_V = 224 * MiB, WS_ZS = 288 * MiB;
constexpr size_t WS_QI = 352 * MiB, WS_KI = 384 * MiB, WS_WI = 388 * MiB;
constexpr size_t WS_U = 96 * MiB, WS_VB = 224 * MiB, WS_ZB = 352 * MiB;
constexpr size_t WS_END = 480 * MiB;

extern "C" void kernel_launch(void* const* d_in, const int* in_sizes, int n_in, void* d_out, int out_size, void* d_ws, size_t ws_size, hipStream_t stream) {
    static int init = 0;
    if (init == 0) {
        if (n_in != 12 || in_sizes[0] != M * DM || out_size != M * DM || ws_size < WS_END) { fprintf(stderr, "kernel_launch: unexpected shapes (n_in %d, in0 %d, out %d, ws %zu)\n", n_in, n_in > 0 ? in_sizes[0] : -1, out_size, ws_size); init = -1; return; }
        hipError_t e0 = hipFuncSetAttribute((const void*)k_gemm<0>, hipFuncAttributeMaxDynamicSharedMemorySize, GEMM_LDS);
        hipError_t e1 = hipFuncSetAttribute((const void*)k_gemm<1>, hipFuncAttributeMaxDynamicSharedMemorySize, GEMM_LDS);
        hipError_t e2 = hipFuncSetAttribute((const void*)k_gemm<2>, hipFuncAttributeMaxDynamicSharedMemorySize, GEMM_LDS);
        hipError_t e3 = hipFuncSetAttribute((const void*)k_naive_dsa, hipFuncAttributeMaxDynamicSharedMemorySize, NAIVE_DSA_LDS);
        if (e0 != hipSuccess || e1 != hipSuccess || e2 != hipSuccess || e3 != hipSuccess) { fprintf(stderr, "kernel_launch: hipFuncSetAttribute failed\n"); init = -1; return; }
        init = 1;
    }
    if (init < 0) return;
    const float* x = (const float*)d_in[0]; const float* norm_g = (const float*)d_in[1]; const float* final_g = (const float*)d_in[2]; const float* rel_bias = (const float*)d_in[3];
    const float* a_w_in = (const float*)d_in[4]; const float* a_w_out = (const float*)d_in[5]; const float* b_w_in = (const float*)d_in[6];
    const float* b_ln_g = (const float*)d_in[7]; const float* b_ln_b = (const float*)d_in[8]; const float* b_w_s = (const float*)d_in[9]; const float* b_b_s = (const float*)d_in[10]; const float* b_w_out = (const float*)d_in[11];
    unsigned char* ws = (unsigned char*)d_ws; float* out = (float*)d_out;
    bf16 *WAI = (bf16*)(ws + WS_WAI), *WAO = (bf16*)(ws + WS_WAO), *WBI = (bf16*)(ws + WS_WBI), *WBO = (bf16*)(ws + WS_WBO), *H = (bf16*)(ws + WS_H);
    bf16 *Qb = (bf16*)(ws + WS_Q), *Kb = (bf16*)(ws + WS_K), *Vb = (bf16*)(ws + WS_V), *ZS = (bf16*)(ws + WS_ZS), *QI = (bf16*)(ws + WS_QI), *KI = (bf16*)(ws + WS_KI);
    float* WI = (float*)(ws + WS_WI); float* stats = (float*)(ws + WS_STATS);
    bf16 *U = (bf16*)(ws + WS_U), *V1 = (bf16*)(ws + WS_VB), *Z1 = (bf16*)(ws + WS_ZB);
    const int G = 256;
    k_prep<<<G, 512, 0, stream>>>(x, norm_g, a_w_in, a_w_out, b_w_in, b_w_out, WAI, WAO, WBI, WBO, H);
    { GArgs a{}; a.A = H; a.Bt = WAI; a.Mr = M; a.N = A_NPAD; a.K = 1024; a.p0 = Qb; a.p1 = Kb; a.p2 = Vb; a.p3 = ZS; a.p4 = QI; a.p5 = KI; a.p6 = WI;
      k_gemm<0><<<G, 512, GEMM_LDS, stream>>>(a); }
    k_naive_dsa<<<M, 256, NAIVE_DSA_LDS, stream>>>(Qb, Kb, Vb, ZS, QI, KI, WI, rel_bias, Qb);
    { GArgs a{}; a.A = Qb; a.Bt = WAO; a.Mr = M; a.N = 1024; a.K = 1024; a.p0 = (void*)x; a.p1 = out;
      k_gemm<2><<<G, 512, GEMM_LDS, stream>>>(a); }
    k_norm_bf16<<<G, 512, 0, stream>>>(out, norm_g + DM, H);
    { GArgs a{}; a.A = H; a.Bt = WBI; a.Mr = M; a.N = B_COLS; a.K = 1024; a.p0 = U; a.p1 = V1; a.p2 = Z1;
      k_gemm<1><<<G, 512, GEMM_LDS, stream>>>(a); }
    k_lnstats<<<G, 512, 0, stream>>>(V1, stats);
    k_naive_sgu<<<(M / 128) * 8, 256, 0, stream>>>(U, V1, Z1, stats, b_ln_g, b_ln_b, b_w_s, b_b_s);
    { GArgs a{}; a.A = U; a.Bt = WBO; a.Mr = M; a.N = 1024; a.K = 2048; a.p0 = out; a.p1 = out;
      k_gemm<2><<<G, 512, GEMM_LDS, stream>>>(a); }
    k_norm_f32<<<G, 512, 0, stream>>>(out, final_g);
}
```

```cpp
#include <hip/hip_runtime.h>
#include <cstdio>
#include <cstdint>

constexpr int NB = 2, S = 16384, DM = 1024, M = NB * S;
constexpr int A_COLS = 4680, A_NPAD = 4864;
constexpr int BW = 2048, B_COLS = 3 * BW;
constexpr float RMS_EPS = 1e-6f, LN_EPS = 1e-5f;
constexpr float LOG2E = 1.4426950408889634f;
constexpr float QSCALE = 0.08838834764831845f * LOG2E;
constexpr float WI_SCALE = 0.35355339059327373f;
constexpr float QI_SCALE = 0.125f;
constexpr int TOPK = 256;

namespace pg8 {
#define PG8_LAS __attribute__((address_space(3)))
typedef unsigned short bf16_t;
typedef short bf16x8 __attribute__((ext_vector_type(8)));
typedef float f32x4 __attribute__((ext_vector_type(4)));
typedef unsigned u32x4 __attribute__((ext_vector_type(4)));
constexpr int BM = 256, BK = 64, HALF = 128, HTB = HALF * BK * 2  , STAGE_BYTES = 8 * HTB, NXCD = 8, WGM = 8;

__host__ __device__ __forceinline__ int lds_byte(int r, int c) { const int st = (r >> 4) * 2 + (c >> 5), rr = r & 15, cc = c & 31, ob = rr * 64 + cc * 2; return st * 1024 + (ob ^ (((ob >> 9) & 1) << 5)); }
__host__ __device__ __forceinline__ void stage_rc(int b, int& R, int& C) { const int st = b / 1024, sb = b % 1024, swz = sb ^ (((sb >> 9) & 1) << 5); R = (st >> 1) * 16 + swz / 64; C = (st & 1) * 32 + (swz % 64) / 2; }
__host__ __device__ __forceinline__ int perm32(int rho) { const int n = rho >> 4, i = rho & 15; return 8 * (i >> 2) + 4 * n + (i & 3); }

struct Unit { int pm, pn; };
struct Gemm { const bf16_t* A; const bf16_t* Bt; int M, N, K; };

struct StaticOrder {
    int nM, nN, nwg, G, c;
    __host__ __device__ void init(int M, int N, int G_, int c_) { nM = M / BM; nN = N / BM; nwg = nM * nN; G = G_; c = c_; }
    __host__ __device__ bool next(int i, Unit& u) const {
        const long L = (long)i * G + c; if (L >= nwg) return false;
        int wgid = (int)L; { const int q = nwg / NXCD, r = nwg % NXCD, xcd = wgid % NXCD, off = wgid / NXCD; wgid = (xcd < r ? xcd * (q + 1) : r * (q + 1) + (xcd - r) * q) + off; }
        const int nig = WGM * nN, gid = wgid / nig, fm = gid * WGM, gsz = (nM - fm) < WGM ? (nM - fm) : WGM;
        u.pm = fm + ((wgid % nig) % gsz); u.pn = (wgid % nig) / gsz; return true;
    }
    __device__ __forceinline__ void a_ready(const Unit&) const {}
    __device__ __forceinline__ void done(const Unit&) const {}
};

__device__ __forceinline__ unsigned cvt_pk_bf16(float lo, float hi) { unsigned r; asm volatile("v_cvt_pk_bf16_f32 %0, %1, %2" : "=v"(r) : "v"(lo), "v"(hi)); return r; }
typedef float f32x2 __attribute__((ext_vector_type(2)));
__device__ __forceinline__ float silu_f(float z) { return z * __builtin_amdgcn_rcpf(1.0f + __builtin_amdgcn_exp2f(-z * 1.4426950408889634f)); }

struct EpiA {
    static constexpr bool PERM = true, AFTER_DRAIN = false;
    bf16_t *Q, *K, *V, *ZS, *QI, *KI; float* WI; const float* RS;
    __device__ __forceinline__ void operator()(const f32x4 (&acc)[2][2][4][2], const Unit& u, int wr, int wc, int fr, int fq) const {
        const int pn = u.pn, row0 = u.pm * BM + wr * 64 + fr;
        if (pn < 18) {
            bf16_t* base; int ldc, colt; float sc = 1.f; bool act = false;
            if (pn < 4) { base = Q; ldc = 1024; colt = pn * 256; sc = 0.08838834764831845f * 1.4426950408889634f; }
            else if (pn < 8) { base = K; ldc = 1024; colt = (pn - 4) * 256; }
            else if (pn < 12) { base = V; ldc = 1024; colt = (pn - 8) * 256; }
            else if (pn < 16) { base = ZS; ldc = 1024; colt = (pn - 12) * 256; act = true; }
            else { base = QI; ldc = 512; colt = (pn - 16) * 256; sc = 0.125f; }
            const int col0 = colt + wc * 32 + 8 * fq;
#pragma unroll
            for (int ai = 0; ai < 2; ++ai)
#pragma unroll
                for (int m = 0; m < 4; ++m) { bf16_t* rowp = base + (size_t)(row0 + ai * HALF + m * 16) * ldc + col0; const float rs = RS[row0 + ai * HALF + m * 16] * sc;
#pragma unroll
                    for (int bj = 0; bj < 2; ++bj) { f32x4 v0 = acc[ai][bj][m][0] * rs, v1 = acc[ai][bj][m][1] * rs;
                        if (act) { v0 = (f32x4){silu_f(v0[0]), silu_f(v0[1]), silu_f(v0[2]), silu_f(v0[3])}; v1 = (f32x4){silu_f(v1[0]), silu_f(v1[1]), silu_f(v1[2]), silu_f(v1[3])}; }
                        u32x4 w; w.x = cvt_pk_bf16(v0[0], v0[1]); w.y = cvt_pk_bf16(v0[2], v0[3]); w.z = cvt_pk_bf16(v1[0], v1[1]); w.w = cvt_pk_bf16(v1[2], v1[3]);
                        *(u32x4*)(rowp + bj * HALF) = w; } }
        } else {
#pragma unroll
            for (int ai = 0; ai < 2; ++ai)
#pragma unroll
                for (int m = 0; m < 4; ++m) { const size_t row = (size_t)(row0 + ai * HALF + m * 16);
                    const float rs = RS[row]; const f32x4 v0 = acc[ai][0][m][0] * rs, v1 = acc[ai][0][m][1] * rs;
                    if (wc < 2) { u32x4 w; w.x = cvt_pk_bf16(v0[0], v0[1]); w.y = cvt_pk_bf16(v0[2], v0[3]); w.z = cvt_pk_bf16(v1[0], v1[1]); w.w = cvt_pk_bf16(v1[2], v1[3]);
                        *(u32x4*)(KI + row * 64 + wc * 32 + 8 * fq) = w; }
                    else if (wc == 2 && fq == 0) { const float s = 0.35355339059327373f; *(f32x4*)(WI + row * 8) = v0 * s; *(f32x4*)(WI + row * 8 + 4) = v1 * s; } }
        }
    }
};

struct EpiB {
    static constexpr bool PERM = true, AFTER_DRAIN = false;
    bf16_t* Gt; bf16_t* Vt;
    const float* PS;
    float* LNP;
    __device__ __forceinline__ float rowscale(const float* psrow) const {
        const f32x4* pp = (const f32x4*)psrow; const f32x4 q0 = pp[0], q1 = pp[1], q2 = pp[2], q3 = pp[3];
        const float ss = ((q0[0] + q0[1]) + (q0[2] + q0[3])) + ((q1[0] + q1[1]) + (q1[2] + q1[3])) + ((q2[0] + q2[1]) + (q2[2] + q2[3])) + ((q3[0] + q3[1]) + (q3[2] + q3[3]));
        return 1.0f / sqrtf(ss * (1.f / 1024.f) + 1e-6f); }
    __device__ __forceinline__ void operator()(const f32x4 (&acc)[2][2][4][2], const Unit& u, int wr, int wc, int fr, int fq) const {
        const int pn = u.pn, row0 = u.pm * BM + wr * 64 + fr;
        const float* psrow = PS + (size_t)row0 * 16;
        if (pn < 16) {
            bf16_t* p = Gt + (size_t)row0 * 2048 + pn * 128 + wc * 32 + 8 * fq;
#pragma unroll
            for (int ai = 0; ai < 2; ++ai)
#pragma unroll
                for (int m = 0; m < 4; ++m) { const float rs = rowscale(psrow + (size_t)(ai * HALF + m * 16) * 16);
                    const f32x4 u0 = acc[ai][0][m][0] * rs, u1 = acc[ai][0][m][1] * rs, z0 = acc[ai][1][m][0] * rs, z1 = acc[ai][1][m][1] * rs;
                    u32x4 w; w.x = cvt_pk_bf16(u0[0] * silu_f(z0[0]), u0[1] * silu_f(z0[1])); w.y = cvt_pk_bf16(u0[2] * silu_f(z0[2]), u0[3] * silu_f(z0[3]));
                    w.z = cvt_pk_bf16(u1[0] * silu_f(z1[0]), u1[1] * silu_f(z1[1])); w.w = cvt_pk_bf16(u1[2] * silu_f(z1[2]), u1[3] * silu_f(z1[3]));
                    *(u32x4*)(p + (size_t)(ai * HALF + m * 16) * 2048) = w; }
        } else {
            const int tv = pn - 16; bf16_t* p = Vt + (size_t)row0 * 2048 + tv * 256 + wc * 32 + 8 * fq;
#pragma unroll
            for (int ai = 0; ai < 2; ++ai)
#pragma unroll
                for (int m = 0; m < 4; ++m) { const int ro = ai * HALF + m * 16; const float rs = rowscale(psrow + (size_t)ro * 16); float s1 = 0.f, s2 = 0.f;
#pragma unroll
                    for (int bj = 0; bj < 2; ++bj) { const f32x4 v0 = acc[ai][bj][m][0] * rs, v1 = acc[ai][bj][m][1] * rs;
                        s1 += ((v0[0] + v0[1]) + (v0[2] + v0[3])) + ((v1[0] + v1[1]) + (v1[2] + v1[3]));
                        s2 += ((v0[0] * v0[0] + v0[1] * v0[1]) + (v0[2] * v0[2] + v0[3] * v0[3])) + ((v1[0] * v1[0] + v1[1] * v1[1]) + (v1[2] * v1[2] + v1[3] * v1[3]));
                        u32x4 w; w.x = cvt_pk_bf16(v0[0], v0[1]); w.y = cvt_pk_bf16(v0[2], v0[3]); w.z = cvt_pk_bf16(v1[0], v1[1]); w.w = cvt_pk_bf16(v1[2], v1[3]);
                        *(u32x4*)(p + (size_t)ro * 2048 + bj * HALF) = w; }
                    s1 += __shfl_xor(s1, 16); s1 += __shfl_xor(s1, 32); s2 += __shfl_xor(s2, 16); s2 += __shfl_xor(s2, 32);
                    if (fq == 0) { typedef float f32x2_ __attribute__((ext_vector_type(2))); *(f32x2_*)(LNP + ((size_t)(row0 + ro) * 32 + tv * 4 + wc) * 2) = (f32x2_){s1, s2}; } }
        }
    }
};

struct EpiRes2 {
    static constexpr bool PERM = true, AFTER_DRAIN = false;
    bf16_t* XB;
    __device__ __forceinline__ void operator()(const f32x4 (&acc)[2][2][4][2], const Unit& u, int wr, int wc, int fr, int fq) const {
        const int row0 = u.pm * BM + wr * 64 + fr, col0 = u.pn * BM + wc * 32 + 8 * fq;
#pragma unroll
        for (int ai = 0; ai < 2; ++ai) { u32x4 bb[4][2];
#pragma unroll
            for (int m = 0; m < 4; ++m)
#pragma unroll
                for (int bj = 0; bj < 2; ++bj) bb[m][bj] = *(const u32x4*)(XB + (size_t)(row0 + ai * HALF + m * 16) * 1024 + col0 + bj * HALF);
#pragma unroll
            for (int m = 0; m < 4; ++m)
#pragma unroll
                for (int bj = 0; bj < 2; ++bj) { const u32x4 b = bb[m][bj]; const f32x4 a0 = acc[ai][bj][m][0], a1 = acc[ai][bj][m][1]; u32x4 w;
                    w.x = cvt_pk_bf16(__uint_as_float(b.x << 16) + a0[0], __uint_as_float(b.x & 0xffff0000u) + a0[1]);
                    w.y = cvt_pk_bf16(__uint_as_float(b.y << 16) + a0[2], __uint_as_float(b.y & 0xffff0000u) + a0[3]);
                    w.z = cvt_pk_bf16(__uint_as_float(b.z << 16) + a1[0], __uint_as_float(b.z & 0xffff0000u) + a1[1]);
                    w.w = cvt_pk_bf16(__uint_as_float(b.w << 16) + a1[2], __uint_as_float(b.w & 0xffff0000u) + a1[3]);
                    *(u32x4*)(XB + (size_t)(row0 + ai * HALF + m * 16) * 1024 + col0 + bj * HALF) = w; } }
    }
};

struct EpiRes1 {
    static constexpr bool PERM = true, AFTER_DRAIN = false;
    bf16_t* XB; float* PS;
    __device__ __forceinline__ void operator()(const f32x4 (&acc)[2][2][4][2], const Unit& u, int wr, int wc, int fr, int fq) const {
        const int row0 = u.pm * BM + wr * 64 + fr, col0 = u.pn * BM + wc * 32 + 8 * fq;
#pragma unroll
        for (int ai = 0; ai < 2; ++ai) { u32x4 bb[4][2];
#pragma unroll
            for (int m = 0; m < 4; ++m)
#pragma unroll
                for (int bj = 0; bj < 2; ++bj) bb[m][bj] = *(const u32x4*)(XB + (size_t)(row0 + ai * HALF + m * 16) * 1024 + col0 + bj * HALF);
#pragma unroll
            for (int m = 0; m < 4; ++m) { const size_t row = (size_t)(row0 + ai * HALF + m * 16); float ss = 0.f;
#pragma unroll
                for (int bj = 0; bj < 2; ++bj) { const u32x4 b = bb[m][bj]; const f32x4 a0 = acc[ai][bj][m][0], a1 = acc[ai][bj][m][1];
                    const f32x4 v0 = {__uint_as_float(b.x << 16) + a0[0], __uint_as_float(b.x & 0xffff0000u) + a0[1], __uint_as_float(b.y << 16) + a0[2], __uint_as_float(b.y & 0xffff0000u) + a0[3]};
                    const f32x4 v1 = {__uint_as_float(b.z << 16) + a1[0], __uint_as_float(b.z & 0xffff0000u) + a1[1], __uint_as_float(b.w << 16) + a1[2], __uint_as_float(b.w & 0xffff0000u) + a1[3]};
                    ss += ((v0[0] * v0[0] + v0[1] * v0[1]) + (v0[2] * v0[2] + v0[3] * v0[3])) + ((v1[0] * v1[0] + v1[1] * v1[1]) + (v1[2] * v1[2] + v1[3] * v1[3]));
                    u32x4 w; w.x = cvt_pk_bf16(v0[0], v0[1]); w.y = cvt_pk_bf16(v0[2], v0[3]); w.z = cvt_pk_bf16(v1[0], v1[1]); w.w = cvt_pk_bf16(v1[2], v1[3]);
                    *(u32x4*)(XB + row * 1024 + col0 + bj * HALF) = w; }
                ss += __shfl_xor(ss, 16); ss += __shfl_xor(ss, 32);
                if (fq == 0) PS[row * 16 + u.pn * 4 + wc] = ss; } }
    }
};

template <class Epi, class Sched, bool ALIGN_EPI = false, bool SP2 = false>
__device__ __forceinline__ void gemm_phase(PG8_LAS unsigned char* lds, const Gemm g, const Sched& S, const Epi& E) {
    const int tid = threadIdx.x, wid = __builtin_amdgcn_readfirstlane(tid >> 6), lane = tid & 63, wr = wid >> 2, wc = wid & 3, fr = lane & 15, fq = lane >> 4;
    const int K = g.K, nt = K / BK;
    unsigned voffA[2], voffB[2];
#pragma unroll
    for (int i = 0; i < 2; ++i) { int R, C; stage_rc(tid * 16 + i * 8192, R, C); const int Rb = Epi::PERM ? ((R & ~31) + perm32(R & 31)) : R;
        voffA[i] = (unsigned)(R * K + C) * 2u; voffB[i] = (unsigned)(Rb * K + C) * 2u; }
    const size_t kstep = (size_t)(BK * 2);
    const size_t hstep = (size_t)HALF * K * 2;
    const size_t tstep = 2 * hstep;
    const unsigned ldsw = (unsigned)wid * 1024u;
    const int aoff = lds_byte(wr * 64 + fr, fq * 8), boff = lds_byte(wc * 32 + fr, fq * 8);
#define PG8_SA(b, h) (((b) * 2 + (h)) * HTB)
#define PG8_SB(b, h) ((4 + (b) * 2 + (h)) * HTB)
#define PG8_STAGE(bufoff, gbase, voff) do { _Pragma("unroll") for (int _i = 0; _i < 2; ++_i) \
        __builtin_amdgcn_global_load_lds((const unsigned*)((const char*)(gbase) + (voff)[_i]), (PG8_LAS unsigned*)(lds + (bufoff) + ldsw + _i * 8192), 16, 0, 0); } while (0)
#define PG8_LDA(dst, b, h) do { _Pragma("unroll") for (int m = 0; m < 4; ++m) _Pragma("unroll") for (int k = 0; k < 2; ++k) dst[m][k] = *(const PG8_LAS bf16x8*)(lds + PG8_SA(b, h) + aoff + m * 2048 + k * 1024); } while (0)
#define PG8_LDB(dst, b, h) do { _Pragma("unroll") for (int n = 0; n < 2; ++n) _Pragma("unroll") for (int k = 0; k < 2; ++k) dst[n][k] = *(const PG8_LAS bf16x8*)(lds + PG8_SB(b, h) + boff + n * 2048 + k * 1024); } while (0)
#define PG8_MMA(ai, bj, At, Bt) do { __builtin_amdgcn_s_setprio(1); _Pragma("unroll") for (int m = 0; m < 4; ++m) _Pragma("unroll") for (int n = 0; n < 2; ++n) _Pragma("unroll") for (int k = 0; k < 2; ++k) \
        acc[ai][bj][m][n] = __builtin_amdgcn_mfma_f32_16x16x32_bf16(Bt[n][k], At[m][k], acc[ai][bj][m][n], 0, 0, 0); __builtin_amdgcn_s_setprio(0); } while (0)
#define PG8_WAIT_V(n) asm volatile("s_waitcnt vmcnt(" #n ")" ::: "memory")
#define PG8_WAIT_L(n) asm volatile("s_waitcnt lgkmcnt(" #n ")" ::: "memory")
#define PG8_BAR __builtin_amdgcn_s_barrier()
#define PG8_SCHED __builtin_amdgcn_sched_barrier(0)
    Unit cur, nxt; int ui = 0;
    if (!S.next(0, cur)) return;
    f32x4 acc[2][2][4][2];
#pragma unroll
    for (int a = 0; a < 2; ++a)
#pragma unroll
        for (int b = 0; b < 2; ++b)
#pragma unroll
            for (int m = 0; m < 4; ++m)
#pragma unroll
                for (int n = 0; n < 2; ++n) acc[a][b][m][n] = (f32x4){0.f, 0.f, 0.f, 0.f};
    bf16x8 At[4][2], B0[2][2], B1[2][2];
    const char* cA = (const char*)g.A + (size_t)cur.pm * tstep; const char* cB = (const char*)g.Bt + (size_t)cur.pn * tstep;
    S.a_ready(cur);
    if constexpr (SP2) {
        PG8_STAGE(PG8_SB(0, 0), cB, voffB); PG8_STAGE(PG8_SB(0, 1), cB + hstep, voffB); PG8_STAGE(PG8_SA(0, 0), cA, voffA); PG8_STAGE(PG8_SA(0, 1), cA + hstep, voffA);
        if (wr == 1) PG8_BAR;
        PG8_WAIT_V(2); PG8_BAR;
        PG8_STAGE(PG8_SB(1, 0), cB + kstep, voffB); PG8_STAGE(PG8_SA(1, 0), cA + kstep, voffA); PG8_STAGE(PG8_SB(1, 1), cB + hstep + kstep, voffB);
        PG8_WAIT_V(6); PG8_BAR;
    } else {
        PG8_STAGE(PG8_SB(0, 0), cB, voffB); PG8_STAGE(PG8_SA(0, 0), cA, voffA); PG8_STAGE(PG8_SB(0, 1), cB + hstep, voffB); PG8_STAGE(PG8_SA(0, 1), cA + hstep, voffA);
        if (wr == 1) PG8_BAR;
        PG8_WAIT_V(4); PG8_BAR;
        PG8_STAGE(PG8_SB(1, 0), cB + kstep, voffB); PG8_STAGE(PG8_SA(1, 0), cA + kstep, voffA); PG8_STAGE(PG8_SB(1, 1), cB + hstep + kstep, voffB);
        PG8_WAIT_V(6); PG8_BAR;
    }
    for (;;) {
        const bool has_next = S.next(ui + 1, nxt);
        const char* nA = has_next ? (const char*)g.A + (size_t)nxt.pm * tstep : cA; const char* nB = has_next ? (const char*)g.Bt + (size_t)nxt.pn * tstep : cB;
        for (int t = 0; t < nt; t += 2) {
            const bool last = (t == nt - 2);
            const char* a1 = cA + (size_t)(t + 1) * kstep;
            const char* a2 = last ? nA : cA + (size_t)(t + 2) * kstep; const char* b2 = last ? nB : cB + (size_t)(t + 2) * kstep;
            const char* a3 = a2 + kstep; const char* b3 = b2 + kstep;
            if (last && has_next) S.a_ready(nxt);
            if constexpr (SP2) {
            PG8_LDB(B0, 0, 0); PG8_LDB(B1, 0, 1); PG8_SCHED; PG8_LDA(At, 0, 0); PG8_STAGE(PG8_SA(1, 1), a1 + hstep, voffA);
            PG8_WAIT_V(8); PG8_WAIT_L(0); PG8_BAR; PG8_MMA(0, 0, At, B0); PG8_MMA(0, 1, At, B1); PG8_BAR; PG8_SCHED;
            PG8_LDA(At, 0, 1); PG8_STAGE(PG8_SB(0, 0), b2, voffB); PG8_STAGE(PG8_SB(0, 1), b2 + hstep, voffB); PG8_STAGE(PG8_SA(0, 0), a2, voffA);
            PG8_WAIT_V(8); PG8_WAIT_L(0); PG8_BAR; PG8_MMA(1, 0, At, B0); PG8_MMA(1, 1, At, B1); PG8_BAR; PG8_SCHED;
            PG8_LDB(B0, 1, 0); PG8_LDB(B1, 1, 1); PG8_SCHED; PG8_LDA(At, 1, 0); PG8_STAGE(PG8_SA(0, 1), a2 + hstep, voffA);
            PG8_WAIT_V(8); PG8_WAIT_L(0); PG8_BAR; PG8_MMA(0, 0, At, B0); PG8_MMA(0, 1, At, B1); PG8_BAR; PG8_SCHED;
            PG8_LDA(At, 1, 1); PG8_STAGE(PG8_SB(1, 0), b3, voffB); PG8_STAGE(PG8_SB(1, 1), b3 + hstep, voffB); PG8_STAGE(PG8_SA(1, 0), a3, voffA);
            PG8_WAIT_V(8); PG8_WAIT_L(0); PG8_BAR; PG8_MMA(1, 0, At, B0); PG8_MMA(1, 1, At, B1); PG8_BAR; PG8_SCHED;
            } else {
            PG8_LDB(B0, 0, 0); PG8_SCHED; PG8_LDA(At, 0, 0); PG8_STAGE(PG8_SA(1, 1), a1 + hstep, voffA);
            PG8_WAIT_L(8); PG8_BAR; PG8_WAIT_L(0); PG8_MMA(0, 0, At, B0); PG8_BAR; PG8_SCHED;
            PG8_LDB(B1, 0, 1); PG8_STAGE(PG8_SB(0, 0), b2, voffB);
            PG8_BAR; PG8_WAIT_L(0); PG8_MMA(0, 1, At, B1); PG8_BAR;
            PG8_LDA(At, 0, 1); PG8_STAGE(PG8_SA(0, 0), a2, voffA);
            PG8_BAR; PG8_WAIT_L(0); PG8_MMA(1, 0, At, B0); PG8_BAR; PG8_SCHED;
            PG8_STAGE(PG8_SB(0, 1), b2 + hstep, voffB);
            PG8_WAIT_V(6); PG8_BAR; PG8_MMA(1, 1, At, B1); PG8_BAR;
            PG8_LDB(B0, 1, 0); PG8_SCHED; PG8_LDA(At, 1, 0); PG8_STAGE(PG8_SA(0, 1), a2 + hstep, voffA);
            PG8_WAIT_L(8); PG8_BAR; PG8_WAIT_L(0); PG8_MMA(0, 0, At, B0); PG8_BAR; PG8_SCHED;
            PG8_LDB(B1, 1, 1); PG8_STAGE(PG8_SB(1, 0), b3, voffB);
            PG8_BAR; PG8_WAIT_L(0); PG8_MMA(0, 1, At, B1); PG8_BAR;
            PG8_LDA(At, 1, 1); PG8_STAGE(PG8_SA(1, 0), a3, voffA);
            PG8_BAR; PG8_WAIT_L(0); PG8_MMA(1, 0, At, B0); PG8_BAR; PG8_SCHED;
            PG8_STAGE(PG8_SB(1, 1), b3 + hstep, voffB);
            PG8_WAIT_V(6); PG8_BAR; PG8_MMA(1, 1, At, B1); PG8_BAR;
            }
        }
        if constexpr (ALIGN_EPI) { if (wr == 0) PG8_BAR; }
        if constexpr (!Epi::AFTER_DRAIN) { E(acc, cur, wr, wc, fr, fq); S.done(cur); }
        if (!has_next) break;
#pragma unroll
        for (int a = 0; a < 2; ++a)
#pragma unroll
            for (int b = 0; b < 2; ++b)
#pragma unroll
                for (int m = 0; m < 4; ++m)
#pragma unroll
                    for (int n = 0; n < 2; ++n) acc[a][b][m][n] = (f32x4){0.f, 0.f, 0.f, 0.f};
        cur = nxt; cA = nA; cB = nB; ++ui;
        if constexpr (ALIGN_EPI) { if (wr == 1) PG8_BAR; }
    }
    PG8_WAIT_V(0);
    if constexpr (!ALIGN_EPI) { if (wr == 0) PG8_BAR; }
    PG8_BAR;
    if constexpr (Epi::AFTER_DRAIN) { E.fused(acc, cur, wr, wc, fr, fq, lds, wid, lane); S.done(cur); }
#undef PG8_SA
#undef PG8_SB
#undef PG8_STAGE
#undef PG8_LDA
#undef PG8_LDB
#undef PG8_MMA
#undef PG8_WAIT_V
#undef PG8_WAIT_L
#undef PG8_BAR
#undef PG8_SCHED
}
}
#define LAS __attribute__((address_space(3)))
typedef unsigned short bf16;
typedef float f32x4 __attribute__((ext_vector_type(4)));
typedef unsigned v4u __attribute__((ext_vector_type(4)));
typedef unsigned v2u __attribute__((ext_vector_type(2)));
__device__ __forceinline__ unsigned f2bf(float f) { unsigned u = __builtin_bit_cast(unsigned, f); return (u + 0x7fffu + ((u >> 16) & 1u)) >> 16; }
__device__ __forceinline__ unsigned pk2(float lo, float hi) { return f2bf(lo) | (f2bf(hi) << 16); }
__device__ __forceinline__ float bflo(unsigned w) { return __builtin_bit_cast(float, w << 16); }
__device__ __forceinline__ float bfhi(unsigned w) { return __builtin_bit_cast(float, w & 0xffff0000u); }
__device__ __forceinline__ float wave_sum(float v) {
#pragma unroll
    for (int o = 1; o < 64; o <<= 1) v += __shfl_xor(v, o);
    return v;
}
__device__ __forceinline__ float wave_max(float v) {
#pragma unroll
    for (int o = 1; o < 64; o <<= 1) v = fmaxf(v, __shfl_xor(v, o));
    return v;
}
__device__ __forceinline__ int t5_bucket(int rel) {
    const int ret = rel < 0 ? 16 : 0; const int n = rel < 0 ? -rel : rel;
    int v;
    if (n < 8) v = n; else if (n < 12) v = 8; else if (n < 16) v = 9; else if (n < 23) v = 10; else if (n < 32) v = 11; else if (n < 46) v = 12; else if (n < 64) v = 13; else if (n < 91) v = 14; else v = 15;
    return ret + v;
}

__device__ __forceinline__ void transpose_item(const float* W, int K, int N, int Npad, bf16* WT, LAS float* scr, int item, int lane, const float* gk = nullptr  , bool uzv = false  ) {
    const int nblk = Npad / 32, kb = item / nblk, nb = item % nblk, k0 = 64 * kb, n0 = 32 * nb;
    const int nn = n0 + (lane & 31);
    const int d0 = !uzv ? n0 : n0 < 2048 ? 256 * (n0 >> 7) + (n0 & 127) : n0 < 4096 ? n0 + 2048 : 256 * ((n0 - 4096) >> 7) + 128 + (n0 & 127);
#pragma unroll 8
    for (int i = 0; i < 32; ++i) { const int kk = 2 * i + (lane >> 5); scr[kk * 33 + (lane & 31)] = nn < N ? W[(size_t)(k0 + kk) * N + nn] * (gk ? gk[k0 + kk] : 1.f) : 0.f; }
    asm volatile("s_waitcnt lgkmcnt(0)" ::: "memory");
    const int c = lane & 7;
#pragma unroll
    for (int j = 0; j < 4; ++j) { const int n = (lane >> 3) + 8 * j; const LAS float* s = scr + (8 * c) * 33 + n;
        v4u o; o.x = pk2(s[0 * 33], s[1 * 33]); o.y = pk2(s[2 * 33], s[3 * 33]); o.z = pk2(s[4 * 33], s[5 * 33]); o.w = pk2(s[6 * 33], s[7 * 33]);
        *(v4u*)(WT + (size_t)(d0 + n) * K + k0 + 8 * c) = o; }
    asm volatile("s_waitcnt lgkmcnt(0)" ::: "memory");
}
__device__ __forceinline__ void rms_row_to_bf16(const float* xrow, const float* g, bf16* orow, int lane) {
    const f32x4* xr = (const f32x4*)xrow + lane; const f32x4* gr = (const f32x4*)g + lane;
    f32x4 v[4]; float s = 0.f;
#pragma unroll
    for (int j = 0; j < 4; ++j) { v[j] = xr[64 * j]; s += (v[j].x * v[j].x + v[j].y * v[j].y) + (v[j].z * v[j].z + v[j].w * v[j].w); }
    const float rs = 1.0f / sqrtf(wave_sum(s) * (1.f / 1024.f) + RMS_EPS);
    v2u* o8 = (v2u*)orow + lane;
#pragma unroll
    for (int j = 0; j < 4; ++j) { const f32x4 gg = gr[64 * j]; v2u o; o.x = pk2(v[j].x * rs * gg.x, v[j].y * rs * gg.y); o.y = pk2(v[j].z * rs * gg.z, v[j].w * rs * gg.w); o8[64 * j] = o; }
}
__device__ __forceinline__ void rms_row_f32(const float* xrow, const float* g, float* orow, int lane) {
    const f32x4* xr = (const f32x4*)xrow + lane; const f32x4* gr = (const f32x4*)g + lane;
    f32x4 v[4]; float s = 0.f;
#pragma unroll
    for (int j = 0; j < 4; ++j) { v[j] = xr[64 * j]; s += (v[j].x * v[j].x + v[j].y * v[j].y) + (v[j].z * v[j].z + v[j].w * v[j].w); }
    const float rs = 1.0f / sqrtf(wave_sum(s) * (1.f / 1024.f) + RMS_EPS);
    f32x4* o = (f32x4*)orow + lane;
#pragma unroll
    for (int j = 0; j < 4; ++j) { const f32x4 gg = gr[64 * j]; o[64 * j] = v[j] * rs * gg; }
}


__device__ __forceinline__ void rms_row_bf16_to_f32(const bf16* xrow, const float* g, float* orow, int lane) {
    typedef unsigned u32x4_ __attribute__((ext_vector_type(4)));
    float v[2][8]; float s = 0.f;
#pragma unroll
    for (int j = 0; j < 2; ++j) { const u32x4_ b = *((const u32x4_*)xrow + 64 * j + lane);
        v[j][0] = __uint_as_float(b.x << 16); v[j][1] = __uint_as_float(b.x & 0xffff0000u); v[j][2] = __uint_as_float(b.y << 16); v[j][3] = __uint_as_float(b.y & 0xffff0000u);
        v[j][4] = __uint_as_float(b.z << 16); v[j][5] = __uint_as_float(b.z & 0xffff0000u); v[j][6] = __uint_as_float(b.w << 16); v[j][7] = __uint_as_float(b.w & 0xffff0000u);
#pragma unroll
        for (int e = 0; e < 8; ++e) s += v[j][e] * v[j][e]; }
    const float rs = 1.0f / sqrtf(wave_sum(s) * (1.f / 1024.f) + RMS_EPS);
#pragma unroll
    for (int j = 0; j < 2; ++j) { const f32x4* gr = (const f32x4*)g + 128 * j + 2 * lane; f32x4* o = (f32x4*)orow + 128 * j + 2 * lane; const f32x4 g0 = gr[0], g1 = gr[1];
        o[0] = (f32x4){v[j][0] * rs * g0.x, v[j][1] * rs * g0.y, v[j][2] * rs * g0.z, v[j][3] * rs * g0.w};
        o[1] = (f32x4){v[j][4] * rs * g1.x, v[j][5] * rs * g1.y, v[j][6] * rs * g1.z, v[j][7] * rs * g1.w}; }
}

__device__ __forceinline__ void row_to_bf16_rs(const float* xrow, bf16* orow, float* rs_out, int lane) {
    const f32x4* xr = (const f32x4*)xrow + lane;
    f32x4 v[4]; float s = 0.f;
#pragma unroll
    for (int j = 0; j < 4; ++j) { v[j] = xr[64 * j]; s += (v[j].x * v[j].x + v[j].y * v[j].y) + (v[j].z * v[j].z + v[j].w * v[j].w); }
    v2u* o8 = (v2u*)orow + lane;
#pragma unroll
    for (int j = 0; j < 4; ++j) { v2u o; o.x = pk2(v[j].x, v[j].y); o.y = pk2(v[j].z, v[j].w); o8[64 * j] = o; }
    const float rs = 1.0f / sqrtf(wave_sum(s) * (1.f / 1024.f) + RMS_EPS);
    if (lane == 0) *rs_out = rs;
}
namespace idx {
typedef unsigned short bf16;
typedef short bf16x8 __attribute__((ext_vector_type(8)));
typedef float f32x16 __attribute__((ext_vector_type(16)));
typedef unsigned long long u64;
constexpr int NBINS = 256, HSTR = 257, CAP = 512, FCAP = 2048;
constexpr int OFF_HIST = 0;
constexpr int OFF_STAT = 64 * 513 * 4 + 128;
constexpr int OFF_QPAR = OFF_STAT + 2048;
constexpr int OFF_BSTAR = OFF_QPAR + 512, OFF_NEED = OFF_BSTAR + 256, OFF_BCNT = OFF_NEED + 256;
constexpr int OFF_FB = OFF_BCNT + 256;
constexpr int OFF_FBH = OFF_FB + 512;
constexpr int OFF_QF = OFF_FBH + 1024 + 64;
constexpr int OFF_WV = OFF_QF + 2048;
constexpr int OFF_FLAT = OFF_WV + 2048;
constexpr int IDX_LDS_BYTES = OFF_FLAT + 2 * FCAP * 4;
#ifndef IDX_REPS
#define IDX_REPS 1
#endif
#ifndef DBG_FORCE_FB
#define DBG_FORCE_FB 0
#endif

__device__ __forceinline__ int crow(int r, int hi) { return (r & 3) + 8 * (r >> 2) + 4 * hi; }
__device__ __forceinline__ float z_upper(float p) {
    const bool flip = p > 0.5f; const float pp = flip ? 1.f - p : p; const float t = sqrtf(-2.f * logf(pp));
    const float z = t - (2.515517f + 0.802853f * t + 0.010328f * t * t) / (1.f + 1.432788f * t + 0.189269f * t * t + 0.001308f * t * t * t);
    return flip ? -z : z;
}
__device__ __forceinline__ void load_a(bf16x8 (&a)[4], const char* kib, int j, int r32, int hi) {
    const char* kp = kib + (size_t)(unsigned)((j * 32 + r32) * 128 + hi * 16);
#pragma unroll
    for (int kk = 0; kk < 4; ++kk) a[kk] = *reinterpret_cast<const bf16x8*>(kp + kk * 32);
}
template <bool PF>
__device__ __forceinline__ void tile_scores(bf16x8 (&a)[4], const bf16x8 (&qreg)[8][4], const bf16x8 (&qL)[4], const float* wvl  , float (&sc)[16], const char* kib, int jn, int r32, int hi) {
    f32x16 dl = {};
#pragma unroll
    for (int kk = 0; kk < 4; ++kk) dl = __builtin_amdgcn_mfma_f32_32x32x16_bf16(a[kk], qL[kk], dl, 0, 0, 0);
#pragma unroll
    for (int h = 0; h < 8; ++h) { f32x16 d = {};
#pragma unroll
        for (int kk = 0; kk < 4; ++kk) d = __builtin_amdgcn_mfma_f32_32x32x16_bf16(a[kk], qreg[h][kk], d, 0, 0, 0);
        asm volatile("" ::: "memory");
        if (PF && h == 7) load_a(a, kib, jn, r32, hi);
        const float w = wvl[h];
#pragma unroll
        for (int r = 0; r < 16; ++r) sc[r] = fmaf(w, __builtin_fabsf(d[r]), h == 0 ? dl[r] : sc[r]); }
}
__device__ __forceinline__ unsigned fkey(float f) { const unsigned u = __builtin_bit_cast(unsigned, f); return (u & 0x80000000u) ? ~u : (u | 0x80000000u); }

__device__ __forceinline__ void mask_or_bit(u64* mwq, int qc, int s) {
    const int kk = s & 31, hk = (kk >> 2) & 1, r = (kk & 3) + 4 * (kk >> 3);
    __hip_atomic_fetch_or(mwq + (size_t)(s >> 5) * 16 + r, 1ull << (qc + 32 * hk), __ATOMIC_RELAXED, __HIP_MEMORY_SCOPE_AGENT);
}

__device__ __forceinline__ void fallback_query(char* lds, int tid, int tg  , int qc, int n, const bf16* QI, const char* kib, const float* WI, u64* mwq) {
    asm volatile("" : "+v"(tid));
    float* sc = (float*)(lds + OFF_HIST); unsigned* hist = (unsigned*)(lds + OFF_FBH); unsigned* misc = hist + 256; float* qf = (float*)(lds + OFF_QF);
    __syncthreads();
    if (tid < 256) { const unsigned w = ((const unsigned*)(QI + (size_t)tg * 512))[tid]; qf[2 * tid] = __builtin_bit_cast(float, w << 16); qf[2 * tid + 1] = __builtin_bit_cast(float, w & 0xffff0000u); }
    __syncthreads();
    for (int s = tid; s < n; s += 1024) {
        const int s2 = s + 512 < n ? s + 512 : s;
        const uint4* kp0 = (const uint4*)(kib + (size_t)s * 128); const uint4* kp1 = (const uint4*)(kib + (size_t)s2 * 128);
        float kf0[64], kf1[64];
#pragma unroll
        for (int c = 0; c < 8; ++c) { const uint4 w = kp0[c], x = kp1[c];
            kf0[8 * c] = __builtin_bit_cast(float, w.x << 16); kf0[8 * c + 1] = __builtin_bit_cast(float, w.x & 0xffff0000u); kf0[8 * c + 2] = __builtin_bit_cast(float, w.y << 16); kf0[8 * c + 3] = __builtin_bit_cast(float, w.y & 0xffff0000u);
            kf0[8 * c + 4] = __builtin_bit_cast(float, w.z << 16); kf0[8 * c + 5] = __builtin_bit_cast(float, w.z & 0xffff0000u); kf0[8 * c + 6] = __builtin_bit_cast(float, w.w << 16); kf0[8 * c + 7] = __builtin_bit_cast(float, w.w & 0xffff0000u);
            kf1[8 * c] = __builtin_bit_cast(float, x.x << 16); kf1[8 * c + 1] = __builtin_bit_cast(float, x.x & 0xffff0000u); kf1[8 * c + 2] = __builtin_bit_cast(float, x.y << 16); kf1[8 * c + 3] = __builtin_bit_cast(float, x.y & 0xffff0000u);
            kf1[8 * c + 4] = __builtin_bit_cast(float, x.z << 16); kf1[8 * c + 5] = __builtin_bit_cast(float, x.z & 0xffff0000u); kf1[8 * c + 6] = __builtin_bit_cast(float, x.w << 16); kf1[8 * c + 7] = __builtin_bit_cast(float, x.w & 0xffff0000u); }
        float sc0 = 0.f, sc1 = 0.f;
#pragma unroll 1
        for (int h = 0; h < 8; ++h) { float d0 = 0.f, d1 = 0.f;
#pragma unroll
            for (int j = 0; j < 64; ++j) { const float qv = qf[h * 64 + j]; d0 = fmaf(qv, kf0[j], d0); d1 = fmaf(qv, kf1[j], d1); }
            const float w = WI[(size_t)tg * 8 + h]; sc0 = fmaf(w, fmaxf(d0, 0.f), sc0); sc1 = fmaf(w, fmaxf(d1, 0.f), sc1); }
        sc[s] = sc0; sc[s2] = sc1;
    }
    __syncthreads();
    unsigned prefix = 0u, need = TOPK, eq_total = 0u;
    for (int pass = 0; pass < 4; ++pass) {
        const int shift = 24 - 8 * pass; const unsigned mask = pass == 0 ? 0u : (0xFFFFFFFFu << (shift + 8));
        if (tid < 256) hist[tid] = 0u;
        __syncthreads();
        for (int s = tid; s < n; s += 512) { const unsigned k = fkey(sc[s]); if ((k & mask) == (prefix & mask)) atomicAdd(&hist[(k >> shift) & 255u], 1u); }
        __syncthreads();
        if (tid == 0) { unsigned c = 0u; int bin = 255; for (; bin > 0; --bin) { if (c + hist[bin] >= need) break; c += hist[bin]; }
            misc[0] = (unsigned)bin; misc[1] = need - c; misc[2] = hist[bin]; }
        __syncthreads();
        prefix |= misc[0] << shift; need = misc[1]; eq_total = misc[2];
        __syncthreads();
    }
    const int nw = (n >> 5) * 16; const u64 clr = ~((1ull << qc) | (1ull << (qc + 32)));
    for (int i = tid; i < nw; i += 512) __hip_atomic_fetch_and(mwq + i, clr, __ATOMIC_RELAXED, __HIP_MEMORY_SCOPE_AGENT);
    asm volatile("s_waitcnt vmcnt(0)" ::: "memory");
    __syncthreads();
    const bool take_all_eq = (eq_total == need);
    for (int s = tid; s < n; s += 512) { const unsigned k = fkey(sc[s]); if (k > prefix || (take_all_eq && k == prefix)) mask_or_bit(mwq, qc, s); }
    if (!take_all_eq) {
        const int per = (n + 511) >> 9, s0 = tid * per, s1 = (s0 + per < n) ? s0 + per : n; unsigned* ce = (unsigned*)qf;
        unsigned mine = 0u; for (int s = s0; s < s1; ++s) mine += fkey(sc[s]) == prefix;
        __syncthreads(); ce[tid] = mine; __syncthreads();
        unsigned before = 0u; for (int t2 = 0; t2 < tid; ++t2) before += ce[t2];
        for (int s = s0; s < s1 && before < need; ++s) if (fkey(sc[s]) == prefix) { mask_or_bit(mwq, qc, s); ++before; }
    }
    __syncthreads();
}

__device__ __forceinline__ void indexer_unit(char* lds, int b, int c, const bf16* QI, const bf16* KI, const float* WI, u64* MASKW, char* codes  ) {
    const int tid = threadIdx.x, wid = __builtin_amdgcn_readfirstlane(tid >> 6), lane = tid & 63, r32 = lane & 31, hi = lane >> 5, qg = wid & 1, ks = wid >> 1;
    const int n = 64 * (c + 1), ntile = n >> 5, jend = 2 * ((c | 3) + 1);
    const int row0 = b * S + 64 * c;
    u64* mw = MASKW + ((size_t)(b * (S / 32) + 2 * c + qg) * (S / 32)) * 16;
    const char* kib = (const char*)(KI + (size_t)b * S * 64);
    if (n <= TOPK) {
        for (int j = ks; j < jend; j += 4) if (lane < 16) __hip_atomic_store(mw + (size_t)j * 16 + lane, j < ntile ? ~0ull : 0ull, __ATOMIC_RELAXED, __HIP_MEMORY_SCOPE_AGENT);
        return;
    }
    unsigned* hist = (unsigned*)(lds + OFF_HIST);
    float2* stat = (float2*)(lds + OFF_STAT); float2* qpar = (float2*)(lds + OFF_QPAR);
    int* bstar = (int*)(lds + OFF_BSTAR); int* needv = (int*)(lds + OFF_NEED); unsigned* bcnt = (unsigned*)(lds + OFF_BCNT); unsigned* fb = (unsigned*)(lds + OFF_FB);
    unsigned* fl = (unsigned*)(lds + OFF_FLAT);
    const int ql = qg * 32 + r32;
    {
    bf16x8 qreg[8][4]; const float* wvl = (const float*)(lds + OFF_WV) + ql * 8;
    { const char* qp = (const char*)QI + (size_t)(unsigned)(row0 + ql) * 1024 + hi * 16;
#pragma unroll
        for (int h = 0; h < 8; ++h)
#pragma unroll
            for (int kk = 0; kk < 4; ++kk) qreg[h][kk] = *reinterpret_cast<const bf16x8*>(qp + h * 128 + kk * 32);
        { unsigned to_ = (unsigned)tid; asm volatile("" : "+v"(to_)); if (to_ < 128u) { float4 w4 = *(const float4*)((const char*)(WI + (size_t)row0 * 8) + (size_t)(to_ * 16u)); w4.x *= 0.5f; w4.y *= 0.5f; w4.z *= 0.5f; w4.w *= 0.5f; *(float4*)(lds + OFF_WV + to_ * 16u) = w4; } } }
    bf16x8 qL[4];
    { const float4 w0 = *(const float4*)(WI + (size_t)(row0 + ql) * 8), w1 = *(const float4*)(WI + (size_t)(row0 + ql) * 8 + 4);
        const float wh[8] = {0.5f * w0.x, 0.5f * w0.y, 0.5f * w0.z, 0.5f * w0.w, 0.5f * w1.x, 0.5f * w1.y, 0.5f * w1.z, 0.5f * w1.w};
#pragma unroll
        for (int kk = 0; kk < 4; ++kk) { float acc8[8] = {0.f, 0.f, 0.f, 0.f, 0.f, 0.f, 0.f, 0.f};
#pragma unroll
            for (int h = 0; h < 8; ++h) { const bf16x8 q = qreg[h][kk];
#pragma unroll
                for (int e = 0; e < 8; ++e) acc8[e] = fmaf(wh[h], __builtin_bit_cast(float, (unsigned)(unsigned short)q[e] << 16), acc8[e]); }
            bf16x8 o;
#pragma unroll
            for (int e = 0; e < 8; ++e) { const unsigned u = __builtin_bit_cast(unsigned, acc8[e]); o[e] = (short)((u + 0x7fffu + ((u >> 16) & 1u)) >> 16); }
            qL[kk] = o; } }
    float sc[16];
    { unsigned z0; asm volatile("v_mov_b32 %0, 0" : "=v"(z0)); const uint4 z4 = make_uint4(z0, z0, z0, z0);
        unsigned zoff = (unsigned)tid * 16u; asm volatile("" : "+v"(zoff));
#pragma unroll 1
        for (int i = 0; i < 8; ++i) { *(uint4*)((char*)hist + zoff) = z4; zoff += 8192u; }
        if (tid < 16) *(uint4*)((char*)hist + zoff) = z4; }
    __syncthreads();
    { float s1 = 0.f, s2 = 0.f;
#pragma unroll 1
        for (int u = 0; u < 2; ++u) { const int j = ((ks + 4 * u) * ntile) >> 3; bf16x8 a[4]; load_a(a, kib, j, r32, hi); tile_scores<false>(a, qreg, qL, wvl, sc, kib, 0, r32, hi);
#pragma unroll
            for (int r = 0; r < 16; ++r) { s1 += sc[r]; s2 = fmaf(sc[r], sc[r], s2); } }
        s1 += __shfl_xor(s1, 32); s2 += __shfl_xor(s2, 32);
        { int qo_ = ql; asm volatile("" : "+v"(qo_)); if (hi == 0) stat[ks * 64 + qo_] = make_float2(s1, s2); } }
    __syncthreads();
    { int tq_ = tid; asm volatile("" : "+v"(tq_));
    if (tq_ < 64) { float s1 = 0.f, s2 = 0.f;
#pragma unroll
        for (int k = 0; k < 4; ++k) { const float2 v = stat[k * 64 + tq_]; s1 += v.x; s2 += v.y; }
        const float mu = s1 * (1.f / 256.f); float var = s2 * (1.f / 256.f) - mu * mu; var = var > 0.f ? var : 0.f;
        const float sg = fmaxf(sqrtf(var), 1e-30f); const float zp = z_upper(256.f / (float)n);
        const float lo = mu + (zp - 2.0f) * sg, a = (float)(NBINS - 2) / (4.0f * sg); float bb = 1.f - lo * a;
        float aa = a; if (!(aa < 3.0e38f) || !(fabsf(bb) < 3.0e38f)) { aa = 0.f; bb = 1.f; }
        qpar[tq_] = make_float2(aa, bb); bcnt[tq_] = 0u; if (tq_ == 0) { fb[0] = 0u; fb[100] = 0u; } } }
    __syncthreads();
    { unsigned* hq = hist + ql * HSTR; bf16x8 aC[4]; load_a(aC, kib, ks, r32, hi);
        unsigned cso = (unsigned)(qg * 1024 + lane * 16); asm volatile("" : "+v"(cso));
#pragma unroll 1
        for (int j = ks; j < ntile; j += 4) {
            tile_scores<true>(aC, qreg, qL, wvl, sc, kib, j + 4 < ntile ? j + 4 : j, r32, hi);
            const float2 ab = qpar[ql]; unsigned cw[4];
#pragma unroll
            for (int d = 0; d < 4; ++d) { unsigned w = 0u;
#pragma unroll
                for (int k = 3; k >= 0; --k) { const unsigned bin = (unsigned)__builtin_amdgcn_fmed3f(fmaf(sc[4 * d + k], ab.x, ab.y), 0.f, (float)(NBINS - 1));
                    __hip_atomic_fetch_add(hq + bin, 1u, __ATOMIC_RELAXED, __HIP_MEMORY_SCOPE_WORKGROUP); w = (w << 8) | bin; }
                cw[d] = w; }
            *(uint4*)(codes + (size_t)(unsigned)(j * 2048) + cso) = make_uint4(cw[0], cw[1], cw[2], cw[3]); } }
    }
    __syncthreads();
#pragma unroll 1
    for (int qq = 0; qq < 8; ++qq) { const int q = wid * 8 + qq; int lo_ = lane; asm volatile("" : "+v"(lo_)); const unsigned* hp = hist + q * HSTR + 4 * lo_; const unsigned hb[4] = {hp[0], hp[1], hp[2], hp[3]};
        const unsigned ls = (hb[0] + hb[1]) + (hb[2] + hb[3]);
        unsigned T = ls;
#pragma unroll
        for (int o = 1; o < 64; o <<= 1) { const unsigned v = __shfl_down(T, o); if (lane + o < 64) T += v; }
        const u64 bal = __ballot(T >= (unsigned)TOPK); const int lstar = 63 - __builtin_clzll(bal);
        if (lane == lstar) { unsigned acc = T - ls; int bsel = 0;
#pragma unroll
            for (int i = 3; i >= 0; --i) { if (acc + hb[i] >= (unsigned)TOPK) { bsel = i; break; } acc += hb[i]; }
            bstar[q] = 4 * lane + bsel; needv[q] = (int)(TOPK - acc); } }
    __syncthreads();
    { unsigned cso = (unsigned)(qg * 1024 + lane * 16); asm volatile("" : "+v"(cso));
        const unsigned bs = (unsigned)bstar[ql]; const unsigned bsx = bs * 0x01010101u; const unsigned qtag = (unsigned)ql << 14;
#define IDX_LDC(jj) (*(const uint4*)(codes + (size_t)(unsigned)(((jj) < ntile ? (jj) : ks) * 2048) + cso))
#define IDX_SEL(D, K) asm volatile("v_cmp_gt_u32_sdwa vcc, %2, %3 src0_sel:BYTE_" #K " src1_sel:DWORD\n\ts_nop 3\n\tv_writelane_b32 %0, vcc_lo, %4\n\tv_writelane_b32 %1, vcc_hi, %4" \
                : "+v"(mlo), "+v"(mhi) : "v"(cwd[D]), "v"(bs), "n"(4 * (D) + (K)) : "vcc")
#define IDX_PROC(CUR, jj) do { const int j_ = (jj); const unsigned cwd[4] = {CUR.x, CUR.y, CUR.z, CUR.w}; unsigned mlo = 0u, mhi = 0u;                                  \
            IDX_SEL(0, 0); IDX_SEL(0, 1); IDX_SEL(0, 2); IDX_SEL(0, 3); IDX_SEL(1, 0); IDX_SEL(1, 1); IDX_SEL(1, 2); IDX_SEL(1, 3);                                       \
            IDX_SEL(2, 0); IDX_SEL(2, 1); IDX_SEL(2, 2); IDX_SEL(2, 3); IDX_SEL(3, 0); IDX_SEL(3, 1); IDX_SEL(3, 2); IDX_SEL(3, 3);                                       \
            if (lane < 16) mw[(size_t)j_ * 16 + lane] = ((u64)mhi << 32) | mlo;                  \
                                     \
            _Pragma("unroll") for (int d = 0; d < 4; ++d) { const unsigned x = cwd[d] ^ bsx; const unsigned hz = (x - 0x01010101u) & ~x & 0x80808080u;                   \
                if (__ballot(hz != 0u)) {                                                                                                                                \
                    _Pragma("unroll") for (int k = 0; k < 4; ++k) { const bool eq = ((cwd[d] >> (8 * k)) & 255u) == bs;                                                  \
                        if (eq) { const unsigned pos = __hip_atomic_fetch_add(&fb[100], 1u, __ATOMIC_RELAXED, __HIP_MEMORY_SCOPE_WORKGROUP);                             \
                            if (pos < (unsigned)FCAP) fl[pos] = qtag | (unsigned)(j_ * 32 + crow(4 * d + k, hi)); } } } } } while (0)
        uint4 cA = IDX_LDC(ks), cB = IDX_LDC(ks + 4), cC = IDX_LDC(ks + 8), cD = IDX_LDC(ks + 12);
#pragma unroll 1
        for (int j = ks; j < ntile; j += 16) {
            IDX_PROC(cA, j); cA = IDX_LDC(j + 16);
            if (j + 4 < ntile) { IDX_PROC(cB, j + 4); cB = IDX_LDC(j + 20); }
            if (j + 8 < ntile) { IDX_PROC(cC, j + 8); cC = IDX_LDC(j + 24); }
            if (j + 12 < ntile) { IDX_PROC(cD, j + 12); cD = IDX_LDC(j + 28); }
        }
#undef IDX_PROC
#undef IDX_SEL
#undef IDX_LDC
        for (int j = ntile + ks; j < jend; j += 4) if (lane < 16) mw[(size_t)j * 16 + lane] = 0ull; }
    __syncthreads();
    { const unsigned nfl = fb[100] < (unsigned)FCAP ? fb[100] : (unsigned)FCAP; const float* wv = (const float*)(lds + OFF_WV); unsigned* blq = (unsigned*)(lds + OFF_HIST);
        unsigned ti_ = (unsigned)tid; asm volatile("" : "+v"(ti_));
#pragma unroll 1
        for (unsigned i = ti_; i < nfl; i += 512u) { const unsigned e = fl[i]; const int q = (int)(e >> 14), key = (int)(e & 16383u);
            const uint4* kp = (const uint4*)(kib + (size_t)key * 128); float kf[64];
#pragma unroll
            for (int cc = 0; cc < 8; ++cc) { const uint4 w = kp[cc];
                kf[8 * cc] = __builtin_bit_cast(float, w.x << 16); kf[8 * cc + 1] = __builtin_bit_cast(float, w.x & 0xffff0000u); kf[8 * cc + 2] = __builtin_bit_cast(float, w.y << 16); kf[8 * cc + 3] = __builtin_bit_cast(float, w.y & 0xffff0000u);
                kf[8 * cc + 4] = __builtin_bit_cast(float, w.z << 16); kf[8 * cc + 5] = __builtin_bit_cast(float, w.z & 0xffff0000u); kf[8 * cc + 6] = __builtin_bit_cast(float, w.w << 16); kf[8 * cc + 7] = __builtin_bit_cast(float, w.w & 0xffff0000u); }
            const char* qp = (const char*)QI + (size_t)(unsigned)(row0 + q) * 1024; float s = 0.f;
#pragma unroll 4
            for (int h = 0; h < 8; ++h) { float d = 0.f; const uint4* qh = (const uint4*)(qp + h * 128);
#pragma unroll
                for (int cc = 0; cc < 8; ++cc) { const uint4 w = qh[cc];
                    d = fmaf(__builtin_bit_cast(float, w.x << 16), kf[8 * cc], d); d = fmaf(__builtin_bit_cast(float, w.x & 0xffff0000u), kf[8 * cc + 1], d);
                    d = fmaf(__builtin_bit_cast(float, w.y << 16), kf[8 * cc + 2], d); d = fmaf(__builtin_bit_cast(float, w.y & 0xffff0000u), kf[8 * cc + 3], d);
                    d = fmaf(__builtin_bit_cast(float, w.z << 16), kf[8 * cc + 4], d); d = fmaf(__builtin_bit_cast(float, w.z & 0xffff0000u), kf[8 * cc + 5], d);
                    d = fmaf(__builtin_bit_cast(float, w.w << 16), kf[8 * cc + 6], d); d = fmaf(__builtin_bit_cast(float, w.w & 0xffff0000u), kf[8 * cc + 7], d); }
                s = fmaf(2.f * wv[q * 8 + h], fmaxf(d, 0.f), s); }
            const float2 ab = qpar[q]; const float u = fmaf(s, ab.x, ab.y);
            const unsigned fine = (unsigned)__builtin_amdgcn_fmed3f((u - (float)bstar[q]) * 262144.f, 0.f, 262143.f);
            const unsigned pos = __hip_atomic_fetch_add(&bcnt[q], 1u, __ATOMIC_RELAXED, __HIP_MEMORY_SCOPE_WORKGROUP);
            const unsigned word = (fine << 14) | (16383u - (unsigned)key); fl[FCAP + i] = word;
            if (pos < (unsigned)CAP) blq[q * CAP + pos] = word; } }
    asm volatile("s_waitcnt vmcnt(0)" ::: "memory");
    __syncthreads();
    { const bool flat_over = fb[100] > (unsigned)FCAP; const unsigned nfl = flat_over ? (unsigned)FCAP : fb[100]; const unsigned* blq = (const unsigned*)(lds + OFF_HIST);
        unsigned ti_ = (unsigned)tid; asm volatile("" : "+v"(ti_));
        if (ti_ < 64u) { const int q = (int)ti_; if (flat_over || bcnt[q] > (unsigned)CAP || bstar[q] <= 0 || bstar[q] >= NBINS - 1 || (DBG_FORCE_FB && (q & 15) == 3)) {
            const unsigned p = __hip_atomic_fetch_add(&fb[0], 1u, __ATOMIC_RELAXED, __HIP_MEMORY_SCOPE_WORKGROUP); fb[1 + p] = (unsigned)q; } }
        if (!flat_over) {
#pragma unroll 1
        for (unsigned i = ti_; i < nfl; i += 512u) { const unsigned ef = fl[i]; const int q = (int)(ef >> 14); const unsigned cnt = bcnt[q];
            if (cnt > (unsigned)CAP || bstar[q] <= 0 || bstar[q] >= NBINS - 1 || (DBG_FORCE_FB && (q & 15) == 3)) continue;
            const unsigned mine = fl[FCAP + i];
            const unsigned* bl = blq + q * CAP; int rk = 0;
            for (unsigned m = 0; m < cnt; ++m) rk += bl[m] > mine;
            if (rk < needv[q]) mask_or_bit(MASKW + ((size_t)(b * (S / 32) + 2 * c + (q >> 5)) * (S / 32)) * 16, q & 31, (int)(16383u - (mine & 16383u))); } } }
    __syncthreads();
    { const int nfb = (int)fb[0];
        for (int f = 0; f < nfb; ++f) { const int q = (int)fb[1 + f];
            fallback_query(lds, tid, row0 + q, q & 31, n, QI, kib, WI, MASKW + ((size_t)(b * (S / 32) + 2 * c + (q >> 5)) * (S / 32)) * 16); } }
    __syncthreads();
}
__device__ __forceinline__ void indexer_phase(char* lds, int vcu, int G, const bf16* QI, const bf16* KI, const float* WI, u64* MASKW, char* area_out, char* area_tail, char* area_gap, char* area_wai) {
    for (int item = vcu; item < 256; item += G) { const int b = (item >> 7) & 1, x = item & 127;
        const unsigned cum = (unsigned)(256 * x - x * (x - 1) / 2);
        char* codes = b == 0 ? area_out + (size_t)cum * 4096 : x < 33 ? area_out + (size_t)(24640u + cum) * 4096 : x < 73 ? area_tail + (size_t)(cum - 7920u) * 4096 : x < 115 ? area_gap + (size_t)(cum - 16060u) * 4096 : area_wai + (size_t)(cum - 22885u) * 4096;
#pragma unroll 1
        for (int pass = 0; pass < 2; ++pass) indexer_unit(lds, b, pass ? 255 - x : x, QI, KI, WI, MASKW, codes); }
}
}
namespace att {
typedef unsigned short bf16;
typedef short bf16x8 __attribute__((ext_vector_type(8)));
typedef short s16x4 __attribute__((ext_vector_type(4)));
typedef float f32x16 __attribute__((ext_vector_type(16)));
typedef float f32x4 __attribute__((ext_vector_type(4)));
typedef unsigned u32x4 __attribute__((ext_vector_type(4)));
typedef unsigned long long u64;
typedef const __attribute__((address_space(4))) u64* cu64p;
typedef float f32x2_t __attribute__((ext_vector_type(2))); typedef __bf16 bf16x2_t __attribute__((ext_vector_type(2)));
__device__ __forceinline__ unsigned cvtpk_s(float lo, float hi) { f32x2_t v = {lo, hi}; bf16x2_t b = __builtin_convertvector(v, bf16x2_t); return __builtin_bit_cast(unsigned, b); }
constexpr int D = 128, PITCH = 1024, NW = 8, QBLK = 32, KVBLK = 64, QB = NW * QBLK;
constexpr int SHM_V = KVBLK * D * 2, SHM_K = KVBLK * D * 2;
constexpr int NBUF = 4;
constexpr int OFF_WS = NBUF * SHM_V + NBUF * SHM_K;
constexpr int OFF_TAB = OFF_WS + NW * 64 * 4;
constexpr int OFF_EP = 0;
constexpr int EP_PITCH = 272, EP_WAVE = 32 * EP_PITCH;
constexpr int ATTN_LDS_BYTES = OFF_TAB + 448 * 4;
static_assert(NW * EP_WAVE <= OFF_WS, "epilogue staging fits the ring");
constexpr float THR2 = 11.5f;
constexpr int MW_PER_QB = (S / 32) * 16;

#define KSWZ(row, colB) ((row) * 256 + ((colB) ^ (((row) & 7) << 4)))
#define SBAR() __builtin_amdgcn_sched_barrier(0)
__device__ __forceinline__ int v_st(int k, int c) { const int kk = (k & ~0xC) | ((k & 4) << 1) | ((k & 8) >> 1); return ((kk >> 3) * 4 + (c >> 5)) * 512 + ((kk & 7) * 32 + (c & 31)) * 2; }
__device__ __forceinline__ int v_st_nat(int k, int c) { return ((k >> 3) * 4 + (c >> 5)) * 512 + ((k & 7) * 32 + (c & 31)) * 2; }
__device__ __forceinline__ int v_rd_base(int lane) { return ((lane & 3) << 3) | (((lane >> 2) & 3) << 6) | (((lane >> 4) & 1) << 5) | (((lane >> 5) & 1) << 8); }
constexpr int v_rd_off(int d0, int ks, int half) { return d0 * 512 + ks * 4096 + half * 2048; }
__device__ __forceinline__ int crow(int r, int hi) { return (r & 3) + 8 * (r >> 2) + 4 * hi; }
__device__ __forceinline__ unsigned cvtpk(float lo, float hi) { unsigned r; asm volatile("v_cvt_pk_bf16_f32 %0, %1, %2" : "=v"(r) : "v"(lo), "v"(hi)); return r; }

template <bool NEAR>
__device__ __forceinline__ void init_tile(f32x16& p0, f32x16& p1, cu64p w, float cb  , const float* tabp, float mcur) {
    const float NEG = -__builtin_inff();
    u64 m0[16], m1[16];
#pragma unroll
    for (int r = 0; r < 16; ++r) { m0[r] = w[r]; m1[r] = w[16 + r]; }
#pragma unroll
    for (int r = 0; r < 16; ++r) { float bv = cb; if (NEAR) bv = tabp[59 - ((r & 3) + 8 * (r >> 2))] - mcur;
        float o; asm volatile("v_cndmask_b32_e64 %0, %1, %2, %3" : "=v"(o) : "v"(NEG), "v"(bv), "s"(m0[r])); p0[r] = o; }
#pragma unroll
    for (int r = 0; r < 16; ++r) { float bv = cb; if (NEAR) bv = tabp[27 - ((r & 3) + 8 * (r >> 2))] - mcur;
        float o; asm volatile("v_cndmask_b32_e64 %0, %1, %2, %3" : "=v"(o) : "v"(NEG), "v"(bv), "s"(m1[r])); p1[r] = o; }
}
__device__ __forceinline__ void partialSM(f32x16& p0, f32x16& p1, float& m_reg, float& alpha, float l_cur, float pmax_in) {
    float pmax = pmax_in;
    { auto rr = __builtin_amdgcn_permlane32_swap(__float_as_uint(pmax), __float_as_uint(pmax), false, false);
      pmax = fmaxf(__uint_as_float(rr[0]), __uint_as_float(rr[1])); }
    const bool low = pmax < -64.f && pmax > -__builtin_inff();
    alpha = 1.f;
    if (__builtin_expect(__any(pmax > THR2 || low), 0)) {
        float delta = 0.f;
        if (pmax > THR2) { delta = pmax; alpha = __builtin_amdgcn_exp2f(-delta); }
        else if (low && l_cur == 0.f) delta = pmax;
        m_reg += delta;
#pragma unroll
        for (int r = 0; r < 16; ++r) p0[r] = p0[r] - delta;
#pragma unroll
        for (int r = 0; r < 16; ++r) p1[r] = p1[r] - delta; }
#pragma unroll
    for (int r = 0; r < 16; ++r) p0[r] = __builtin_amdgcn_exp2f(p0[r]);
}
__device__ __forceinline__ void finishSM(f32x16& p0, f32x16& p1, float alpha, float& l_reg, bf16x8& pa0, bf16x8& pa1, bf16x8& pa2, bf16x8& pa3) {
#pragma unroll
    for (int r = 0; r < 16; ++r) p1[r] = __builtin_amdgcn_exp2f(p1[r]);
    float ps = 0;
#pragma unroll
    for (int r = 0; r < 16; ++r) ps += p0[r];
#pragma unroll
    for (int r = 0; r < 16; ++r) ps += p1[r];
    { auto rr = __builtin_amdgcn_permlane32_swap(__float_as_uint(ps), __float_as_uint(ps), false, false);
      ps = __uint_as_float(rr[0]) + __uint_as_float(rr[1]); }
    l_reg = l_reg * alpha + ps;
#define PK4(P, B_, OUT) do { u32x4 w = {cvtpk(P[B_+0], P[B_+1]), cvtpk(P[B_+2], P[B_+3]), cvtpk(P[B_+4], P[B_+5]), cvtpk(P[B_+6], P[B_+7])};   \
        OUT = *reinterpret_cast<bf16x8*>(&w); } while (0)
    PK4(p0, 0, pa0); PK4(p0, 8, pa1); PK4(p1, 0, pa2); PK4(p1, 8, pa3);
#undef PK4
}
template <int KB>
__device__ __forceinline__ void qkt(f32x16& p0, f32x16& p1, const char* K_lds, int r32, int hi, const bf16x8* qr) {
    const char* kb[4];
#pragma unroll
    for (int dd = 0; dd < 4; ++dd) kb[dd] = K_lds + KB * SHM_K + KSWZ(r32, (dd * 16 + hi * 8) * 2);
#pragma unroll
    for (int d0 = 0; d0 < 8; ++d0) { const char* a = kb[d0 & 3] + (d0 >> 2) * 128;
        bf16x8 b0 = *reinterpret_cast<const bf16x8*>(a);
        bf16x8 b1 = *reinterpret_cast<const bf16x8*>(a + 32 * 256);
        p0 = __builtin_amdgcn_mfma_f32_32x32x16_bf16(b0, qr[d0], p0, 0, 0, 0);
        p1 = __builtin_amdgcn_mfma_f32_32x32x16_bf16(b1, qr[d0], p1, 0, 0, 0); }
}
template <int VB>
__device__ __forceinline__ void pv_tile(f32x16* o, int vb0, bf16x8 pa0, bf16x8 pa1, bf16x8 pa2, bf16x8 pa3) {
#define TRRD(dst, off) asm volatile("ds_read_b64_tr_b16 %0, %1 offset:%2" : "=&v"(dst) : "v"(vb0), "i"(off) : "memory")
#define PV_D0(d0) do { s16x4 l0, l1, l2, l3, h0, h1, h2, h3; constexpr int b_ = VB * SHM_V + v_rd_off(d0, 0, 0); \
        TRRD(l0, b_); TRRD(h0, b_ + 2048); TRRD(l1, b_ + 4096); TRRD(h1, b_ + 6144); TRRD(l2, b_ + 8192); TRRD(h2, b_ + 10240); TRRD(l3, b_ + 12288); TRRD(h3, b_ + 14336); \
        asm volatile("s_waitcnt lgkmcnt(0)" ::: "memory"); SBAR();   \
        o[d0] = __builtin_amdgcn_mfma_f32_32x32x16_bf16(pa0, (bf16x8){l0[0], l0[1], l0[2], l0[3], h0[0], h0[1], h0[2], h0[3]}, o[d0], 0, 0, 0);   \
        o[d0] = __builtin_amdgcn_mfma_f32_32x32x16_bf16(pa1, (bf16x8){l1[0], l1[1], l1[2], l1[3], h1[0], h1[1], h1[2], h1[3]}, o[d0], 0, 0, 0);   \
        o[d0] = __builtin_amdgcn_mfma_f32_32x32x16_bf16(pa2, (bf16x8){l2[0], l2[1], l2[2], l2[3], h2[0], h2[1], h2[2], h2[3]}, o[d0], 0, 0, 0);   \
        o[d0] = __builtin_amdgcn_mfma_f32_32x32x16_bf16(pa3, (bf16x8){l3[0], l3[1], l3[2], l3[3], h3[0], h3[1], h3[2], h3[3]}, o[d0], 0, 0, 0); } while (0)
    PV_D0(0); PV_D0(1); PV_D0(2); PV_D0(3);
#undef PV_D0
#undef TRRD
}

template <int VB>
__device__ __forceinline__ float pv_tile_max(f32x16* o, int vb0, bf16x8 pa0, bf16x8 pa1, bf16x8 pa2, bf16x8 pa3, const f32x16& p0, const f32x16& p1) {
#define TRRD(dst, off) asm volatile("ds_read_b64_tr_b16 %0, %1 offset:%2" : "=&v"(dst) : "v"(vb0), "i"(off) : "memory")
#define MX3(a, b, c) fmaxf(fmaxf(a, b), c)
#define PV_D0(d0, HOOK) do { s16x4 l0, l1, l2, l3, h0, h1, h2, h3; constexpr int b_ = VB * SHM_V + v_rd_off(d0, 0, 0); \
        TRRD(l0, b_); TRRD(h0, b_ + 2048); TRRD(l1, b_ + 4096); TRRD(h1, b_ + 6144); TRRD(l2, b_ + 8192); TRRD(h2, b_ + 10240); TRRD(l3, b_ + 12288); TRRD(h3, b_ + 14336); \
        HOOK; asm volatile("s_waitcnt lgkmcnt(0)" ::: "memory"); SBAR();   \
        o[d0] = __builtin_amdgcn_mfma_f32_32x32x16_bf16(pa0, (bf16x8){l0[0], l0[1], l0[2], l0[3], h0[0], h0[1], h0[2], h0[3]}, o[d0], 0, 0, 0);   \
        o[d0] = __builtin_amdgcn_mfma_f32_32x32x16_bf16(pa1, (bf16x8){l1[0], l1[1], l1[2], l1[3], h1[0], h1[1], h1[2], h1[3]}, o[d0], 0, 0, 0);   \
        o[d0] = __builtin_amdgcn_mfma_f32_32x32x16_bf16(pa2, (bf16x8){l2[0], l2[1], l2[2], l2[3], h2[0], h2[1], h2[2], h2[3]}, o[d0], 0, 0, 0);   \
        o[d0] = __builtin_amdgcn_mfma_f32_32x32x16_bf16(pa3, (bf16x8){l3[0], l3[1], l3[2], l3[3], h3[0], h3[1], h3[2], h3[3]}, o[d0], 0, 0, 0); } while (0)
    float m;
    PV_D0(0, m = MX3(p0[0], p0[1], p0[2]); m = MX3(m, p0[3], p0[4]); m = MX3(m, p0[5], p0[6]); m = MX3(m, p0[7], p0[8]));
    PV_D0(1, m = MX3(m, p0[9], p0[10]); m = MX3(m, p0[11], p0[12]); m = MX3(m, p0[13], p0[14]); m = MX3(m, p0[15], p1[0]));
    PV_D0(2, m = MX3(m, p1[1], p1[2]); m = MX3(m, p1[3], p1[4]); m = MX3(m, p1[5], p1[6]); m = MX3(m, p1[7], p1[8]));
    PV_D0(3, m = MX3(m, p1[9], p1[10]); m = MX3(m, p1[11], p1[12]); m = MX3(m, p1[13], p1[14]); m = fmaxf(m, p1[15]));
#undef PV_D0
#undef MX3
#undef TRRD
    return m;
}

struct BlockRef { const bf16* Q; const bf16* K; const bf16* V; const bf16* ZS; bf16* O; const u64* MW; const float* bias; int P0; };
struct Seam { bf16x8 qr[8]; bf16x8 st_v0, st_v1, st_k0, st_k1; };
#define ROW(p, k0, rr) ((const bf16*)((const char*)(p) + (size_t)(unsigned)(((k0) + (rr)) * (PITCH * 2) + sc * 2)))
#define VMW() asm volatile("s_waitcnt vmcnt(0)" ::: "memory")
#define VMWN(n) asm volatile("s_waitcnt vmcnt(%0)" :: "i"(n) : "memory")
#define LD8(p) (*reinterpret_cast<const bf16x8*>(p))
#define SLOAD_H(Kp, Vp, k0) do { S.st_v0 = LD8(ROW(Vp, k0, sr)); S.st_v1 = LD8(ROW(Vp, k0, 32 + sr)); S.st_k0 = LD8(ROW(Kp, k0, sr)); S.st_k1 = LD8(ROW(Kp, k0, 32 + sr)); } while (0)
#define SWRITE_HK(bf) do { *(bf16x8*)(K_lds + (bf) * SHM_K + kws) = S.st_k0; *(bf16x8*)(K_lds + (bf) * SHM_K + kws + 32 * 256) = S.st_k1; } while (0)
#define SWRITE_HV(bf) do { *(bf16x8*)(V_lds + (bf) * SHM_V + vst0) = S.st_v0; *(bf16x8*)(V_lds + (bf) * SHM_V + vst1) = S.st_v1; } while (0)
#define SWRITE_H(bf) do { SWRITE_HV(bf); SWRITE_HK(bf); } while (0)
__device__ __forceinline__ void attn_block(const BlockRef& cur, char* lds) {
    Seam S;
    int tid_ = threadIdx.x; asm volatile("" : "+v"(tid_));
    const int tid = tid_, wid = __builtin_amdgcn_readfirstlane(tid >> 6), lane = tid & 63, r32 = lane & 31, hi = lane >> 5;
    const int NT = (cur.P0 + QB) / KVBLK;
    const int qlo = cur.P0 + wid * QBLK;
    char* V_lds = lds; char* K_lds = lds + NBUF * SHM_V;
    float* ws = (float*)(lds + OFF_WS) + wid * 64; float* li_l = ws, * al_l = ws + 32;
    float* tab = (float*)(lds + OFF_TAB);
    float m_reg = 0.f, l_reg = 0; f32x16 o[4] = {};
    const int sr = tid >> 4, sc = (tid & 15) * 8, vst0 = v_st_nat(sr, sc), vst1 = v_st_nat(32 + sr, sc), kws = KSWZ(sr, sc * 2);
    const int vb0 = (int)(uintptr_t)V_lds + v_rd_base(lane);
    const bf16* Kh = cur.K; const bf16* Vh = cur.V;
    { int tq_ = tid; asm volatile("" : "+v"(tq_));
    if (tq_ < 448) { const int rel = tq_ - 256; const int ret = rel < 0 ? 16 : 0; const int n = rel < 0 ? -rel : rel; int v;
        if (n < 8) v = n; else if (n < 12) v = 8; else if (n < 16) v = 9; else if (n < 23) v = 10; else if (n < 32) v = 11; else if (n < 46) v = 12; else if (n < 64) v = 13; else if (n < 91) v = 14; else v = 15;
        tab[tq_] = cur.bias[(ret + v) * 8] * 1.4426950408889634f; } }
    const float cbfar = cur.bias[15 * 8] * 1.4426950408889634f;
    const cu64p mwv = (cu64p)(uintptr_t)(cur.MW + (size_t)wid * MW_PER_QB);
#define RESC(a) do { if (__any((a) < 1.f)) { if (hi == 0) al_l[r32] = (a); asm volatile("s_waitcnt lgkmcnt(0)" ::: "memory");              \
                     for (int d_ = 0; d_ < 4; ++d_) for (int r = 0; r < 16; ++r) o[d_][r] *= al_l[crow(r, hi)]; } } while (0)
#define KBASE(t) ((t) * KVBLK)
#define INIT(P0_, P1_, t) do { const int kb_ = KBASE(t); const cu64p w_ = mwv + (size_t)(t) * 32;                              \
        if (kb_ + 154 <= qlo) init_tile<false>(P0_, P1_, w_, cbfar - m_reg, tab, m_reg);                                        \
        else init_tile<true>(P0_, P1_, w_, cbfar - m_reg, tab + (qlo + r32 - kb_ - 4 * hi + 197), m_reg); } while (0)
    unsigned pm0 = 0u, pm1 = 0u, pm2 = 0u, pm3 = 0u;
#define MPREF(t) do { const __attribute__((address_space(4))) unsigned* w_ = (const __attribute__((address_space(4))) unsigned*)(mwv + (size_t)(t) * 32); pm0 = w_[0]; pm1 = w_[16]; pm2 = w_[32]; pm3 = w_[48]; SBAR(); } while (0)
#define MUSE() asm volatile("" :: "s"(pm0), "s"(pm1), "s"(pm2), "s"(pm3))
    f32x16 pA0, pA1, pB0, pB1; float alA, alB; bf16x8 pa0, pa1, pa2, pa3;
#pragma unroll
    for (int d0 = 0; d0 < 8; ++d0) S.qr[d0] = LD8((const char*)cur.Q + (size_t)(unsigned)((wid * QBLK + r32) * (PITCH * 2) + d0 * 32 + hi * 16));
    SLOAD_H(Kh, Vh, 0); VMW(); SWRITE_H(0); SBAR();
    if (NT > 1) SLOAD_H(Kh, Vh, KBASE(1));
    __syncthreads();
    INIT(pA0, pA1, 0);
    SBAR(); qkt<0>(pA0, pA1, K_lds, r32, hi, S.qr);
    MPREF(1);
    { float pm_ = pA0[0];
#pragma unroll
      for (int r = 1; r < 16; ++r) pm_ = fmaxf(pm_, pA0[r]);
#pragma unroll
      for (int r = 0; r < 16; ++r) pm_ = fmaxf(pm_, pA1[r]);
      partialSM(pA0, pA1, m_reg, alA, l_reg, pm_); }
    if (NT > 1) { VMW(); SWRITE_H(1); }
    __syncthreads();
#define HALF_STEP(PX0, PX1, alX, PY0, PY1, alY, t, KB, VB, SB) do {                                                           \
        MUSE(); INIT(PX0, PX1, (t)); SBAR(); qkt<KB>(PX0, PX1, K_lds, r32, hi, S.qr);                                        \
        finishSM(PY0, PY1, alY, l_reg, pa0, pa1, pa2, pa3); SBAR();                                                           \
        SLOAD_H(Kh, Vh, KBASE((t) + 1)); SBAR();                                                                              \
        { const float pm_ = pv_tile_max<VB>(o, vb0, pa0, pa1, pa2, pa3, PX0, PX1); MPREF((t) + 1); partialSM(PX0, PX1, m_reg, alX, l_reg, pm_); }   \
        VMW(); SWRITE_H(SB);                                                                                                  \
        RESC(alX); __syncthreads(); } while (0)
    int t = 1;
    for (; t + 4 < NT; t += 4) {
        HALF_STEP(pB0, pB1, alB, pA0, pA1, alA, t, 1, 0, 2);
        HALF_STEP(pA0, pA1, alA, pB0, pB1, alB, t + 1, 2, 1, 3);
        HALF_STEP(pB0, pB1, alB, pA0, pA1, alA, t + 2, 3, 2, 0);
        HALF_STEP(pA0, pA1, alA, pB0, pB1, alB, t + 3, 0, 3, 1);
    }
    HALF_STEP(pB0, pB1, alB, pA0, pA1, alA, NT - 3, 1, 0, 2);
    HALF_STEP(pA0, pA1, alA, pB0, pB1, alB, NT - 2, 2, 1, 3);
    MUSE(); INIT(pB0, pB1, NT - 1); SBAR(); qkt<3>(pB0, pB1, K_lds, r32, hi, S.qr); SBAR();
    finishSM(pA0, pA1, alA, l_reg, pa0, pa1, pa2, pa3); SBAR();
    { const float pm_ = pv_tile_max<2>(o, vb0, pa0, pa1, pa2, pa3, pB0, pB1); partialSM(pB0, pB1, m_reg, alB, l_reg, pm_); } RESC(alB);
    finishSM(pB0, pB1, alB, l_reg, pa0, pa1, pa2, pa3); SBAR(); pv_tile<3>(o, vb0, pa0, pa1, pa2, pa3);
    SBAR();
    __syncthreads();
    if (hi == 0) li_l[r32] = l_reg; asm volatile("s_waitcnt lgkmcnt(0)" ::: "memory");
    float rli[16];
#pragma unroll
    for (int r = 0; r < 16; ++r) rli[r] = __builtin_amdgcn_rcpf(li_l[crow(r, hi)]);
    {
        char* ep = lds + OFF_EP + wid * EP_WAVE; unsigned ew_off = (unsigned)(4 * hi * EP_PITCH + r32 * 2); asm volatile("" : "+v"(ew_off));
#pragma unroll
        for (int r = 0; r < 16; ++r) { const int rw = (r & 3) + 8 * (r >> 2);
#pragma unroll
            for (int d0 = 0; d0 < 4; ++d0) *(unsigned short*)(ep + ew_off + rw * EP_PITCH + d0 * 64) = (unsigned short)(cvtpk_s(o[d0][r] * rli[r], 0.f) & 0xffffu); }
        asm volatile("s_waitcnt lgkmcnt(0)" ::: "memory");
        unsigned lane_off = (unsigned)((wid * QBLK + (lane >> 4)) * PITCH + (lane & 15) * 8) * 2u;
        asm volatile("" : "+v"(lane_off));
        unsigned er_off = (unsigned)((lane >> 4) * EP_PITCH + (lane & 15) * 16); asm volatile("" : "+v"(er_off));
        char* op = (char*)cur.O + (size_t)lane_off; const char* zp = (const char*)cur.ZS + (size_t)lane_off; const char* er = ep + er_off;
#pragma unroll
        for (int ph = 0; ph < 2; ++ph) {
            asm volatile("" ::: "memory");
            uint4 zz[4];
#pragma unroll
            for (int p4 = 0; p4 < 4; ++p4) zz[p4] = *(const uint4*)(zp + (ph * 4 + p4) * 4 * PITCH * 2);
#pragma unroll
            for (int p4 = 0; p4 < 4; ++p4) { const int p = ph * 4 + p4; const uint4 m = *(const uint4*)(er + p * 4 * EP_PITCH); const uint4 z = zz[p4]; uint4 y;
                y.x = cvtpk_s(__uint_as_float(m.x << 16) * __uint_as_float(z.x << 16), __uint_as_float(m.x & 0xffff0000u) * __uint_as_float(z.x & 0xffff0000u));
                y.y = cvtpk_s(__uint_as_float(m.y << 16) * __uint_as_float(z.y << 16), __uint_as_float(m.y & 0xffff0000u) * __uint_as_float(z.y & 0xffff0000u));
                y.z = cvtpk_s(__uint_as_float(m.z << 16) * __uint_as_float(z.z << 16), __uint_as_float(m.z & 0xffff0000u) * __uint_as_float(z.z & 0xffff0000u));
                y.w = cvtpk_s(__uint_as_float(m.w << 16) * __uint_as_float(z.w << 16), __uint_as_float(m.w & 0xffff0000u) * __uint_as_float(z.w & 0xffff0000u));
                *(uint4*)(op + p * 4 * PITCH * 2) = y; } }
    }
    __syncthreads();
#undef RESC
#undef KBASE
#undef INIT
#undef MPREF
#undef MUSE
#undef HALF_STEP
}
#undef ROW
#undef VMW
#undef VMWN
#undef LD8
#undef SLOAD_H
#undef SWRITE_HK
#undef SWRITE_HV
#undef SWRITE_H

__device__ __forceinline__ BlockRef make_ref(int L, int pass, const bf16* Q, const bf16* K, const bf16* V, const bf16* ZS, bf16* O, const u64* MASKW, const float* rel_bias) {
    const int bh = L >> 5, x = L & 31, b = bh >> 3, h = bh & 7, qb = pass ? 63 - x : x;
    BlockRef r; const size_t row0 = (size_t)b * S + (size_t)qb * QB;
    r.Q = Q + row0 * PITCH + h * D; r.O = O + row0 * PITCH + h * D; r.ZS = ZS + row0 * PITCH + h * D;
    r.K = K + (size_t)b * S * PITCH + h * D; r.V = V + (size_t)b * S * PITCH + h * D;
    r.MW = MASKW + ((size_t)b * (S / 32) + (size_t)qb * 8) * MW_PER_QB; r.bias = rel_bias + h; r.P0 = qb * QB;
    return r;
}
__device__ __forceinline__ void attn_phase(char* lds, int vcu, int G, const bf16* Q, const bf16* K, const bf16* V, const bf16* ZS, bf16* O, const u64* MASKW, const float* rel_bias) {
    constexpr int TOTAL = 512;
    for (int L = vcu; L < TOTAL; L += G)
#pragma unroll 1
        for (int pass = 0; pass < 2; ++pass) { const BlockRef cur = make_ref(L, pass, Q, K, V, ZS, O, MASKW, rel_bias); attn_block(cur, lds); }
}
}

namespace sgu {
typedef unsigned short bf16;
typedef short bf16x8 __attribute__((ext_vector_type(8)));
typedef short s16x4 __attribute__((ext_vector_type(4)));
typedef float f32x16 __attribute__((ext_vector_type(16)));
typedef float f32x2_t __attribute__((ext_vector_type(2))); typedef __bf16 bf16x2_t __attribute__((ext_vector_type(2)));
__device__ __forceinline__ unsigned cvtpk_s(float lo, float hi) { f32x2_t v = {lo, hi}; bf16x2_t b = __builtin_convertvector(v, bf16x2_t); return __builtin_bit_cast(unsigned, b); }
constexpr int OFF_B = 0;
constexpr int OFF_ST = 65536;
constexpr int OFF_EP = 66560;
constexpr int EP_PITCH = 80, EP_WAVE = 128 * EP_PITCH;
constexpr int SGU_LDS_BYTES = OFF_EP + 8 * EP_WAVE;

template <bool WRITE>
__device__ __forceinline__ void sgu_phase(char* lds, int vcu, int G, bf16* U  , const bf16* Vb, const float* LNP, const bf16* WS16, const float* ln_g, const float* ln_b, const float* b_s) {
    const int tid = threadIdx.x, wid = __builtin_amdgcn_readfirstlane(tid >> 6), lane = tid & 63, r32 = lane & 31, hi = lane >> 5;
    float2* stats = (float2*)(lds + OFF_ST);
    for (int chunk = vcu; chunk < M / 128; chunk += G) {
        const size_t row0 = (size_t)chunk * 128;
        { int tq_ = tid; asm volatile("" : "+v"(tq_));
          if (tq_ < 128) { const float4* pp = (const float4*)(LNP + (row0 + tq_) * 64); float s1 = 0.f, s2 = 0.f;
#pragma unroll
            for (int j = 0; j < 16; ++j) { const float4 q = pp[j]; s1 += q.x + q.z; s2 += q.y + q.w; }
            const float mean = s1 * (1.f / BW); const float var = fmaxf(s2 * (1.f / BW) - mean * mean, 0.f);
            stats[tq_] = make_float2(mean, 1.0f / sqrtf(var + LN_EPS)); } }
        __syncthreads();
#pragma unroll 1
        for (int g = 0; g < 8; ++g) {
            bf16x8 A0[2], A1[4], A2[6], A3[8];
            { const char* ap = (const char*)WS16 + (size_t)(unsigned)(((g * 128 + r32) * 128 + 8 * hi) * 2);
#pragma unroll
                for (int kk = 0; kk < 2; ++kk) A0[kk] = *reinterpret_cast<const bf16x8*>(ap + kk * 32);
#pragma unroll
                for (int kk = 0; kk < 4; ++kk) A1[kk] = *reinterpret_cast<const bf16x8*>(ap + 32 * 256 + kk * 32);
#pragma unroll
                for (int kk = 0; kk < 6; ++kk) A2[kk] = *reinterpret_cast<const bf16x8*>(ap + 64 * 256 + kk * 32);
#pragma unroll
                for (int kk = 0; kk < 8; ++kk) A3[kk] = *reinterpret_cast<const bf16x8*>(ap + 96 * 256 + kk * 32); }
            { const int e8 = (tid & 31) * 8, ch = g * 256 + e8;
                const float4 g0 = *(const float4*)(ln_g + ch), g1 = *(const float4*)(ln_g + ch + 4), b0 = *(const float4*)(ln_b + ch), b1 = *(const float4*)(ln_b + ch + 4);
#pragma unroll
                for (int i = 0; i < 8; ++i) { const int s = (tid >> 5) + 16 * i; const uint4 w = *(const uint4*)(Vb + (row0 + s) * BW + ch); const float2 st = stats[s];
                    const float x0 = (bflo(w.x) - st.x) * st.y * g0.x + b0.x, x1 = (bfhi(w.x) - st.x) * st.y * g0.y + b0.y, x2 = (bflo(w.y) - st.x) * st.y * g0.z + b0.z, x3 = (bfhi(w.y) - st.x) * st.y * g0.w + b0.w;
                    const float x4 = (bflo(w.z) - st.x) * st.y * g1.x + b1.x, x5 = (bfhi(w.z) - st.x) * st.y * g1.y + b1.y, x6 = (bflo(w.w) - st.x) * st.y * g1.z + b1.z, x7 = (bfhi(w.w) - st.x) * st.y * g1.w + b1.w;
                    uint4 o; o.x = att::cvtpk(x0, x1); o.y = att::cvtpk(x2, x3); o.z = att::cvtpk(x4, x5); o.w = att::cvtpk(x6, x7);
                    *(uint4*)(lds + OFF_B + ((s >> 6) * 2 + (e8 >> 7)) * 16384 + att::v_st(s & 63, e8 & 127)) = o; } }
            __syncthreads();
            f32x16 acc[4] = {};
            { const int eh = wid >> 2, d0 = wid & 3;
                const int vb0 = (int)(uintptr_t)(lds + OFF_B) + att::v_rd_base(lane) + eh * 16384 + d0 * 512;
#define TRRD(dst, off) asm volatile("ds_read_b64_tr_b16 %0, %1 offset:%2" : "=&v"(dst) : "v"(vb0), "i"(off) : "memory")
#define BFRAG(dst, sh, ks) do { s16x4 l_, h_; TRRD(l_, (sh) * 32768 + (ks) * 4096); TRRD(h_, (sh) * 32768 + (ks) * 4096 + 2048); asm volatile("s_waitcnt lgkmcnt(0)" ::: "memory"); \
                dst = (bf16x8){l_[0], l_[1], l_[2], l_[3], h_[0], h_[1], h_[2], h_[3]}; } while (0)
                bf16x8 Bf[8];
                BFRAG(Bf[0], 0, 0); BFRAG(Bf[1], 0, 1); BFRAG(Bf[2], 0, 2); BFRAG(Bf[3], 0, 3); BFRAG(Bf[4], 1, 0); BFRAG(Bf[5], 1, 1); BFRAG(Bf[6], 1, 2); BFRAG(Bf[7], 1, 3);
#undef BFRAG
#undef TRRD
#pragma unroll
                for (int kk = 0; kk < 2; ++kk) acc[0] = __builtin_amdgcn_mfma_f32_32x32x16_bf16(A0[kk], Bf[kk], acc[0], 0, 0, 0);
#pragma unroll
                for (int kk = 0; kk < 4; ++kk) acc[1] = __builtin_amdgcn_mfma_f32_32x32x16_bf16(A1[kk], Bf[kk], acc[1], 0, 0, 0);
#pragma unroll
                for (int kk = 0; kk < 6; ++kk) acc[2] = __builtin_amdgcn_mfma_f32_32x32x16_bf16(A2[kk], Bf[kk], acc[2], 0, 0, 0);
#pragma unroll
                for (int kk = 0; kk < 8; ++kk) acc[3] = __builtin_amdgcn_mfma_f32_32x32x16_bf16(A3[kk], Bf[kk], acc[3], 0, 0, 0);
                char* ep = lds + OFF_EP + wid * EP_WAVE;
#pragma unroll
                for (int tb = 0; tb < 4; ++tb)
#pragma unroll
                    for (int r = 0; r < 16; ++r) { const int tl = 32 * tb + (r & 3) + 8 * (r >> 2) + 4 * hi;
                        *(unsigned short*)(ep + tl * EP_PITCH + r32 * 2) = (unsigned short)(cvtpk_s(acc[tb][r], 0.f) & 0xffffu); }
                asm volatile("s_waitcnt lgkmcnt(0)" ::: "memory");
                const int rq = lane >> 2, cq = (lane & 3) * 8;
                const size_t gbase = (row0 * BW + (size_t)(g * 256 + eh * 128 + d0 * 32 + cq)) * 2;
#pragma unroll
                for (int ph = 0; ph < 2; ++ph) {
                    uint4 uu[4], mm[4]; float bs[4];
#pragma unroll
                    for (int p = 0; p < 4; ++p) { const int t = 16 * (ph * 4 + p) + rq; const size_t o = gbase + (size_t)t * (BW * 2);
                        uu[p] = *(const uint4*)((const char*)U + o); bs[p] = b_s[g * 128 + t]; mm[p] = *(const uint4*)(ep + t * EP_PITCH + cq * 2); }
#pragma unroll
                    for (int p = 0; p < 4; ++p) { const int t = 16 * (ph * 4 + p) + rq; const size_t o = gbase + (size_t)t * (BW * 2);
                        uint4 y;
                        y.x = att::cvtpk(bflo(uu[p].x) * (bflo(mm[p].x) + bs[p]), bfhi(uu[p].x) * (bfhi(mm[p].x) + bs[p]));
                        y.y = att::cvtpk(bflo(uu[p].y) * (bflo(mm[p].y) + bs[p]), bfhi(uu[p].y) * (bfhi(mm[p].y) + bs[p]));
                        y.z = att::cvtpk(bflo(uu[p].z) * (bflo(mm[p].z) + bs[p]), bfhi(uu[p].z) * (bfhi(mm[p].z) + bs[p]));
                        y.w = att::cvtpk(bflo(uu[p].w) * (bflo(mm[p].w) + bs[p]), bfhi(uu[p].w) * (bfhi(mm[p].w) + bs[p]));
                        if (WRITE || y.x == 0x12345678u) *(uint4*)((char*)U + o) = y; } } }
            __syncthreads();
        }
    }
}
}

constexpr size_t MiB = 1u << 20;
constexpr size_t WS_CTL = 0, CTL_ZERO_BYTES = 64 * 1024;
constexpr size_t WS_WAI = 2 * MiB, WS_WAO = 12 * MiB, WS_WBI = 14 * MiB, WS_WBO = 26 * MiB;
constexpr size_t WS_WS16 = 1 * MiB;
constexpr size_t WS_RS0 = 1 * MiB + 512 * 1024;
constexpr size_t WS_H = 32 * MiB;
constexpr size_t WS_Q = 96 * MiB, WS_K = 160 * MiB, WS_V = 224 * MiB, WS_ZS = 288 * MiB;
constexpr size_t WS_QI = 352 * MiB, WS_KI = 384 * MiB, WS_WI = 388 * MiB;
constexpr size_t WS_MASK = 416 * MiB;
constexpr size_t WS_PS = 30 * MiB;
constexpr size_t WS_XB = 32 * MiB;
constexpr size_t WS_OG = 352 * MiB;
constexpr size_t WS_U = 96 * MiB, WS_VB = 224 * MiB, WS_ZB = 352 * MiB;
constexpr size_t WS_LNP = 352 * MiB;
constexpr size_t WS_TAIL = 480 * MiB;
constexpr size_t WS_END = 512 * MiB;
constexpr int CW_BAR = 1024;
constexpr int LDS_BYTES = 162816;
constexpr int MISC_OFF = 160000;
static_assert(att::ATTN_LDS_BYTES <= MISC_OFF && idx::IDX_LDS_BYTES <= MISC_OFF && sgu::SGU_LDS_BYTES <= MISC_OFF, "LDS map");

#define XB_TMO      128
#define XB_XCNT(j)  (256  + 64 * (j))
#define XB_XSUB(j)  (1280 + 64 * (j))
#define XB_XGEN(j)  (2304 + 64 * (j))
#define XB_TOP      3328
#define XB_TOPGEN   3392
#define XCD_BAR_WORDS 3456
#define XB_SPIN_CAP (1u << 18)
__device__ __forceinline__ unsigned xb_ld(unsigned* p)              { return __hip_atomic_load(p, __ATOMIC_RELAXED, __HIP_MEMORY_SCOPE_AGENT); }
__device__ __forceinline__ unsigned xb_add(unsigned* p, unsigned v) { return __hip_atomic_fetch_add(p, v, __ATOMIC_RELAXED, __HIP_MEMORY_SCOPE_AGENT); }
__device__ __forceinline__ unsigned xb_xcc_id() { return (unsigned)__builtin_amdgcn_s_getreg((3 << 11) | 20) & 0xFu; }
#define XB_SPIN(cond, bar) do { unsigned _sp = 0; while (cond) { __builtin_amdgcn_s_sleep(1); \
    if ((++_sp & 255u) == 0u) { if (xb_ld(&(bar)[XB_TMO])) break; if (_sp > XB_SPIN_CAP) { atomicAdd(&(bar)[XB_TMO], 1u); break; } } } } while (0)
struct XcdBarrier { unsigned* bar; unsigned x; volatile LAS unsigned* st; };
__device__ __forceinline__ XcdBarrier xcd_barrier_post(unsigned* bar, volatile LAS unsigned* st) {
    XcdBarrier b; b.bar = bar; b.x = xb_xcc_id(); b.st = st;
    if (threadIdx.x == 0) (void)xb_add(&bar[XB_XCNT(b.x)], 1u);
    return b;
}
__device__ __forceinline__ void xcd_barrier_complete(unsigned* bar, unsigned x, unsigned& nloc, unsigned& nx) {
    const unsigned G = gridDim.x * gridDim.y * gridDim.z;
    unsigned sum, cnt, mine, sp = 0u;
    for (;;) {
        sum = 0u; cnt = 0u; mine = 0u;
#pragma unroll
        for (unsigned j = 0; j < 16; ++j) { const unsigned c = xb_ld(&bar[XB_XCNT(j)]); sum += c; cnt += (c > 0u) ? 1u : 0u; mine = (j == x) ? c : mine; }
        if (sum == G) break;
        __builtin_amdgcn_s_sleep(1);
        if ((++sp & 255u) == 0u) { if (xb_ld(&bar[XB_TMO])) break; if (sp > XB_SPIN_CAP) { atomicAdd(&bar[XB_TMO], 1u); break; } }
    }
    nloc = mine > 0u ? mine : 1u; nx = cnt > 0u ? cnt : 1u;
}
__device__ __forceinline__ void xcd_barrier(const XcdBarrier& b) {
    asm volatile("s_waitcnt vmcnt(0)" ::: "memory");
    __syncthreads();
    if (threadIdx.x == 0) {
        unsigned* bar = b.bar;
        __builtin_amdgcn_s_waitcnt(0);
        unsigned nloc = b.st[0], nx = b.st[1];
        if (nloc == 0u) { xcd_barrier_complete(bar, b.x, nloc, nx); b.st[0] = nloc; b.st[1] = nx; }
        const unsigned old = xb_add(&bar[XB_XSUB(b.x)], 1u);
        const unsigned gen = old / nloc;
        if (old + 1u == (gen + 1u) * nloc) {
            __builtin_amdgcn_fence(__ATOMIC_RELEASE, "agent");
            asm volatile("s_waitcnt vmcnt(0)" ::: "memory");
            const unsigned og = xb_add(&bar[XB_TOP], 1u);
            const unsigned tg = og / nx;
            if (og + 1u == (tg + 1u) * nx) xb_add(&bar[XB_TOPGEN], 1u);
            else XB_SPIN(xb_ld(&bar[XB_TOPGEN]) == tg, bar);
            __builtin_amdgcn_fence(__ATOMIC_ACQUIRE, "agent");
            xb_add(&bar[XB_XGEN(b.x)], 1u);
            asm volatile("s_waitcnt vmcnt(0)" ::: "memory");
        } else {
            XB_SPIN(xb_ld(&bar[XB_XGEN(b.x)]) == gen, bar);
            __builtin_amdgcn_fence(__ATOMIC_ACQUIRE, "agent");
            asm volatile("s_waitcnt vmcnt(0)" ::: "memory");
        }
    }
    __syncthreads();
}

#ifndef MK_PER_PHASE
#define MK_PER_PHASE 0
#endif
constexpr int NPHASES = 10;
struct Args { const float* in[12]; float* out; unsigned char* ws; int ph_lo, ph_hi; };
__global__ void __launch_bounds__(512, 2) fwd(Args args) {
    extern __shared__ __attribute__((aligned(16))) unsigned char lds[];
    LAS unsigned char* ldsl = (LAS unsigned char*)lds;
    volatile LAS unsigned* MISC = (volatile LAS unsigned*)(ldsl + MISC_OFF);
    const int tid = threadIdx.x, lane = tid & 63, wave = __builtin_amdgcn_readfirstlane(tid >> 6);
    const int G = gridDim.x; const int bx = blockIdx.x; const int vcu = (G % 8 == 0) ? (bx % 8) * (G / 8) + bx / 8 : bx;
    const int gw = vcu * 8 + wave, NGW = G * 8;
    unsigned char* ws = args.ws;
    const float* x = args.in[0]; const float* norm_g = args.in[1]; const float* final_g = args.in[2]; const float* rel_bias = args.in[3];
    const float* a_w_in = args.in[4]; const float* a_w_out = args.in[5]; const float* b_w_in = args.in[6];
    const float* b_ln_g = args.in[7]; const float* b_ln_b = args.in[8]; const float* b_w_s = args.in[9]; const float* b_b_s = args.in[10]; const float* b_w_out = args.in[11];
    float* out = args.out;
    bf16 *WAI = (bf16*)(ws + WS_WAI), *WAO = (bf16*)(ws + WS_WAO), *WBI = (bf16*)(ws + WS_WBI), *WBO = (bf16*)(ws + WS_WBO), *H = (bf16*)(ws + WS_H);
    bf16 *Qb = (bf16*)(ws + WS_Q), *Kb = (bf16*)(ws + WS_K), *Vb = (bf16*)(ws + WS_V), *ZS = (bf16*)(ws + WS_ZS), *QI = (bf16*)(ws + WS_QI), *KI = (bf16*)(ws + WS_KI);
    float* WI = (float*)(ws + WS_WI); bf16* WS16 = (bf16*)(ws + WS_WS16);
    bf16 *U = (bf16*)(ws + WS_U), *V1 = (bf16*)(ws + WS_VB), *Z1 = (bf16*)(ws + WS_ZB), *XB = (bf16*)(ws + WS_XB); float* PS = (float*)(ws + WS_PS);
    if (tid < 32) MISC[tid] = 0u;
    __syncthreads();
    XcdBarrier bar; bar.bar = (unsigned*)(ws + WS_CTL) + CW_BAR; bar.x = 0; bar.st = nullptr;
    if (!MK_PER_PHASE) bar = xcd_barrier_post((unsigned*)(ws + WS_CTL) + CW_BAR, MISC + 8);
    const int lo = args.ph_lo, hi = args.ph_hi;
#ifdef DBG_SKIP
#define IN(k) (((DBG_SKIP >> (k)) & 1) == 0 && lo <= (k) && (k) < hi)
#else
#define IN(k) (lo <= (k) && (k) < hi)
#endif
#ifndef DBG_REPEAT
#define DBG_REPEAT 0
#endif
#define REP(k) _Pragma("unroll 1") for (int rep_ = 0; rep_ < 1 + ((DBG_REPEAT >> (k)) & 1); ++rep_)
#define SEAM(k) do { if (IN(k) && IN((k) + 1)) xcd_barrier(bar); } while (0)

    if (IN(0)) REP(0) {
        LAS float* scr = (LAS float*)ldsl + wave * 64 * 33;
        constexpr int I_AI = 16 * (A_NPAD / 32), I_AO = 16 * 32, I_BI = 16 * (B_COLS / 32), I_BO = 32 * 32;
        for (int it = gw; it < I_AI + I_AO + I_BI + I_BO; it += NGW) {
            int r = it;
            if (r < I_AI) { transpose_item(a_w_in, 1024, A_COLS, A_NPAD, WAI, scr, r, lane, norm_g); continue; } r -= I_AI;
            if (r < I_AO) { transpose_item(a_w_out, 1024, 1024, 1024, WAO, scr, r, lane); continue; } r -= I_AO;
            if (r < I_BI) { transpose_item(b_w_in, 1024, B_COLS, B_COLS, WBI, scr, r, lane, norm_g + DM, true); continue; } r -= I_BI;
            transpose_item(b_w_out, 2048, 1024, 1024, WBO, scr, r, lane);
        }
        for (int i = vcu * 512 + tid; i < 8 * 128 * 128; i += G * 512) WS16[i] = (i & 127) <= ((i >> 7) & 127) ? (bf16)f2bf(b_w_s[i]) : (bf16)0;
        for (int m = gw; m < M; m += NGW) row_to_bf16_rs(x + (size_t)m * DM, H + (size_t)m * DM, (float*)(ws + WS_RS0) + m, lane);
        __syncthreads();
    }
    SEAM(0);
    if (IN(1)) REP(1) {
        pg8::Gemm g{H, WAI, M, A_NPAD, 1024}; pg8::StaticOrder So; So.init(M, A_NPAD, G, bx);
        pg8::EpiA E{Qb, Kb, Vb, ZS, QI, KI, WI, (const float*)(ws + WS_RS0)};
        pg8::gemm_phase<pg8::EpiA, pg8::StaticOrder, true, true>(ldsl, g, So, E);
    }
    SEAM(1);
    if (IN(2)) REP(2) idx::indexer_phase((char*)lds, vcu, G, QI, KI, WI, (idx::u64*)(ws + WS_MASK), (char*)out, (char*)(ws + WS_TAIL), (char*)(ws + WS_WI + 1 * MiB), (char*)(ws + WS_WAI));
    SEAM(2);
    if (IN(3)) REP(3) {
        att::attn_phase((char*)lds, vcu, G, Qb, Kb, Vb, ZS, (bf16*)(ws + WS_OG), (const att::u64*)(ws + WS_MASK), rel_bias); }
    SEAM(3);
    if (IN(4)) REP(4) {
        pg8::Gemm g{(const bf16*)(ws + WS_OG), WAO, M, 1024, 1024}; pg8::StaticOrder So; So.init(M, 1024, G, bx);
        pg8::EpiRes1 E{XB, PS};
        pg8::gemm_phase<pg8::EpiRes1, pg8::StaticOrder, true, true>(ldsl, g, So, E);
    }
    if (IN(4) && IN(6)) xcd_barrier(bar);
    if (IN(6)) REP(6) {
        pg8::Gemm g{XB, WBI, M, B_COLS, 1024}; pg8::StaticOrder So; So.init(M, B_COLS, G, bx);
        pg8::EpiB E{U, V1, PS, (float*)(ws + WS_LNP)};
        pg8::gemm_phase<pg8::EpiB, pg8::StaticOrder, true, true>(ldsl, g, So, E);
    }
    SEAM(6);
#ifdef DBG_SGU2
    if (IN(7)) sgu::sgu_phase<false>((char*)lds, vcu, G, U, V1, (const float*)(ws + WS_LNP), WS16, b_ln_g, b_ln_b, b_b_s);
#endif
    if (IN(7)) sgu::sgu_phase<true>((char*)lds, vcu, G, U, V1, (const float*)(ws + WS_LNP), WS16, b_ln_g, b_ln_b, b_b_s);
    SEAM(7);
    if (IN(8)) REP(8) {
        pg8::Gemm g{U, WBO, M, 1024, 2048}; pg8::StaticOrder So; So.init(M, 1024, G, bx);
        pg8::EpiRes2 E{XB};
        pg8::gemm_phase<pg8::EpiRes2, pg8::StaticOrder, true, true>(ldsl, g, So, E);
    }
    SEAM(8);
    if (IN(9)) REP(9) { for (int m = gw; m < M; m += NGW) rms_row_bf16_to_f32(XB + (size_t)m * DM, final_g, out + (size_t)m * DM, lane); }
#undef IN
#undef SEAM
}

extern "C" void kernel_launch(void* const* d_in, const int* in_sizes, int n_in, void* d_out, int out_size, void* d_ws, size_t ws_size, hipStream_t stream) {
    static int grid = 0;
    if (grid == 0) {
        if (n_in != 12 || in_sizes[0] != M * DM || out_size != M * DM || ws_size < WS_END) { fprintf(stderr, "kernel_launch: unexpected shapes (n_in %d, in0 %d, out %d, ws %zu)\n", n_in, n_in > 0 ? in_sizes[0] : -1, out_size, ws_size); grid = -1; return; }
        int dev = 0, cus = 0, per_cu = 0;
        if (hipGetDevice(&dev) != hipSuccess || hipDeviceGetAttribute(&cus, hipDeviceAttributeMultiprocessorCount, dev) != hipSuccess) { fprintf(stderr, "kernel_launch: device query failed\n"); grid = -1; return; }
        if (hipFuncSetAttribute((const void*)fwd, hipFuncAttributeMaxDynamicSharedMemorySize, LDS_BYTES) != hipSuccess) { fprintf(stderr, "kernel_launch: hipFuncSetAttribute failed\n"); grid = -1; return; }
        if (hipOccupancyMaxActiveBlocksPerMultiprocessor(&per_cu, (const void*)fwd, 512, LDS_BYTES) != hipSuccess || per_cu < 1) { fprintf(stderr, "kernel_launch: occupancy query says %d workgroups per CU\n", per_cu); }
        (void)hipGetLastError();
        grid = cus;
    }
    if (grid < 0) return;
    if (hipMemsetAsync((char*)d_ws + WS_CTL, 0, CTL_ZERO_BYTES, stream) != hipSuccess) { fprintf(stderr, "kernel_launch: memset failed\n"); return; }
    Args a{};
    for (int i = 0; i < 12; ++i) a.in[i] = (const float*)d_in[i];
    a.out = (float*)d_out; a.ws = (unsigned char*)d_ws;
#if MK_PER_PHASE
    for (int p = 0; p < NPHASES; ++p) { a.ph_lo = p; a.ph_hi = p + 1; hipLaunchKernelGGL(fwd, dim3(grid), dim3(512), LDS_BYTES, stream, a); }
#else
    a.ph_lo = 0; a.ph_hi = NPHASES;
    hipLaunchKernelGGL(fwd, dim3(grid), dim3(512), LDS_BYTES, stream, a);
#endif
    const hipError_t le = hipPeekAtLastError();
    if (le != hipSuccess) fprintf(stderr, "kernel_launch: launch failed: %s\n", hipGetErrorName(le));
}
```

```cpp
#include <hip/hip_runtime.h>
#include <cstdio>
#include <cstdint>

constexpr int NB = 2, S = 16384, DM = 1024, M = NB * S;
constexpr int A_COLS = 4680, A_NPAD = 4864;
constexpr int BW = 2048, B_COLS = 3 * BW;
constexpr float RMS_EPS = 1e-6f, LN_EPS = 1e-5f;
constexpr float LOG2E = 1.4426950408889634f;
constexpr float QSCALE = 0.08838834764831845f * LOG2E;
constexpr float WI_SCALE = 0.35355339059327373f;
constexpr float QI_SCALE = 0.125f;
constexpr int TOPK = 256;

namespace pg8 {
#define PG8_LAS __attribute__((address_space(3)))
typedef unsigned short bf16_t;
typedef short bf16x8 __attribute__((ext_vector_type(8)));
typedef float f32x4 __attribute__((ext_vector_type(4)));
typedef unsigned u32x4 __attribute__((ext_vector_type(4)));
constexpr int BM = 256, BK = 64, HALF = 128, HTB = HALF * BK * 2  , STAGE_BYTES = 8 * HTB, NXCD = 8, WGM = 8;

__host__ __device__ __forceinline__ int lds_byte(int r, int c) { const int st = (r >> 4) * 2 + (c >> 5), rr = r & 15, cc = c & 31, ob = rr * 64 + cc * 2; return st * 1024 + (ob ^ (((ob >> 9) & 1) << 5)); }
__host__ __device__ __forceinline__ void stage_rc(int b, int& R, int& C) { const int st = b / 1024, sb = b % 1024, swz = sb ^ (((sb >> 9) & 1) << 5); R = (st >> 1) * 16 + swz / 64; C = (st & 1) * 32 + (swz % 64) / 2; }
__host__ __device__ __forceinline__ int perm32(int rho) { const int n = rho >> 4, i = rho & 15; return 8 * (i >> 2) + 4 * n + (i & 3); }

struct Unit { int pm, pn; };
struct Gemm { const bf16_t* A; const bf16_t* Bt; int M, N, K; };

struct StaticOrder {
    int nM, nN, nwg, G, c;
    __host__ __device__ void init(int M, int N, int G_, int c_) { nM = M / BM; nN = N / BM; nwg = nM * nN; G = G_; c = c_; }
    __host__ __device__ bool next(int i, Unit& u) const {
        const long L = (long)i * G + c; if (L >= nwg) return false;
        int wgid = (int)L; { const int q = nwg / NXCD, r = nwg % NXCD, xcd = wgid % NXCD, off = wgid / NXCD; wgid = (xcd < r ? xcd * (q + 1) : r * (q + 1) + (xcd - r) * q) + off; }
        const int nig = WGM * nN, gid = wgid / nig, fm = gid * WGM, gsz = (nM - fm) < WGM ? (nM - fm) : WGM;
        u.pm = fm + ((wgid % nig) % gsz); u.pn = (wgid % nig) / gsz; return true;
    }
    __device__ __forceinline__ void a_ready(const Unit&) const {}
    __device__ __forceinline__ void done(const Unit&) const {}
};

__device__ __forceinline__ unsigned cvt_pk_bf16(float lo, float hi) { unsigned r; asm volatile("v_cvt_pk_bf16_f32 %0, %1, %2" : "=v"(r) : "v"(lo), "v"(hi)); return r; }
typedef float f32x2 __attribute__((ext_vector_type(2)));
__device__ __forceinline__ float silu_f(float z) { return z * __builtin_amdgcn_rcpf(1.0f + __builtin_amdgcn_exp2f(-z * 1.4426950408889634f)); }

struct EpiA {
    static constexpr bool PERM = true, AFTER_DRAIN = false;
    bf16_t *Q, *K, *V, *ZS, *QI, *KI; float* WI; const float* RS;
    __device__ __forceinline__ void operator()(const f32x4 (&acc)[2][2][4][2], const Unit& u, int wr, int wc, int fr, int fq) const {
        const int pn = u.pn, row0 = u.pm * BM + wr * 64 + fr;
        if (pn < 18) {
            bf16_t* base; int ldc, colt; float sc = 1.f; bool act = false;
            if (pn < 4) { base = Q; ldc = 1024; colt = pn * 256; sc = 0.08838834764831845f * 1.4426950408889634f; }
            else if (pn < 8) { base = K; ldc = 1024; colt = (pn - 4) * 256; }
            else if (pn < 12) { base = V; ldc = 1024; colt = (pn - 8) * 256; }
            else if (pn < 16) { base = ZS; ldc = 1024; colt = (pn - 12) * 256; act = true; }
            else { base = QI; ldc = 512; colt = (pn - 16) * 256; sc = 0.125f; }
            const int col0 = colt + wc * 32 + 8 * fq;
#pragma unroll
            for (int ai = 0; ai < 2; ++ai)
#pragma unroll
                for (int m = 0; m < 4; ++m) { bf16_t* rowp = base + (size_t)(row0 + ai * HALF + m * 16) * ldc + col0; const float rs = RS[row0 + ai * HALF + m * 16] * sc;
#pragma unroll
                    for (int bj = 0; bj < 2; ++bj) { f32x4 v0 = acc[ai][bj][m][0] * rs, v1 = acc[ai][bj][m][1] * rs;
                        if (act) { v0 = (f32x4){silu_f(v0[0]), silu_f(v0[1]), silu_f(v0[2]), silu_f(v0[3])}; v1 = (f32x4){silu_f(v1[0]), silu_f(v1[1]), silu_f(v1[2]), silu_f(v1[3])}; }
                        u32x4 w; w.x = cvt_pk_bf16(v0[0], v0[1]); w.y = cvt_pk_bf16(v0[2], v0[3]); w.z = cvt_pk_bf16(v1[0], v1[1]); w.w = cvt_pk_bf16(v1[2], v1[3]);
                        *(u32x4*)(rowp + bj * HALF) = w; } }
        } else {
#pragma unroll
            for (int ai = 0; ai < 2; ++ai)
#pragma unroll
                for (int m = 0; m < 4; ++m) { const size_t row = (size_t)(row0 + ai * HALF + m * 16);
                    const float rs = RS[row]; const f32x4 v0 = acc[ai][0][m][0] * rs, v1 = acc[ai][0][m][1] * rs;
                    if (wc < 2) { u32x4 w; w.x = cvt_pk_bf16(v0[0], v0[1]); w.y = cvt_pk_bf16(v0[2], v0[3]); w.z = cvt_pk_bf16(v1[0], v1[1]); w.w = cvt_pk_bf16(v1[2], v1[3]);
                        *(u32x4*)(KI + row * 64 + wc * 32 + 8 * fq) = w; }
                    else if (wc == 2 && fq == 0) { const float s = 0.35355339059327373f; *(f32x4*)(WI + row * 8) = v0 * s; *(f32x4*)(WI + row * 8 + 4) = v1 * s; } }
        }
    }
};

struct EpiB {
    static constexpr bool PERM = true, AFTER_DRAIN = false;
    bf16_t* Gt; bf16_t* Vt;
    const float* PS;
    float* LNP;
    __device__ __forceinline__ float rowscale(const float* psrow) const {
        const f32x4* pp = (const f32x4*)psrow; const f32x4 q0 = pp[0], q1 = pp[1], q2 = pp[2], q3 = pp[3];
        const float ss = ((q0[0] + q0[1]) + (q0[2] + q0[3])) + ((q1[0] + q1[1]) + (q1[2] + q1[3])) + ((q2[0] + q2[1]) + (q2[2] + q2[3])) + ((q3[0] + q3[1]) + (q3[2] + q3[3]));
        return 1.0f / sqrtf(ss * (1.f / 1024.f) + 1e-6f); }
    __device__ __forceinline__ void operator()(const f32x4 (&acc)[2][2][4][2], const Unit& u, int wr, int wc, int fr, int fq) const {
        const int pn = u.pn, row0 = u.pm * BM + wr * 64 + fr;
        const float* psrow = PS + (size_t)row0 * 16;
        if (pn < 16) {
            bf16_t* p = Gt + (size_t)row0 * 2048 + pn * 128 + wc * 32 + 8 * fq;
#pragma unroll
            for (int ai = 0; ai < 2; ++ai)
#pragma unroll
                for (int m = 0; m < 4; ++m) { const float rs = rowscale(psrow + (size_t)(ai * HALF + m * 16) * 16);
                    const f32x4 u0 = acc[ai][0][m][0] * rs, u1 = acc[ai][0][m][1] * rs, z0 = acc[ai][1][m][0] * rs, z1 = acc[ai][1][m][1] * rs;
                    u32x4 w; w.x = cvt_pk_bf16(u0[0] * silu_f(z0[0]), u0[1] * silu_f(z0[1])); w.y = cvt_pk_bf16(u0[2] * silu_f(z0[2]), u0[3] * silu_f(z0[3]));
                    w.z = cvt_pk_bf16(u1[0] * silu_f(z1[0]), u1[1] * silu_f(z1[1])); w.w = cvt_pk_bf16(u1[2] * silu_f(z1[2]), u1[3] * silu_f(z1[3]));
                    *(u32x4*)(p + (size_t)(ai * HALF + m * 16) * 2048) = w; }
        } else {
            const int tv = pn - 16; bf16_t* p = Vt + (size_t)row0 * 2048 + tv * 256 + wc * 32 + 8 * fq;
#pragma unroll
            for (int ai = 0; ai < 2; ++ai)
#pragma unroll
                for (int m = 0; m < 4; ++m) { const int ro = ai * HALF + m * 16; const float rs = rowscale(psrow + (size_t)ro * 16); float s1 = 0.f, s2 = 0.f;
#pragma unroll
                    for (int bj = 0; bj < 2; ++bj) { const f32x4 v0 = acc[ai][bj][m][0] * rs, v1 = acc[ai][bj][m][1] * rs;
                        s1 += ((v0[0] + v0[1]) + (v0[2] + v0[3])) + ((v1[0] + v1[1]) + (v1[2] + v1[3]));
                        s2 += ((v0[0] * v0[0] + v0[1] * v0[1]) + (v0[2] * v0[2] + v0[3] * v0[3])) + ((v1[0] * v1[0] + v1[1] * v1[1]) + (v1[2] * v1[2] + v1[3] * v1[3]));
                        u32x4 w; w.x = cvt_pk_bf16(v0[0], v0[1]); w.y = cvt_pk_bf16(v0[2], v0[3]); w.z = cvt_pk_bf16(v1[0], v1[1]); w.w = cvt_pk_bf16(v1[2], v1[3]);
                        *(u32x4*)(p + (size_t)ro * 2048 + bj * HALF) = w; }
                    s1 += __shfl_xor(s1, 16); s1 += __shfl_xor(s1, 32); s2 += __shfl_xor(s2, 16); s2 += __shfl_xor(s2, 32);
                    if (fq == 0) { typedef float f32x2_ __attribute__((ext_vector_type(2))); *(f32x2_*)(LNP + ((size_t)(row0 + ro) * 32 + tv * 4 + wc) * 2) = (f32x2_){s1, s2}; } }
        }
    }
};

struct EpiRes2 {
    static constexpr bool PERM = true, AFTER_DRAIN = false;
    bf16_t* XB;
    __device__ __forceinline__ void operator()(const f32x4 (&acc)[2][2][4][2], const Unit& u, int wr, int wc, int fr, int fq) const {
        const int row0 = u.pm * BM + wr * 64 + fr, col0 = u.pn * BM + wc * 32 + 8 * fq;
#pragma unroll
        for (int ai = 0; ai < 2; ++ai) { u32x4 bb[4][2];
#pragma unroll
            for (int m = 0; m < 4; ++m)
#pragma unroll
                for (int bj = 0; bj < 2; ++bj) bb[m][bj] = *(const u32x4*)(XB + (size_t)(row0 + ai * HALF + m * 16) * 1024 + col0 + bj * HALF);
#pragma unroll
            for (int m = 0; m < 4; ++m)
#pragma unroll
                for (int bj = 0; bj < 2; ++bj) { const u32x4 b = bb[m][bj]; const f32x4 a0 = acc[ai][bj][m][0], a1 = acc[ai][bj][m][1]; u32x4 w;
                    w.x = cvt_pk_bf16(__uint_as_float(b.x << 16) + a0[0], __uint_as_float(b.x & 0xffff0000u) + a0[1]);
                    w.y = cvt_pk_bf16(__uint_as_float(b.y << 16) + a0[2], __uint_as_float(b.y & 0xffff0000u) + a0[3]);
                    w.z = cvt_pk_bf16(__uint_as_float(b.z << 16) + a1[0], __uint_as_float(b.z & 0xffff0000u) + a1[1]);
                    w.w = cvt_pk_bf16(__uint_as_float(b.w << 16) + a1[2], __uint_as_float(b.w & 0xffff0000u) + a1[3]);
                    *(u32x4*)(XB + (size_t)(row0 + ai * HALF + m * 16) * 1024 + col0 + bj * HALF) = w; } }
    }
};

struct EpiRes1 {
    static constexpr bool PERM = true, AFTER_DRAIN = false;
    bf16_t* XB; float* PS;
    __device__ __forceinline__ void operator()(const f32x4 (&acc)[2][2][4][2], const Unit& u, int wr, int wc, int fr, int fq) const {
        const int row0 = u.pm * BM + wr * 64 + fr, col0 = u.pn * BM + wc * 32 + 8 * fq;
#pragma unroll
        for (int ai = 0; ai < 2; ++ai) { u32x4 bb[4][2];
#pragma unroll
            for (int m = 0; m < 4; ++m)
#pragma unroll
                for (int bj = 0; bj < 2; ++bj) bb[m][bj] = *(const u32x4*)(XB + (size_t)(row0 + ai * HALF + m * 16) * 1024 + col0 + bj * HALF);
#pragma unroll
            for (int m = 0; m < 4; ++m) { const size_t row = (size_t)(row0 + ai * HALF + m * 16); float ss = 0.f;
#pragma unroll
                for (int bj = 0; bj < 2; ++bj) { const u32x4 b = bb[m][bj]; const f32x4 a0 = acc[ai][bj][m][0], a1 = acc[ai][bj][m][1];
                    const f32x4 v0 = {__uint_as_float(b.x << 16) + a0[0], __uint_as_float(b.x & 0xffff0000u) + a0[1], __uint_as_float(b.y << 16) + a0[2], __uint_as_float(b.y & 0xffff0000u) + a0[3]};
                    const f32x4 v1 = {__uint_as_float(b.z << 16) + a1[0], __uint_as_float(b.z & 0xffff0000u) + a1[1], __uint_as_float(b.w << 16) + a1[2], __uint_as_float(b.w & 0xffff0000u) + a1[3]};
                    ss += ((v0[0] * v0[0] + v0[1] * v0[1]) + (v0[2] * v0[2] + v0[3] * v0[3])) + ((v1[0] * v1[0] + v1[1] * v1[1]) + (v1[2] * v1[2] + v1[3] * v1[3]));
                    u32x4 w; w.x = cvt_pk_bf16(v0[0], v0[1]); w.y = cvt_pk_bf16(v0[2], v0[3]); w.z = cvt_pk_bf16(v1[0], v1[1]); w.w = cvt_pk_bf16(v1[2], v1[3]);
                    *(u32x4*)(XB + row * 1024 + col0 + bj * HALF) = w; }
                ss += __shfl_xor(ss, 16); ss += __shfl_xor(ss, 32);
                if (fq == 0) PS[row * 16 + u.pn * 4 + wc] = ss; } }
    }
};

template <class Epi, class Sched, bool ALIGN_EPI = false, bool SP2 = false>
__device__ __forceinline__ void gemm_phase(PG8_LAS unsigned char* lds, const Gemm g, const Sched& S, const Epi& E) {
    const int tid = threadIdx.x, wid = __builtin_amdgcn_readfirstlane(tid >> 6), lane = tid & 63, wr = wid >> 2, wc = wid & 3, fr = lane & 15, fq = lane >> 4;
    const int K = g.K, nt = K / BK;
    unsigned voffA[2], voffB[2];
#pragma unroll
    for (int i = 0; i < 2; ++i) { int R, C; stage_rc(tid * 16 + i * 8192, R, C); const int Rb = Epi::PERM ? ((R & ~31) + perm32(R & 31)) : R;
        voffA[i] = (unsigned)(R * K + C) * 2u; voffB[i] = (unsigned)(Rb * K + C) * 2u; }
    const size_t kstep = (size_t)(BK * 2);
    const size_t hstep = (size_t)HALF * K * 2;
    const size_t tstep = 2 * hstep;
    const unsigned ldsw = (unsigned)wid * 1024u;
    const int aoff = lds_byte(wr * 64 + fr, fq * 8), boff = lds_byte(wc * 32 + fr, fq * 8);
#define PG8_SA(b, h) (((b) * 2 + (h)) * HTB)
#define PG8_SB(b, h) ((4 + (b) * 2 + (h)) * HTB)
#define PG8_STAGE(bufoff, gbase, voff) do { _Pragma("unroll") for (int _i = 0; _i < 2; ++_i) \
        __builtin_amdgcn_global_load_lds((const unsigned*)((const char*)(gbase) + (voff)[_i]), (PG8_LAS unsigned*)(lds + (bufoff) + ldsw + _i * 8192), 16, 0, 0); } while (0)
#define PG8_LDA(dst, b, h) do { _Pragma("unroll") for (int m = 0; m < 4; ++m) _Pragma("unroll") for (int k = 0; k < 2; ++k) dst[m][k] = *(const PG8_LAS bf16x8*)(lds + PG8_SA(b, h) + aoff + m * 2048 + k * 1024); } while (0)
#define PG8_LDB(dst, b, h) do { _Pragma("unroll") for (int n = 0; n < 2; ++n) _Pragma("unroll") for (int k = 0; k < 2; ++k) dst[n][k] = *(const PG8_LAS bf16x8*)(lds + PG8_SB(b, h) + boff + n * 2048 + k * 1024); } while (0)
#define PG8_MMA(ai, bj, At, Bt) do { __builtin_amdgcn_s_setprio(1); _Pragma("unroll") for (int m = 0; m < 4; ++m) _Pragma("unroll") for (int n = 0; n < 2; ++n) _Pragma("unroll") for (int k = 0; k < 2; ++k) \
        acc[ai][bj][m][n] = __builtin_amdgcn_mfma_f32_16x16x32_bf16(Bt[n][k], At[m][k], acc[ai][bj][m][n], 0, 0, 0); __builtin_amdgcn_s_setprio(0); } while (0)
#define PG8_WAIT_V(n) asm volatile("s_waitcnt vmcnt(" #n ")" ::: "memory")
#define PG8_WAIT_L(n) asm volatile("s_waitcnt lgkmcnt(" #n ")" ::: "memory")
#define PG8_BAR __builtin_amdgcn_s_barrier()
#define PG8_SCHED __builtin_amdgcn_sched_barrier(0)
    Unit cur, nxt; int ui = 0;
    if (!S.next(0, cur)) return;
    f32x4 acc[2][2][4][2];
#pragma unroll
    for (int a = 0; a < 2; ++a)
#pragma unroll
        for (int b = 0; b < 2; ++b)
#pragma unroll
            for (int m = 0; m < 4; ++m)
#pragma unroll
                for (int n = 0; n < 2; ++n) acc[a][b][m][n] = (f32x4){0.f, 0.f, 0.f, 0.f};
    bf16x8 At[4][2], B0[2][2], B1[2][2];
    const char* cA = (const char*)g.A + (size_t)cur.pm * tstep; const char* cB = (const char*)g.Bt + (size_t)cur.pn * tstep;
    S.a_ready(cur);
    if constexpr (SP2) {
        PG8_STAGE(PG8_SB(0, 0), cB, voffB); PG8_STAGE(PG8_SB(0, 1), cB + hstep, voffB); PG8_STAGE(PG8_SA(0, 0), cA, voffA); PG8_STAGE(PG8_SA(0, 1), cA + hstep, voffA);
        if (wr == 1) PG8_BAR;
        PG8_WAIT_V(2); PG8_BAR;
        PG8_STAGE(PG8_SB(1, 0), cB + kstep, voffB); PG8_STAGE(PG8_SA(1, 0), cA + kstep, voffA); PG8_STAGE(PG8_SB(1, 1), cB + hstep + kstep, voffB);
        PG8_WAIT_V(6); PG8_BAR;
    } else {
        PG8_STAGE(PG8_SB(0, 0), cB, voffB); PG8_STAGE(PG8_SA(0, 0), cA, voffA); PG8_STAGE(PG8_SB(0, 1), cB + hstep, voffB); PG8_STAGE(PG8_SA(0, 1), cA + hstep, voffA);
        if (wr == 1) PG8_BAR;
        PG8_WAIT_V(4); PG8_BAR;
        PG8_STAGE(PG8_SB(1, 0), cB + kstep, voffB); PG8_STAGE(PG8_SA(1, 0), cA + kstep, voffA); PG8_STAGE(PG8_SB(1, 1), cB + hstep + kstep, voffB);
        PG8_WAIT_V(6); PG8_BAR;
    }
    for (;;) {
        const bool has_next = S.next(ui + 1, nxt);
        const char* nA = has_next ? (const char*)g.A + (size_t)nxt.pm * tstep : cA; const char* nB = has_next ? (const char*)g.Bt + (size_t)nxt.pn * tstep : cB;
        for (int t = 0; t < nt; t += 2) {
            const bool last = (t == nt - 2);
            const char* a1 = cA + (size_t)(t + 1) * kstep;
            const char* a2 = last ? nA : cA + (size_t)(t + 2) * kstep; const char* b2 = last ? nB : cB + (size_t)(t + 2) * kstep;
            const char* a3 = a2 + kstep; const char* b3 = b2 + kstep;
            if (last && has_next) S.a_ready(nxt);
            if constexpr (SP2) {
            PG8_LDB(B0, 0, 0); PG8_LDB(B1, 0, 1); PG8_SCHED; PG8_LDA(At, 0, 0); PG8_STAGE(PG8_SA(1, 1), a1 + hstep, voffA);
            PG8_WAIT_V(8); PG8_WAIT_L(0); PG8_BAR; PG8_MMA(0, 0, At, B0); PG8_MMA(0, 1, At, B1); PG8_BAR; PG8_SCHED;
            PG8_LDA(At, 0, 1); PG8_STAGE(PG8_SB(0, 0), b2, voffB); PG8_STAGE(PG8_SB(0, 1), b2 + hstep, voffB); PG8_STAGE(PG8_SA(0, 0), a2, voffA);
            PG8_WAIT_V(8); PG8_WAIT_L(0); PG8_BAR; PG8_MMA(1, 0, At, B0); PG8_MMA(1, 1, At, B1); PG8_BAR; PG8_SCHED;
            PG8_LDB(B0, 1, 0); PG8_LDB(B1, 1, 1); PG8_SCHED; PG8_LDA(At, 1, 0); PG8_STAGE(PG8_SA(0, 1), a2 + hstep, voffA);
            PG8_WAIT_V(8); PG8_WAIT_L(0); PG8_BAR; PG8_MMA(0, 0, At, B0); PG8_MMA(0, 1, At, B1); PG8_BAR; PG8_SCHED;
            PG8_LDA(At, 1, 1); PG8_STAGE(PG8_SB(1, 0), b3, voffB); PG8_STAGE(PG8_SB(1, 1), b3 + hstep, voffB); PG8_STAGE(PG8_SA(1, 0), a3, voffA);
            PG8_WAIT_V(8); PG8_WAIT_L(0); PG8_BAR; PG8_MMA(1, 0, At, B0); PG8_MMA(1, 1, At, B1); PG8_BAR; PG8_SCHED;
            } else {
            PG8_LDB(B0, 0, 0); PG8_SCHED; PG8_LDA(At, 0, 0); PG8_STAGE(PG8_SA(1, 1), a1 + hstep, voffA);
            PG8_WAIT_L(8); PG8_BAR; PG8_WAIT_L(0); PG8_MMA(0, 0, At, B0); PG8_BAR; PG8_SCHED;
            PG8_LDB(B1, 0, 1); PG8_STAGE(PG8_SB(0, 0), b2, voffB);
            PG8_BAR; PG8_WAIT_L(0); PG8_MMA(0, 1, At, B1); PG8_BAR;
            PG8_LDA(At, 0, 1); PG8_STAGE(PG8_SA(0, 0), a2, voffA);
            PG8_BAR; PG8_WAIT_L(0); PG8_MMA(1, 0, At, B0); PG8_BAR; PG8_SCHED;
            PG8_STAGE(PG8_SB(0, 1), b2 + hstep, voffB);
            PG8_WAIT_V(6); PG8_BAR; PG8_MMA(1, 1, At, B1); PG8_BAR;
            PG8_LDB(B0, 1, 0); PG8_SCHED; PG8_LDA(At, 1, 0); PG8_STAGE(PG8_SA(0, 1), a2 + hstep, voffA);
            PG8_WAIT_L(8); PG8_BAR; PG8_WAIT_L(0); PG8_MMA(0, 0, At, B0); PG8_BAR; PG8_SCHED;
            PG8_LDB(B1, 1, 1); PG8_STAGE(PG8_SB(1, 0), b3, voffB);
            PG8_BAR; PG8_WAIT_L(0); PG8_MMA(0, 1, At, B1); PG8_BAR;
            PG8_LDA(At, 1, 1); PG8_STAGE(PG8_SA(1, 0), a3, voffA);
            PG8_BAR; PG8_WAIT_L(0); PG8_MMA(1, 0, At, B0); PG8_BAR; PG8_SCHED;
            PG8_STAGE(PG8_SB(1, 1), b3 + hstep, voffB);
            PG8_WAIT_V(6); PG8_BAR; PG8_MMA(1, 1, At, B1); PG8_BAR;
            }
        }
        if constexpr (ALIGN_EPI) { if (wr == 0) PG8_BAR; }
        if constexpr (!Epi::AFTER_DRAIN) { E(acc, cur, wr, wc, fr, fq); S.done(cur); }
        if (!has_next) break;
#pragma unroll
        for (int a = 0; a < 2; ++a)
#pragma unroll
            for (int b = 0; b < 2; ++b)
#pragma unroll
                for (int m = 0; m < 4; ++m)
#pragma unroll
                    for (int n = 0; n < 2; ++n) acc[a][b][m][n] = (f32x4){0.f, 0.f, 0.f, 0.f};
        cur = nxt; cA = nA; cB = nB; ++ui;
        if constexpr (ALIGN_EPI) { if (wr == 1) PG8_BAR; }
    }
    PG8_WAIT_V(0);
    if constexpr (!ALIGN_EPI) { if (wr == 0) PG8_BAR; }
    PG8_BAR;
    if constexpr (Epi::AFTER_DRAIN) { E.fused(acc, cur, wr, wc, fr, fq, lds, wid, lane); S.done(cur); }
#undef PG8_SA
#undef PG8_SB
#undef PG8_STAGE
#undef PG8_LDA
#undef PG8_LDB
#undef PG8_MMA
#undef PG8_WAIT_V
#undef PG8_WAIT_L
#undef PG8_BAR
#undef PG8_SCHED
}
}
#define LAS __attribute__((address_space(3)))
typedef unsigned short bf16;
typedef float f32x4 __attribute__((ext_vector_type(4)));
typedef unsigned v4u __attribute__((ext_vector_type(4)));
typedef unsigned v2u __attribute__((ext_vector_type(2)));
__device__ __forceinline__ unsigned f2bf(float f) { unsigned u = __builtin_bit_cast(unsigned, f); return (u + 0x7fffu + ((u >> 16) & 1u)) >> 16; }
__device__ __forceinline__ unsigned pk2(float lo, float hi) { return f2bf(lo) | (f2bf(hi) << 16); }
__device__ __forceinline__ float bflo(unsigned w) { return __builtin_bit_cast(float, w << 16); }
__device__ __forceinline__ float bfhi(unsigned w) { return __builtin_bit_cast(float, w & 0xffff0000u); }
__device__ __forceinline__ float wave_sum(float v) {
#pragma unroll
    for (int o = 1; o < 64; o <<= 1) v += __shfl_xor(v, o);
    return v;
}
__device__ __forceinline__ float wave_max(float v) {
#pragma unroll
    for (int o = 1; o < 64; o <<= 1) v = fmaxf(v, __shfl_xor(v, o));
    return v;
}
__device__ __forceinline__ int t5_bucket(int rel) {
    const int ret = rel < 0 ? 16 : 0; const int n = rel < 0 ? -rel : rel;
    int v;
    if (n < 8) v = n; else if (n < 12) v = 8; else if (n < 16) v = 9; else if (n < 23) v = 10; else if (n < 32) v = 11; else if (n < 46) v = 12; else if (n < 64) v = 13; else if (n < 91) v = 14; else v = 15;
    return ret + v;
}

__device__ __forceinline__ void transpose_item(const float* W, int K, int N, int Npad, bf16* WT, LAS float* scr, int item, int lane, const float* gk = nullptr  , bool uzv = false  ) {
    const int nblk = Npad / 32, kb = item / nblk, nb = item % nblk, k0 = 64 * kb, n0 = 32 * nb;
    const int nn = n0 + (lane & 31);
    const int d0 = !uzv ? n0 : n0 < 2048 ? 256 * (n0 >> 7) + (n0 & 127) : n0 < 4096 ? n0 + 2048 : 256 * ((n0 - 4096) >> 7) + 128 + (n0 & 127);
#pragma unroll 8
    for (int i = 0; i < 32; ++i) { const int kk = 2 * i + (lane >> 5); scr[kk * 33 + (lane & 31)] = nn < N ? W[(size_t)(k0 + kk) * N + nn] * (gk ? gk[k0 + kk] : 1.f) : 0.f; }
    asm volatile("s_waitcnt lgkmcnt(0)" ::: "memory");
    const int c = lane & 7;
#pragma unroll
    for (int j = 0; j < 4; ++j) { const int n = (lane >> 3) + 8 * j; const LAS float* s = scr + (8 * c) * 33 + n;
        v4u o; o.x = pk2(s[0 * 33], s[1 * 33]); o.y = pk2(s[2 * 33], s[3 * 33]); o.z = pk2(s[4 * 33], s[5 * 33]); o.w = pk2(s[6 * 33], s[7 * 33]);
        *(v4u*)(WT + (size_t)(d0 + n) * K + k0 + 8 * c) = o; }
    asm volatile("s_waitcnt lgkmcnt(0)" ::: "memory");
}
__device__ __forceinline__ void rms_row_to_bf16(const float* xrow, const float* g, bf16* orow, int lane) {
    const f32x4* xr = (const f32x4*)xrow + lane; const f32x4* gr = (const f32x4*)g + lane;
    f32x4 v[4]; float s = 0.f;
#pragma unroll
    for (int j = 0; j < 4; ++j) { v[j] = xr[64 * j]; s += (v[j].x * v[j].x + v[j].y * v[j].y) + (v[j].z * v[j].z + v[j].w * v[j].w); }
    const float rs = 1.0f / sqrtf(wave_sum(s) * (1.f / 1024.f) + RMS_EPS);
    v2u* o8 = (v2u*)orow + lane;
#pragma unroll
    for (int j = 0; j < 4; ++j) { const f32x4 gg = gr[64 * j]; v2u o; o.x = pk2(v[j].x * rs * gg.x, v[j].y * rs * gg.y); o.y = pk2(v[j].z * rs * gg.z, v[j].w * rs * gg.w); o8[64 * j] = o; }
}
__device__ __forceinline__ void rms_row_f32(const float* xrow, const float* g, float* orow, int lane) {
    const f32x4* xr = (const f32x4*)xrow + lane; const f32x4* gr = (const f32x4*)g + lane;
    f32x4 v[4]; float s = 0.f;
#pragma unroll
    for (int j = 0; j < 4; ++j) { v[j] = xr[64 * j]; s += (v[j].x * v[j].x + v[j].y * v[j].y) + (v[j].z * v[j].z + v[j].w * v[j].w); }
    const float rs = 1.0f / sqrtf(wave_sum(s) * (1.f / 1024.f) + RMS_EPS);
    f32x4* o = (f32x4*)orow + lane;
#pragma unroll
    for (int j = 0; j < 4; ++j) { const f32x4 gg = gr[64 * j]; o[64 * j] = v[j] * rs * gg; }
}


__device__ __forceinline__ void rms_row_bf16_to_f32(const bf16* xrow, const float* g, float* orow, int lane) {
    typedef unsigned u32x4_ __attribute__((ext_vector_type(4)));
    float v[2][8]; float s = 0.f;
#pragma unroll
    for (int j = 0; j < 2; ++j) { const u32x4_ b = *((const u32x4_*)xrow + 64 * j + lane);
        v[j][0] = __uint_as_float(b.x << 16); v[j][1] = __uint_as_float(b.x & 0xffff0000u); v[j][2] = __uint_as_float(b.y << 16); v[j][3] = __uint_as_float(b.y & 0xffff0000u);
        v[j][4] = __uint_as_float(b.z << 16); v[j][5] = __uint_as_float(b.z & 0xffff0000u); v[j][6] = __uint_as_float(b.w << 16); v[j][7] = __uint_as_float(b.w & 0xffff0000u);
#pragma unroll
        for (int e = 0; e < 8; ++e) s += v[j][e] * v[j][e]; }
    const float rs = 1.0f / sqrtf(wave_sum(s) * (1.f / 1024.f) + RMS_EPS);
#pragma unroll
    for (int j = 0; j < 2; ++j) { const f32x4* gr = (const f32x4*)g + 128 * j + 2 * lane; f32x4* o = (f32x4*)orow + 128 * j + 2 * lane; const f32x4 g0 = gr[0], g1 = gr[1];
        o[0] = (f32x4){v[j][0] * rs * g0.x, v[j][1] * rs * g0.y, v[j][2] * rs * g0.z, v[j][3] * rs * g0.w};
        o[1] = (f32x4){v[j][4] * rs * g1.x, v[j][5] * rs * g1.y, v[j][6] * rs * g1.z, v[j][7] * rs * g1.w}; }
}

__device__ __forceinline__ void row_to_bf16_rs(const float* xrow, bf16* orow, float* rs_out, int lane) {
    const f32x4* xr = (const f32x4*)xrow + lane;
    f32x4 v[4]; float s = 0.f;
#pragma unroll
    for (int j = 0; j < 4; ++j) { v[j] = xr[64 * j]; s += (v[j].x * v[j].x + v[j].y * v[j].y) + (v[j].z * v[j].z + v[j].w * v[j].w); }
    v2u* o8 = (v2u*)orow + lane;
#pragma unroll
    for (int j = 0; j < 4; ++j) { v2u o; o.x = pk2(v[j].x, v[j].y); o.y = pk2(v[j].z, v[j].w); o8[64 * j] = o; }
    const float rs = 1.0f / sqrtf(wave_sum(s) * (1.f / 1024.f) + RMS_EPS);
    if (lane == 0) *rs_out = rs;
}
namespace idx {
typedef unsigned short bf16;
typedef short bf16x8 __attribute__((ext_vector_type(8)));
typedef float f32x16 __attribute__((ext_vector_type(16)));
typedef unsigned long long u64;
constexpr int NBINS = 256, HSTR = 257, CAP = 512, FCAP = 2048;
constexpr int OFF_HIST = 0;
constexpr int OFF_STAT = 64 * 513 * 4 + 128;
constexpr int OFF_QPAR = OFF_STAT + 2048;
constexpr int OFF_BSTAR = OFF_QPAR + 512, OFF_NEED = OFF_BSTAR + 256, OFF_BCNT = OFF_NEED + 256;
constexpr int OFF_FB = OFF_BCNT + 256;
constexpr int OFF_FBH = OFF_FB + 512;
constexpr int OFF_QF = OFF_FBH + 1024 + 64;
constexpr int OFF_WV = OFF_QF + 2048;
constexpr int OFF_FLAT = OFF_WV + 2048;
constexpr int IDX_LDS_BYTES = OFF_FLAT + 2 * FCAP * 4;
#ifndef IDX_REPS
#define IDX_REPS 1
#endif
#ifndef DBG_FORCE_FB
#define DBG_FORCE_FB 0
#endif

__device__ __forceinline__ int crow(int r, int hi) { return (r & 3) + 8 * (r >> 2) + 4 * hi; }
__device__ __forceinline__ float z_upper(float p) {
    const bool flip = p > 0.5f; const float pp = flip ? 1.f - p : p; const float t = sqrtf(-2.f * logf(pp));
    const float z = t - (2.515517f + 0.802853f * t + 0.010328f * t * t) / (1.f + 1.432788f * t + 0.189269f * t * t + 0.001308f * t * t * t);
    return flip ? -z : z;
}
__device__ __forceinline__ void load_a(bf16x8 (&a)[4], const char* kib, int j, int r32, int hi) {
    const char* kp = kib + (size_t)(unsigned)((j * 32 + r32) * 128 + hi * 16);
#pragma unroll
    for (int kk = 0; kk < 4; ++kk) a[kk] = *reinterpret_cast<const bf16x8*>(kp + kk * 32);
}
template <bool PF>
__device__ __forceinline__ void tile_scores(bf16x8 (&a)[4], const bf16x8 (&qreg)[8][4], const bf16x8 (&qL)[4], const float* wvl  , float (&sc)[16], const char* kib, int jn, int r32, int hi) {
    f32x16 dl = {};
#pragma unroll
    for (int kk = 0; kk < 4; ++kk) dl = __builtin_amdgcn_mfma_f32_32x32x16_bf16(a[kk], qL[kk], dl, 0, 0, 0);
#pragma unroll
    for (int h = 0; h < 8; ++h) { f32x16 d = {};
#pragma unroll
        for (int kk = 0; kk < 4; ++kk) d = __builtin_amdgcn_mfma_f32_32x32x16_bf16(a[kk], qreg[h][kk], d, 0, 0, 0);
        asm volatile("" ::: "memory");
        if (PF && h == 7) load_a(a, kib, jn, r32, hi);
        const float w = wvl[h];
#pragma unroll
        for (int r = 0; r < 16; ++r) sc[r] = fmaf(w, __builtin_fabsf(d[r]), h == 0 ? dl[r] : sc[r]); }
}
__device__ __forceinline__ unsigned fkey(float f) { const unsigned u = __builtin_bit_cast(unsigned, f); return (u & 0x80000000u) ? ~u : (u | 0x80000000u); }

__device__ __forceinline__ void mask_or_bit(u64* mwq, int qc, int s) {
    const int kk = s & 31, hk = (kk >> 2) & 1, r = (kk & 3) + 4 * (kk >> 3);
    __hip_atomic_fetch_or(mwq + (size_t)(s >> 5) * 16 + r, 1ull << (qc + 32 * hk), __ATOMIC_RELAXED, __HIP_MEMORY_SCOPE_AGENT);
}

__device__ __forceinline__ void fallback_query(char* lds, int tid, int tg  , int qc, int n, const bf16* QI, const char* kib, const float* WI, u64* mwq) {
    asm volatile("" : "+v"(tid));
    float* sc = (float*)(lds + OFF_HIST); unsigned* hist = (unsigned*)(lds + OFF_FBH); unsigned* misc = hist + 256; float* qf = (float*)(lds + OFF_QF);
    __syncthreads();
    if (tid < 256) { const unsigned w = ((const unsigned*)(QI + (size_t)tg * 512))[tid]; qf[2 * tid] = __builtin_bit_cast(float, w << 16); qf[2 * tid + 1] = __builtin_bit_cast(float, w & 0xffff0000u); }
    __syncthreads();
    for (int s = tid; s < n; s += 1024) {
        const int s2 = s + 512 < n ? s + 512 : s;
        const uint4* kp0 = (const uint4*)(kib + (size_t)s * 128); const uint4* kp1 = (const uint4*)(kib + (size_t)s2 * 128);
        float kf0[64], kf1[64];
#pragma unroll
        for (int c = 0; c < 8; ++c) { const uint4 w = kp0[c], x = kp1[c];
            kf0[8 * c] = __builtin_bit_cast(float, w.x << 16); kf0[8 * c + 1] = __builtin_bit_cast(float, w.x & 0xffff0000u); kf0[8 * c + 2] = __builtin_bit_cast(float, w.y << 16); kf0[8 * c + 3] = __builtin_bit_cast(float, w.y & 0xffff0000u);
            kf0[8 * c + 4] = __builtin_bit_cast(float, w.z << 16); kf0[8 * c + 5] = __builtin_bit_cast(float, w.z & 0xffff0000u); kf0[8 * c + 6] = __builtin_bit_cast(float, w.w << 16); kf0[8 * c + 7] = __builtin_bit_cast(float, w.w & 0xffff0000u);
            kf1[8 * c] = __builtin_bit_cast(float, x.x << 16); kf1[8 * c + 1] = __builtin_bit_cast(float, x.x & 0xffff0000u); kf1[8 * c + 2] = __builtin_bit_cast(float, x.y << 16); kf1[8 * c + 3] = __builtin_bit_cast(float, x.y & 0xffff0000u);
            kf1[8 * c + 4] = __builtin_bit_cast(float, x.z << 16); kf1[8 * c + 5] = __builtin_bit_cast(float, x.z & 0xffff0000u); kf1[8 * c + 6] = __builtin_bit_cast(float, x.w << 16); kf1[8 * c + 7] = __builtin_bit_cast(float, x.w & 0xffff0000u); }
        float sc0 = 0.f, sc1 = 0.f;
#pragma unroll 1
        for (int h = 0; h < 8; ++h) { float d0 = 0.f, d1 = 0.f;
#pragma unroll
            for (int j = 0; j < 64; ++j) { const float qv = qf[h * 64 + j]; d0 = fmaf(qv, kf0[j], d0); d1 = fmaf(qv, kf1[j], d1); }
            const float w = WI[(size_t)tg * 8 + h]; sc0 = fmaf(w, fmaxf(d0, 0.f), sc0); sc1 = fmaf(w, fmaxf(d1, 0.f), sc1); }
        sc[s] = sc0; sc[s2] = sc1;
    }
    __syncthreads();
    unsigned prefix = 0u, need = TOPK, eq_total = 0u;
    for (int pass = 0; pass < 4; ++pass) {
        const int shift = 24 - 8 * pass; const unsigned mask = pass == 0 ? 0u : (0xFFFFFFFFu << (shift + 8));
        if (tid < 256) hist[tid] = 0u;
        __syncthreads();
        for (int s = tid; s < n; s += 512) { const unsigned k = fkey(sc[s]); if ((k & mask) == (prefix & mask)) atomicAdd(&hist[(k >> shift) & 255u], 1u); }
        __syncthreads();
        if (tid == 0) { unsigned c = 0u; int bin = 255; for (; bin > 0; --bin) { if (c + hist[bin] >= need) break; c += hist[bin]; }
            misc[0] = (unsigned)bin; misc[1] = need - c; misc[2] = hist[bin]; }
        __syncthreads();
        prefix |= misc[0] << shift; need = misc[1]; eq_total = misc[2];
        __syncthreads();
    }
    const int nw = (n >> 5) * 16; const u64 clr = ~((1ull << qc) | (1ull << (qc + 32)));
    for (int i = tid; i < nw; i += 512) __hip_atomic_fetch_and(mwq + i, clr, __ATOMIC_RELAXED, __HIP_MEMORY_SCOPE_AGENT);
    asm volatile("s_waitcnt vmcnt(0)" ::: "memory");
    __syncthreads();
    const bool take_all_eq = (eq_total == need);
    for (int s = tid; s < n; s += 512) { const unsigned k = fkey(sc[s]); if (k > prefix || (take_all_eq && k == prefix)) mask_or_bit(mwq, qc, s); }
    if (!take_all_eq) {
        const int per = (n + 511) >> 9, s0 = tid * per, s1 = (s0 + per < n) ? s0 + per : n; unsigned* ce = (unsigned*)qf;
        unsigned mine = 0u; for (int s = s0; s < s1; ++s) mine += fkey(sc[s]) == prefix;
        __syncthreads(); ce[tid] = mine; __syncthreads();
        unsigned before = 0u; for (int t2 = 0; t2 < tid; ++t2) before += ce[t2];
        for (int s = s0; s < s1 && before < need; ++s) if (fkey(sc[s]) == prefix) { mask_or_bit(mwq, qc, s); ++before; }
    }
    __syncthreads();
}

__device__ __forceinline__ void indexer_unit(char* lds, int b, int c, const bf16* QI, const bf16* KI, const float* WI, u64* MASKW, char* codes  ) {
    const int tid = threadIdx.x, wid = __builtin_amdgcn_readfirstlane(tid >> 6), lane = tid & 63, r32 = lane & 31, hi = lane >> 5, qg = wid & 1, ks = wid >> 1;
    const int n = 64 * (c + 1), ntile = n >> 5, jend = 2 * ((c | 3) + 1);
    const int row0 = b * S + 64 * c;
    u64* mw = MASKW + ((size_t)(b * (S / 32) + 2 * c + qg) * (S / 32)) * 16;
    const char* kib = (const char*)(KI + (size_t)b * S * 64);
    if (n <= TOPK) {
        for (int j = ks; j < jend; j += 4) if (lane < 16) __hip_atomic_store(mw + (size_t)j * 16 + lane, j < ntile ? ~0ull : 0ull, __ATOMIC_RELAXED, __HIP_MEMORY_SCOPE_AGENT);
        return;
    }
    unsigned* hist = (unsigned*)(lds + OFF_HIST);
    float2* stat = (float2*)(lds + OFF_STAT); float2* qpar = (float2*)(lds + OFF_QPAR);
    int* bstar = (int*)(lds + OFF_BSTAR); int* needv = (int*)(lds + OFF_NEED); unsigned* bcnt = (unsigned*)(lds + OFF_BCNT); unsigned* fb = (unsigned*)(lds + OFF_FB);
    unsigned* fl = (unsigned*)(lds + OFF_FLAT);
    const int ql = qg * 32 + r32;
    {
    bf16x8 qreg[8][4]; const float* wvl = (const float*)(lds + OFF_WV) + ql * 8;
    { const char* qp = (const char*)QI + (size_t)(unsigned)(row0 + ql) * 1024 + hi * 16;
#pragma unroll
        for (int h = 0; h < 8; ++h)
#pragma unroll
            for (int kk = 0; kk < 4; ++kk) qreg[h][kk] = *reinterpret_cast<const bf16x8*>(qp + h * 128 + kk * 32);
        { unsigned to_ = (unsigned)tid; asm volatile("" : "+v"(to_)); if (to_ < 128u) { float4 w4 = *(const float4*)((const char*)(WI + (size_t)row0 * 8) + (size_t)(to_ * 16u)); w4.x *= 0.5f; w4.y *= 0.5f; w4.z *= 0.5f; w4.w *= 0.5f; *(float4*)(lds + OFF_WV + to_ * 16u) = w4; } } }
    bf16x8 qL[4];
    { const float4 w0 = *(const float4*)(WI + (size_t)(row0 + ql) * 8), w1 = *(const float4*)(WI + (size_t)(row0 + ql) * 8 + 4);
        const float wh[8] = {0.5f * w0.x, 0.5f * w0.y, 0.5f * w0.z, 0.5f * w0.w, 0.5f * w1.x, 0.5f * w1.y, 0.5f * w1.z, 0.5f * w1.w};
#pragma unroll
        for (int kk = 0; kk < 4; ++kk) { float acc8[8] = {0.f, 0.f, 0.f, 0.f, 0.f, 0.f, 0.f, 0.f};
#pragma unroll
            for (int h = 0; h < 8; ++h) { const bf16x8 q = qreg[h][kk];
#pragma unroll
                for (int e = 0; e < 8; ++e) acc8[e] = fmaf(wh[h], __builtin_bit_cast(float, (unsigned)(unsigned short)q[e] << 16), acc8[e]); }
            bf16x8 o;
#pragma unroll
            for (int e = 0; e < 8; ++e) { const unsigned u = __builtin_bit_cast(unsigned, acc8[e]); o[e] = (short)((u + 0x7fffu + ((u >> 16) & 1u)) >> 16); }
            qL[kk] = o; } }
    float sc[16];
    { unsigned z0; asm volatile("v_mov_b32 %0, 0" : "=v"(z0)); const uint4 z4 = make_uint4(z0, z0, z0, z0);
        unsigned zoff = (unsigned)tid * 16u; asm volatile("" : "+v"(zoff));
#pragma unroll 1
        for (int i = 0; i < 8; ++i) { *(uint4*)((char*)hist + zoff) = z4; zoff += 8192u; }
        if (tid < 16) *(uint4*)((char*)hist + zoff) = z4; }
    __syncthreads();
    { float s1 = 0.f, s2 = 0.f;
#pragma unroll 1
        for (int u = 0; u < 2; ++u) { const int j = ((ks + 4 * u) * ntile) >> 3; bf16x8 a[4]; load_a(a, kib, j, r32, hi); tile_scores<false>(a, qreg, qL, wvl, sc, kib, 0, r32, hi);
#pragma unroll
            for (int r = 0; r < 16; ++r) { s1 += sc[r]; s2 = fmaf(sc[r], sc[r], s2); } }
        s1 += __shfl_xor(s1, 32); s2 += __shfl_xor(s2, 32);
        { int qo_ = ql; asm volatile("" : "+v"(qo_)); if (hi == 0) stat[ks * 64 + qo_] = make_float2(s1, s2); } }
    __syncthreads();
    { int tq_ = tid; asm volatile("" : "+v"(tq_));
    if (tq_ < 64) { float s1 = 0.f, s2 = 0.f;
#pragma unroll
        for (int k = 0; k < 4; ++k) { const float2 v = stat[k * 64 + tq_]; s1 += v.x; s2 += v.y; }
        const float mu = s1 * (1.f / 256.f); float var = s2 * (1.f / 256.f) - mu * mu; var = var > 0.f ? var : 0.f;
        const float sg = fmaxf(sqrtf(var), 1e-30f); const float zp = z_upper(256.f / (float)n);
        const float lo = mu + (zp - 2.0f) * sg, a = (float)(NBINS - 2) / (4.0f * sg); float bb = 1.f - lo * a;
        float aa = a; if (!(aa < 3.0e38f) || !(fabsf(bb) < 3.0e38f)) { aa = 0.f; bb = 1.f; }
        qpar[tq_] = make_float2(aa, bb); bcnt[tq_] = 0u; if (tq_ == 0) { fb[0] = 0u; fb[100] = 0u; } } }
    __syncthreads();
    { unsigned* hq = hist + ql * HSTR; bf16x8 aC[4]; load_a(aC, kib, ks, r32, hi);
        unsigned cso = (unsigned)(qg * 1024 + lane * 16); asm volatile("" : "+v"(cso));
#pragma unroll 1
        for (int j = ks; j < ntile; j += 4) {
            tile_scores<true>(aC, qreg, qL, wvl, sc, kib, j + 4 < ntile ? j + 4 : j, r32, hi);
            const float2 ab = qpar[ql]; unsigned cw[4];
#pragma unroll
            for (int d = 0; d < 4; ++d) { unsigned w = 0u;
#pragma unroll
                for (int k = 3; k >= 0; --k) { const unsigned bin = (unsigned)__builtin_amdgcn_fmed3f(fmaf(sc[4 * d + k], ab.x, ab.y), 0.f, (float)(NBINS - 1));
                    __hip_atomic_fetch_add(hq + bin, 1u, __ATOMIC_RELAXED, __HIP_MEMORY_SCOPE_WORKGROUP); w = (w << 8) | bin; }
                cw[d] = w; }
            *(uint4*)(codes + (size_t)(unsigned)(j * 2048) + cso) = make_uint4(cw[0], cw[1], cw[2], cw[3]); } }
    }
    __syncthreads();
#pragma unroll 1
    for (int qq = 0; qq < 8; ++qq) { const int q = wid * 8 + qq; int lo_ = lane; asm volatile("" : "+v"(lo_)); const unsigned* hp = hist + q * HSTR + 4 * lo_; const unsigned hb[4] = {hp[0], hp[1], hp[2], hp[3]};
        const unsigned ls = (hb[0] + hb[1]) + (hb[2] + hb[3]);
        unsigned T = ls;
#pragma unroll
        for (int o = 1; o < 64; o <<= 1) { const unsigned v = __shfl_down(T, o); if (lane + o < 64) T += v; }
        const u64 bal = __ballot(T >= (unsigned)TOPK); const int lstar = 63 - __builtin_clzll(bal);
        if (lane == lstar) { unsigned acc = T - ls; int bsel = 0;
#pragma unroll
            for (int i = 3; i >= 0; --i) { if (acc + hb[i] >= (unsigned)TOPK) { bsel = i; break; } acc += hb[i]; }
            bstar[q] = 4 * lane + bsel; needv[q] = (int)(TOPK - acc); } }
    __syncthreads();
    { unsigned cso = (unsigned)(qg * 1024 + lane * 16); asm volatile("" : "+v"(cso));
        const unsigned bs = (unsigned)bstar[ql]; const unsigned bsx = bs * 0x01010101u; const unsigned qtag = (unsigned)ql << 14;
#define IDX_LDC(jj) (*(const uint4*)(codes + (size_t)(unsigned)(((jj) < ntile ? (jj) : ks) * 2048) + cso))
#define IDX_SEL(D, K) asm volatile("v_cmp_gt_u32_sdwa vcc, %2, %3 src0_sel:BYTE_" #K " src1_sel:DWORD\n\ts_nop 3\n\tv_writelane_b32 %0, vcc_lo, %4\n\tv_writelane_b32 %1, vcc_hi, %4" \
                : "+v"(mlo), "+v"(mhi) : "v"(cwd[D]), "v"(bs), "n"(4 * (D) + (K)) : "vcc")
#define IDX_PROC(CUR, jj) do { const int j_ = (jj); const unsigned cwd[4] = {CUR.x, CUR.y, CUR.z, CUR.w}; unsigned mlo = 0u, mhi = 0u;                                  \
            IDX_SEL(0, 0); IDX_SEL(0, 1); IDX_SEL(0, 2); IDX_SEL(0, 3); IDX_SEL(1, 0); IDX_SEL(1, 1); IDX_SEL(1, 2); IDX_SEL(1, 3);                                       \
            IDX_SEL(2, 0); IDX_SEL(2, 1); IDX_SEL(2, 2); IDX_SEL(2, 3); IDX_SEL(3, 0); IDX_SEL(3, 1); IDX_SEL(3, 2); IDX_SEL(3, 3);                                       \
            if (lane < 16) mw[(size_t)j_ * 16 + lane] = ((u64)mhi << 32) | mlo;                  \
                                     \
            _Pragma("unroll") for (int d = 0; d < 4; ++d) { const unsigned x = cwd[d] ^ bsx; const unsigned hz = (x - 0x01010101u) & ~x & 0x80808080u;                   \
                if (__ballot(hz != 0u)) {                                                                                                                                \
                    _Pragma("unroll") for (int k = 0; k < 4; ++k) { const bool eq = ((cwd[d] >> (8 * k)) & 255u) == bs;                                                  \
                        if (eq) { const unsigned pos = __hip_atomic_fetch_add(&fb[100], 1u, __ATOMIC_RELAXED, __HIP_MEMORY_SCOPE_WORKGROUP);                             \
                            if (pos < (unsigned)FCAP) fl[pos] = qtag | (unsigned)(j_ * 32 + crow(4 * d + k, hi)); } } } } } while (0)
        uint4 cA = IDX_LDC(ks), cB = IDX_LDC(ks + 4), cC = IDX_LDC(ks + 8), cD = IDX_LDC(ks + 12);
#pragma unroll 1
        for (int j = ks; j < ntile; j += 16) {
            IDX_PROC(cA, j); cA = IDX_LDC(j + 16);
            if (j + 4 < ntile) { IDX_PROC(cB, j + 4); cB = IDX_LDC(j + 20); }
            if (j + 8 < ntile) { IDX_PROC(cC, j + 8); cC = IDX_LDC(j + 24); }
            if (j + 12 < ntile) { IDX_PROC(cD, j + 12); cD = IDX_LDC(j + 28); }
        }
#undef IDX_PROC
#undef IDX_SEL
#undef IDX_LDC
        for (int j = ntile + ks; j < jend; j += 4) if (lane < 16) mw[(size_t)j * 16 + lane] = 0ull; }
    __syncthreads();
    { const unsigned nfl = fb[100] < (unsigned)FCAP ? fb[100] : (unsigned)FCAP; const float* wv = (const float*)(lds + OFF_WV); unsigned* blq = (unsigned*)(lds + OFF_HIST);
        unsigned ti_ = (unsigned)tid; asm volatile("" : "+v"(ti_));
#pragma unroll 1
        for (unsigned i = ti_; i < nfl; i += 512u) { const unsigned e = fl[i]; const int q = (int)(e >> 14), key = (int)(e & 16383u);
            const uint4* kp = (const uint4*)(kib + (size_t)key * 128); float kf[64];
#pragma unroll
            for (int cc = 0; cc < 8; ++cc) { const uint4 w = kp[cc];
                kf[8 * cc] = __builtin_bit_cast(float, w.x << 16); kf[8 * cc + 1] = __builtin_bit_cast(float, w.x & 0xffff0000u); kf[8 * cc + 2] = __builtin_bit_cast(float, w.y << 16); kf[8 * cc + 3] = __builtin_bit_cast(float, w.y & 0xffff0000u);
                kf[8 * cc + 4] = __builtin_bit_cast(float, w.z << 16); kf[8 * cc + 5] = __builtin_bit_cast(float, w.z & 0xffff0000u); kf[8 * cc + 6] = __builtin_bit_cast(float, w.w << 16); kf[8 * cc + 7] = __builtin_bit_cast(float, w.w & 0xffff0000u); }
            const char* qp = (const char*)QI + (size_t)(unsigned)(row0 + q) * 1024; float s = 0.f;
#pragma unroll 4
            for (int h = 0; h < 8; ++h) { float d = 0.f; const uint4* qh = (const uint4*)(qp + h * 128);
#pragma unroll
                for (int cc = 0; cc < 8; ++cc) { const uint4 w = qh[cc];
                    d = fmaf(__builtin_bit_cast(float, w.x << 16), kf[8 * cc], d); d = fmaf(__builtin_bit_cast(float, w.x & 0xffff0000u), kf[8 * cc + 1], d);
                    d = fmaf(__builtin_bit_cast(float, w.y << 16), kf[8 * cc + 2], d); d = fmaf(__builtin_bit_cast(float, w.y & 0xffff0000u), kf[8 * cc + 3], d);
                    d = fmaf(__builtin_bit_cast(float, w.z << 16), kf[8 * cc + 4], d); d = fmaf(__builtin_bit_cast(float, w.z & 0xffff0000u), kf[8 * cc + 5], d);
                    d = fmaf(__builtin_bit_cast(float, w.w << 16), kf[8 * cc + 6], d); d = fmaf(__builtin_bit_cast(float, w.w & 0xffff0000u), kf[8 * cc + 7], d); }
                s = fmaf(2.f * wv[q * 8 + h], fmaxf(d, 0.f), s); }
            const float2 ab = qpar[q]; const float u = fmaf(s, ab.x, ab.y);
            const unsigned fine = (unsigned)__builtin_amdgcn_fmed3f((u - (float)bstar[q]) * 262144.f, 0.f, 262143.f);
            const unsigned pos = __hip_atomic_fetch_add(&bcnt[q], 1u, __ATOMIC_RELAXED, __HIP_MEMORY_SCOPE_WORKGROUP);
            const unsigned word = (fine << 14) | (16383u - (unsigned)key); fl[FCAP + i] = word;
            if (pos < (unsigned)CAP) blq[q * CAP + pos] = word; } }
    asm volatile("s_waitcnt vmcnt(0)" ::: "memory");
    __syncthreads();
    { const bool flat_over = fb[100] > (unsigned)FCAP; const unsigned nfl = flat_over ? (unsigned)FCAP : fb[100]; const unsigned* blq = (const unsigned*)(lds + OFF_HIST);
        unsigned ti_ = (unsigned)tid; asm volatile("" : "+v"(ti_));
        if (ti_ < 64u) { const int q = (int)ti_; if (flat_over || bcnt[q] > (unsigned)CAP || bstar[q] <= 0 || bstar[q] >= NBINS - 1 || (DBG_FORCE_FB && (q & 15) == 3)) {
            const unsigned p = __hip_atomic_fetch_add(&fb[0], 1u, __ATOMIC_RELAXED, __HIP_MEMORY_SCOPE_WORKGROUP); fb[1 + p] = (unsigned)q; } }
        if (!flat_over) {
#pragma unroll 1
        for (unsigned i = ti_; i < nfl; i += 512u) { const unsigned ef = fl[i]; const int q = (int)(ef >> 14); const unsigned cnt = bcnt[q];
            if (cnt > (unsigned)CAP || bstar[q] <= 0 || bstar[q] >= NBINS - 1 || (DBG_FORCE_FB && (q & 15) == 3)) continue;
            const unsigned mine = fl[FCAP + i];
            const unsigned* bl = blq + q * CAP; int rk = 0;
            for (unsigned m = 0; m < cnt; ++m) rk += bl[m] > mine;
            if (rk < needv[q]) mask_or_bit(MASKW + ((size_t)(b * (S / 32) + 2 * c + (q >> 5)) * (S / 32)) * 16, q & 31, (int)(16383u - (mine & 16383u))); } } }
    __syncthreads();
    { const int nfb = (int)fb[0];
        for (int f = 0; f < nfb; ++f) { const int q = (int)fb[1 + f];
            fallback_query(lds, tid, row0 + q, q & 31, n, QI, kib, WI, MASKW + ((size_t)(b * (S / 32) + 2 * c + (q >> 5)) * (S / 32)) * 16); } }
    __syncthreads();
}
__device__ __forceinline__ void indexer_phase(char* lds, int vcu, int G, const bf16* QI, const bf16* KI, const float* WI, u64* MASKW, char* area_out, char* area_tail, char* area_gap, char* area_wai) {
    for (int item = vcu; item < 256; item += G) { const int b = (item >> 7) & 1, x = item & 127;
        const unsigned cum = (unsigned)(256 * x - x * (x - 1) / 2);
        char* codes = b == 0 ? area_out + (size_t)cum * 4096 : x < 33 ? area_out + (size_t)(24640u + cum) * 4096 : x < 73 ? area_tail + (size_t)(cum - 7920u) * 4096 : x < 115 ? area_gap + (size_t)(cum - 16060u) * 4096 : area_wai + (size_t)(cum - 22885u) * 4096;
#pragma unroll 1
        for (int pass = 0; pass < 2; ++pass) indexer_unit(lds, b, pass ? 255 - x : x, QI, KI, WI, MASKW, codes); }
}
}
namespace att {
typedef unsigned short bf16;
typedef short bf16x8 __attribute__((ext_vector_type(8)));
typedef short s16x4 __attribute__((ext_vector_type(4)));
typedef float f32x16 __attribute__((ext_vector_type(16)));
typedef float f32x4 __attribute__((ext_vector_type(4)));
typedef unsigned u32x4 __attribute__((ext_vector_type(4)));
typedef unsigned long long u64;
typedef const __attribute__((address_space(4))) u64* cu64p;
typedef float f32x2_t __attribute__((ext_vector_type(2))); typedef __bf16 bf16x2_t __attribute__((ext_vector_type(2)));
__device__ __forceinline__ unsigned cvtpk_s(float lo, float hi) { f32x2_t v = {lo, hi}; bf16x2_t b = __builtin_convertvector(v, bf16x2_t); return __builtin_bit_cast(unsigned, b); }
constexpr int D = 128, PITCH = 1024, NW = 8, QBLK = 32, KVBLK = 64, QB = NW * QBLK;
constexpr int SHM_V = KVBLK * D * 2, SHM_K = KVBLK * D * 2;
constexpr int NBUF = 4;
constexpr int OFF_WS = NBUF * SHM_V + NBUF * SHM_K;
constexpr int OFF_TAB = OFF_WS + NW * 64 * 4;
constexpr int OFF_EP = 0;
constexpr int EP_PITCH = 272, EP_WAVE = 32 * EP_PITCH;
constexpr int ATTN_LDS_BYTES = OFF_TAB + 448 * 4;
static_assert(NW * EP_WAVE <= OFF_WS, "epilogue staging fits the ring");
constexpr float THR2 = 11.5f;
constexpr int MW_PER_QB = (S / 32) * 16;

#define KSWZ(row, colB) ((row) * 256 + ((colB) ^ (((row) & 7) << 4)))
#define SBAR() __builtin_amdgcn_sched_barrier(0)
__device__ __forceinline__ int v_st(int k, int c) { const int kk = (k & ~0xC) | ((k & 4) << 1) | ((k & 8) >> 1); return ((kk >> 3) * 4 + (c >> 5)) * 512 + ((kk & 7) * 32 + (c & 31)) * 2; }
__device__ __forceinline__ int v_st_nat(int k, int c) { return ((k >> 3) * 4 + (c >> 5)) * 512 + ((k & 7) * 32 + (c & 31)) * 2; }
__device__ __forceinline__ int v_rd_base(int lane) { return ((lane & 3) << 3) | (((lane >> 2) & 3) << 6) | (((lane >> 4) & 1) << 5) | (((lane >> 5) & 1) << 8); }
constexpr int v_rd_off(int d0, int ks, int half) { return d0 * 512 + ks * 4096 + half * 2048; }
__device__ __forceinline__ int crow(int r, int hi) { return (r & 3) + 8 * (r >> 2) + 4 * hi; }
__device__ __forceinline__ unsigned cvtpk(float lo, float hi) { unsigned r; asm volatile("v_cvt_pk_bf16_f32 %0, %1, %2" : "=v"(r) : "v"(lo), "v"(hi)); return r; }

template <bool NEAR>
__device__ __forceinline__ void init_tile(f32x16& p0, f32x16& p1, cu64p w, float cb  , const float* tabp, float mcur) {
    const float NEG = -__builtin_inff();
    u64 m0[16], m1[16];
#pragma unroll
    for (int r = 0; r < 16; ++r) { m0[r] = w[r]; m1[r] = w[16 + r]; }
#pragma unroll
    for (int r = 0; r < 16; ++r) { float bv = cb; if (NEAR) bv = tabp[59 - ((r & 3) + 8 * (r >> 2))] - mcur;
        float o; asm volatile("v_cndmask_b32_e64 %0, %1, %2, %3" : "=v"(o) : "v"(NEG), "v"(bv), "s"(m0[r])); p0[r] = o; }
#pragma unroll
    for (int r = 0; r < 16; ++r) { float bv = cb; if (NEAR) bv = tabp[27 - ((r & 3) + 8 * (r >> 2))] - mcur;
        float o; asm volatile("v_cndmask_b32_e64 %0, %1, %2, %3" : "=v"(o) : "v"(NEG), "v"(bv), "s"(m1[r])); p1[r] = o; }
}
__device__ __forceinline__ void partialSM(f32x16& p0, f32x16& p1, float& m_reg, float& alpha, float l_cur, float pmax_in) {
    float pmax = pmax_in;
    { auto rr = __builtin_amdgcn_permlane32_swap(__float_as_uint(pmax), __float_as_uint(pmax), false, false);
      pmax = fmaxf(__uint_as_float(rr[0]), __uint_as_float(rr[1])); }
    const bool low = pmax < -64.f && pmax > -__builtin_inff();
    alpha = 1.f;
    if (__builtin_expect(__any(pmax > THR2 || low), 0)) {
        float delta = 0.f;
        if (pmax > THR2) { delta = pmax; alpha = __builtin_amdgcn_exp2f(-delta); }
        else if (low && l_cur == 0.f) delta = pmax;
        m_reg += delta;
#pragma unroll
        for (int r = 0; r < 16; ++r) p0[r] = p0[r] - delta;
#pragma unroll
        for (int r = 0; r < 16; ++r) p1[r] = p1[r] - delta; }
#pragma unroll
    for (int r = 0; r < 16; ++r) p0[r] = __builtin_amdgcn_exp2f(p0[r]);
}
__device__ __forceinline__ void finishSM(f32x16& p0, f32x16& p1, float alpha, float& l_reg, bf16x8& pa0, bf16x8& pa1, bf16x8& pa2, bf16x8& pa3) {
#pragma unroll
    for (int r = 0; r < 16; ++r) p1[r] = __builtin_amdgcn_exp2f(p1[r]);
    float ps = 0;
#pragma unroll
    for (int r = 0; r < 16; ++r) ps += p0[r];
#pragma unroll
    for (int r = 0; r < 16; ++r) ps += p1[r];
    { auto rr = __builtin_amdgcn_permlane32_swap(__float_as_uint(ps), __float_as_uint(ps), false, false);
      ps = __uint_as_float(rr[0]) + __uint_as_float(rr[1]); }
    l_reg = l_reg * alpha + ps;
#define PK4(P, B_, OUT) do { u32x4 w = {cvtpk(P[B_+0], P[B_+1]), cvtpk(P[B_+2], P[B_+3]), cvtpk(P[B_+4], P[B_+5]), cvtpk(P[B_+6], P[B_+7])};   \
        OUT = *reinterpret_cast<bf16x8*>(&w); } while (0)
    PK4(p0, 0, pa0); PK4(p0, 8, pa1); PK4(p1, 0, pa2); PK4(p1, 8, pa3);
#undef PK4
}
template <int KB>
__device__ __forceinline__ void qkt(f32x16& p0, f32x16& p1, const char* K_lds, int r32, int hi, const bf16x8* qr) {
    const char* kb[4];
#pragma unroll
    for (int dd = 0; dd < 4; ++dd) kb[dd] = K_lds + KB * SHM_K + KSWZ(r32, (dd * 16 + hi * 8) * 2);
#pragma unroll
    for (int d0 = 0; d0 < 8; ++d0) { const char* a = kb[d0 & 3] + (d0 >> 2) * 128;
        bf16x8 b0 = *reinterpret_cast<const bf16x8*>(a);
        bf16x8 b1 = *reinterpret_cast<const bf16x8*>(a + 32 * 256);
        p0 = __builtin_amdgcn_mfma_f32_32x32x16_bf16(b0, qr[d0], p0, 0, 0, 0);
        p1 = __builtin_amdgcn_mfma_f32_32x32x16_bf16(b1, qr[d0], p1, 0, 0, 0); }
}
template <int VB>
__device__ __forceinline__ void pv_tile(f32x16* o, int vb0, bf16x8 pa0, bf16x8 pa1, bf16x8 pa2, bf16x8 pa3) {
#define TRRD(dst, off) asm volatile("ds_read_b64_tr_b16 %0, %1 offset:%2" : "=&v"(dst) : "v"(vb0), "i"(off) : "memory")
#define PV_D0(d0) do { s16x4 l0, l1, l2, l3, h0, h1, h2, h3; constexpr int b_ = VB * SHM_V + v_rd_off(d0, 0, 0); \
        TRRD(l0, b_); TRRD(h0, b_ + 2048); TRRD(l1, b_ + 4096); TRRD(h1, b_ + 6144); TRRD(l2, b_ + 8192); TRRD(h2, b_ + 10240); TRRD(l3, b_ + 12288); TRRD(h3, b_ + 14336); \
        asm volatile("s_waitcnt lgkmcnt(0)" ::: "memory"); SBAR();   \
        o[d0] = __builtin_amdgcn_mfma_f32_32x32x16_bf16(pa0, (bf16x8){l0[0], l0[1], l0[2], l0[3], h0[0], h0[1], h0[2], h0[3]}, o[d0], 0, 0, 0);   \
        o[d0] = __builtin_amdgcn_mfma_f32_32x32x16_bf16(pa1, (bf16x8){l1[0], l1[1], l1[2], l1[3], h1[0], h1[1], h1[2], h1[3]}, o[d0], 0, 0, 0);   \
        o[d0] = __builtin_amdgcn_mfma_f32_32x32x16_bf16(pa2, (bf16x8){l2[0], l2[1], l2[2], l2[3], h2[0], h2[1], h2[2], h2[3]}, o[d0], 0, 0, 0);   \
        o[d0] = __builtin_amdgcn_mfma_f32_32x32x16_bf16(pa3, (bf16x8){l3[0], l3[1], l3[2], l3[3], h3[0], h3[1], h3[2], h3[3]}, o[d0], 0, 0, 0); } while (0)
    PV_D0(0); PV_D0(1); PV_D0(2); PV_D0(3);
#undef PV_D0
#undef TRRD
}

template <int VB>
__device__ __forceinline__ float pv_tile_max(f32x16* o, int vb0, bf16x8 pa0, bf16x8 pa1, bf16x8 pa2, bf16x8 pa3, const f32x16& p0, const f32x16& p1) {
#define TRRD(dst, off) asm volatile("ds_read_b64_tr_b16 %0, %1 offset:%2" : "=&v"(dst) : "v"(vb0), "i"(off) : "memory")
#define MX3(a, b, c) fmaxf(fmaxf(a, b), c)
#define PV_D0(d0, HOOK) do { s16x4 l0, l1, l2, l3, h0, h1, h2, h3; constexpr int b_ = VB * SHM_V + v_rd_off(d0, 0, 0); \
        TRRD(l0, b_); TRRD(h0, b_ + 2048); TRRD(l1, b_ + 4096); TRRD(h1, b_ + 6144); TRRD(l2, b_ + 8192); TRRD(h2, b_ + 10240); TRRD(l3, b_ + 12288); TRRD(h3, b_ + 14336); \
        HOOK; asm volatile("s_waitcnt lgkmcnt(0)" ::: "memory"); SBAR();   \
        o[d0] = __builtin_amdgcn_mfma_f32_32x32x16_bf16(pa0, (bf16x8){l0[0], l0[1], l0[2], l0[3], h0[0], h0[1], h0[2], h0[3]}, o[d0], 0, 0, 0);   \
        o[d0] = __builtin_amdgcn_mfma_f32_32x32x16_bf16(pa1, (bf16x8){l1[0], l1[1], l1[2], l1[3], h1[0], h1[1], h1[2], h1[3]}, o[d0], 0, 0, 0);   \
        o[d0] = __builtin_amdgcn_mfma_f32_32x32x16_bf16(pa2, (bf16x8){l2[0], l2[1], l2[2], l2[3], h2[0], h2[1], h2[2], h2[3]}, o[d0], 0, 0, 0);   \
        o[d0] = __builtin_amdgcn_mfma_f32_32x32x16_bf16(pa3, (bf16x8){l3[0], l3[1], l3[2], l3[3], h3[0], h3[1], h3[2], h3[3]}, o[d0], 0, 0, 0); } while (0)
    float m;
    PV_D0(0, m = MX3(p0[0], p0[1], p0[2]); m = MX3(m, p0[3], p0[4]); m = MX3(m, p0[5], p0[6]); m = MX3(m, p0[7], p0[8]));
    PV_D0(1, m = MX3(m, p0[9], p0[10]); m = MX3(m, p0[11], p0[12]); m = MX3(m, p0[13], p0[14]); m = MX3(m, p0[15], p1[0]));
    PV_D0(2, m = MX3(m, p1[1], p1[2]); m = MX3(m, p1[3], p1[4]); m = MX3(m, p1[5], p1[6]); m = MX3(m, p1[7], p1[8]));
    PV_D0(3, m = MX3(m, p1[9], p1[10]); m = MX3(m, p1[11], p1[12]); m = MX3(m, p1[13], p1[14]); m = fmaxf(m, p1[15]));
#undef PV_D0
#undef MX3
#undef TRRD
    return m;
}

struct BlockRef { const bf16* Q; const bf16* K; const bf16* V; const bf16* ZS; bf16* O; const u64* MW; const float* bias; int P0; };
struct Seam { bf16x8 qr[8]; bf16x8 st_v0, st_v1, st_k0, st_k1; };
#define ROW(p, k0, rr) ((const bf16*)((const char*)(p) + (size_t)(unsigned)(((k0) + (rr)) * (PITCH * 2) + sc * 2)))
#define VMW() asm volatile("s_waitcnt vmcnt(0)" ::: "memory")
#define VMWN(n) asm volatile("s_waitcnt vmcnt(%0)" :: "i"(n) : "memory")
#define LD8(p) (*reinterpret_cast<const bf16x8*>(p))
#define SLOAD_H(Kp, Vp, k0) do { S.st_v0 = LD8(ROW(Vp, k0, sr)); S.st_v1 = LD8(ROW(Vp, k0, 32 + sr)); S.st_k0 = LD8(ROW(Kp, k0, sr)); S.st_k1 = LD8(ROW(Kp, k0, 32 + sr)); } while (0)
#define SWRITE_HK(bf) do { *(bf16x8*)(K_lds + (bf) * SHM_K + kws) = S.st_k0; *(bf16x8*)(K_lds + (bf) * SHM_K + kws + 32 * 256) = S.st_k1; } while (0)
#define SWRITE_HV(bf) do { *(bf16x8*)(V_lds + (bf) * SHM_V + vst0) = S.st_v0; *(bf16x8*)(V_lds + (bf) * SHM_V + vst1) = S.st_v1; } while (0)
#define SWRITE_H(bf) do { SWRITE_HV(bf); SWRITE_HK(bf); } while (0)
__device__ __forceinline__ void attn_block(const BlockRef& cur, char* lds) {
    Seam S;
    int tid_ = threadIdx.x; asm volatile("" : "+v"(tid_));
    const int tid = tid_, wid = __builtin_amdgcn_readfirstlane(tid >> 6), lane = tid & 63, r32 = lane & 31, hi = lane >> 5;
    const int NT = (cur.P0 + QB) / KVBLK;
    const int qlo = cur.P0 + wid * QBLK;
    char* V_lds = lds; char* K_lds = lds + NBUF * SHM_V;
    float* ws = (float*)(lds + OFF_WS) + wid * 64; float* li_l = ws, * al_l = ws + 32;
    float* tab = (float*)(lds + OFF_TAB);
    float m_reg = 0.f, l_reg = 0; f32x16 o[4] = {};
    const int sr = tid >> 4, sc = (tid & 15) * 8, vst0 = v_st_nat(sr, sc), vst1 = v_st_nat(32 + sr, sc), kws = KSWZ(sr, sc * 2);
    const int vb0 = (int)(uintptr_t)V_lds + v_rd_base(lane);
    const bf16* Kh = cur.K; const bf16* Vh = cur.V;
    { int tq_ = tid; asm volatile("" : "+v"(tq_));
    if (tq_ < 448) { const int rel = tq_ - 256; const int ret = rel < 0 ? 16 : 0; const int n = rel < 0 ? -rel : rel; int v;
        if (n < 8) v = n; else if (n < 12) v = 8; else if (n < 16) v = 9; else if (n < 23) v = 10; else if (n < 32) v = 11; else if (n < 46) v = 12; else if (n < 64) v = 13; else if (n < 91) v = 14; else v = 15;
        tab[tq_] = cur.bias[(ret + v) * 8] * 1.4426950408889634f; } }
    const float cbfar = cur.bias[15 * 8] * 1.4426950408889634f;
    const cu64p mwv = (cu64p)(uintptr_t)(cur.MW + (size_t)wid * MW_PER_QB);
#define RESC(a) do { if (__any((a) < 1.f)) { if (hi == 0) al_l[r32] = (a); asm volatile("s_waitcnt lgkmcnt(0)" ::: "memory");              \
                     for (int d_ = 0; d_ < 4; ++d_) for (int r = 0; r < 16; ++r) o[d_][r] *= al_l[crow(r, hi)]; } } while (0)
#define KBASE(t) ((t) * KVBLK)
#define INIT(P0_, P1_, t) do { const int kb_ = KBASE(t); const cu64p w_ = mwv + (size_t)(t) * 32;                              \
        if (kb_ + 154 <= qlo) init_tile<false>(P0_, P1_, w_, cbfar - m_reg, tab, m_reg);                                        \
        else init_tile<true>(P0_, P1_, w_, cbfar - m_reg, tab + (qlo + r32 - kb_ - 4 * hi + 197), m_reg); } while (0)
    unsigned pm0 = 0u, pm1 = 0u, pm2 = 0u, pm3 = 0u;
#define MPREF(t) do { const __attribute__((address_space(4))) unsigned* w_ = (const __attribute__((address_space(4))) unsigned*)(mwv + (size_t)(t) * 32); pm0 = w_[0]; pm1 = w_[16]; pm2 = w_[32]; pm3 = w_[48]; SBAR(); } while (0)
#define MUSE() asm volatile("" :: "s"(pm0), "s"(pm1), "s"(pm2), "s"(pm3))
    f32x16 pA0, pA1, pB0, pB1; float alA, alB; bf16x8 pa0, pa1, pa2, pa3;
#pragma unroll
    for (int d0 = 0; d0 < 8; ++d0) S.qr[d0] = LD8((const char*)cur.Q + (size_t)(unsigned)((wid * QBLK + r32) * (PITCH * 2) + d0 * 32 + hi * 16));
    SLOAD_H(Kh, Vh, 0); VMW(); SWRITE_H(0); SBAR();
    if (NT > 1) SLOAD_H(Kh, Vh, KBASE(1));
    __syncthreads();
    INIT(pA0, pA1, 0);
    SBAR(); qkt<0>(pA0, pA1, K_lds, r32, hi, S.qr);
    MPREF(1);
    { float pm_ = pA0[0];
#pragma unroll
      for (int r = 1; r < 16; ++r) pm_ = fmaxf(pm_, pA0[r]);
#pragma unroll
      for (int r = 0; r < 16; ++r) pm_ = fmaxf(pm_, pA1[r]);
      partialSM(pA0, pA1, m_reg, alA, l_reg, pm_); }
    if (NT > 1) { VMW(); SWRITE_H(1); }
    __syncthreads();
#define HALF_STEP(PX0, PX1, alX, PY0, PY1, alY, t, KB, VB, SB) do {                                                           \
        MUSE(); INIT(PX0, PX1, (t)); SBAR(); qkt<KB>(PX0, PX1, K_lds, r32, hi, S.qr);                                        \
        finishSM(PY0, PY1, alY, l_reg, pa0, pa1, pa2, pa3); SBAR();                                                           \
        SLOAD_H(Kh, Vh, KBASE((t) + 1)); SBAR();                                                                              \
        { const float pm_ = pv_tile_max<VB>(o, vb0, pa0, pa1, pa2, pa3, PX0, PX1); MPREF((t) + 1); partialSM(PX0, PX1, m_reg, alX, l_reg, pm_); }   \
        VMW(); SWRITE_H(SB);                                                                                                  \
        RESC(alX); __syncthreads(); } while (0)
    int t = 1;
    for (; t + 4 < NT; t += 4) {
        HALF_STEP(pB0, pB1, alB, pA0, pA1, alA, t, 1, 0, 2);
        HALF_STEP(pA0, pA1, alA, pB0, pB1, alB, t + 1, 2, 1, 3);
        HALF_STEP(pB0, pB1, alB, pA0, pA1, alA, t + 2, 3, 2, 0);
        HALF_STEP(pA0, pA1, alA, pB0, pB1, alB, t + 3, 0, 3, 1);
    }
    HALF_STEP(pB0, pB1, alB, pA0, pA1, alA, NT - 3, 1, 0, 2);
    HALF_STEP(pA0, pA1, alA, pB0, pB1, alB, NT - 2, 2, 1, 3);
    MUSE(); INIT(pB0, pB1, NT - 1); SBAR(); qkt<3>(pB0, pB1, K_lds, r32, hi, S.qr); SBAR();
    finishSM(pA0, pA1, alA, l_reg, pa0, pa1, pa2, pa3); SBAR();
    { const float pm_ = pv_tile_max<2>(o, vb0, pa0, pa1, pa2, pa3, pB0, pB1); partialSM(pB0, pB1, m_reg, alB, l_reg, pm_); } RESC(alB);
    finishSM(pB0, pB1, alB, l_reg, pa0, pa1, pa2, pa3); SBAR(); pv_tile<3>(o, vb0, pa0, pa1, pa2, pa3);
    SBAR();
    __syncthreads();
    if (hi == 0) li_l[r32] = l_reg; asm volatile("s_waitcnt lgkmcnt(0)" ::: "memory");
    float rli[16];
#pragma unroll
    for (int r = 0; r < 16; ++r) rli[r] = __builtin_amdgcn_rcpf(li_l[crow(r, hi)]);
    {
        char* ep = lds + OFF_EP + wid * EP_WAVE; unsigned ew_off = (unsigned)(4 * hi * EP_PITCH + r32 * 2); asm volatile("" : "+v"(ew_off));
#pragma unroll
        for (int r = 0; r < 16; ++r) { const int rw = (r & 3) + 8 * (r >> 2);
#pragma unroll
            for (int d0 = 0; d0 < 4; ++d0) *(unsigned short*)(ep + ew_off + rw * EP_PITCH + d0 * 64) = (unsigned short)(cvtpk_s(o[d0][r] * rli[r], 0.f) & 0xffffu); }
        asm volatile("s_waitcnt lgkmcnt(0)" ::: "memory");
        unsigned lane_off = (unsigned)((wid * QBLK + (lane >> 4)) * PITCH + (lane & 15) * 8) * 2u;
        asm volatile("" : "+v"(lane_off));
        unsigned er_off = (unsigned)((lane >> 4) * EP_PITCH + (lane & 15) * 16); asm volatile("" : "+v"(er_off));
        char* op = (char*)cur.O + (size_t)lane_off; const char* zp = (const char*)cur.ZS + (size_t)lane_off; const char* er = ep + er_off;
#pragma unroll
        for (int ph = 0; ph < 2; ++ph) {
            asm volatile("" ::: "memory");
            uint4 zz[4];
#pragma unroll
            for (int p4 = 0; p4 < 4; ++p4) zz[p4] = *(const uint4*)(zp + (ph * 4 + p4) * 4 * PITCH * 2);
#pragma unroll
            for (int p4 = 0; p4 < 4; ++p4) { const int p = ph * 4 + p4; const uint4 m = *(const uint4*)(er + p * 4 * EP_PITCH); const uint4 z = zz[p4]; uint4 y;
                y.x = cvtpk_s(__uint_as_float(m.x << 16) * __uint_as_float(z.x << 16), __uint_as_float(m.x & 0xffff0000u) * __uint_as_float(z.x & 0xffff0000u));
                y.y = cvtpk_s(__uint_as_float(m.y << 16) * __uint_as_float(z.y << 16), __uint_as_float(m.y & 0xffff0000u) * __uint_as_float(z.y & 0xffff0000u));
                y.z = cvtpk_s(__uint_as_float(m.z << 16) * __uint_as_float(z.z << 16), __uint_as_float(m.z & 0xffff0000u) * __uint_as_float(z.z & 0xffff0000u));
                y.w = cvtpk_s(__uint_as_float(m.w << 16) * __uint_as_float(z.w << 16), __uint_as_float(m.w & 0xffff0000u) * __uint_as_float(z.w & 0xffff0000u));
                *(uint4*)(op + p * 4 * PITCH * 2) = y; } }
    }
    __syncthreads();
#undef RESC
#undef KBASE
#undef INIT
#undef MPREF
#undef MUSE
#undef HALF_STEP
}
#undef ROW
#undef VMW
#undef VMWN
#undef LD8
#undef SLOAD_H
#undef SWRITE_HK
#undef SWRITE_HV
#undef SWRITE_H

__device__ __forceinline__ BlockRef make_ref(int L, int pass, const bf16* Q, const bf16* K, const bf16* V, const bf16* ZS, bf16* O, const u64* MASKW, const float* rel_bias) {
    const int bh = L >> 5, x = L & 31, b = bh >> 3, h = bh & 7, qb = pass ? 63 - x : x;
    BlockRef r; const size_t row0 = (size_t)b * S + (size_t)qb * QB;
    r.Q = Q + row0 * PITCH + h * D; r.O = O + row0 * PITCH + h * D; r.ZS = ZS + row0 * PITCH + h * D;
    r.K = K + (size_t)b * S * PITCH + h * D; r.V = V + (size_t)b * S * PITCH + h * D;
    r.MW = MASKW + ((size_t)b * (S / 32) + (size_t)qb * 8) * MW_PER_QB; r.bias = rel_bias + h; r.P0 = qb * QB;
    return r;
}
__device__ __forceinline__ void attn_phase(char* lds, int vcu, int G, const bf16* Q, const bf16* K, const bf16* V, const bf16* ZS, bf16* O, const u64* MASKW, const float* rel_bias) {
    constexpr int TOTAL = 512;
    for (int L = vcu; L < TOTAL; L += G)
#pragma unroll 1
        for (int pass = 0; pass < 2; ++pass) { const BlockRef cur = make_ref(L, pass, Q, K, V, ZS, O, MASKW, rel_bias); attn_block(cur, lds); }
}
}

namespace sgu {
typedef unsigned short bf16;
typedef short bf16x8 __attribute__((ext_vector_type(8)));
typedef short s16x4 __attribute__((ext_vector_type(4)));
typedef float f32x16 __attribute__((ext_vector_type(16)));
typedef float f32x2_t __attribute__((ext_vector_type(2))); typedef __bf16 bf16x2_t __attribute__((ext_vector_type(2)));
__device__ __forceinline__ unsigned cvtpk_s(float lo, float hi) { f32x2_t v = {lo, hi}; bf16x2_t b = __builtin_convertvector(v, bf16x2_t); return __builtin_bit_cast(unsigned, b); }
constexpr int OFF_B = 0;
constexpr int OFF_ST = 65536;
constexpr int OFF_EP = 66560;
constexpr int EP_PITCH = 80, EP_WAVE = 128 * EP_PITCH;
constexpr int SGU_LDS_BYTES = OFF_EP + 8 * EP_WAVE;

template <bool WRITE>
__device__ __forceinline__ void sgu_phase(char* lds, int vcu, int G, bf16* U  , const bf16* Vb, const float* LNP, const bf16* WS16, const float* ln_g, const float* ln_b, const float* b_s) {
    const int tid = threadIdx.x, wid = __builtin_amdgcn_readfirstlane(tid >> 6), lane = tid & 63, r32 = lane & 31, hi = lane >> 5;
    float2* stats = (float2*)(lds + OFF_ST);
    for (int chunk = vcu; chunk < M / 128; chunk += G) {
        const size_t row0 = (size_t)chunk * 128;
        { int tq_ = tid; asm volatile("" : "+v"(tq_));
          if (tq_ < 128) { const float4* pp = (const float4*)(LNP + (row0 + tq_) * 64); float s1 = 0.f, s2 = 0.f;
#pragma unroll
            for (int j = 0; j < 16; ++j) { const float4 q = pp[j]; s1 += q.x + q.z; s2 += q.y + q.w; }
            const float mean = s1 * (1.f / BW); const float var = fmaxf(s2 * (1.f / BW) - mean * mean, 0.f);
            stats[tq_] = make_float2(mean, 1.0f / sqrtf(var + LN_EPS)); } }
        __syncthreads();
#pragma unroll 1
        for (int g = 0; g < 8; ++g) {
            bf16x8 A0[2], A1[4], A2[6], A3[8];
            uint4 ug[8];
            { const size_t gb_ = (row0 * BW + (size_t)(g * 256 + (wid >> 2) * 128 + (wid & 3) * 32 + (lane & 3) * 8)) * 2;
#pragma unroll
                for (int p = 0; p < 8; ++p) ug[p] = *(const uint4*)((const char*)U + gb_ + (size_t)(16 * p + (lane >> 2)) * (BW * 2)); }
            { const char* ap = (const char*)WS16 + (size_t)(unsigned)(((g * 128 + r32) * 128 + 8 * hi) * 2);
#pragma unroll
                for (int kk = 0; kk < 2; ++kk) A0[kk] = *reinterpret_cast<const bf16x8*>(ap + kk * 32);
#pragma unroll
                for (int kk = 0; kk < 4; ++kk) A1[kk] = *reinterpret_cast<const bf16x8*>(ap + 32 * 256 + kk * 32);
#pragma unroll
                for (int kk = 0; kk < 6; ++kk) A2[kk] = *reinterpret_cast<const bf16x8*>(ap + 64 * 256 + kk * 32);
#pragma unroll
                for (int kk = 0; kk < 8; ++kk) A3[kk] = *reinterpret_cast<const bf16x8*>(ap + 96 * 256 + kk * 32); }
            { const int e8 = (tid & 31) * 8, ch = g * 256 + e8;
                const float4 g0 = *(const float4*)(ln_g + ch), g1 = *(const float4*)(ln_g + ch + 4), b0 = *(const float4*)(ln_b + ch), b1 = *(const float4*)(ln_b + ch + 4);
#pragma unroll
                for (int i = 0; i < 8; ++i) { const int s = (tid >> 5) + 16 * i; const uint4 w = *(const uint4*)(Vb + (row0 + s) * BW + ch); const float2 st = stats[s];
                    const float x0 = (bflo(w.x) - st.x) * st.y * g0.x + b0.x, x1 = (bfhi(w.x) - st.x) * st.y * g0.y + b0.y, x2 = (bflo(w.y) - st.x) * st.y * g0.z + b0.z, x3 = (bfhi(w.y) - st.x) * st.y * g0.w + b0.w;
                    const float x4 = (bflo(w.z) - st.x) * st.y * g1.x + b1.x, x5 = (bfhi(w.z) - st.x) * st.y * g1.y + b1.y, x6 = (bflo(w.w) - st.x) * st.y * g1.z + b1.z, x7 = (bfhi(w.w) - st.x) * st.y * g1.w + b1.w;
                    uint4 o; o.x = att::cvtpk(x0, x1); o.y = att::cvtpk(x2, x3); o.z = att::cvtpk(x4, x5); o.w = att::cvtpk(x6, x7);
                    *(uint4*)(lds + OFF_B + ((s >> 6) * 2 + (e8 >> 7)) * 16384 + att::v_st(s & 63, e8 & 127)) = o; } }
            __syncthreads();
            f32x16 acc[4] = {};
            { const int eh = wid >> 2, d0 = wid & 3;
                const int vb0 = (int)(uintptr_t)(lds + OFF_B) + att::v_rd_base(lane) + eh * 16384 + d0 * 512;
#define TRRD(dst, off) asm volatile("ds_read_b64_tr_b16 %0, %1 offset:%2" : "=&v"(dst) : "v"(vb0), "i"(off) : "memory")
#define BFRAG(dst, sh, ks) do { s16x4 l_, h_; TRRD(l_, (sh) * 32768 + (ks) * 4096); TRRD(h_, (sh) * 32768 + (ks) * 4096 + 2048); asm volatile("s_waitcnt lgkmcnt(0)" ::: "memory"); \
                dst = (bf16x8){l_[0], l_[1], l_[2], l_[3], h_[0], h_[1], h_[2], h_[3]}; } while (0)
                bf16x8 Bf[8];
                BFRAG(Bf[0], 0, 0); BFRAG(Bf[1], 0, 1); BFRAG(Bf[2], 0, 2); BFRAG(Bf[3], 0, 3); BFRAG(Bf[4], 1, 0); BFRAG(Bf[5], 1, 1); BFRAG(Bf[6], 1, 2); BFRAG(Bf[7], 1, 3);
#undef BFRAG
#undef TRRD
#pragma unroll
                for (int kk = 0; kk < 2; ++kk) acc[0] = __builtin_amdgcn_mfma_f32_32x32x16_bf16(A0[kk], Bf[kk], acc[0], 0, 0, 0);
#pragma unroll
                for (int kk = 0; kk < 4; ++kk) acc[1] = __builtin_amdgcn_mfma_f32_32x32x16_bf16(A1[kk], Bf[kk], acc[1], 0, 0, 0);
#pragma unroll
                for (int kk = 0; kk < 6; ++kk) acc[2] = __builtin_amdgcn_mfma_f32_32x32x16_bf16(A2[kk], Bf[kk], acc[2], 0, 0, 0);
#pragma unroll
                for (int kk = 0; kk < 8; ++kk) acc[3] = __builtin_amdgcn_mfma_f32_32x32x16_bf16(A3[kk], Bf[kk], acc[3], 0, 0, 0);
                char* ep = lds + OFF_EP + wid * EP_WAVE;
#pragma unroll
                for (int tb = 0; tb < 4; ++tb)
#pragma unroll
                    for (int r = 0; r < 16; ++r) { const int tl = 32 * tb + (r & 3) + 8 * (r >> 2) + 4 * hi;
                        *(unsigned short*)(ep + tl * EP_PITCH + r32 * 2) = (unsigned short)(cvtpk_s(acc[tb][r], 0.f) & 0xffffu); }
                asm volatile("s_waitcnt lgkmcnt(0)" ::: "memory");
                const int rq = lane >> 2, cq = (lane & 3) * 8;
                const size_t gbase = (row0 * BW + (size_t)(g * 256 + eh * 128 + d0 * 32 + cq)) * 2;
#pragma unroll
                for (int ph = 0; ph < 2; ++ph) {
                    uint4 uu[4], mm[4]; float bs[4];
#pragma unroll
                    for (int p = 0; p < 4; ++p) { const int t = 16 * (ph * 4 + p) + rq; const size_t o = gbase + (size_t)t * (BW * 2);
                        uu[p] = ug[ph * 4 + p]; bs[p] = b_s[g * 128 + t]; mm[p] = *(const uint4*)(ep + t * EP_PITCH + cq * 2); }
#pragma unroll
                    for (int p = 0; p < 4; ++p) { const int t = 16 * (ph * 4 + p) + rq; const size_t o = gbase + (size_t)t * (BW * 2);
                        uint4 y;
                        y.x = att::cvtpk(bflo(uu[p].x) * (bflo(mm[p].x) + bs[p]), bfhi(uu[p].x) * (bfhi(mm[p].x) + bs[p]));
                        y.y = att::cvtpk(bflo(uu[p].y) * (bflo(mm[p].y) + bs[p]), bfhi(uu[p].y) * (bfhi(mm[p].y) + bs[p]));
                        y.z = att::cvtpk(bflo(uu[p].z) * (bflo(mm[p].z) + bs[p]), bfhi(uu[p].z) * (bfhi(mm[p].z) + bs[p]));
                        y.w = att::cvtpk(bflo(uu[p].w) * (bflo(mm[p].w) + bs[p]), bfhi(uu[p].w) * (bfhi(mm[p].w) + bs[p]));
                        if (WRITE || y.x == 0x12345678u) *(uint4*)((char*)U + o) = y; } } }
            __syncthreads();
        }
    }
}
}

constexpr size_t MiB = 1u << 20;
constexpr size_t WS_CTL = 0, CTL_ZERO_BYTES = 64 * 1024;
constexpr size_t WS_WAI = 2 * MiB, WS_WAO = 12 * MiB, WS_WBI = 14 * MiB, WS_WBO = 26 * MiB;
constexpr size_t WS_WS16 = 1 * MiB;
constexpr size_t WS_RS0 = 1 * MiB + 512 * 1024;
constexpr size_t WS_H = 32 * MiB;
constexpr size_t WS_Q = 96 * MiB, WS_K = 160 * MiB, WS_V = 224 * MiB, WS_ZS = 288 * MiB;
constexpr size_t WS_QI = 352 * MiB, WS_KI = 384 * MiB, WS_WI = 388 * MiB;
constexpr size_t WS_MASK = 416 * MiB;
constexpr size_t WS_PS = 30 * MiB;
constexpr size_t WS_XB = 32 * MiB;
constexpr size_t WS_OG = 352 * MiB;
constexpr size_t WS_U = 96 * MiB, WS_VB = 224 * MiB, WS_ZB = 352 * MiB;
constexpr size_t WS_LNP = 352 * MiB;
constexpr size_t WS_TAIL = 480 * MiB;
constexpr size_t WS_END = 512 * MiB;
constexpr int CW_BAR = 1024;
constexpr int LDS_BYTES = 162816;
constexpr int MISC_OFF = 160000;
static_assert(att::ATTN_LDS_BYTES <= MISC_OFF && idx::IDX_LDS_BYTES <= MISC_OFF && sgu::SGU_LDS_BYTES <= MISC_OFF, "LDS map");

#define XB_TMO      128
#define XB_XCNT(j)  (256  + 64 * (j))
#define XB_XSUB(j)  (1280 + 64 * (j))
#define XB_XGEN(j)  (2304 + 64 * (j))
#define XB_TOP      3328
#define XB_TOPGEN   3392
#define XCD_BAR_WORDS 3456
#define XB_SPIN_CAP (1u << 18)
__device__ __forceinline__ unsigned xb_ld(unsigned* p)              { return __hip_atomic_load(p, __ATOMIC_RELAXED, __HIP_MEMORY_SCOPE_AGENT); }
__device__ __forceinline__ unsigned xb_add(unsigned* p, unsigned v) { return __hip_atomic_fetch_add(p, v, __ATOMIC_RELAXED, __HIP_MEMORY_SCOPE_AGENT); }
__device__ __forceinline__ unsigned xb_xcc_id() { return (unsigned)__builtin_amdgcn_s_getreg((3 << 11) | 20) & 0xFu; }
#define XB_SPIN(cond, bar) do { unsigned _sp = 0; while (cond) { __builtin_amdgcn_s_sleep(1); \
    if ((++_sp & 255u) == 0u) { if (xb_ld(&(bar)[XB_TMO])) break; if (_sp > XB_SPIN_CAP) { atomicAdd(&(bar)[XB_TMO], 1u); break; } } } } while (0)
struct XcdBarrier { unsigned* bar; unsigned x; volatile LAS unsigned* st; };
__device__ __forceinline__ XcdBarrier xcd_barrier_post(unsigned* bar, volatile LAS unsigned* st) {
    XcdBarrier b; b.bar = bar; b.x = xb_xcc_id(); b.st = st;
    if (threadIdx.x == 0) (void)xb_add(&bar[XB_XCNT(b.x)], 1u);
    return b;
}
__device__ __forceinline__ void xcd_barrier_complete(unsigned* bar, unsigned x, unsigned& nloc, unsigned& nx) {
    const unsigned G = gridDim.x * gridDim.y * gridDim.z;
    unsigned sum, cnt, mine, sp = 0u;
    for (;;) {
        sum = 0u; cnt = 0u; mine = 0u;
#pragma unroll
        for (unsigned j = 0; j < 16; ++j) { const unsigned c = xb_ld(&bar[XB_XCNT(j)]); sum += c; cnt += (c > 0u) ? 1u : 0u; mine = (j == x) ? c : mine; }
        if (sum == G) break;
        __builtin_amdgcn_s_sleep(1);
        if ((++sp & 255u) == 0u) { if (xb_ld(&bar[XB_TMO])) break; if (sp > XB_SPIN_CAP) { atomicAdd(&bar[XB_TMO], 1u); break; } }
    }
    nloc = mine > 0u ? mine : 1u; nx = cnt > 0u ? cnt : 1u;
}
__device__ __forceinline__ void xcd_barrier(const XcdBarrier& b) {
    asm volatile("s_waitcnt vmcnt(0)" ::: "memory");
    __syncthreads();
    if (threadIdx.x == 0) {
        unsigned* bar = b.bar;
        __builtin_amdgcn_s_waitcnt(0);
        unsigned nloc = b.st[0], nx = b.st[1];
        if (nloc == 0u) { xcd_barrier_complete(bar, b.x, nloc, nx); b.st[0] = nloc; b.st[1] = nx; }
        const unsigned old = xb_add(&bar[XB_XSUB(b.x)], 1u);
        const unsigned gen = old / nloc;
        if (old + 1u == (gen + 1u) * nloc) {
            __builtin_amdgcn_fence(__ATOMIC_RELEASE, "agent");
            asm volatile("s_waitcnt vmcnt(0)" ::: "memory");
            const unsigned og = xb_add(&bar[XB_TOP], 1u);
            const unsigned tg = og / nx;
            if (og + 1u == (tg + 1u) * nx) xb_add(&bar[XB_TOPGEN], 1u);
            else XB_SPIN(xb_ld(&bar[XB_TOPGEN]) == tg, bar);
            __builtin_amdgcn_fence(__ATOMIC_ACQUIRE, "agent");
            xb_add(&bar[XB_XGEN(b.x)], 1u);
            asm volatile("s_waitcnt vmcnt(0)" ::: "memory");
        } else {
            XB_SPIN(xb_ld(&bar[XB_XGEN(b.x)]) == gen, bar);
            __builtin_amdgcn_fence(__ATOMIC_ACQUIRE, "agent");
            asm volatile("s_waitcnt vmcnt(0)" ::: "memory");
        }
    }
    __syncthreads();
}

#ifndef MK_PER_PHASE
#define MK_PER_PHASE 0
#endif
constexpr int NPHASES = 10;
struct Args { const float* in[12]; float* out; unsigned char* ws; int ph_lo, ph_hi; };
__global__ void __launch_bounds__(512, 2) fwd(Args args) {
    extern __shared__ __attribute__((aligned(16))) unsigned char lds[];
    LAS unsigned char* ldsl = (LAS unsigned char*)lds;
    volatile LAS unsigned* MISC = (volatile LAS unsigned*)(ldsl + MISC_OFF);
    const int tid = threadIdx.x, lane = tid & 63, wave = __builtin_amdgcn_readfirstlane(tid >> 6);
    const int G = gridDim.x; const int bx = blockIdx.x; const int vcu = (G % 8 == 0) ? (bx % 8) * (G / 8) + bx / 8 : bx;
    const int gw = vcu * 8 + wave, NGW = G * 8;
    unsigned char* ws = args.ws;
    const float* x = args.in[0]; const float* norm_g = args.in[1]; const float* final_g = args.in[2]; const float* rel_bias = args.in[3];
    const float* a_w_in = args.in[4]; const float* a_w_out = args.in[5]; const float* b_w_in = args.in[6];
    const float* b_ln_g = args.in[7]; const float* b_ln_b = args.in[8]; const float* b_w_s = args.in[9]; const float* b_b_s = args.in[10]; const float* b_w_out = args.in[11];
    float* out = args.out;
    bf16 *WAI = (bf16*)(ws + WS_WAI), *WAO = (bf16*)(ws + WS_WAO), *WBI = (bf16*)(ws + WS_WBI), *WBO = (bf16*)(ws + WS_WBO), *H = (bf16*)(ws + WS_H);
    bf16 *Qb = (bf16*)(ws + WS_Q), *Kb = (bf16*)(ws + WS_K), *Vb = (bf16*)(ws + WS_V), *ZS = (bf16*)(ws + WS_ZS), *QI = (bf16*)(ws + WS_QI), *KI = (bf16*)(ws + WS_KI);
    float* WI = (float*)(ws + WS_WI); bf16* WS16 = (bf16*)(ws + WS_WS16);
    bf16 *U = (bf16*)(ws + WS_U), *V1 = (bf16*)(ws + WS_VB), *Z1 = (bf16*)(ws + WS_ZB), *XB = (bf16*)(ws + WS_XB); float* PS = (float*)(ws + WS_PS);
    if (tid < 32) MISC[tid] = 0u;
    __syncthreads();
    XcdBarrier bar; bar.bar = (unsigned*)(ws + WS_CTL) + CW_BAR; bar.x = 0; bar.st = nullptr;
    if (!MK_PER_PHASE) bar = xcd_barrier_post((unsigned*)(ws + WS_CTL) + CW_BAR, MISC + 8);
    const int lo = args.ph_lo, hi = args.ph_hi;
#ifdef DBG_SKIP
#define IN(k) (((DBG_SKIP >> (k)) & 1) == 0 && lo <= (k) && (k) < hi)
#else
#define IN(k) (lo <= (k) && (k) < hi)
#endif
#ifndef DBG_REPEAT
#define DBG_REPEAT 0
#endif
#define REP(k) _Pragma("unroll 1") for (int rep_ = 0; rep_ < 1 + ((DBG_REPEAT >> (k)) & 1); ++rep_)
#define SEAM(k) do { if (IN(k) && IN((k) + 1)) xcd_barrier(bar); } while (0)

    if (IN(0)) REP(0) {
        LAS float* scr = (LAS float*)ldsl + wave * 64 * 33;
        constexpr int I_AI = 16 * (A_NPAD / 32), I_AO = 16 * 32, I_BI = 16 * (B_COLS / 32), I_BO = 32 * 32;
        for (int it = gw; it < I_AI + I_AO + I_BI + I_BO; it += NGW) {
            int r = it;
            if (r < I_AI) { transpose_item(a_w_in, 1024, A_COLS, A_NPAD, WAI, scr, r, lane, norm_g); continue; } r -= I_AI;
            if (r < I_AO) { transpose_item(a_w_out, 1024, 1024, 1024, WAO, scr, r, lane); continue; } r -= I_AO;
            if (r < I_BI) { transpose_item(b_w_in, 1024, B_COLS, B_COLS, WBI, scr, r, lane, norm_g + DM, true); continue; } r -= I_BI;
            transpose_item(b_w_out, 2048, 1024, 1024, WBO, scr, r, lane);
        }
        for (int i = vcu * 512 + tid; i < 8 * 128 * 128; i += G * 512) WS16[i] = (i & 127) <= ((i >> 7) & 127) ? (bf16)f2bf(b_w_s[i]) : (bf16)0;
        for (int m = gw; m < M; m += NGW) row_to_bf16_rs(x + (size_t)m * DM, H + (size_t)m * DM, (float*)(ws + WS_RS0) + m, lane);
        __syncthreads();
    }
    SEAM(0);
    if (IN(1)) REP(1) {
        pg8::Gemm g{H, WAI, M, A_NPAD, 1024}; pg8::StaticOrder So; So.init(M, A_NPAD, G, bx);
        pg8::EpiA E{Qb, Kb, Vb, ZS, QI, KI, WI, (const float*)(ws + WS_RS0)};
        pg8::gemm_phase<pg8::EpiA, pg8::StaticOrder, true, true>(ldsl, g, So, E);
    }
    SEAM(1);
    if (IN(2)) REP(2) idx::indexer_phase((char*)lds, vcu, G, QI, KI, WI, (idx::u64*)(ws + WS_MASK), (char*)out, (char*)(ws + WS_TAIL), (char*)(ws + WS_WI + 1 * MiB), (char*)(ws + WS_WAI));
    SEAM(2);
    if (IN(3)) REP(3) {
        att::attn_phase((char*)lds, vcu, G, Qb, Kb, Vb, ZS, (bf16*)(ws + WS_OG), (const att::u64*)(ws + WS_MASK), rel_bias); }
    SEAM(3);
    if (IN(4)) REP(4) {
        pg8::Gemm g{(const bf16*)(ws + WS_OG), WAO, M, 1024, 1024}; pg8::StaticOrder So; So.init(M, 1024, G, bx);
        pg8::EpiRes1 E{XB, PS};
        pg8::gemm_phase<pg8::EpiRes1, pg8::StaticOrder, true, true>(ldsl, g, So, E);
    }
    if (IN(4) && IN(6)) xcd_barrier(bar);
    if (IN(6)) REP(6) {
        pg8::Gemm g{XB, WBI, M, B_COLS, 1024}; pg8::StaticOrder So; So.init(M, B_COLS, G, bx);
        pg8::EpiB E{U, V1, PS, (float*)(ws + WS_LNP)};
        pg8::gemm_phase<pg8::EpiB, pg8::StaticOrder, true, true>(ldsl, g, So, E);
    }
    SEAM(6);
#ifdef DBG_SGU2
    if (IN(7)) sgu::sgu_phase<false>((char*)lds, vcu, G, U, V1, (const float*)(ws + WS_LNP), WS16, b_ln_g, b_ln_b, b_b_s);
#endif
    if (IN(7)) sgu::sgu_phase<true>((char*)lds, vcu, G, U, V1, (const float*)(ws + WS_LNP), WS16, b_ln_g, b_ln_b, b_b_s);
    SEAM(7);
    if (IN(8)) REP(8) {
        pg8::Gemm g{U, WBO, M, 1024, 2048}; pg8::StaticOrder So; So.init(M, 1024, G, bx);
        pg8::EpiRes2 E{XB};
        pg8::gemm_phase<pg8::EpiRes2, pg8::StaticOrder, true, true>(ldsl, g, So, E);
    }
    SEAM(8);
    if (IN(9)) REP(9) { for (int m = gw; m < M; m += NGW) rms_row_bf16_to_f32(XB + (size_t)m * DM, final_g, out + (size_t)m * DM, lane); }
#undef IN
#undef SEAM
}

extern "C" void kernel_launch(void* const* d_in, const int* in_sizes, int n_in, void* d_out, int out_size, void* d_ws, size_t ws_size, hipStream_t stream) {
    static int grid = 0;
    if (grid == 0) {
        if (n_in != 12 || in_sizes[0] != M * DM || out_size != M * DM || ws_size < WS_END) { fprintf(stderr, "kernel_launch: unexpected shapes (n_in %d, in0 %d, out %d, ws %zu)\n", n_in, n_in > 0 ? in_sizes[0] : -1, out_size, ws_size); grid = -1; return; }
        int dev = 0, cus = 0, per_cu = 0;
        if (hipGetDevice(&dev) != hipSuccess || hipDeviceGetAttribute(&cus, hipDeviceAttributeMultiprocessorCount, dev) != hipSuccess) { fprintf(stderr, "kernel_launch: device query failed\n"); grid = -1; return; }
        if (hipFuncSetAttribute((const void*)fwd, hipFuncAttributeMaxDynamicSharedMemorySize, LDS_BYTES) != hipSuccess) { fprintf(stderr, "kernel_launch: hipFuncSetAttribute failed\n"); grid = -1; return; }
        if (hipOccupancyMaxActiveBlocksPerMultiprocessor(&per_cu, (const void*)fwd, 512, LDS_BYTES) != hipSuccess || per_cu < 1) { fprintf(stderr, "kernel_launch: occupancy query says %d workgroups per CU\n", per_cu); }
        (void)hipGetLastError();
        grid = cus;
    }
    if (grid < 0) return;
    if (hipMemsetAsync((char*)d_ws + WS_CTL, 0, CTL_ZERO_BYTES, stream) != hipSuccess) { fprintf(stderr, "kernel_launch: memset failed\n"); return; }
    Args a{};
    for (int i = 0; i < 12; ++i) a.in[i] = (const float*)d_in[i];
    a.out = (float*)d_out; a.ws = (unsigned char*)d_ws;
#if MK_PER_PHASE
    for (int p = 0; p < NPHASES; ++p) { a.ph_lo = p; a.ph_hi = p + 1; hipLaunchKernelGGL(fwd, dim3(grid), dim3(512), LDS_BYTES, stream, a); }
#else
    a.ph_lo = 0; a.ph_hi = NPHASES;
    hipLaunchKernelGGL(fwd, dim3(grid), dim3(512), LDS_BYTES, stream, a);
#endif
    const hipError_t le = hipPeekAtLastError();
    if (le != hipSuccess) fprintf(stderr, "kernel_launch: launch failed: %s\n", hipGetErrorName(le));
}
```

```cpp
#include <hip/hip_runtime.h>
#include <cstdio>
#include <cstdint>

constexpr int NB = 2, S = 16384, DM = 1024, M = NB * S;
constexpr int A_COLS = 4680, A_NPAD = 4864;
constexpr int BW = 2048, B_COLS = 3 * BW;
constexpr float RMS_EPS = 1e-6f, LN_EPS = 1e-5f;
constexpr float LOG2E = 1.4426950408889634f;
constexpr float QSCALE = 0.08838834764831845f * LOG2E;
constexpr float WI_SCALE = 0.35355339059327373f;
constexpr float QI_SCALE = 0.125f;
constexpr int TOPK = 256;

namespace pg8 {
#define PG8_LAS __attribute__((address_space(3)))
typedef unsigned short bf16_t;
typedef short bf16x8 __attribute__((ext_vector_type(8)));
typedef float f32x4 __attribute__((ext_vector_type(4)));
typedef unsigned u32x4 __attribute__((ext_vector_type(4)));
constexpr int BM = 256, BK = 64, HALF = 128, HTB = HALF * BK * 2  , STAGE_BYTES = 8 * HTB, NXCD = 8, WGM = 8;

__host__ __device__ __forceinline__ int lds_byte(int r, int c) { const int st = (r >> 4) * 2 + (c >> 5), rr = r & 15, cc = c & 31, ob = rr * 64 + cc * 2; return st * 1024 + (ob ^ (((ob >> 9) & 1) << 5)); }
__host__ __device__ __forceinline__ void stage_rc(int b, int& R, int& C) { const int st = b / 1024, sb = b % 1024, swz = sb ^ (((sb >> 9) & 1) << 5); R = (st >> 1) * 16 + swz / 64; C = (st & 1) * 32 + (swz % 64) / 2; }
__host__ __device__ __forceinline__ int perm32(int rho) { const int n = rho >> 4, i = rho & 15; return 8 * (i >> 2) + 4 * n + (i & 3); }

struct Unit { int pm, pn; };
struct Gemm { const bf16_t* A; const bf16_t* Bt; int M, N, K; };

struct StaticOrder {
    int nM, nN, nwg, G, c;
    __host__ __device__ void init(int M, int N, int G_, int c_) { nM = M / BM; nN = N / BM; nwg = nM * nN; G = G_; c = c_; }
    __host__ __device__ bool next(int i, Unit& u) const {
        const long L = (long)i * G + c; if (L >= nwg) return false;
        int wgid = (int)L; { const int q = nwg / NXCD, r = nwg % NXCD, xcd = wgid % NXCD, off = wgid / NXCD; wgid = (xcd < r ? xcd * (q + 1) : r * (q + 1) + (xcd - r) * q) + off; }
        const int nig = WGM * nN, gid = wgid / nig, fm = gid * WGM, gsz = (nM - fm) < WGM ? (nM - fm) : WGM;
        u.pm = fm + ((wgid % nig) % gsz); u.pn = (wgid % nig) / gsz; return true;
    }
    __device__ __forceinline__ void a_ready(const Unit&) const {}
    __device__ __forceinline__ void done(const Unit&) const {}
};

__device__ __forceinline__ unsigned cvt_pk_bf16(float lo, float hi) { unsigned r; asm volatile("v_cvt_pk_bf16_f32 %0, %1, %2" : "=v"(r) : "v"(lo), "v"(hi)); return r; }
typedef float f32x2 __attribute__((ext_vector_type(2)));
__device__ __forceinline__ float silu_f(float z) { return z * __builtin_amdgcn_rcpf(1.0f + __builtin_amdgcn_exp2f(-z * 1.4426950408889634f)); }

struct EpiA {
    static constexpr bool PERM = true, AFTER_DRAIN = false;
    bf16_t *Q, *K, *V, *ZS, *QI, *KI; float* WI; const float* RS;
    __device__ __forceinline__ void operator()(const f32x4 (&acc)[2][2][4][2], const Unit& u, int wr, int wc, int fr, int fq) const {
        const int pn = u.pn, row0 = u.pm * BM + wr * 64 + fr;
        if (pn < 18) {
            bf16_t* base; int ldc, colt; float sc = 1.f; bool act = false;
            if (pn < 4) { base = Q; ldc = 1024; colt = pn * 256; sc = 0.08838834764831845f * 1.4426950408889634f; }
            else if (pn < 8) { base = K; ldc = 1024; colt = (pn - 4) * 256; }
            else if (pn < 12) { base = V; ldc = 1024; colt = (pn - 8) * 256; }
            else if (pn < 16) { base = ZS; ldc = 1024; colt = (pn - 12) * 256; act = true; }
            else { base = QI; ldc = 512; colt = (pn - 16) * 256; sc = 0.125f; }
            const int col0 = colt + wc * 32 + 8 * fq;
#pragma unroll
            for (int ai = 0; ai < 2; ++ai)
#pragma unroll
                for (int m = 0; m < 4; ++m) { bf16_t* rowp = base + (size_t)(row0 + ai * HALF + m * 16) * ldc + col0; const float rs = RS[row0 + ai * HALF + m * 16] * sc;
#pragma unroll
                    for (int bj = 0; bj < 2; ++bj) { f32x4 v0 = acc[ai][bj][m][0] * rs, v1 = acc[ai][bj][m][1] * rs;
                        if (act) { v0 = (f32x4){silu_f(v0[0]), silu_f(v0[1]), silu_f(v0[2]), silu_f(v0[3])}; v1 = (f32x4){silu_f(v1[0]), silu_f(v1[1]), silu_f(v1[2]), silu_f(v1[3])}; }
                        u32x4 w; w.x = cvt_pk_bf16(v0[0], v0[1]); w.y = cvt_pk_bf16(v0[2], v0[3]); w.z = cvt_pk_bf16(v1[0], v1[1]); w.w = cvt_pk_bf16(v1[2], v1[3]);
                        *(u32x4*)(rowp + bj * HALF) = w; } }
        } else {
#pragma unroll
            for (int ai = 0; ai < 2; ++ai)
#pragma unroll
                for (int m = 0; m < 4; ++m) { const size_t row = (size_t)(row0 + ai * HALF + m * 16);
                    const float rs = RS[row]; const f32x4 v0 = acc[ai][0][m][0] * rs, v1 = acc[ai][0][m][1] * rs;
                    if (wc < 2) { u32x4 w; w.x = cvt_pk_bf16(v0[0], v0[1]); w.y = cvt_pk_bf16(v0[2], v0[3]); w.z = cvt_pk_bf16(v1[0], v1[1]); w.w = cvt_pk_bf16(v1[2], v1[3]);
                        *(u32x4*)(KI + row * 64 + wc * 32 + 8 * fq) = w; }
                    else if (wc == 2 && fq == 0) { const float s = 0.35355339059327373f; *(f32x4*)(WI + row * 8) = v0 * s; *(f32x4*)(WI + row * 8 + 4) = v1 * s; } }
        }
    }
};

struct EpiB {
    static constexpr bool PERM = true, AFTER_DRAIN = false;
    bf16_t* Gt; bf16_t* Vt;
    const float* PS;
    float* LNP;
    __device__ __forceinline__ float rowscale(const float* psrow) const {
        const f32x4* pp = (const f32x4*)psrow; const f32x4 q0 = pp[0], q1 = pp[1], q2 = pp[2], q3 = pp[3];
        const float ss = ((q0[0] + q0[1]) + (q0[2] + q0[3])) + ((q1[0] + q1[1]) + (q1[2] + q1[3])) + ((q2[0] + q2[1]) + (q2[2] + q2[3])) + ((q3[0] + q3[1]) + (q3[2] + q3[3]));
        return 1.0f / sqrtf(ss * (1.f / 1024.f) + 1e-6f); }
    __device__ __forceinline__ void operator()(const f32x4 (&acc)[2][2][4][2], const Unit& u, int wr, int wc, int fr, int fq) const {
        const int pn = u.pn, row0 = u.pm * BM + wr * 64 + fr;
        const float* psrow = PS + (size_t)row0 * 16;
        if (pn < 16) {
            bf16_t* p = Gt + (size_t)row0 * 2048 + pn * 128 + wc * 32 + 8 * fq;
#pragma unroll
            for (int ai = 0; ai < 2; ++ai)
#pragma unroll
                for (int m = 0; m < 4; ++m) { const float rs = rowscale(psrow + (size_t)(ai * HALF + m * 16) * 16);
                    const f32x4 u0 = acc[ai][0][m][0] * rs, u1 = acc[ai][0][m][1] * rs, z0 = acc[ai][1][m][0] * rs, z1 = acc[ai][1][m][1] * rs;
                    u32x4 w; w.x = cvt_pk_bf16(u0[0] * silu_f(z0[0]), u0[1] * silu_f(z0[1])); w.y = cvt_pk_bf16(u0[2] * silu_f(z0[2]), u0[3] * silu_f(z0[3]));
                    w.z = cvt_pk_bf16(u1[0] * silu_f(z1[0]), u1[1] * silu_f(z1[1])); w.w = cvt_pk_bf16(u1[2] * silu_f(z1[2]), u1[3] * silu_f(z1[3]));
                    *(u32x4*)(p + (size_t)(ai * HALF + m * 16) * 2048) = w; }
        } else {
            const int tv = pn - 16; bf16_t* p = Vt + (size_t)row0 * 2048 + tv * 256 + wc * 32 + 8 * fq;
#pragma unroll
            for (int ai = 0; ai < 2; ++ai)
#pragma unroll
                for (int m = 0; m < 4; ++m) { const int ro = ai * HALF + m * 16; const float rs = rowscale(psrow + (size_t)ro * 16); float s1 = 0.f, s2 = 0.f;
#pragma unroll
                    for (int bj = 0; bj < 2; ++bj) { const f32x4 v0 = acc[ai][bj][m][0] * rs, v1 = acc[ai][bj][m][1] * rs;
                        s1 += ((v0[0] + v0[1]) + (v0[2] + v0[3])) + ((v1[0] + v1[1]) + (v1[2] + v1[3]));
                        s2 += ((v0[0] * v0[0] + v0[1] * v0[1]) + (v0[2] * v0[2] + v0[3] * v0[3])) + ((v1[0] * v1[0] + v1[1] * v1[1]) + (v1[2] * v1[2] + v1[3] * v1[3]));
                        u32x4 w; w.x = cvt_pk_bf16(v0[0], v0[1]); w.y = cvt_pk_bf16(v0[2], v0[3]); w.z = cvt_pk_bf16(v1[0], v1[1]); w.w = cvt_pk_bf16(v1[2], v1[3]);
                        *(u32x4*)(p + (size_t)ro * 2048 + bj * HALF) = w; }
                    s1 += __shfl_xor(s1, 16); s1 += __shfl_xor(s1, 32); s2 += __shfl_xor(s2, 16); s2 += __shfl_xor(s2, 32);
                    if (fq == 0) { typedef float f32x2_ __attribute__((ext_vector_type(2))); *(f32x2_*)(LNP + ((size_t)(row0 + ro) * 32 + tv * 4 + wc) * 2) = (f32x2_){s1, s2}; } }
        }
    }
};

struct EpiRes2 {
    static constexpr bool PERM = true, AFTER_DRAIN = false;
    bf16_t* XB;
    __device__ __forceinline__ void operator()(const f32x4 (&acc)[2][2][4][2], const Unit& u, int wr, int wc, int fr, int fq) const {
        const int row0 = u.pm * BM + wr * 64 + fr, col0 = u.pn * BM + wc * 32 + 8 * fq;
#pragma unroll
        for (int ai = 0; ai < 2; ++ai) { u32x4 bb[4][2];
#pragma unroll
            for (int m = 0; m < 4; ++m)
#pragma unroll
                for (int bj = 0; bj < 2; ++bj) bb[m][bj] = *(const u32x4*)(XB + (size_t)(row0 + ai * HALF + m * 16) * 1024 + col0 + bj * HALF);
#pragma unroll
            for (int m = 0; m < 4; ++m)
#pragma unroll
                for (int bj = 0; bj < 2; ++bj) { const u32x4 b = bb[m][bj]; const f32x4 a0 = acc[ai][bj][m][0], a1 = acc[ai][bj][m][1]; u32x4 w;
                    w.x = cvt_pk_bf16(__uint_as_float(b.x << 16) + a0[0], __uint_as_float(b.x & 0xffff0000u) + a0[1]);
                    w.y = cvt_pk_bf16(__uint_as_float(b.y << 16) + a0[2], __uint_as_float(b.y & 0xffff0000u) + a0[3]);
                    w.z = cvt_pk_bf16(__uint_as_float(b.z << 16) + a1[0], __uint_as_float(b.z & 0xffff0000u) + a1[1]);
                    w.w = cvt_pk_bf16(__uint_as_float(b.w << 16) + a1[2], __uint_as_float(b.w & 0xffff0000u) + a1[3]);
                    *(u32x4*)(XB + (size_t)(row0 + ai * HALF + m * 16) * 1024 + col0 + bj * HALF) = w; } }
    }
};

struct EpiRes1 {
    static constexpr bool PERM = true, AFTER_DRAIN = false;
    bf16_t* XB; float* PS;
    __device__ __forceinline__ void operator()(const f32x4 (&acc)[2][2][4][2], const Unit& u, int wr, int wc, int fr, int fq) const {
        const int row0 = u.pm * BM + wr * 64 + fr, col0 = u.pn * BM + wc * 32 + 8 * fq;
#pragma unroll
        for (int ai = 0; ai < 2; ++ai) { u32x4 bb[4][2];
#pragma unroll
            for (int m = 0; m < 4; ++m)
#pragma unroll
                for (int bj = 0; bj < 2; ++bj) bb[m][bj] = *(const u32x4*)(XB + (size_t)(row0 + ai * HALF + m * 16) * 1024 + col0 + bj * HALF);
#pragma unroll
            for (int m = 0; m < 4; ++m) { const size_t row = (size_t)(row0 + ai * HALF + m * 16); float ss = 0.f;
#pragma unroll
                for (int bj = 0; bj < 2; ++bj) { const u32x4 b = bb[m][bj]; const f32x4 a0 = acc[ai][bj][m][0], a1 = acc[ai][bj][m][1];
                    const f32x4 v0 = {__uint_as_float(b.x << 16) + a0[0], __uint_as_float(b.x & 0xffff0000u) + a0[1], __uint_as_float(b.y << 16) + a0[2], __uint_as_float(b.y & 0xffff0000u) + a0[3]};
                    const f32x4 v1 = {__uint_as_float(b.z << 16) + a1[0], __uint_as_float(b.z & 0xffff0000u) + a1[1], __uint_as_float(b.w << 16) + a1[2], __uint_as_float(b.w & 0xffff0000u) + a1[3]};
                    ss += ((v0[0] * v0[0] + v0[1] * v0[1]) + (v0[2] * v0[2] + v0[3] * v0[3])) + ((v1[0] * v1[0] + v1[1] * v1[1]) + (v1[2] * v1[2] + v1[3] * v1[3]));
                    u32x4 w; w.x = cvt_pk_bf16(v0[0], v0[1]); w.y = cvt_pk_bf16(v0[2], v0[3]); w.z = cvt_pk_bf16(v1[0], v1[1]); w.w = cvt_pk_bf16(v1[2], v1[3]);
                    *(u32x4*)(XB + row * 1024 + col0 + bj * HALF) = w; }
                ss += __shfl_xor(ss, 16); ss += __shfl_xor(ss, 32);
                if (fq == 0) PS[row * 16 + u.pn * 4 + wc] = ss; } }
    }
};

template <class Epi, class Sched, bool ALIGN_EPI = false, bool SP2 = false>
__device__ __forceinline__ void gemm_phase(PG8_LAS unsigned char* lds, const Gemm g, const Sched& S, const Epi& E) {
    const int tid = threadIdx.x, wid = __builtin_amdgcn_readfirstlane(tid >> 6), lane = tid & 63, wr = wid >> 2, wc = wid & 3, fr = lane & 15, fq = lane >> 4;
    const int K = g.K, nt = K / BK;
    unsigned voffA[2], voffB[2];
#pragma unroll
    for (int i = 0; i < 2; ++i) { int R, C; stage_rc(tid * 16 + i * 8192, R, C); const int Rb = Epi::PERM ? ((R & ~31) + perm32(R & 31)) : R;
        voffA[i] = (unsigned)(R * K + C) * 2u; voffB[i] = (unsigned)(Rb * K + C) * 2u; }
    const size_t kstep = (size_t)(BK * 2);
    const size_t hstep = (size_t)HALF * K * 2;
    const size_t tstep = 2 * hstep;
    const unsigned ldsw = (unsigned)wid * 1024u;
    const int aoff = lds_byte(wr * 64 + fr, fq * 8), boff = lds_byte(wc * 32 + fr, fq * 8);
#define PG8_SA(b, h) (((b) * 2 + (h)) * HTB)
#define PG8_SB(b, h) ((4 + (b) * 2 + (h)) * HTB)
#define PG8_STAGE(bufoff, gbase, voff) do { _Pragma("unroll") for (int _i = 0; _i < 2; ++_i) \
        __builtin_amdgcn_global_load_lds((const unsigned*)((const char*)(gbase) + (voff)[_i]), (PG8_LAS unsigned*)(lds + (bufoff) + ldsw + _i * 8192), 16, 0, 0); } while (0)
#define PG8_LDA(dst, b, h) do { _Pragma("unroll") for (int m = 0; m < 4; ++m) _Pragma("unroll") for (int k = 0; k < 2; ++k) dst[m][k] = *(const PG8_LAS bf16x8*)(lds + PG8_SA(b, h) + aoff + m * 2048 + k * 1024); } while (0)
#define PG8_LDB(dst, b, h) do { _Pragma("unroll") for (int n = 0; n < 2; ++n) _Pragma("unroll") for (int k = 0; k < 2; ++k) dst[n][k] = *(const PG8_LAS bf16x8*)(lds + PG8_SB(b, h) + boff + n * 2048 + k * 1024); } while (0)
#define PG8_MMA(ai, bj, At, Bt) do { __builtin_amdgcn_s_setprio(1); _Pragma("unroll") for (int m = 0; m < 4; ++m) _Pragma("unroll") for (int n = 0; n < 2; ++n) _Pragma("unroll") for (int k = 0; k < 2; ++k) \
        acc[ai][bj][m][n] = __builtin_amdgcn_mfma_f32_16x16x32_bf16(Bt[n][k], At[m][k], acc[ai][bj][m][n], 0, 0, 0); __builtin_amdgcn_s_setprio(0); } while (0)
#define PG8_WAIT_V(n) asm volatile("s_waitcnt vmcnt(" #n ")" ::: "memory")
#define PG8_WAIT_L(n) asm volatile("s_waitcnt lgkmcnt(" #n ")" ::: "memory")
#define PG8_BAR __builtin_amdgcn_s_barrier()
#define PG8_SCHED __builtin_amdgcn_sched_barrier(0)
    Unit cur, nxt; int ui = 0;
    if (!S.next(0, cur)) return;
    f32x4 acc[2][2][4][2];
#pragma unroll
    for (int a = 0; a < 2; ++a)
#pragma unroll
        for (int b = 0; b < 2; ++b)
#pragma unroll
            for (int m = 0; m < 4; ++m)
#pragma unroll
                for (int n = 0; n < 2; ++n) acc[a][b][m][n] = (f32x4){0.f, 0.f, 0.f, 0.f};
    bf16x8 At[4][2], B0[2][2], B1[2][2];
    const char* cA = (const char*)g.A + (size_t)cur.pm * tstep; const char* cB = (const char*)g.Bt + (size_t)cur.pn * tstep;
    S.a_ready(cur);
    if constexpr (SP2) {
        PG8_STAGE(PG8_SB(0, 0), cB, voffB); PG8_STAGE(PG8_SB(0, 1), cB + hstep, voffB); PG8_STAGE(PG8_SA(0, 0), cA, voffA); PG8_STAGE(PG8_SA(0, 1), cA + hstep, voffA);
        if (wr == 1) PG8_BAR;
        PG8_WAIT_V(2); PG8_BAR;
        PG8_STAGE(PG8_SB(1, 0), cB + kstep, voffB); PG8_STAGE(PG8_SA(1, 0), cA + kstep, voffA); PG8_STAGE(PG8_SB(1, 1), cB + hstep + kstep, voffB);
        PG8_WAIT_V(6); PG8_BAR;
    } else {
        PG8_STAGE(PG8_SB(0, 0), cB, voffB); PG8_STAGE(PG8_SA(0, 0), cA, voffA); PG8_STAGE(PG8_SB(0, 1), cB + hstep, voffB); PG8_STAGE(PG8_SA(0, 1), cA + hstep, voffA);
        if (wr == 1) PG8_BAR;
        PG8_WAIT_V(4); PG8_BAR;
        PG8_STAGE(PG8_SB(1, 0), cB + kstep, voffB); PG8_STAGE(PG8_SA(1, 0), cA + kstep, voffA); PG8_STAGE(PG8_SB(1, 1), cB + hstep + kstep, voffB);
        PG8_WAIT_V(6); PG8_BAR;
    }
    for (;;) {
        const bool has_next = S.next(ui + 1, nxt);
        const char* nA = has_next ? (const char*)g.A + (size_t)nxt.pm * tstep : cA; const char* nB = has_next ? (const char*)g.Bt + (size_t)nxt.pn * tstep : cB;
        for (int t = 0; t < nt; t += 2) {
            const bool last = (t == nt - 2);
            const char* a1 = cA + (size_t)(t + 1) * kstep;
            const char* a2 = last ? nA : cA + (size_t)(t + 2) * kstep; const char* b2 = last ? nB : cB + (size_t)(t + 2) * kstep;
            const char* a3 = a2 + kstep; const char* b3 = b2 + kstep;
            if (last && has_next) S.a_ready(nxt);
            if constexpr (SP2) {
            PG8_LDB(B0, 0, 0); PG8_LDB(B1, 0, 1); PG8_SCHED; PG8_LDA(At, 0, 0); PG8_STAGE(PG8_SA(1, 1), a1 + hstep, voffA);
            PG8_WAIT_V(8); PG8_WAIT_L(0); PG8_BAR; PG8_MMA(0, 0, At, B0); PG8_MMA(0, 1, At, B1); PG8_BAR; PG8_SCHED;
            PG8_LDA(At, 0, 1); PG8_STAGE(PG8_SB(0, 0), b2, voffB); PG8_STAGE(PG8_SB(0, 1), b2 + hstep, voffB); PG8_STAGE(PG8_SA(0, 0), a2, voffA);
            PG8_WAIT_V(8); PG8_WAIT_L(0); PG8_BAR; PG8_MMA(1, 0, At, B0); PG8_MMA(1, 1, At, B1); PG8_BAR; PG8_SCHED;
            PG8_LDB(B0, 1, 0); PG8_LDB(B1, 1, 1); PG8_SCHED; PG8_LDA(At, 1, 0); PG8_STAGE(PG8_SA(0, 1), a2 + hstep, voffA);
            PG8_WAIT_V(8); PG8_WAIT_L(0); PG8_BAR; PG8_MMA(0, 0, At, B0); PG8_MMA(0, 1, At, B1); PG8_BAR; PG8_SCHED;
            PG8_LDA(At, 1, 1); PG8_STAGE(PG8_SB(1, 0), b3, voffB); PG8_STAGE(PG8_SB(1, 1), b3 + hstep, voffB); PG8_STAGE(PG8_SA(1, 0), a3, voffA);
            PG8_WAIT_V(8); PG8_WAIT_L(0); PG8_BAR; PG8_MMA(1, 0, At, B0); PG8_MMA(1, 1, At, B1); PG8_BAR; PG8_SCHED;
            } else {
            PG8_LDB(B0, 0, 0); PG8_SCHED; PG8_LDA(At, 0, 0); PG8_STAGE(PG8_SA(1, 1), a1 + hstep, voffA);
            PG8_WAIT_L(8); PG8_BAR; PG8_WAIT_L(0); PG8_MMA(0, 0, At, B0); PG8_BAR; PG8_SCHED;
            PG8_LDB(B1, 0, 1); PG8_STAGE(PG8_SB(0, 0), b2, voffB);
            PG8_BAR; PG8_WAIT_L(0); PG8_MMA(0, 1, At, B1); PG8_BAR;
            PG8_LDA(At, 0, 1); PG8_STAGE(PG8_SA(0, 0), a2, voffA);
            PG8_BAR; PG8_WAIT_L(0); PG8_MMA(1, 0, At, B0); PG8_BAR; PG8_SCHED;
            PG8_STAGE(PG8_SB(0, 1), b2 + hstep, voffB);
            PG8_WAIT_V(6); PG8_BAR; PG8_MMA(1, 1, At, B1); PG8_BAR;
            PG8_LDB(B0, 1, 0); PG8_SCHED; PG8_LDA(At, 1, 0); PG8_STAGE(PG8_SA(0, 1), a2 + hstep, voffA);
            PG8_WAIT_L(8); PG8_BAR; PG8_WAIT_L(0); PG8_MMA(0, 0, At, B0); PG8_BAR; PG8_SCHED;
            PG8_LDB(B1, 1, 1); PG8_STAGE(PG8_SB(1, 0), b3, voffB);
            PG8_BAR; PG8_WAIT_L(0); PG8_MMA(0, 1, At, B1); PG8_BAR;
            PG8_LDA(At, 1, 1); PG8_STAGE(PG8_SA(1, 0), a3, voffA);
            PG8_BAR; PG8_WAIT_L(0); PG8_MMA(1, 0, At, B0); PG8_BAR; PG8_SCHED;
            PG8_STAGE(PG8_SB(1, 1), b3 + hstep, voffB);
            PG8_WAIT_V(6); PG8_BAR; PG8_MMA(1, 1, At, B1); PG8_BAR;
            }
        }
        if constexpr (ALIGN_EPI) { if (wr == 0) PG8_BAR; }
        if constexpr (!Epi::AFTER_DRAIN) { E(acc, cur, wr, wc, fr, fq); S.done(cur); }
        if (!has_next) break;
#pragma unroll
        for (int a = 0; a < 2; ++a)
#pragma unroll
            for (int b = 0; b < 2; ++b)
#pragma unroll
                for (int m = 0; m < 4; ++m)
#pragma unroll
                    for (int n = 0; n < 2; ++n) acc[a][b][m][n] = (f32x4){0.f, 0.f, 0.f, 0.f};
        cur = nxt; cA = nA; cB = nB; ++ui;
        if constexpr (ALIGN_EPI) { if (wr == 1) PG8_BAR; }
    }
    PG8_WAIT_V(0);
    if constexpr (!ALIGN_EPI) { if (wr == 0) PG8_BAR; }
    PG8_BAR;
    if constexpr (Epi::AFTER_DRAIN) { E.fused(acc, cur, wr, wc, fr, fq, lds, wid, lane); S.done(cur); }
#undef PG8_SA
#undef PG8_SB
#undef PG8_STAGE
#undef PG8_LDA
#undef PG8_LDB
#undef PG8_MMA
#undef PG8_WAIT_V
#undef PG8_WAIT_L
#undef PG8_BAR
#undef PG8_SCHED
}
}
#define LAS __attribute__((address_space(3)))
typedef unsigned short bf16;
typedef float f32x4 __attribute__((ext_vector_type(4)));
typedef unsigned v4u __attribute__((ext_vector_type(4)));
typedef unsigned v2u __attribute__((ext_vector_type(2)));
__device__ __forceinline__ unsigned f2bf(float f) { unsigned u = __builtin_bit_cast(unsigned, f); return (u + 0x7fffu + ((u >> 16) & 1u)) >> 16; }
__device__ __forceinline__ unsigned pk2(float lo, float hi) { return f2bf(lo) | (f2bf(hi) << 16); }
__device__ __forceinline__ float bflo(unsigned w) { return __builtin_bit_cast(float, w << 16); }
__device__ __forceinline__ float bfhi(unsigned w) { return __builtin_bit_cast(float, w & 0xffff0000u); }
__device__ __forceinline__ float wave_sum(float v) {
#pragma unroll
    for (int o = 1; o < 64; o <<= 1) v += __shfl_xor(v, o);
    return v;
}
__device__ __forceinline__ float wave_max(float v) {
#pragma unroll
    for (int o = 1; o < 64; o <<= 1) v = fmaxf(v, __shfl_xor(v, o));
    return v;
}
__device__ __forceinline__ int t5_bucket(int rel) {
    const int ret = rel < 0 ? 16 : 0; const int n = rel < 0 ? -rel : rel;
    int v;
    if (n < 8) v = n; else if (n < 12) v = 8; else if (n < 16) v = 9; else if (n < 23) v = 10; else if (n < 32) v = 11; else if (n < 46) v = 12; else if (n < 64) v = 13; else if (n < 91) v = 14; else v = 15;
    return ret + v;
}

__device__ __forceinline__ void transpose_item(const float* W, int K, int N, int Npad, bf16* WT, LAS float* scr, int item, int lane, const float* gk = nullptr  , bool uzv = false  ) {
    const int nblk = Npad / 32, kb = item / nblk, nb = item % nblk, k0 = 64 * kb, n0 = 32 * nb;
    const int nn = n0 + (lane & 31);
    const int d0 = !uzv ? n0 : n0 < 2048 ? 256 * (n0 >> 7) + (n0 & 127) : n0 < 4096 ? n0 + 2048 : 256 * ((n0 - 4096) >> 7) + 128 + (n0 & 127);
#pragma unroll 8
    for (int i = 0; i < 32; ++i) { const int kk = 2 * i + (lane >> 5); scr[kk * 33 + (lane & 31)] = nn < N ? W[(size_t)(k0 + kk) * N + nn] * (gk ? gk[k0 + kk] : 1.f) : 0.f; }
    asm volatile("s_waitcnt lgkmcnt(0)" ::: "memory");
    const int c = lane & 7;
#pragma unroll
    for (int j = 0; j < 4; ++j) { const int n = (lane >> 3) + 8 * j; const LAS float* s = scr + (8 * c) * 33 + n;
        v4u o; o.x = pk2(s[0 * 33], s[1 * 33]); o.y = pk2(s[2 * 33], s[3 * 33]); o.z = pk2(s[4 * 33], s[5 * 33]); o.w = pk2(s[6 * 33], s[7 * 33]);
        *(v4u*)(WT + (size_t)(d0 + n) * K + k0 + 8 * c) = o; }
    asm volatile("s_waitcnt lgkmcnt(0)" ::: "memory");
}
__device__ __forceinline__ void rms_row_to_bf16(const float* xrow, const float* g, bf16* orow, int lane) {
    const f32x4* xr = (const f32x4*)xrow + lane; const f32x4* gr = (const f32x4*)g + lane;
    f32x4 v[4]; float s = 0.f;
#pragma unroll
    for (int j = 0; j < 4; ++j) { v[j] = xr[64 * j]; s += (v[j].x * v[j].x + v[j].y * v[j].y) + (v[j].z * v[j].z + v[j].w * v[j].w); }
    const float rs = 1.0f / sqrtf(wave_sum(s) * (1.f / 1024.f) + RMS_EPS);
    v2u* o8 = (v2u*)orow + lane;
#pragma unroll
    for (int j = 0; j < 4; ++j) { const f32x4 gg = gr[64 * j]; v2u o; o.x = pk2(v[j].x * rs * gg.x, v[j].y * rs * gg.y); o.y = pk2(v[j].z * rs * gg.z, v[j].w * rs * gg.w); o8[64 * j] = o; }
}
__device__ __forceinline__ void rms_row_f32(const float* xrow, const float* g, float* orow, int lane) {
    const f32x4* xr = (const f32x4*)xrow + lane; const f32x4* gr = (const f32x4*)g + lane;
    f32x4 v[4]; float s = 0.f;
#pragma unroll
    for (int j = 0; j < 4; ++j) { v[j] = xr[64 * j]; s += (v[j].x * v[j].x + v[j].y * v[j].y) + (v[j].z * v[j].z + v[j].w * v[j].w); }
    const float rs = 1.0f / sqrtf(wave_sum(s) * (1.f / 1024.f) + RMS_EPS);
    f32x4* o = (f32x4*)orow + lane;
#pragma unroll
    for (int j = 0; j < 4; ++j) { const f32x4 gg = gr[64 * j]; o[64 * j] = v[j] * rs * gg; }
}


__device__ __forceinline__ void rms_row_bf16_to_f32(const bf16* xrow, const float* g, float* orow, int lane) {
    typedef unsigned u32x4_ __attribute__((ext_vector_type(4)));
    float v[2][8]; float s = 0.f;
#pragma unroll
    for (int j = 0; j < 2; ++j) { const u32x4_ b = *((const u32x4_*)xrow + 64 * j + lane);
        v[j][0] = __uint_as_float(b.x << 16); v[j][1] = __uint_as_float(b.x & 0xffff0000u); v[j][2] = __uint_as_float(b.y << 16); v[j][3] = __uint_as_float(b.y & 0xffff0000u);
        v[j][4] = __uint_as_float(b.z << 16); v[j][5] = __uint_as_float(b.z & 0xffff0000u); v[j][6] = __uint_as_float(b.w << 16); v[j][7] = __uint_as_float(b.w & 0xffff0000u);
#pragma unroll
        for (int e = 0; e < 8; ++e) s += v[j][e] * v[j][e]; }
    const float rs = 1.0f / sqrtf(wave_sum(s) * (1.f / 1024.f) + RMS_EPS);
#pragma unroll
    for (int j = 0; j < 2; ++j) { const f32x4* gr = (const f32x4*)g + 128 * j + 2 * lane; f32x4* o = (f32x4*)orow + 128 * j + 2 * lane; const f32x4 g0 = gr[0], g1 = gr[1];
        o[0] = (f32x4){v[j][0] * rs * g0.x, v[j][1] * rs * g0.y, v[j][2] * rs * g0.z, v[j][3] * rs * g0.w};
        o[1] = (f32x4){v[j][4] * rs * g1.x, v[j][5] * rs * g1.y, v[j][6] * rs * g1.z, v[j][7] * rs * g1.w}; }
}

__device__ __forceinline__ void row_to_bf16_rs(const float* xrow, bf16* orow, float* rs_out, int lane) {
    const f32x4* xr = (const f32x4*)xrow + lane;
    f32x4 v[4]; float s = 0.f;
#pragma unroll
    for (int j = 0; j < 4; ++j) { v[j] = xr[64 * j]; s += (v[j].x * v[j].x + v[j].y * v[j].y) + (v[j].z * v[j].z + v[j].w * v[j].w); }
    v2u* o8 = (v2u*)orow + lane;
#pragma unroll
    for (int j = 0; j < 4; ++j) { v2u o; o.x = pk2(v[j].x, v[j].y); o.y = pk2(v[j].z, v[j].w); o8[64 * j] = o; }
    const float rs = 1.0f / sqrtf(wave_sum(s) * (1.f / 1024.f) + RMS_EPS);
    if (lane == 0) *rs_out = rs;
}
namespace idx {
typedef unsigned short bf16;
typedef short bf16x8 __attribute__((ext_vector_type(8)));
typedef float f32x16 __attribute__((ext_vector_type(16)));
typedef unsigned long long u64;
constexpr int NBINS = 256, HSTR = 257, CAP = 512, FCAP = 2048;
constexpr int OFF_HIST = 0;
constexpr int OFF_QL = 66048;
constexpr int OFF_STAT = 64 * 513 * 4 + 128;
constexpr int OFF_QPAR = OFF_STAT + 2048;
constexpr int OFF_BSTAR = OFF_QPAR + 512, OFF_NEED = OFF_BSTAR + 256, OFF_BCNT = OFF_NEED + 256;
constexpr int OFF_FB = OFF_BCNT + 256;
constexpr int OFF_FBH = OFF_FB + 512;
constexpr int OFF_QF = OFF_FBH + 1024 + 64;
constexpr int OFF_WV = OFF_QF + 2048;
constexpr int OFF_FLAT = OFF_WV + 2048;
constexpr int IDX_LDS_BYTES = OFF_FLAT + 2 * FCAP * 4;
#ifndef IDX_REPS
#define IDX_REPS 1
#endif
#ifndef DBG_FORCE_FB
#define DBG_FORCE_FB 0
#endif

__device__ __forceinline__ int crow(int r, int hi) { return (r & 3) + 8 * (r >> 2) + 4 * hi; }
__device__ __forceinline__ float z_upper(float p) {
    const bool flip = p > 0.5f; const float pp = flip ? 1.f - p : p; const float t = sqrtf(-2.f * logf(pp));
    float num = 2.515517f + t * (0.802853f + t * 0.010328f); asm volatile("" : "+v"(num));
    const float den = 1.f + t * (1.432788f + t * (0.189269f + t * 0.001308f));
    const float z = t - num / den;
    return flip ? -z : z;
}
__device__ __forceinline__ void load_a(bf16x8 (&a)[4], const char* kib, int j, int r32, int hi) {
    const char* kp = kib + (size_t)(unsigned)((j * 32 + r32) * 128 + hi * 16);
#pragma unroll
    for (int kk = 0; kk < 4; ++kk) a[kk] = *reinterpret_cast<const bf16x8*>(kp + kk * 32);
}
template <bool PF>
__device__ __forceinline__ void tile_scores(bf16x8 (&a)[4], const bf16x8 (&qreg)[8][4], const bf16x8 (&qL)[4], const float* wvl  , float (&sc)[16], const char* kib, int jn, int r32, int hi) {
    f32x16 dl = {};
#pragma unroll
    for (int kk = 0; kk < 4; ++kk) dl = __builtin_amdgcn_mfma_f32_32x32x16_bf16(a[kk], qL[kk], dl, 0, 0, 0);
#pragma unroll
    for (int h = 0; h < 8; ++h) { f32x16 d = {};
#pragma unroll
        for (int kk = 0; kk < 4; ++kk) d = __builtin_amdgcn_mfma_f32_32x32x16_bf16(a[kk], qreg[h][kk], d, 0, 0, 0);
        asm volatile("" ::: "memory");
        if (PF && h == 7) load_a(a, kib, jn, r32, hi);
        const float w = wvl[h];
#pragma unroll
        for (int r = 0; r < 16; ++r) sc[r] = fmaf(w, __builtin_fabsf(d[r]), h == 0 ? dl[r] : sc[r]); }
}
typedef float f32x4_t __attribute__((ext_vector_type(4)));
__device__ __forceinline__ void load_a16(bf16x8 (&a)[2][2], const char* kib, int j, int l15, int kq) {
    const char* kp = kib + (size_t)(unsigned)((j * 32 + l15) * 128 + kq * 16);
#pragma unroll
    for (int rb = 0; rb < 2; ++rb)
#pragma unroll
        for (int ks = 0; ks < 2; ++ks) a[rb][ks] = *reinterpret_cast<const bf16x8*>(kp + rb * 2048 + ks * 64);
}
template <bool PF>
__device__ __forceinline__ void tile_scores16(bf16x8 (&a)[2][2], const bf16x8 (&qreg)[8][2][2], const char* qlp  , const float* wv0, const float* wv1, float (&sc)[16], const char* kib, int jn, int l15, int kq) {
    f32x4_t dl[2][2]; bf16x8 qL[2][2];
#pragma unroll
    for (int cb = 0; cb < 2; ++cb)
#pragma unroll
        for (int ks = 0; ks < 2; ++ks) qL[cb][ks] = *reinterpret_cast<const bf16x8*>(qlp + (cb * 2 + ks) * 8192);
#pragma unroll
    for (int rb = 0; rb < 2; ++rb)
#pragma unroll
        for (int cb = 0; cb < 2; ++cb) { f32x4_t t = {0.f, 0.f, 0.f, 0.f};
#pragma unroll
            for (int ks = 0; ks < 2; ++ks) t = __builtin_amdgcn_mfma_f32_16x16x32_bf16(a[rb][ks], qL[cb][ks], t, 0, 0, 0);
            dl[rb][cb] = t; }
#pragma unroll
    for (int h = 0; h < 8; ++h) { f32x4_t d[2][2];
#pragma unroll
        for (int rb = 0; rb < 2; ++rb)
#pragma unroll
            for (int cb = 0; cb < 2; ++cb) { f32x4_t t = {0.f, 0.f, 0.f, 0.f};
#pragma unroll
                for (int ks = 0; ks < 2; ++ks) t = __builtin_amdgcn_mfma_f32_16x16x32_bf16(a[rb][ks], qreg[h][cb][ks], t, 0, 0, 0);
                d[rb][cb] = t; }
        asm volatile("" ::: "memory");
        if (PF && h == 7) load_a16(a, kib, jn, l15, kq);
        const float w0 = wv0[h], w1 = wv1[h];
#pragma unroll
        for (int rb = 0; rb < 2; ++rb)
#pragma unroll
            for (int cb = 0; cb < 2; ++cb)
#pragma unroll
                for (int r = 0; r < 4; ++r) { const int i = (2 * rb + cb) * 4 + r; sc[i] = fmaf(cb ? w1 : w0, __builtin_fabsf(d[rb][cb][r]), h == 0 ? dl[rb][cb][r] : sc[i]); } }
}
__device__ __forceinline__ unsigned fkey(float f) { const unsigned u = __builtin_bit_cast(unsigned, f); return (u & 0x80000000u) ? ~u : (u | 0x80000000u); }

__device__ __forceinline__ void mask_or_bit(u64* mwq, int qc, int s) {
    const int kk = s & 31, hk = (kk >> 2) & 1, r = (kk & 3) + 4 * (kk >> 3);
    __hip_atomic_fetch_or(mwq + (size_t)(s >> 5) * 16 + r, 1ull << (qc + 32 * hk), __ATOMIC_RELAXED, __HIP_MEMORY_SCOPE_AGENT);
}

__device__ __forceinline__ void fallback_query(char* lds, int tid, int tg  , int qc, int n, const bf16* QI, const char* kib, const float* WI, u64* mwq) {
    asm volatile("" : "+v"(tid));
    float* sc = (float*)(lds + OFF_HIST); unsigned* hist = (unsigned*)(lds + OFF_FBH); unsigned* misc = hist + 256; float* qf = (float*)(lds + OFF_QF);
    __syncthreads();
    if (tid < 256) { const unsigned w = ((const unsigned*)(QI + (size_t)tg * 512))[tid]; qf[2 * tid] = __builtin_bit_cast(float, w << 16); qf[2 * tid + 1] = __builtin_bit_cast(float, w & 0xffff0000u); }
    __syncthreads();
    for (int s = tid; s < n; s += 1024) {
        const int s2 = s + 512 < n ? s + 512 : s;
        const uint4* kp0 = (const uint4*)(kib + (size_t)s * 128); const uint4* kp1 = (const uint4*)(kib + (size_t)s2 * 128);
        float kf0[64], kf1[64];
#pragma unroll
        for (int c = 0; c < 8; ++c) { const uint4 w = kp0[c], x = kp1[c];
            kf0[8 * c] = __builtin_bit_cast(float, w.x << 16); kf0[8 * c + 1] = __builtin_bit_cast(float, w.x & 0xffff0000u); kf0[8 * c + 2] = __builtin_bit_cast(float, w.y << 16); kf0[8 * c + 3] = __builtin_bit_cast(float, w.y & 0xffff0000u);
            kf0[8 * c + 4] = __builtin_bit_cast(float, w.z << 16); kf0[8 * c + 5] = __builtin_bit_cast(float, w.z & 0xffff0000u); kf0[8 * c + 6] = __builtin_bit_cast(float, w.w << 16); kf0[8 * c + 7] = __builtin_bit_cast(float, w.w & 0xffff0000u);
            kf1[8 * c] = __builtin_bit_cast(float, x.x << 16); kf1[8 * c + 1] = __builtin_bit_cast(float, x.x & 0xffff0000u); kf1[8 * c + 2] = __builtin_bit_cast(float, x.y << 16); kf1[8 * c + 3] = __builtin_bit_cast(float, x.y & 0xffff0000u);
            kf1[8 * c + 4] = __builtin_bit_cast(float, x.z << 16); kf1[8 * c + 5] = __builtin_bit_cast(float, x.z & 0xffff0000u); kf1[8 * c + 6] = __builtin_bit_cast(float, x.w << 16); kf1[8 * c + 7] = __builtin_bit_cast(float, x.w & 0xffff0000u); }
        float sc0 = 0.f, sc1 = 0.f;
#pragma unroll 1
        for (int h = 0; h < 8; ++h) { float d0 = 0.f, d1 = 0.f;
#pragma unroll
            for (int j = 0; j < 64; ++j) { const float qv = qf[h * 64 + j]; d0 = fmaf(qv, kf0[j], d0); d1 = fmaf(qv, kf1[j], d1); }
            const float w = WI[(size_t)tg * 8 + h]; sc0 = fmaf(w, fmaxf(d0, 0.f), sc0); sc1 = fmaf(w, fmaxf(d1, 0.f), sc1); }
        sc[s] = sc0; sc[s2] = sc1;
    }
    __syncthreads();
    unsigned prefix = 0u, need = TOPK, eq_total = 0u;
    for (int pass = 0; pass < 4; ++pass) {
        const int shift = 24 - 8 * pass; const unsigned mask = pass == 0 ? 0u : (0xFFFFFFFFu << (shift + 8));
        if (tid < 256) hist[tid] = 0u;
        __syncthreads();
        for (int s = tid; s < n; s += 512) { const unsigned k = fkey(sc[s]); if ((k & mask) == (prefix & mask)) atomicAdd(&hist[(k >> shift) & 255u], 1u); }
        __syncthreads();
        if (tid == 0) { unsigned c = 0u; int bin = 255; for (; bin > 0; --bin) { if (c + hist[bin] >= need) break; c += hist[bin]; }
            misc[0] = (unsigned)bin; misc[1] = need - c; misc[2] = hist[bin]; }
        __syncthreads();
        prefix |= misc[0] << shift; need = misc[1]; eq_total = misc[2];
        __syncthreads();
    }
    const int nw = (n >> 5) * 16; const u64 clr = ~((1ull << qc) | (1ull << (qc + 32)));
    for (int i = tid; i < nw; i += 512) __hip_atomic_fetch_and(mwq + i, clr, __ATOMIC_RELAXED, __HIP_MEMORY_SCOPE_AGENT);
    asm volatile("s_waitcnt vmcnt(0)" ::: "memory");
    __syncthreads();
    const bool take_all_eq = (eq_total == need);
    for (int s = tid; s < n; s += 512) { const unsigned k = fkey(sc[s]); if (k > prefix || (take_all_eq && k == prefix)) mask_or_bit(mwq, qc, s); }
    if (!take_all_eq) {
        const int per = (n + 511) >> 9, s0 = tid * per, s1 = (s0 + per < n) ? s0 + per : n; unsigned* ce = (unsigned*)qf;
        unsigned mine = 0u; for (int s = s0; s < s1; ++s) mine += fkey(sc[s]) == prefix;
        __syncthreads(); ce[tid] = mine; __syncthreads();
        unsigned before = 0u; for (int t2 = 0; t2 < tid; ++t2) before += ce[t2];
        for (int s = s0; s < s1 && before < need; ++s) if (fkey(sc[s]) == prefix) { mask_or_bit(mwq, qc, s); ++before; }
    }
    __syncthreads();
}

__device__ __forceinline__ void indexer_unit(char* lds, int b, int c, const bf16* QI, const bf16* KI, const float* WI, u64* MASKW, char* codes  ) {
    int tid_ = threadIdx.x; asm volatile("" : "+v"(tid_));
    const int tid = tid_, wid = __builtin_amdgcn_readfirstlane(tid >> 6), lane = tid & 63, r32 = lane & 31, hi = lane >> 5, qg = wid & 1, ks = wid >> 1;
    const int n = 64 * (c + 1), ntile = n >> 5, jend = 2 * ((c | 3) + 1);
    const int row0 = b * S + 64 * c;
    u64* mw = MASKW + ((size_t)(b * (S / 32) + 2 * c + qg) * (S / 32)) * 16;
    const char* kib = (const char*)(KI + (size_t)b * S * 64);
    if (n <= TOPK) {
        for (int j = ks; j < jend; j += 4) if (lane < 16) __hip_atomic_store(mw + (size_t)j * 16 + lane, j < ntile ? ~0ull : 0ull, __ATOMIC_RELAXED, __HIP_MEMORY_SCOPE_AGENT);
        return;
    }
    unsigned* hist = (unsigned*)(lds + OFF_HIST);
    float2* stat = (float2*)(lds + OFF_STAT); float2* qpar = (float2*)(lds + OFF_QPAR);
    int* bstar = (int*)(lds + OFF_BSTAR); int* needv = (int*)(lds + OFF_NEED); unsigned* bcnt = (unsigned*)(lds + OFF_BCNT); unsigned* fb = (unsigned*)(lds + OFF_FB);
    unsigned* fl = (unsigned*)(lds + OFF_FLAT);
    const int ql = qg * 32 + r32;
    {
    int ln_ = lane; asm volatile("" : "+v"(ln_));
    const int l15 = ln_ & 15, kq = ln_ >> 4; const int q0 = qg * 32 + l15, q1 = q0 + 16;
    bf16x8 qreg[8][2][2]; const float* wv0 = (const float*)(lds + OFF_WV) + q0 * 8; const float* wv1 = wv0 + 16 * 8;
    { const char* qp = (const char*)QI + (size_t)(unsigned)(row0 + q0) * 1024 + kq * 16;
#pragma unroll
        for (int h = 0; h < 8; ++h)
#pragma unroll
            for (int cb = 0; cb < 2; ++cb)
#pragma unroll
                for (int ks = 0; ks < 2; ++ks) qreg[h][cb][ks] = *reinterpret_cast<const bf16x8*>(qp + cb * 16 * 1024 + h * 128 + ks * 64);
        { unsigned to_ = (unsigned)tid; asm volatile("" : "+v"(to_)); if (to_ < 128u) { float4 w4 = *(const float4*)((const char*)(WI + (size_t)row0 * 8) + (size_t)(to_ * 16u)); w4.x *= 0.5f; w4.y *= 0.5f; w4.z *= 0.5f; w4.w *= 0.5f; *(float4*)(lds + OFF_WV + to_ * 16u) = w4; } } }
    char* qlp = lds + OFF_QL + tid * 16;
#pragma unroll
    for (int cb = 0; cb < 2; ++cb) { const float* wp = WI + (size_t)(row0 + q0 + 16 * cb) * 8; const float4 w0 = *(const float4*)wp, w1 = *(const float4*)(wp + 4);
        const float wh[8] = {0.5f * w0.x, 0.5f * w0.y, 0.5f * w0.z, 0.5f * w0.w, 0.5f * w1.x, 0.5f * w1.y, 0.5f * w1.z, 0.5f * w1.w};
#pragma unroll
        for (int ks = 0; ks < 2; ++ks) { float acc8[8] = {0.f, 0.f, 0.f, 0.f, 0.f, 0.f, 0.f, 0.f};
#pragma unroll
            for (int h = 0; h < 8; ++h) { const bf16x8 q = qreg[h][cb][ks];
#pragma unroll
                for (int e = 0; e < 8; ++e) acc8[e] = fmaf(wh[h], __builtin_bit_cast(float, (unsigned)(unsigned short)q[e] << 16), acc8[e]); }
            bf16x8 o;
#pragma unroll
            for (int e = 0; e < 8; ++e) { const unsigned u = __builtin_bit_cast(unsigned, acc8[e]); o[e] = (short)((u + 0x7fffu + ((u >> 16) & 1u)) >> 16); }
            *reinterpret_cast<bf16x8*>(qlp + (cb * 2 + ks) * 8192) = o; } }
    float sc[16];
    { unsigned z0; asm volatile("v_mov_b32 %0, 0" : "=v"(z0)); const uint4 z4 = make_uint4(z0, z0, z0, z0);
        unsigned zoff = (unsigned)tid * 16u; asm volatile("" : "+v"(zoff));
#pragma unroll 1
        for (int i = 0; i < 8; ++i) { *(uint4*)((char*)hist + zoff) = z4; zoff += 8192u; }
        if (tid < 16) *(uint4*)((char*)hist + zoff) = z4; }
    __syncthreads();
    { float s1a = 0.f, s2a = 0.f, s1b = 0.f, s2b = 0.f;
#pragma unroll 1
        for (int u = 0; u < 2; ++u) { const int j = ((ks + 4 * u) * ntile) >> 3; bf16x8 a[2][2]; load_a16(a, kib, j, l15, kq); tile_scores16<false>(a, qreg, qlp, wv0, wv1, sc, kib, 0, l15, kq);
#pragma unroll
            for (int i = 0; i < 16; ++i) { if ((i >> 2) & 1) { s1b += sc[i]; s2b = fmaf(sc[i], sc[i], s2b); } else { s1a += sc[i]; s2a = fmaf(sc[i], sc[i], s2a); } } }
        s1a += __shfl_xor(s1a, 16); s2a += __shfl_xor(s2a, 16); s1b += __shfl_xor(s1b, 16); s2b += __shfl_xor(s2b, 16);
        s1a += __shfl_xor(s1a, 32); s2a += __shfl_xor(s2a, 32); s1b += __shfl_xor(s1b, 32); s2b += __shfl_xor(s2b, 32);
        { int qo_ = q0; asm volatile("" : "+v"(qo_)); if (kq == 0) { stat[ks * 64 + qo_] = make_float2(s1a, s2a); stat[ks * 64 + qo_ + 16] = make_float2(s1b, s2b); } } }
    __syncthreads();
    { int tq_ = tid; asm volatile("" : "+v"(tq_));
    if (tq_ < 64) { float s1 = 0.f, s2 = 0.f;
#pragma unroll
        for (int k = 0; k < 4; ++k) { const float2 v = stat[k * 64 + tq_]; s1 += v.x; s2 += v.y; }
        const float mu = s1 * (1.f / 256.f); float var = s2 * (1.f / 256.f) - mu * mu; var = var > 0.f ? var : 0.f;
        const float sg = fmaxf(sqrtf(var), 1e-30f); const float zp = z_upper(256.f / (float)n);
        const float lo = mu + (zp - 2.0f) * sg, a = (float)(NBINS - 2) / (4.0f * sg); float bb = 1.f - lo * a;
        float aa = a; if (!(aa < 3.0e38f) || !(fabsf(bb) < 3.0e38f)) { aa = 0.f; bb = 1.f; }
        qpar[tq_] = make_float2(aa, bb); bcnt[tq_] = 0u; if (tq_ == 0) { fb[0] = 0u; fb[100] = 0u; } } }
    __syncthreads();
    { unsigned* hq0 = hist + q0 * HSTR; unsigned* hq1 = hq0 + 16 * HSTR; bf16x8 aC[2][2]; load_a16(aC, kib, ks, l15, kq);
        unsigned cso = (unsigned)(qg * 1024 + (l15 + 32 * (kq & 1)) * 16 + (kq >> 1) * 4); asm volatile("" : "+v"(cso));
#pragma unroll 1
        for (int j = ks; j < ntile; j += 4) {
            tile_scores16<true>(aC, qreg, qlp, wv0, wv1, sc, kib, j + 4 < ntile ? j + 4 : j, l15, kq);
            const float2 ab0 = qpar[q0], ab1 = qpar[q1];
            char* cp = codes + (size_t)(unsigned)(j * 2048) + cso;
#pragma unroll
            for (int rb = 0; rb < 2; ++rb)
#pragma unroll
                for (int cb = 0; cb < 2; ++cb) { unsigned w = 0u;
#pragma unroll
                    for (int r = 3; r >= 0; --r) { const float v = sc[(2 * rb + cb) * 4 + r];
                        const unsigned bin = (unsigned)__builtin_amdgcn_fmed3f(cb ? fmaf(v, ab1.x, ab1.y) : fmaf(v, ab0.x, ab0.y), 0.f, (float)(NBINS - 1));
                        __hip_atomic_fetch_add((cb ? hq1 : hq0) + bin, 1u, __ATOMIC_RELAXED, __HIP_MEMORY_SCOPE_WORKGROUP); w = (w << 8) | bin; }
                    *(unsigned*)(cp + cb * 256 + rb * 8) = w; } } }
    }
    __syncthreads();
#pragma unroll 1
    for (int qq = 0; qq < 8; ++qq) { const int q = wid * 8 + qq; int lo_ = lane; asm volatile("" : "+v"(lo_)); const unsigned* hp = hist + q * HSTR + 4 * lo_; const unsigned hb[4] = {hp[0], hp[1], hp[2], hp[3]};
        const unsigned ls = (hb[0] + hb[1]) + (hb[2] + hb[3]);
        unsigned T = ls;
#pragma unroll
        for (int o = 1; o < 64; o <<= 1) { const unsigned v = __shfl_down(T, o); if (lane + o < 64) T += v; }
        const u64 bal = __ballot(T >= (unsigned)TOPK); const int lstar = 63 - __builtin_clzll(bal);
        if (lane == lstar) { unsigned acc = T - ls; int bsel = 0;
#pragma unroll
            for (int i = 3; i >= 0; --i) { if (acc + hb[i] >= (unsigned)TOPK) { bsel = i; break; } acc += hb[i]; }
            bstar[q] = 4 * lane + bsel; needv[q] = (int)(TOPK - acc); } }
    __syncthreads();
    { unsigned cso = (unsigned)(qg * 1024 + lane * 16); asm volatile("" : "+v"(cso));
        const unsigned bs = (unsigned)bstar[ql]; const unsigned bsx = bs * 0x01010101u; const unsigned qtag = (unsigned)ql << 14;
#define IDX_LDC(jj) (*(const uint4*)(codes + (size_t)(unsigned)(((jj) < ntile ? (jj) : ks) * 2048) + cso))
#define IDX_SEL(D, K) asm volatile("v_cmp_gt_u32_sdwa vcc, %2, %3 src0_sel:BYTE_" #K " src1_sel:DWORD\n\ts_nop 3\n\tv_writelane_b32 %0, vcc_lo, %4\n\tv_writelane_b32 %1, vcc_hi, %4" \
                : "+v"(mlo), "+v"(mhi) : "v"(cwd[D]), "v"(bs), "n"(4 * (D) + (K)) : "vcc")
#define IDX_PROC(CUR, jj) do { const int j_ = (jj); const unsigned cwd[4] = {CUR.x, CUR.y, CUR.z, CUR.w}; unsigned mlo = 0u, mhi = 0u;                                  \
            IDX_SEL(0, 0); IDX_SEL(0, 1); IDX_SEL(0, 2); IDX_SEL(0, 3); IDX_SEL(1, 0); IDX_SEL(1, 1); IDX_SEL(1, 2); IDX_SEL(1, 3);                                       \
            IDX_SEL(2, 0); IDX_SEL(2, 1); IDX_SEL(2, 2); IDX_SEL(2, 3); IDX_SEL(3, 0); IDX_SEL(3, 1); IDX_SEL(3, 2); IDX_SEL(3, 3);                                       \
            if (lane < 16) mw[(size_t)j_ * 16 + lane] = ((u64)mhi << 32) | mlo;                  \
                                     \
            _Pragma("unroll") for (int d = 0; d < 4; ++d) { const unsigned x = cwd[d] ^ bsx; const unsigned hz = (x - 0x01010101u) & ~x & 0x80808080u;                   \
                if (__ballot(hz != 0u)) {                                                                                                                                \
                    _Pragma("unroll") for (int k = 0; k < 4; ++k) { const bool eq = ((cwd[d] >> (8 * k)) & 255u) == bs;                                                  \
                        if (eq) { const unsigned pos = __hip_atomic_fetch_add(&fb[100], 1u, __ATOMIC_RELAXED, __HIP_MEMORY_SCOPE_WORKGROUP);                             \
                            if (pos < (unsigned)FCAP) fl[pos] = qtag | (unsigned)(j_ * 32 + crow(4 * d + k, hi)); } } } } } while (0)
        uint4 cA = IDX_LDC(ks), cB = IDX_LDC(ks + 4), cC = IDX_LDC(ks + 8), cD = IDX_LDC(ks + 12);
#pragma unroll 1
        for (int j = ks; j < ntile; j += 16) {
            IDX_PROC(cA, j); cA = IDX_LDC(j + 16);
            if (j + 4 < ntile) { IDX_PROC(cB, j + 4); cB = IDX_LDC(j + 20); }
            if (j + 8 < ntile) { IDX_PROC(cC, j + 8); cC = IDX_LDC(j + 24); }
            if (j + 12 < ntile) { IDX_PROC(cD, j + 12); cD = IDX_LDC(j + 28); }
        }
#undef IDX_PROC
#undef IDX_SEL
#undef IDX_LDC
        for (int j = ntile + ks; j < jend; j += 4) if (lane < 16) mw[(size_t)j * 16 + lane] = 0ull; }
    __syncthreads();
    { const unsigned nfl = fb[100] < (unsigned)FCAP ? fb[100] : (unsigned)FCAP; const float* wv = (const float*)(lds + OFF_WV); unsigned* blq = (unsigned*)(lds + OFF_HIST);
        unsigned ti_ = (unsigned)tid; asm volatile("" : "+v"(ti_));
#pragma unroll 1
        for (unsigned i = ti_; i < nfl; i += 512u) { const unsigned e = fl[i]; const int q = (int)(e >> 14), key = (int)(e & 16383u);
            const uint4* kp = (const uint4*)(kib + (size_t)key * 128); float kf[64];
#pragma unroll
            for (int cc = 0; cc < 8; ++cc) { const uint4 w = kp[cc];
                kf[8 * cc] = __builtin_bit_cast(float, w.x << 16); kf[8 * cc + 1] = __builtin_bit_cast(float, w.x & 0xffff0000u); kf[8 * cc + 2] = __builtin_bit_cast(float, w.y << 16); kf[8 * cc + 3] = __builtin_bit_cast(float, w.y & 0xffff0000u);
                kf[8 * cc + 4] = __builtin_bit_cast(float, w.z << 16); kf[8 * cc + 5] = __builtin_bit_cast(float, w.z & 0xffff0000u); kf[8 * cc + 6] = __builtin_bit_cast(float, w.w << 16); kf[8 * cc + 7] = __builtin_bit_cast(float, w.w & 0xffff0000u); }
            const char* qp = (const char*)QI + (size_t)(unsigned)(row0 + q) * 1024; float s = 0.f;
#pragma unroll 4
            for (int h = 0; h < 8; ++h) { float d = 0.f; const uint4* qh = (const uint4*)(qp + h * 128);
#pragma unroll
                for (int cc = 0; cc < 8; ++cc) { const uint4 w = qh[cc];
                    d = fmaf(__builtin_bit_cast(float, w.x << 16), kf[8 * cc], d); d = fmaf(__builtin_bit_cast(float, w.x & 0xffff0000u), kf[8 * cc + 1], d);
                    d = fmaf(__builtin_bit_cast(float, w.y << 16), kf[8 * cc + 2], d); d = fmaf(__builtin_bit_cast(float, w.y & 0xffff0000u), kf[8 * cc + 3], d);
                    d = fmaf(__builtin_bit_cast(float, w.z << 16), kf[8 * cc + 4], d); d = fmaf(__builtin_bit_cast(float, w.z & 0xffff0000u), kf[8 * cc + 5], d);
                    d = fmaf(__builtin_bit_cast(float, w.w << 16), kf[8 * cc + 6], d); d = fmaf(__builtin_bit_cast(float, w.w & 0xffff0000u), kf[8 * cc + 7], d); }
                s = fmaf(2.f * wv[q * 8 + h], fmaxf(d, 0.f), s); }
            const float2 ab = qpar[q]; const float u = fmaf(s, ab.x, ab.y);
            const unsigned fine = (unsigned)__builtin_amdgcn_fmed3f((u - (float)bstar[q]) * 262144.f, 0.f, 262143.f);
            const unsigned pos = __hip_atomic_fetch_add(&bcnt[q], 1u, __ATOMIC_RELAXED, __HIP_MEMORY_SCOPE_WORKGROUP);
            const unsigned word = (fine << 14) | (16383u - (unsigned)key); fl[FCAP + i] = word;
            if (pos < (unsigned)CAP) blq[q * CAP + pos] = word; } }
    asm volatile("s_waitcnt vmcnt(0)" ::: "memory");
    __syncthreads();
    { const bool flat_over = fb[100] > (unsigned)FCAP; const unsigned nfl = flat_over ? (unsigned)FCAP : fb[100]; const unsigned* blq = (const unsigned*)(lds + OFF_HIST);
        unsigned ti_ = (unsigned)tid; asm volatile("" : "+v"(ti_));
        if (ti_ < 64u) { const int q = (int)ti_; if (flat_over || bcnt[q] > (unsigned)CAP || bstar[q] <= 0 || bstar[q] >= NBINS - 1 || (DBG_FORCE_FB && (q & 15) == 3)) {
            const unsigned p = __hip_atomic_fetch_add(&fb[0], 1u, __ATOMIC_RELAXED, __HIP_MEMORY_SCOPE_WORKGROUP); fb[1 + p] = (unsigned)q; } }
        if (!flat_over) {
#pragma unroll 1
        for (unsigned i = ti_; i < nfl; i += 512u) { const unsigned ef = fl[i]; const int q = (int)(ef >> 14); const unsigned cnt = bcnt[q];
            if (cnt > (unsigned)CAP || bstar[q] <= 0 || bstar[q] >= NBINS - 1 || (DBG_FORCE_FB && (q & 15) == 3)) continue;
            const unsigned mine = fl[FCAP + i];
            const unsigned* bl = blq + q * CAP; int rk = 0;
            for (unsigned m = 0; m < cnt; ++m) rk += bl[m] > mine;
            if (rk < needv[q]) mask_or_bit(MASKW + ((size_t)(b * (S / 32) + 2 * c + (q >> 5)) * (S / 32)) * 16, q & 31, (int)(16383u - (mine & 16383u))); } } }
    __syncthreads();
    { const int nfb = (int)fb[0];
        for (int f = 0; f < nfb; ++f) { const int q = (int)fb[1 + f];
            fallback_query(lds, tid, row0 + q, q & 31, n, QI, kib, WI, MASKW + ((size_t)(b * (S / 32) + 2 * c + (q >> 5)) * (S / 32)) * 16); } }
    __syncthreads();
}
__device__ __forceinline__ void indexer_phase(char* lds, int vcu, int G, const bf16* QI, const bf16* KI, const float* WI, u64* MASKW, char* area_out, char* area_tail, char* area_gap, char* area_wai) {
    for (int item = vcu; item < 256; item += G) { const int b = (item >> 7) & 1, x = item & 127;
        const unsigned cum = (unsigned)(256 * x - x * (x - 1) / 2);
        char* codes = b == 0 ? area_out + (size_t)cum * 4096 : x < 33 ? area_out + (size_t)(24640u + cum) * 4096 : x < 73 ? area_tail + (size_t)(cum - 7920u) * 4096 : x < 115 ? area_gap + (size_t)(cum - 16060u) * 4096 : area_wai + (size_t)(cum - 22885u) * 4096;
#pragma unroll 1
        for (int pass = 0; pass < 2; ++pass) indexer_unit(lds, b, pass ? 255 - x : x, QI, KI, WI, MASKW, codes); }
}
}
namespace att {
typedef unsigned short bf16;
typedef short bf16x8 __attribute__((ext_vector_type(8)));
typedef short s16x4 __attribute__((ext_vector_type(4)));
typedef float f32x16 __attribute__((ext_vector_type(16)));
typedef float f32x4 __attribute__((ext_vector_type(4)));
typedef unsigned u32x4 __attribute__((ext_vector_type(4)));
typedef unsigned long long u64;
typedef const __attribute__((address_space(4))) u64* cu64p;
typedef float f32x2_t __attribute__((ext_vector_type(2))); typedef __bf16 bf16x2_t __attribute__((ext_vector_type(2)));
__device__ __forceinline__ unsigned cvtpk_s(float lo, float hi) { f32x2_t v = {lo, hi}; bf16x2_t b = __builtin_convertvector(v, bf16x2_t); return __builtin_bit_cast(unsigned, b); }
constexpr int D = 128, PITCH = 1024, NW = 8, QBLK = 32, KVBLK = 64, QB = NW * QBLK;
constexpr int SHM_V = KVBLK * D * 2, SHM_K = KVBLK * D * 2;
constexpr int NBUF = 4;
constexpr int OFF_WS = NBUF * SHM_V + NBUF * SHM_K;
constexpr int OFF_TAB = OFF_WS + NW * 64 * 4;
constexpr int OFF_EP = 0;
constexpr int EP_PITCH = 272, EP_WAVE = 32 * EP_PITCH;
constexpr int ATTN_LDS_BYTES = OFF_TAB + 448 * 4;
static_assert(NW * EP_WAVE <= OFF_WS, "epilogue staging fits the ring");
constexpr float THR2 = 11.5f;
constexpr int MW_PER_QB = (S / 32) * 16;

#define KSWZ(row, colB) ((row) * 256 + ((colB) ^ (((row) & 7) << 4)))
#define SBAR() __builtin_amdgcn_sched_barrier(0)
__device__ __forceinline__ int v_st(int k, int c) { const int kk = (k & ~0xC) | ((k & 4) << 1) | ((k & 8) >> 1); return ((kk >> 3) * 4 + (c >> 5)) * 512 + ((kk & 7) * 32 + (c & 31)) * 2; }
__device__ __forceinline__ int v_st_nat(int k, int c) { return ((k >> 3) * 4 + (c >> 5)) * 512 + ((k & 7) * 32 + (c & 31)) * 2; }
__device__ __forceinline__ int v_rd_base(int lane) { return ((lane & 3) << 3) | (((lane >> 2) & 3) << 6) | (((lane >> 4) & 1) << 5) | (((lane >> 5) & 1) << 8); }
constexpr int v_rd_off(int d0, int ks, int half) { return d0 * 512 + ks * 4096 + half * 2048; }
__device__ __forceinline__ int crow(int r, int hi) { return (r & 3) + 8 * (r >> 2) + 4 * hi; }
__device__ __forceinline__ unsigned cvtpk(float lo, float hi) { unsigned r; asm volatile("v_cvt_pk_bf16_f32 %0, %1, %2" : "=v"(r) : "v"(lo), "v"(hi)); return r; }

template <bool NEAR>
__device__ __forceinline__ void init_tile(f32x16& p0, f32x16& p1, cu64p w, float cb  , const float* tabp, float mcur) {
    const float NEG = -__builtin_inff();
    u64 m0[16], m1[16];
#pragma unroll
    for (int r = 0; r < 16; ++r) { m0[r] = w[r]; m1[r] = w[16 + r]; }
#pragma unroll
    for (int r = 0; r < 16; ++r) { float bv = cb; if (NEAR) bv = tabp[59 - ((r & 3) + 8 * (r >> 2))] - mcur;
        float o; asm volatile("v_cndmask_b32_e64 %0, %1, %2, %3" : "=v"(o) : "v"(NEG), "v"(bv), "s"(m0[r])); p0[r] = o; }
#pragma unroll
    for (int r = 0; r < 16; ++r) { float bv = cb; if (NEAR) bv = tabp[27 - ((r & 3) + 8 * (r >> 2))] - mcur;
        float o; asm volatile("v_cndmask_b32_e64 %0, %1, %2, %3" : "=v"(o) : "v"(NEG), "v"(bv), "s"(m1[r])); p1[r] = o; }
}
__device__ __forceinline__ void partialSM(f32x16& p0, f32x16& p1, float& m_reg, float& alpha, float l_cur, float pmax_in) {
    float pmax = pmax_in;
    { auto rr = __builtin_amdgcn_permlane32_swap(__float_as_uint(pmax), __float_as_uint(pmax), false, false);
      pmax = fmaxf(__uint_as_float(rr[0]), __uint_as_float(rr[1])); }
    const bool low = pmax < -64.f && pmax > -__builtin_inff();
    alpha = 1.f;
    if (__builtin_expect(__any(pmax > THR2 || low), 0)) {
        float delta = 0.f;
        if (pmax > THR2) { delta = pmax; alpha = __builtin_amdgcn_exp2f(-delta); }
        else if (low && l_cur == 0.f) delta = pmax;
        m_reg += delta;
#pragma unroll
        for (int r = 0; r < 16; ++r) p0[r] = p0[r] - delta;
#pragma unroll
        for (int r = 0; r < 16; ++r) p1[r] = p1[r] - delta; }
#pragma unroll
    for (int r = 0; r < 16; ++r) p0[r] = __builtin_amdgcn_exp2f(p0[r]);
}
__device__ __forceinline__ void finishSM(f32x16& p0, f32x16& p1, float alpha, float& l_reg, bf16x8& pa0, bf16x8& pa1, bf16x8& pa2, bf16x8& pa3) {
#pragma unroll
    for (int r = 0; r < 16; ++r) p1[r] = __builtin_amdgcn_exp2f(p1[r]);
    float ps = 0;
#pragma unroll
    for (int r = 0; r < 16; ++r) ps += p0[r];
#pragma unroll
    for (int r = 0; r < 16; ++r) ps += p1[r];
    { auto rr = __builtin_amdgcn_permlane32_swap(__float_as_uint(ps), __float_as_uint(ps), false, false);
      ps = __uint_as_float(rr[0]) + __uint_as_float(rr[1]); }
    l_reg = l_reg * alpha + ps;
#define PK4(P, B_, OUT) do { u32x4 w = {cvtpk(P[B_+0], P[B_+1]), cvtpk(P[B_+2], P[B_+3]), cvtpk(P[B_+4], P[B_+5]), cvtpk(P[B_+6], P[B_+7])};   \
        OUT = *reinterpret_cast<bf16x8*>(&w); } while (0)
    PK4(p0, 0, pa0); PK4(p0, 8, pa1); PK4(p1, 0, pa2); PK4(p1, 8, pa3);
#undef PK4
}
template <int KB>
__device__ __forceinline__ void qkt(f32x16& p0, f32x16& p1, const char* K_lds, int r32, int hi, const bf16x8* qr) {
    const char* kb[4];
#pragma unroll
    for (int dd = 0; dd < 4; ++dd) kb[dd] = K_lds + KB * SHM_K + KSWZ(r32, (dd * 16 + hi * 8) * 2);
#pragma unroll
    for (int d0 = 0; d0 < 8; ++d0) { const char* a = kb[d0 & 3] + (d0 >> 2) * 128;
        bf16x8 b0 = *reinterpret_cast<const bf16x8*>(a);
        bf16x8 b1 = *reinterpret_cast<const bf16x8*>(a + 32 * 256);
        p0 = __builtin_amdgcn_mfma_f32_32x32x16_bf16(b0, qr[d0], p0, 0, 0, 0);
        p1 = __builtin_amdgcn_mfma_f32_32x32x16_bf16(b1, qr[d0], p1, 0, 0, 0); }
}
template <int VB>
__device__ __forceinline__ void pv_tile(f32x16* o, int vb0, bf16x8 pa0, bf16x8 pa1, bf16x8 pa2, bf16x8 pa3) {
#define TRRD(dst, off) asm volatile("ds_read_b64_tr_b16 %0, %1 offset:%2" : "=&v"(dst) : "v"(vb0), "i"(off) : "memory")
#define PV_D0(d0) do { s16x4 l0, l1, l2, l3, h0, h1, h2, h3; constexpr int b_ = VB * SHM_V + v_rd_off(d0, 0, 0); \
        TRRD(l0, b_); TRRD(h0, b_ + 2048); TRRD(l1, b_ + 4096); TRRD(h1, b_ + 6144); TRRD(l2, b_ + 8192); TRRD(h2, b_ + 10240); TRRD(l3, b_ + 12288); TRRD(h3, b_ + 14336); \
        asm volatile("s_waitcnt lgkmcnt(0)" ::: "memory"); SBAR();   \
        o[d0] = __builtin_amdgcn_mfma_f32_32x32x16_bf16(pa0, (bf16x8){l0[0], l0[1], l0[2], l0[3], h0[0], h0[1], h0[2], h0[3]}, o[d0], 0, 0, 0);   \
        o[d0] = __builtin_amdgcn_mfma_f32_32x32x16_bf16(pa1, (bf16x8){l1[0], l1[1], l1[2], l1[3], h1[0], h1[1], h1[2], h1[3]}, o[d0], 0, 0, 0);   \
        o[d0] = __builtin_amdgcn_mfma_f32_32x32x16_bf16(pa2, (bf16x8){l2[0], l2[1], l2[2], l2[3], h2[0], h2[1], h2[2], h2[3]}, o[d0], 0, 0, 0);   \
        o[d0] = __builtin_amdgcn_mfma_f32_32x32x16_bf16(pa3, (bf16x8){l3[0], l3[1], l3[2], l3[3], h3[0], h3[1], h3[2], h3[3]}, o[d0], 0, 0, 0); } while (0)
    PV_D0(0); PV_D0(1); PV_D0(2); PV_D0(3);
#undef PV_D0
#undef TRRD
}

template <int VB>
__device__ __forceinline__ float pv_tile_max(f32x16* o, int vb0, bf16x8 pa0, bf16x8 pa1, bf16x8 pa2, bf16x8 pa3, const f32x16& p0, const f32x16& p1) {
#define TRRD(dst, off) asm volatile("ds_read_b64_tr_b16 %0, %1 offset:%2" : "=&v"(dst) : "v"(vb0), "i"(off) : "memory")
#define MX3(a, b, c) fmaxf(fmaxf(a, b), c)
#define PV_D0(d0, HOOK) do { s16x4 l0, l1, l2, l3, h0, h1, h2, h3; constexpr int b_ = VB * SHM_V + v_rd_off(d0, 0, 0); \
        TRRD(l0, b_); TRRD(h0, b_ + 2048); TRRD(l1, b_ + 4096); TRRD(h1, b_ + 6144); TRRD(l2, b_ + 8192); TRRD(h2, b_ + 10240); TRRD(l3, b_ + 12288); TRRD(h3, b_ + 14336); \
        HOOK; asm volatile("s_waitcnt lgkmcnt(0)" ::: "memory"); SBAR();   \
        o[d0] = __builtin_amdgcn_mfma_f32_32x32x16_bf16(pa0, (bf16x8){l0[0], l0[1], l0[2], l0[3], h0[0], h0[1], h0[2], h0[3]}, o[d0], 0, 0, 0);   \
        o[d0] = __builtin_amdgcn_mfma_f32_32x32x16_bf16(pa1, (bf16x8){l1[0], l1[1], l1[2], l1[3], h1[0], h1[1], h1[2], h1[3]}, o[d0], 0, 0, 0);   \
        o[d0] = __builtin_amdgcn_mfma_f32_32x32x16_bf16(pa2, (bf16x8){l2[0], l2[1], l2[2], l2[3], h2[0], h2[1], h2[2], h2[3]}, o[d0], 0, 0, 0);   \
        o[d0] = __builtin_amdgcn_mfma_f32_32x32x16_bf16(pa3, (bf16x8){l3[0], l3[1], l3[2], l3[3], h3[0], h3[1], h3[2], h3[3]}, o[d0], 0, 0, 0); } while (0)
    float m;
    PV_D0(0, m = MX3(p0[0], p0[1], p0[2]); m = MX3(m, p0[3], p0[4]); m = MX3(m, p0[5], p0[6]); m = MX3(m, p0[7], p0[8]));
    PV_D0(1, m = MX3(m, p0[9], p0[10]); m = MX3(m, p0[11], p0[12]); m = MX3(m, p0[13], p0[14]); m = MX3(m, p0[15], p1[0]));
    PV_D0(2, m = MX3(m, p1[1], p1[2]); m = MX3(m, p1[3], p1[4]); m = MX3(m, p1[5], p1[6]); m = MX3(m, p1[7], p1[8]));
    PV_D0(3, m = MX3(m, p1[9], p1[10]); m = MX3(m, p1[11], p1[12]); m = MX3(m, p1[13], p1[14]); m = fmaxf(m, p1[15]));
#undef PV_D0
#undef MX3
#undef TRRD
    return m;
}

struct BlockRef { const bf16* Q; const bf16* K; const bf16* V; const bf16* ZS; bf16* O; const u64* MW; const float* bias; int P0; };
struct Seam { bf16x8 qr[8]; bf16x8 st_v0, st_v1, st_k0, st_k1; };
#define ROW(p, k0, rr) ((const bf16*)((const char*)(p) + (size_t)(unsigned)(((k0) + (rr)) * (PITCH * 2) + sc * 2)))
#define VMW() asm volatile("s_waitcnt vmcnt(0)" ::: "memory")
#define VMWN(n) asm volatile("s_waitcnt vmcnt(%0)" :: "i"(n) : "memory")
#define LD8(p) (*reinterpret_cast<const bf16x8*>(p))
#define SLOAD_H(Kp, Vp, k0) do { S.st_v0 = LD8(ROW(Vp, k0, sr)); S.st_v1 = LD8(ROW(Vp, k0, 32 + sr)); S.st_k0 = LD8(ROW(Kp, k0, sr)); S.st_k1 = LD8(ROW(Kp, k0, 32 + sr)); } while (0)
#define SWRITE_HK(bf) do { *(bf16x8*)(K_lds + (bf) * SHM_K + kws) = S.st_k0; *(bf16x8*)(K_lds + (bf) * SHM_K + kws + 32 * 256) = S.st_k1; } while (0)
#define SWRITE_HV(bf) do { *(bf16x8*)(V_lds + (bf) * SHM_V + vst0) = S.st_v0; *(bf16x8*)(V_lds + (bf) * SHM_V + vst1) = S.st_v1; } while (0)
#define SWRITE_H(bf) do { SWRITE_HV(bf); SWRITE_HK(bf); } while (0)
__device__ __forceinline__ void attn_block(const BlockRef& cur, char* lds) {
    Seam S;
    int tid_ = threadIdx.x; asm volatile("" : "+v"(tid_));
    const int tid = tid_, wid = __builtin_amdgcn_readfirstlane(tid >> 6), lane = tid & 63, r32 = lane & 31, hi = lane >> 5;
    const int NT = (cur.P0 + QB) / KVBLK;
    const int qlo = cur.P0 + wid * QBLK;
    char* V_lds = lds; char* K_lds = lds + NBUF * SHM_V;
    float* ws = (float*)(lds + OFF_WS) + wid * 64; float* li_l = ws, * al_l = ws + 32;
    float* tab = (float*)(lds + OFF_TAB);
    float m_reg = 0.f, l_reg = 0; f32x16 o[4] = {};
    const int sr = tid >> 4, sc = (tid & 15) * 8, vst0 = v_st_nat(sr, sc), vst1 = v_st_nat(32 + sr, sc), kws = KSWZ(sr, sc * 2);
    const int vb0 = (int)(uintptr_t)V_lds + v_rd_base(lane);
    const bf16* Kh = cur.K; const bf16* Vh = cur.V;
    { int tq_ = tid; asm volatile("" : "+v"(tq_));
    if (tq_ < 448) { const int rel = tq_ - 256; const int ret = rel < 0 ? 16 : 0; const int n = rel < 0 ? -rel : rel; int v;
        if (n < 8) v = n; else if (n < 12) v = 8; else if (n < 16) v = 9; else if (n < 23) v = 10; else if (n < 32) v = 11; else if (n < 46) v = 12; else if (n < 64) v = 13; else if (n < 91) v = 14; else v = 15;
        tab[tq_] = cur.bias[(ret + v) * 8] * 1.4426950408889634f; } }
    const float cbfar = cur.bias[15 * 8] * 1.4426950408889634f;
    const cu64p mwv = (cu64p)(uintptr_t)(cur.MW + (size_t)wid * MW_PER_QB);
#define RESC(a) do { if (__any((a) < 1.f)) { if (hi == 0) al_l[r32] = (a); asm volatile("s_waitcnt lgkmcnt(0)" ::: "memory");              \
                     for (int d_ = 0; d_ < 4; ++d_) for (int r = 0; r < 16; ++r) o[d_][r] *= al_l[crow(r, hi)]; } } while (0)
#define KBASE(t) ((t) * KVBLK)
#define INIT(P0_, P1_, t) do { const int kb_ = KBASE(t); const cu64p w_ = mwv + (size_t)(t) * 32;                              \
        if (kb_ + 154 <= qlo) init_tile<false>(P0_, P1_, w_, cbfar - m_reg, tab, m_reg);                                        \
        else init_tile<true>(P0_, P1_, w_, cbfar - m_reg, tab + (qlo + r32 - kb_ - 4 * hi + 197), m_reg); } while (0)
    unsigned pm0 = 0u, pm1 = 0u, pm2 = 0u, pm3 = 0u;
#define MPREF(t) do { const __attribute__((address_space(4))) unsigned* w_ = (const __attribute__((address_space(4))) unsigned*)(mwv + (size_t)(t) * 32); pm0 = w_[0]; pm1 = w_[16]; pm2 = w_[32]; pm3 = w_[48]; SBAR(); } while (0)
#define MUSE() asm volatile("" :: "s"(pm0), "s"(pm1), "s"(pm2), "s"(pm3))
    f32x16 pA0, pA1, pB0, pB1; float alA, alB; bf16x8 pa0, pa1, pa2, pa3;
#pragma unroll
    for (int d0 = 0; d0 < 8; ++d0) S.qr[d0] = LD8((const char*)cur.Q + (size_t)(unsigned)((wid * QBLK + r32) * (PITCH * 2) + d0 * 32 + hi * 16));
    SLOAD_H(Kh, Vh, 0); VMW(); SWRITE_H(0); SBAR();
    if (NT > 1) SLOAD_H(Kh, Vh, KBASE(1));
    __syncthreads();
    INIT(pA0, pA1, 0);
    SBAR(); qkt<0>(pA0, pA1, K_lds, r32, hi, S.qr);
    MPREF(1);
    { float pm_ = pA0[0];
#pragma unroll
      for (int r = 1; r < 16; ++r) pm_ = fmaxf(pm_, pA0[r]);
#pragma unroll
      for (int r = 0; r < 16; ++r) pm_ = fmaxf(pm_, pA1[r]);
      partialSM(pA0, pA1, m_reg, alA, l_reg, pm_); }
    if (NT > 1) { VMW(); SWRITE_H(1); }
    __syncthreads();
#define HALF_STEP(PX0, PX1, alX, PY0, PY1, alY, t, KB, VB, SB) do {                                                           \
        MUSE(); INIT(PX0, PX1, (t)); SBAR(); qkt<KB>(PX0, PX1, K_lds, r32, hi, S.qr);                                        \
        finishSM(PY0, PY1, alY, l_reg, pa0, pa1, pa2, pa3); SBAR();                                                           \
        SLOAD_H(Kh, Vh, KBASE((t) + 1)); SBAR();                                                                              \
        { const float pm_ = pv_tile_max<VB>(o, vb0, pa0, pa1, pa2, pa3, PX0, PX1); MPREF((t) + 1); partialSM(PX0, PX1, m_reg, alX, l_reg, pm_); }   \
        VMW(); SWRITE_H(SB);                                                                                                  \
        RESC(alX); __syncthreads(); } while (0)
    int t = 1;
    for (; t + 4 < NT; t += 4) {
        HALF_STEP(pB0, pB1, alB, pA0, pA1, alA, t, 1, 0, 2);
        HALF_STEP(pA0, pA1, alA, pB0, pB1, alB, t + 1, 2, 1, 3);
        HALF_STEP(pB0, pB1, alB, pA0, pA1, alA, t + 2, 3, 2, 0);
        HALF_STEP(pA0, pA1, alA, pB0, pB1, alB, t + 3, 0, 3, 1);
    }
    HALF_STEP(pB0, pB1, alB, pA0, pA1, alA, NT - 3, 1, 0, 2);
    HALF_STEP(pA0, pA1, alA, pB0, pB1, alB, NT - 2, 2, 1, 3);
    MUSE(); INIT(pB0, pB1, NT - 1); SBAR(); qkt<3>(pB0, pB1, K_lds, r32, hi, S.qr); SBAR();
    finishSM(pA0, pA1, alA, l_reg, pa0, pa1, pa2, pa3); SBAR();
    { const float pm_ = pv_tile_max<2>(o, vb0, pa0, pa1, pa2, pa3, pB0, pB1); partialSM(pB0, pB1, m_reg, alB, l_reg, pm_); } RESC(alB);
    finishSM(pB0, pB1, alB, l_reg, pa0, pa1, pa2, pa3); SBAR(); pv_tile<3>(o, vb0, pa0, pa1, pa2, pa3);
    SBAR();
    __syncthreads();
    if (hi == 0) li_l[r32] = l_reg; asm volatile("s_waitcnt lgkmcnt(0)" ::: "memory");
    float rli[16];
#pragma unroll
    for (int r = 0; r < 16; ++r) rli[r] = __builtin_amdgcn_rcpf(li_l[crow(r, hi)]);
    {
        char* ep = lds + OFF_EP + wid * EP_WAVE; unsigned ew_off = (unsigned)(4 * hi * EP_PITCH + r32 * 2); asm volatile("" : "+v"(ew_off));
#pragma unroll
        for (int r = 0; r < 16; ++r) { const int rw = (r & 3) + 8 * (r >> 2);
#pragma unroll
            for (int d0 = 0; d0 < 4; ++d0) *(unsigned short*)(ep + ew_off + rw * EP_PITCH + d0 * 64) = (unsigned short)(cvtpk_s(o[d0][r] * rli[r], 0.f) & 0xffffu); }
        asm volatile("s_waitcnt lgkmcnt(0)" ::: "memory");
        unsigned lane_off = (unsigned)((wid * QBLK + (lane >> 4)) * PITCH + (lane & 15) * 8) * 2u;
        asm volatile("" : "+v"(lane_off));
        unsigned er_off = (unsigned)((lane >> 4) * EP_PITCH + (lane & 15) * 16); asm volatile("" : "+v"(er_off));
        char* op = (char*)cur.O + (size_t)lane_off; const char* zp = (const char*)cur.ZS + (size_t)lane_off; const char* er = ep + er_off;
#pragma unroll
        for (int ph = 0; ph < 2; ++ph) {
            asm volatile("" ::: "memory");
            uint4 zz[4];
#pragma unroll
            for (int p4 = 0; p4 < 4; ++p4) zz[p4] = *(const uint4*)(zp + (ph * 4 + p4) * 4 * PITCH * 2);
#pragma unroll
            for (int p4 = 0; p4 < 4; ++p4) { const int p = ph * 4 + p4; const uint4 m = *(const uint4*)(er + p * 4 * EP_PITCH); const uint4 z = zz[p4]; uint4 y;
                y.x = cvtpk_s(__uint_as_float(m.x << 16) * __uint_as_float(z.x << 16), __uint_as_float(m.x & 0xffff0000u) * __uint_as_float(z.x & 0xffff0000u));
                y.y = cvtpk_s(__uint_as_float(m.y << 16) * __uint_as_float(z.y << 16), __uint_as_float(m.y & 0xffff0000u) * __uint_as_float(z.y & 0xffff0000u));
                y.z = cvtpk_s(__uint_as_float(m.z << 16) * __uint_as_float(z.z << 16), __uint_as_float(m.z & 0xffff0000u) * __uint_as_float(z.z & 0xffff0000u));
                y.w = cvtpk_s(__uint_as_float(m.w << 16) * __uint_as_float(z.w << 16), __uint_as_float(m.w & 0xffff0000u) * __uint_as_float(z.w & 0xffff0000u));
                *(uint4*)(op + p * 4 * PITCH * 2) = y; } }
    }
    __syncthreads();
#undef RESC
#undef KBASE
#undef INIT
#undef MPREF
#undef MUSE
#undef HALF_STEP
}
#undef ROW
#undef VMW
#undef VMWN
#undef LD8
#undef SLOAD_H
#undef SWRITE_HK
#undef SWRITE_HV
#undef SWRITE_H

__device__ __forceinline__ BlockRef make_ref(int L, int pass, const bf16* Q, const bf16* K, const bf16* V, const bf16* ZS, bf16* O, const u64* MASKW, const float* rel_bias) {
    const int bh = L >> 5, x = L & 31, b = bh >> 3, h = bh & 7, qb = pass ? 63 - x : x;
    BlockRef r; const size_t row0 = (size_t)b * S + (size_t)qb * QB;
    r.Q = Q + row0 * PITCH + h * D; r.O = O + row0 * PITCH + h * D; r.ZS = ZS + row0 * PITCH + h * D;
    r.K = K + (size_t)b * S * PITCH + h * D; r.V = V + (size_t)b * S * PITCH + h * D;
    r.MW = MASKW + ((size_t)b * (S / 32) + (size_t)qb * 8) * MW_PER_QB; r.bias = rel_bias + h; r.P0 = qb * QB;
    return r;
}
__device__ __forceinline__ void attn_phase(char* lds, int vcu, int G, const bf16* Q, const bf16* K, const bf16* V, const bf16* ZS, bf16* O, const u64* MASKW, const float* rel_bias) {
    constexpr int TOTAL = 512;
    for (int L = vcu; L < TOTAL; L += G)
#pragma unroll 1
        for (int pass = 0; pass < 2; ++pass) { const BlockRef cur = make_ref(L, pass, Q, K, V, ZS, O, MASKW, rel_bias); attn_block(cur, lds); }
}
}

namespace sgu {
typedef unsigned short bf16;
typedef short bf16x8 __attribute__((ext_vector_type(8)));
typedef short s16x4 __attribute__((ext_vector_type(4)));
typedef float f32x16 __attribute__((ext_vector_type(16)));
typedef float f32x2_t __attribute__((ext_vector_type(2))); typedef __bf16 bf16x2_t __attribute__((ext_vector_type(2)));
__device__ __forceinline__ unsigned cvtpk_s(float lo, float hi) { f32x2_t v = {lo, hi}; bf16x2_t b = __builtin_convertvector(v, bf16x2_t); return __builtin_bit_cast(unsigned, b); }
constexpr int OFF_B = 0;
constexpr int OFF_ST = 65536;
constexpr int OFF_EP = 66560;
constexpr int EP_PITCH = 80, EP_WAVE = 128 * EP_PITCH;
constexpr int SGU_LDS_BYTES = OFF_EP + 8 * EP_WAVE;

template <bool WRITE>
__device__ __forceinline__ void sgu_phase(char* lds, int vcu, int G, bf16* U  , const bf16* Vb, const float* LNP, const bf16* WS16, const float* ln_g, const float* ln_b, const float* b_s) {
    const int tid = threadIdx.x, wid = __builtin_amdgcn_readfirstlane(tid >> 6), lane = tid & 63, r32 = lane & 31, hi = lane >> 5;
    float2* stats = (float2*)(lds + OFF_ST);
    for (int chunk = vcu; chunk < M / 128; chunk += G) {
        const size_t row0 = (size_t)chunk * 128;
        { int tq_ = tid; asm volatile("" : "+v"(tq_));
          if (tq_ < 128) { const float4* pp = (const float4*)(LNP + (row0 + tq_) * 64); float s1 = 0.f, s2 = 0.f;
#pragma unroll
            for (int j = 0; j < 16; ++j) { const float4 q = pp[j]; s1 += q.x + q.z; s2 += q.y + q.w; }
            const float mean = s1 * (1.f / BW); const float var = fmaxf(s2 * (1.f / BW) - mean * mean, 0.f);
            stats[tq_] = make_float2(mean, 1.0f / sqrtf(var + LN_EPS)); } }
        __syncthreads();
#pragma unroll 1
        for (int g = 0; g < 8; ++g) {
            bf16x8 A0[2], A1[4], A2[6], A3[8];
            uint4 ug[8];
            { const size_t gb_ = (row0 * BW + (size_t)(g * 256 + (wid >> 2) * 128 + (wid & 3) * 32 + (lane & 3) * 8)) * 2;
#pragma unroll
                for (int p = 0; p < 8; ++p) ug[p] = *(const uint4*)((const char*)U + gb_ + (size_t)(16 * p + (lane >> 2)) * (BW * 2)); }
            { const char* ap = (const char*)WS16 + (size_t)(unsigned)(((g * 128 + r32) * 128 + 8 * hi) * 2);
#pragma unroll
                for (int kk = 0; kk < 2; ++kk) A0[kk] = *reinterpret_cast<const bf16x8*>(ap + kk * 32);
#pragma unroll
                for (int kk = 0; kk < 4; ++kk) A1[kk] = *reinterpret_cast<const bf16x8*>(ap + 32 * 256 + kk * 32);
#pragma unroll
                for (int kk = 0; kk < 6; ++kk) A2[kk] = *reinterpret_cast<const bf16x8*>(ap + 64 * 256 + kk * 32);
#pragma unroll
                for (int kk = 0; kk < 8; ++kk) A3[kk] = *reinterpret_cast<const bf16x8*>(ap + 96 * 256 + kk * 32); }
            { const int e8 = (tid & 31) * 8, ch = g * 256 + e8;
                const float4 g0 = *(const float4*)(ln_g + ch), g1 = *(const float4*)(ln_g + ch + 4), b0 = *(const float4*)(ln_b + ch), b1 = *(const float4*)(ln_b + ch + 4);
#pragma unroll
                for (int i = 0; i < 8; ++i) { const int s = (tid >> 5) + 16 * i; const uint4 w = *(const uint4*)(Vb + (row0 + s) * BW + ch); const float2 st = stats[s];
                    const float x0 = (bflo(w.x) - st.x) * st.y * g0.x + b0.x, x1 = (bfhi(w.x) - st.x) * st.y * g0.y + b0.y, x2 = (bflo(w.y) - st.x) * st.y * g0.z + b0.z, x3 = (bfhi(w.y) - st.x) * st.y * g0.w + b0.w;
                    const float x4 = (bflo(w.z) - st.x) * st.y * g1.x + b1.x, x5 = (bfhi(w.z) - st.x) * st.y * g1.y + b1.y, x6 = (bflo(w.w) - st.x) * st.y * g1.z + b1.z, x7 = (bfhi(w.w) - st.x) * st.y * g1.w + b1.w;
                    uint4 o; o.x = att::cvtpk(x0, x1); o.y = att::cvtpk(x2, x3); o.z = att::cvtpk(x4, x5); o.w = att::cvtpk(x6, x7);
                    *(uint4*)(lds + OFF_B + ((s >> 6) * 2 + (e8 >> 7)) * 16384 + att::v_st(s & 63, e8 & 127)) = o; } }
            __syncthreads();
            f32x16 acc[4] = {};
            { const int eh = wid >> 2, d0 = wid & 3;
                const int vb0 = (int)(uintptr_t)(lds + OFF_B) + att::v_rd_base(lane) + eh * 16384 + d0 * 512;
#define TRRD(dst, off) asm volatile("ds_read_b64_tr_b16 %0, %1 offset:%2" : "=&v"(dst) : "v"(vb0), "i"(off) : "memory")
#define BFRAG(dst, sh, ks) do { s16x4 l_, h_; TRRD(l_, (sh) * 32768 + (ks) * 4096); TRRD(h_, (sh) * 32768 + (ks) * 4096 + 2048); asm volatile("s_waitcnt lgkmcnt(0)" ::: "memory"); \
                dst = (bf16x8){l_[0], l_[1], l_[2], l_[3], h_[0], h_[1], h_[2], h_[3]}; } while (0)
                bf16x8 Bf[8];
                BFRAG(Bf[0], 0, 0); BFRAG(Bf[1], 0, 1); BFRAG(Bf[2], 0, 2); BFRAG(Bf[3], 0, 3); BFRAG(Bf[4], 1, 0); BFRAG(Bf[5], 1, 1); BFRAG(Bf[6], 1, 2); BFRAG(Bf[7], 1, 3);
#undef BFRAG
#undef TRRD
#pragma unroll
                for (int kk = 0; kk < 2; ++kk) acc[0] = __builtin_amdgcn_mfma_f32_32x32x16_bf16(A0[kk], Bf[kk], acc[0], 0, 0, 0);
#pragma unroll
                for (int kk = 0; kk < 4; ++kk) acc[1] = __builtin_amdgcn_mfma_f32_32x32x16_bf16(A1[kk], Bf[kk], acc[1], 0, 0, 0);
#pragma unroll
                for (int kk = 0; kk < 6; ++kk) acc[2] = __builtin_amdgcn_mfma_f32_32x32x16_bf16(A2[kk], Bf[kk], acc[2], 0, 0, 0);
#pragma unroll
                for (int kk = 0; kk < 8; ++kk) acc[3] = __builtin_amdgcn_mfma_f32_32x32x16_bf16(A3[kk], Bf[kk], acc[3], 0, 0, 0);
                char* ep = lds + OFF_EP + wid * EP_WAVE;
#pragma unroll
                for (int tb = 0; tb < 4; ++tb)
#pragma unroll
                    for (int r = 0; r < 16; ++r) { const int tl = 32 * tb + (r & 3) + 8 * (r >> 2) + 4 * hi;
                        *(unsigned short*)(ep + tl * EP_PITCH + r32 * 2) = (unsigned short)(cvtpk_s(acc[tb][r], 0.f) & 0xffffu); }
                asm volatile("s_waitcnt lgkmcnt(0)" ::: "memory");
                const int rq = lane >> 2, cq = (lane & 3) * 8;
                const size_t gbase = (row0 * BW + (size_t)(g * 256 + eh * 128 + d0 * 32 + cq)) * 2;
#pragma unroll
                for (int ph = 0; ph < 2; ++ph) {
                    uint4 uu[4], mm[4]; float bs[4];
#pragma unroll
                    for (int p = 0; p < 4; ++p) { const int t = 16 * (ph * 4 + p) + rq; const size_t o = gbase + (size_t)t * (BW * 2);
                        uu[p] = ug[ph * 4 + p]; bs[p] = b_s[g * 128 + t]; mm[p] = *(const uint4*)(ep + t * EP_PITCH + cq * 2); }
#pragma unroll
                    for (int p = 0; p < 4; ++p) { const int t = 16 * (ph * 4 + p) + rq; const size_t o = gbase + (size_t)t * (BW * 2);
                        uint4 y;
                        y.x = att::cvtpk(bflo(uu[p].x) * (bflo(mm[p].x) + bs[p]), bfhi(uu[p].x) * (bfhi(mm[p].x) + bs[p]));
                        y.y = att::cvtpk(bflo(uu[p].y) * (bflo(mm[p].y) + bs[p]), bfhi(uu[p].y) * (bfhi(mm[p].y) + bs[p]));
                        y.z = att::cvtpk(bflo(uu[p].z) * (bflo(mm[p].z) + bs[p]), bfhi(uu[p].z) * (bfhi(mm[p].z) + bs[p]));
                        y.w = att::cvtpk(bflo(uu[p].w) * (bflo(mm[p].w) + bs[p]), bfhi(uu[p].w) * (bfhi(mm[p].w) + bs[p]));
                        if (WRITE || y.x == 0x12345678u) *(uint4*)((char*)U + o) = y; } } }
            __syncthreads();
        }
    }
}
}

constexpr size_t MiB = 1u << 20;
constexpr size_t WS_CTL = 0, CTL_ZERO_BYTES = 64 * 1024;
constexpr size_t WS_WAI = 2 * MiB, WS_WAO = 12 * MiB, WS_WBI = 14 * MiB, WS_WBO = 26 * MiB;
constexpr size_t WS_WS16 = 1 * MiB;
constexpr size_t WS_RS0 = 1 * MiB + 512 * 1024;
constexpr size_t WS_H = 32 * MiB;
constexpr size_t WS_Q = 96 * MiB, WS_K = 160 * MiB, WS_V = 224 * MiB, WS_ZS = 288 * MiB;
constexpr size_t WS_QI = 352 * MiB, WS_KI = 384 * MiB, WS_WI = 388 * MiB;
constexpr size_t WS_MASK = 416 * MiB;
constexpr size_t WS_PS = 30 * MiB;
constexpr size_t WS_XB = 32 * MiB;
constexpr size_t WS_OG = 352 * MiB;
constexpr size_t WS_U = 96 * MiB, WS_VB = 224 * MiB, WS_ZB = 352 * MiB;
constexpr size_t WS_LNP = 352 * MiB;
constexpr size_t WS_TAIL = 480 * MiB;
constexpr size_t WS_END = 512 * MiB;
constexpr int CW_BAR = 1024;
constexpr int LDS_BYTES = 162816;
constexpr int MISC_OFF = 160000;
static_assert(att::ATTN_LDS_BYTES <= MISC_OFF && idx::IDX_LDS_BYTES <= MISC_OFF && sgu::SGU_LDS_BYTES <= MISC_OFF, "LDS map");

#define XB_TMO      128
#define XB_XCNT(j)  (256  + 64 * (j))
#define XB_XSUB(j)  (1280 + 64 * (j))
#define XB_XGEN(j)  (2304 + 64 * (j))
#define XB_TOP      3328
#define XB_TOPGEN   3392
#define XCD_BAR_WORDS 3456
#define XB_SPIN_CAP (1u << 18)
__device__ __forceinline__ unsigned xb_ld(unsigned* p)              { return __hip_atomic_load(p, __ATOMIC_RELAXED, __HIP_MEMORY_SCOPE_AGENT); }
__device__ __forceinline__ unsigned xb_add(unsigned* p, unsigned v) { return __hip_atomic_fetch_add(p, v, __ATOMIC_RELAXED, __HIP_MEMORY_SCOPE_AGENT); }
__device__ __forceinline__ unsigned xb_xcc_id() { return (unsigned)__builtin_amdgcn_s_getreg((3 << 11) | 20) & 0xFu; }
#define XB_SPIN(cond, bar) do { unsigned _sp = 0; while (cond) { __builtin_amdgcn_s_sleep(1); \
    if ((++_sp & 255u) == 0u) { if (xb_ld(&(bar)[XB_TMO])) break; if (_sp > XB_SPIN_CAP) { atomicAdd(&(bar)[XB_TMO], 1u); break; } } } } while (0)
struct XcdBarrier { unsigned* bar; unsigned x; volatile LAS unsigned* st; };
__device__ __forceinline__ XcdBarrier xcd_barrier_post(unsigned* bar, volatile LAS unsigned* st) {
    XcdBarrier b; b.bar = bar; b.x = xb_xcc_id(); b.st = st;
    if (threadIdx.x == 0) (void)xb_add(&bar[XB_XCNT(b.x)], 1u);
    return b;
}
__device__ __forceinline__ void xcd_barrier_complete(unsigned* bar, unsigned x, unsigned& nloc, unsigned& nx) {
    const unsigned G = gridDim.x * gridDim.y * gridDim.z;
    unsigned sum, cnt, mine, sp = 0u;
    for (;;) {
        sum = 0u; cnt = 0u; mine = 0u;
#pragma unroll
        for (unsigned j = 0; j < 16; ++j) { const unsigned c = xb_ld(&bar[XB_XCNT(j)]); sum += c; cnt += (c > 0u) ? 1u : 0u; mine = (j == x) ? c : mine; }
        if (sum == G) break;
        __builtin_amdgcn_s_sleep(1);
        if ((++sp & 255u) == 0u) { if (xb_ld(&bar[XB_TMO])) break; if (sp > XB_SPIN_CAP) { atomicAdd(&bar[XB_TMO], 1u); break; } }
    }
    nloc = mine > 0u ? mine : 1u; nx = cnt > 0u ? cnt : 1u;
}
__device__ __forceinline__ void xcd_barrier(const XcdBarrier& b) {
    asm volatile("s_waitcnt vmcnt(0)" ::: "memory");
    __syncthreads();
    if (threadIdx.x == 0) {
        unsigned* bar = b.bar;
        __builtin_amdgcn_s_waitcnt(0);
        unsigned nloc = b.st[0], nx = b.st[1];
        if (nloc == 0u) { xcd_barrier_complete(bar, b.x, nloc, nx); b.st[0] = nloc; b.st[1] = nx; }
        const unsigned old = xb_add(&bar[XB_XSUB(b.x)], 1u);
        const unsigned gen = old / nloc;
        if (old + 1u == (gen + 1u) * nloc) {
            __builtin_amdgcn_fence(__ATOMIC_RELEASE, "agent");
            asm volatile("s_waitcnt vmcnt(0)" ::: "memory");
            const unsigned og = xb_add(&bar[XB_TOP], 1u);
            const unsigned tg = og / nx;
            if (og + 1u == (tg + 1u) * nx) xb_add(&bar[XB_TOPGEN], 1u);
            else XB_SPIN(xb_ld(&bar[XB_TOPGEN]) == tg, bar);
            __builtin_amdgcn_fence(__ATOMIC_ACQUIRE, "agent");
            xb_add(&bar[XB_XGEN(b.x)], 1u);
            asm volatile("s_waitcnt vmcnt(0)" ::: "memory");
        } else {
            XB_SPIN(xb_ld(&bar[XB_XGEN(b.x)]) == gen, bar);
            __builtin_amdgcn_fence(__ATOMIC_ACQUIRE, "agent");
            asm volatile("s_waitcnt vmcnt(0)" ::: "memory");
        }
    }
    __syncthreads();
}

#ifndef MK_PER_PHASE
#define MK_PER_PHASE 0
#endif
constexpr int NPHASES = 10;
struct Args { const float* in[12]; float* out; unsigned char* ws; int ph_lo, ph_hi; };
__global__ void __launch_bounds__(512, 2) fwd(Args args) {
    extern __shared__ __attribute__((aligned(16))) unsigned char lds[];
    LAS unsigned char* ldsl = (LAS unsigned char*)lds;
    volatile LAS unsigned* MISC = (volatile LAS unsigned*)(ldsl + MISC_OFF);
    const int tid = threadIdx.x, lane = tid & 63, wave = __builtin_amdgcn_readfirstlane(tid >> 6);
    const int G = gridDim.x; const int bx = blockIdx.x; const int vcu = (G % 8 == 0) ? (bx % 8) * (G / 8) + bx / 8 : bx;
    const int gw = vcu * 8 + wave, NGW = G * 8;
    unsigned char* ws = args.ws;
    const float* x = args.in[0]; const float* norm_g = args.in[1]; const float* final_g = args.in[2]; const float* rel_bias = args.in[3];
    const float* a_w_in = args.in[4]; const float* a_w_out = args.in[5]; const float* b_w_in = args.in[6];
    const float* b_ln_g = args.in[7]; const float* b_ln_b = args.in[8]; const float* b_w_s = args.in[9]; const float* b_b_s = args.in[10]; const float* b_w_out = args.in[11];
    float* out = args.out;
    bf16 *WAI = (bf16*)(ws + WS_WAI), *WAO = (bf16*)(ws + WS_WAO), *WBI = (bf16*)(ws + WS_WBI), *WBO = (bf16*)(ws + WS_WBO), *H = (bf16*)(ws + WS_H);
    bf16 *Qb = (bf16*)(ws + WS_Q), *Kb = (bf16*)(ws + WS_K), *Vb = (bf16*)(ws + WS_V), *ZS = (bf16*)(ws + WS_ZS), *QI = (bf16*)(ws + WS_QI), *KI = (bf16*)(ws + WS_KI);
    float* WI = (float*)(ws + WS_WI); bf16* WS16 = (bf16*)(ws + WS_WS16);
    bf16 *U = (bf16*)(ws + WS_U), *V1 = (bf16*)(ws + WS_VB), *Z1 = (bf16*)(ws + WS_ZB), *XB = (bf16*)(ws + WS_XB); float* PS = (float*)(ws + WS_PS);
    if (tid < 32) MISC[tid] = 0u;
    __syncthreads();
    XcdBarrier bar; bar.bar = (unsigned*)(ws + WS_CTL) + CW_BAR; bar.x = 0; bar.st = nullptr;
    if (!MK_PER_PHASE) bar = xcd_barrier_post((unsigned*)(ws + WS_CTL) + CW_BAR, MISC + 8);
    const int lo = args.ph_lo, hi = args.ph_hi;
#ifdef DBG_SKIP
#define IN(k) (((DBG_SKIP >> (k)) & 1) == 0 && lo <= (k) && (k) < hi)
#else
#define IN(k) (lo <= (k) && (k) < hi)
#endif
#ifndef DBG_REPEAT
#define DBG_REPEAT 0
#endif
#define REP(k) _Pragma("unroll 1") for (int rep_ = 0; rep_ < 1 + ((DBG_REPEAT >> (k)) & 1); ++rep_)
#define SEAM(k) do { if (IN(k) && IN((k) + 1)) xcd_barrier(bar); } while (0)

    if (IN(0)) REP(0) {
        LAS float* scr = (LAS float*)ldsl + wave * 64 * 33;
        constexpr int I_AI = 16 * (A_NPAD / 32), I_AO = 16 * 32, I_BI = 16 * (B_COLS / 32), I_BO = 32 * 32;
        for (int it = gw; it < I_AI + I_AO + I_BI + I_BO; it += NGW) {
            int r = it;
            if (r < I_AI) { transpose_item(a_w_in, 1024, A_COLS, A_NPAD, WAI, scr, r, lane, norm_g); continue; } r -= I_AI;
            if (r < I_AO) { transpose_item(a_w_out, 1024, 1024, 1024, WAO, scr, r, lane); continue; } r -= I_AO;
            if (r < I_BI) { transpose_item(b_w_in, 1024, B_COLS, B_COLS, WBI, scr, r, lane, norm_g + DM, true); continue; } r -= I_BI;
            transpose_item(b_w_out, 2048, 1024, 1024, WBO, scr, r, lane);
        }
        for (int i = vcu * 512 + tid; i < 8 * 128 * 128; i += G * 512) WS16[i] = (i & 127) <= ((i >> 7) & 127) ? (bf16)f2bf(b_w_s[i]) : (bf16)0;
        for (int m = gw; m < M; m += NGW) row_to_bf16_rs(x + (size_t)m * DM, H + (size_t)m * DM, (float*)(ws + WS_RS0) + m, lane);
        __syncthreads();
    }
    SEAM(0);
    if (IN(1)) REP(1) {
        pg8::Gemm g{H, WAI, M, A_NPAD, 1024}; pg8::StaticOrder So; So.init(M, A_NPAD, G, bx);
        pg8::EpiA E{Qb, Kb, Vb, ZS, QI, KI, WI, (const float*)(ws + WS_RS0)};
        pg8::gemm_phase<pg8::EpiA, pg8::StaticOrder, true, true>(ldsl, g, So, E);
    }
    SEAM(1);
    if (IN(2)) REP(2) idx::indexer_phase((char*)lds, vcu, G, QI, KI, WI, (idx::u64*)(ws + WS_MASK), (char*)out, (char*)(ws + WS_TAIL), (char*)(ws + WS_WI + 1 * MiB), (char*)(ws + WS_WAI));
    SEAM(2);
    if (IN(3)) REP(3) {
        att::attn_phase((char*)lds, vcu, G, Qb, Kb, Vb, ZS, (bf16*)(ws + WS_OG), (const att::u64*)(ws + WS_MASK), rel_bias); }
    SEAM(3);
    if (IN(4)) REP(4) {
        pg8::Gemm g{(const bf16*)(ws + WS_OG), WAO, M, 1024, 1024}; pg8::StaticOrder So; So.init(M, 1024, G, bx);
        pg8::EpiRes1 E{XB, PS};
        pg8::gemm_phase<pg8::EpiRes1, pg8::StaticOrder, true, true>(ldsl, g, So, E);
    }
    if (IN(4) && IN(6)) xcd_barrier(bar);
    if (IN(6)) REP(6) {
        pg8::Gemm g{XB, WBI, M, B_COLS, 1024}; pg8::StaticOrder So; So.init(M, B_COLS, G, bx);
        pg8::EpiB E{U, V1, PS, (float*)(ws + WS_LNP)};
        pg8::gemm_phase<pg8::EpiB, pg8::StaticOrder, true, true>(ldsl, g, So, E);
    }
    SEAM(6);
#ifdef DBG_SGU2
    if (IN(7)) sgu::sgu_phase<false>((char*)lds, vcu, G, U, V1, (const float*)(ws + WS_LNP), WS16, b_ln_g, b_ln_b, b_b_s);
#endif
    if (IN(7)) sgu::sgu_phase<true>((char*)lds, vcu, G, U, V1, (const float*)(ws + WS_LNP), WS16, b_ln_g, b_ln_b, b_b_s);
    SEAM(7);
    if (IN(8)) REP(8) {
        pg8::Gemm g{U, WBO, M, 1024, 2048}; pg8::StaticOrder So; So.init(M, 1024, G, bx);
        pg8::EpiRes2 E{XB};
        pg8::gemm_phase<pg8::EpiRes2, pg8::StaticOrder, true, true>(ldsl, g, So, E);
    }
    SEAM(8);
    if (IN(9)) REP(9) { for (int m = gw; m < M; m += NGW) rms_row_bf16_to_f32(XB + (size_t)m * DM, final_g, out + (size_t)m * DM, lane); }
#undef IN
#undef SEAM
}

extern "C" void kernel_launch(void* const* d_in, const int* in_sizes, int n_in, void* d_out, int out_size, void* d_ws, size_t ws_size, hipStream_t stream) {
    static int grid = 0;
    if (grid == 0) {
        if (n_in != 12 || in_sizes[0] != M * DM || out_size != M * DM || ws_size < WS_END) { fprintf(stderr, "kernel_launch: unexpected shapes (n_in %d, in0 %d, out %d, ws %zu)\n", n_in, n_in > 0 ? in_sizes[0] : -1, out_size, ws_size); grid = -1; return; }
        int dev = 0, cus = 0, per_cu = 0;
        if (hipGetDevice(&dev) != hipSuccess || hipDeviceGetAttribute(&cus, hipDeviceAttributeMultiprocessorCount, dev) != hipSuccess) { fprintf(stderr, "kernel_launch: device query failed\n"); grid = -1; return; }
        if (hipFuncSetAttribute((const void*)fwd, hipFuncAttributeMaxDynamicSharedMemorySize, LDS_BYTES) != hipSuccess) { fprintf(stderr, "kernel_launch: hipFuncSetAttribute failed\n"); grid = -1; return; }
        if (hipOccupancyMaxActiveBlocksPerMultiprocessor(&per_cu, (const void*)fwd, 512, LDS_BYTES) != hipSuccess || per_cu < 1) { fprintf(stderr, "kernel_launch: occupancy query says %d workgroups per CU\n", per_cu); }
        (void)hipGetLastError();
        grid = cus;
    }
    if (grid < 0) return;
    if (hipMemsetAsync((char*)d_ws + WS_CTL, 0, CTL_ZERO_BYTES, stream) != hipSuccess) { fprintf(stderr, "kernel_launch: memset failed\n"); return; }
    Args a{};
    for (int i = 0; i < 12; ++i) a.in[i] = (const float*)d_in[i];
    a.out = (float*)d_out; a.ws = (unsigned char*)d_ws;
#if MK_PER_PHASE
    for (int p = 0; p < NPHASES; ++p) { a.ph_lo = p; a.ph_hi = p + 1; hipLaunchKernelGGL(fwd, dim3(grid), dim3(512), LDS_BYTES, stream, a); }
#else
    a.ph_lo = 0; a.ph_hi = NPHASES;
    hipLaunchKernelGGL(fwd, dim3(grid), dim3(512), LDS_BYTES, stream, a);
#endif
    const hipError_t le = hipPeekAtLastError();
    if (le != hipSuccess) fprintf(stderr, "kernel_launch: launch failed: %s\n", hipGetErrorName(le));
}
```

```cpp
#include <hip/hip_runtime.h>
#include <cstdio>
#include <cstdint>

constexpr int NB = 2, S = 16384, DM = 1024, M = NB * S;
constexpr int A_COLS = 4680, A_NPAD = 4864;
constexpr int BW = 2048, B_COLS = 3 * BW;
constexpr float RMS_EPS = 1e-6f, LN_EPS = 1e-5f;
constexpr float LOG2E = 1.4426950408889634f;
constexpr float QSCALE = 0.08838834764831845f * LOG2E;
constexpr float WI_SCALE = 0.35355339059327373f;
constexpr float QI_SCALE = 0.125f;
constexpr int TOPK = 256;

namespace pg8 {
#define PG8_LAS __attribute__((address_space(3)))
typedef unsigned short bf16_t;
typedef short bf16x8 __attribute__((ext_vector_type(8)));
typedef float f32x4 __attribute__((ext_vector_type(4)));
typedef unsigned u32x4 __attribute__((ext_vector_type(4)));
constexpr int BM = 256, BK = 64, HALF = 128, HTB = HALF * BK * 2  , STAGE_BYTES = 8 * HTB, NXCD = 8, WGM = 8;

__host__ __device__ __forceinline__ int lds_byte(int r, int c) { const int st = (r >> 4) * 2 + (c >> 5), rr = r & 15, cc = c & 31, ob = rr * 64 + cc * 2; return st * 1024 + (ob ^ (((ob >> 9) & 1) << 5)); }
__host__ __device__ __forceinline__ void stage_rc(int b, int& R, int& C) { const int st = b / 1024, sb = b % 1024, swz = sb ^ (((sb >> 9) & 1) << 5); R = (st >> 1) * 16 + swz / 64; C = (st & 1) * 32 + (swz % 64) / 2; }
__host__ __device__ __forceinline__ int perm32(int rho) { const int n = rho >> 4, i = rho & 15; return 8 * (i >> 2) + 4 * n + (i & 3); }

struct Unit { int pm, pn; };
struct Gemm { const bf16_t* A; const bf16_t* Bt; int M, N, K; };

struct StaticOrder {
    int nM, nN, nwg, G, c;
    __host__ __device__ void init(int M, int N, int G_, int c_) { nM = M / BM; nN = N / BM; nwg = nM * nN; G = G_; c = c_; }
    __host__ __device__ bool next(int i, Unit& u) const {
        const long L = (long)i * G + c; if (L >= nwg) return false;
        int wgid = (int)L; { const int q = nwg / NXCD, r = nwg % NXCD, xcd = wgid % NXCD, off = wgid / NXCD; wgid = (xcd < r ? xcd * (q + 1) : r * (q + 1) + (xcd - r) * q) + off; }
        const int nig = WGM * nN, gid = wgid / nig, fm = gid * WGM, gsz = (nM - fm) < WGM ? (nM - fm) : WGM;
        u.pm = fm + ((wgid % nig) % gsz); u.pn = (wgid % nig) / gsz; return true;
    }
    __device__ __forceinline__ void a_ready(const Unit&) const {}
    __device__ __forceinline__ void done(const Unit&) const {}
};

__device__ __forceinline__ unsigned cvt_pk_bf16(float lo, float hi) { unsigned r; asm volatile("v_cvt_pk_bf16_f32 %0, %1, %2" : "=v"(r) : "v"(lo), "v"(hi)); return r; }
typedef float f32x2 __attribute__((ext_vector_type(2)));
__device__ __forceinline__ float silu_f(float z) { return z * __builtin_amdgcn_rcpf(1.0f + __builtin_amdgcn_exp2f(-z * 1.4426950408889634f)); }

struct EpiA {
    static constexpr bool PERM = true, AFTER_DRAIN = false;
    bf16_t *Q, *K, *V, *ZS, *QI, *KI; float* WI; const float* RS;
    __device__ __forceinline__ void operator()(const f32x4 (&acc)[2][2][4][2], const Unit& u, int wr, int wc, int fr, int fq) const {
        const int pn = u.pn, row0 = u.pm * BM + wr * 64 + fr;
        if (pn < 18) {
            bf16_t* base; int ldc, colt; float sc = 1.f; bool act = false;
            if (pn < 4) { base = Q; ldc = 1024; colt = pn * 256; sc = 0.08838834764831845f * 1.4426950408889634f; }
            else if (pn < 8) { base = K; ldc = 1024; colt = (pn - 4) * 256; }
            else if (pn < 12) { base = V; ldc = 1024; colt = (pn - 8) * 256; }
            else if (pn < 16) { base = ZS; ldc = 1024; colt = (pn - 12) * 256; act = true; }
            else { base = QI; ldc = 512; colt = (pn - 16) * 256; sc = 0.125f; }
            const int col0 = colt + wc * 32 + 8 * fq;
#pragma unroll
            for (int ai = 0; ai < 2; ++ai)
#pragma unroll
                for (int m = 0; m < 4; ++m) { bf16_t* rowp = base + (size_t)(row0 + ai * HALF + m * 16) * ldc + col0; const float rs = RS[row0 + ai * HALF + m * 16] * sc;
#pragma unroll
                    for (int bj = 0; bj < 2; ++bj) { f32x4 v0 = acc[ai][bj][m][0] * rs, v1 = acc[ai][bj][m][1] * rs;
                        if (act) { v0 = (f32x4){silu_f(v0[0]), silu_f(v0[1]), silu_f(v0[2]), silu_f(v0[3])}; v1 = (f32x4){silu_f(v1[0]), silu_f(v1[1]), silu_f(v1[2]), silu_f(v1[3])}; }
                        u32x4 w; w.x = cvt_pk_bf16(v0[0], v0[1]); w.y = cvt_pk_bf16(v0[2], v0[3]); w.z = cvt_pk_bf16(v1[0], v1[1]); w.w = cvt_pk_bf16(v1[2], v1[3]);
                        *(u32x4*)(rowp + bj * HALF) = w; } }
        } else {
#pragma unroll
            for (int ai = 0; ai < 2; ++ai)
#pragma unroll
                for (int m = 0; m < 4; ++m) { const size_t row = (size_t)(row0 + ai * HALF + m * 16);
                    const float rs = RS[row]; const f32x4 v0 = acc[ai][0][m][0] * rs, v1 = acc[ai][0][m][1] * rs;
                    if (wc < 2) { u32x4 w; w.x = cvt_pk_bf16(v0[0], v0[1]); w.y = cvt_pk_bf16(v0[2], v0[3]); w.z = cvt_pk_bf16(v1[0], v1[1]); w.w = cvt_pk_bf16(v1[2], v1[3]);
                        *(u32x4*)(KI + row * 64 + wc * 32 + 8 * fq) = w; }
                    else if (wc == 2 && fq == 0) { const float s = 0.35355339059327373f; *(f32x4*)(WI + row * 8) = v0 * s; *(f32x4*)(WI + row * 8 + 4) = v1 * s; } }
        }
    }
};

struct EpiB {
    static constexpr bool PERM = true, AFTER_DRAIN = false;
    bf16_t* Gt; bf16_t* Vt;
    const float* PS;
    float* LNP;
    __device__ __forceinline__ float rowscale(const float* psrow) const {
        const f32x4* pp = (const f32x4*)psrow; const f32x4 q0 = pp[0], q1 = pp[1], q2 = pp[2], q3 = pp[3];
        const float ss = ((q0[0] + q0[1]) + (q0[2] + q0[3])) + ((q1[0] + q1[1]) + (q1[2] + q1[3])) + ((q2[0] + q2[1]) + (q2[2] + q2[3])) + ((q3[0] + q3[1]) + (q3[2] + q3[3]));
        return 1.0f / sqrtf(ss * (1.f / 1024.f) + 1e-6f); }
    __device__ __forceinline__ void operator()(const f32x4 (&acc)[2][2][4][2], const Unit& u, int wr, int wc, int fr, int fq) const {
        const int pn = u.pn, row0 = u.pm * BM + wr * 64 + fr;
        const float* psrow = PS + (size_t)row0 * 16;
        if (pn < 16) {
            bf16_t* p = Gt + (size_t)row0 * 2048 + pn * 128 + wc * 32 + 8 * fq;
#pragma unroll
            for (int ai = 0; ai < 2; ++ai)
#pragma unroll
                for (int m = 0; m < 4; ++m) { const float rs = rowscale(psrow + (size_t)(ai * HALF + m * 16) * 16);
                    const f32x4 u0 = acc[ai][0][m][0] * rs, u1 = acc[ai][0][m][1] * rs, z0 = acc[ai][1][m][0] * rs, z1 = acc[ai][1][m][1] * rs;
                    u32x4 w; w.x = cvt_pk_bf16(u0[0] * silu_f(z0[0]), u0[1] * silu_f(z0[1])); w.y = cvt_pk_bf16(u0[2] * silu_f(z0[2]), u0[3] * silu_f(z0[3]));
                    w.z = cvt_pk_bf16(u1[0] * silu_f(z1[0]), u1[1] * silu_f(z1[1])); w.w = cvt_pk_bf16(u1[2] * silu_f(z1[2]), u1[3] * silu_f(z1[3]));
                    *(u32x4*)(p + (size_t)(ai * HALF + m * 16) * 2048) = w; }
        } else {
            const int tv = pn - 16; bf16_t* p = Vt + (size_t)row0 * 2048 + tv * 256 + wc * 32 + 8 * fq;
#pragma unroll
            for (int ai = 0; ai < 2; ++ai)
#pragma unroll
                for (int m = 0; m < 4; ++m) { const int ro = ai * HALF + m * 16; const float rs = rowscale(psrow + (size_t)ro * 16); float s1 = 0.f, s2 = 0.f;
#pragma unroll
                    for (int bj = 0; bj < 2; ++bj) { const f32x4 v0 = acc[ai][bj][m][0] * rs, v1 = acc[ai][bj][m][1] * rs;
                        s1 += ((v0[0] + v0[1]) + (v0[2] + v0[3])) + ((v1[0] + v1[1]) + (v1[2] + v1[3]));
                        s2 += ((v0[0] * v0[0] + v0[1] * v0[1]) + (v0[2] * v0[2] + v0[3] * v0[3])) + ((v1[0] * v1[0] + v1[1] * v1[1]) + (v1[2] * v1[2] + v1[3] * v1[3]));
                        u32x4 w; w.x = cvt_pk_bf16(v0[0], v0[1]); w.y = cvt_pk_bf16(v0[2], v0[3]); w.z = cvt_pk_bf16(v1[0], v1[1]); w.w = cvt_pk_bf16(v1[2], v1[3]);
                        *(u32x4*)(p + (size_t)ro * 2048 + bj * HALF) = w; }
                    s1 += __shfl_xor(s1, 16); s1 += __shfl_xor(s1, 32); s2 += __shfl_xor(s2, 16); s2 += __shfl_xor(s2, 32);
                    if (fq == 0) { typedef float f32x2_ __attribute__((ext_vector_type(2))); *(f32x2_*)(LNP + ((size_t)(row0 + ro) * 32 + tv * 4 + wc) * 2) = (f32x2_){s1, s2}; } }
        }
    }
};

struct EpiRes2 {
    static constexpr bool PERM = true, AFTER_DRAIN = false;
    bf16_t* XB;
    __device__ __forceinline__ void operator()(const f32x4 (&acc)[2][2][4][2], const Unit& u, int wr, int wc, int fr, int fq) const {
        const int row0 = u.pm * BM + wr * 64 + fr, col0 = u.pn * BM + wc * 32 + 8 * fq;
#pragma unroll
        for (int ai = 0; ai < 2; ++ai) { u32x4 bb[4][2];
#pragma unroll
            for (int m = 0; m < 4; ++m)
#pragma unroll
                for (int bj = 0; bj < 2; ++bj) bb[m][bj] = *(const u32x4*)(XB + (size_t)(row0 + ai * HALF + m * 16) * 1024 + col0 + bj * HALF);
#pragma unroll
            for (int m = 0; m < 4; ++m)
#pragma unroll
                for (int bj = 0; bj < 2; ++bj) { const u32x4 b = bb[m][bj]; const f32x4 a0 = acc[ai][bj][m][0], a1 = acc[ai][bj][m][1]; u32x4 w;
                    w.x = cvt_pk_bf16(__uint_as_float(b.x << 16) + a0[0], __uint_as_float(b.x & 0xffff0000u) + a0[1]);
                    w.y = cvt_pk_bf16(__uint_as_float(b.y << 16) + a0[2], __uint_as_float(b.y & 0xffff0000u) + a0[3]);
                    w.z = cvt_pk_bf16(__uint_as_float(b.z << 16) + a1[0], __uint_as_float(b.z & 0xffff0000u) + a1[1]);
                    w.w = cvt_pk_bf16(__uint_as_float(b.w << 16) + a1[2], __uint_as_float(b.w & 0xffff0000u) + a1[3]);
                    *(u32x4*)(XB + (size_t)(row0 + ai * HALF + m * 16) * 1024 + col0 + bj * HALF) = w; } }
    }
};

struct EpiRes1 {
    static constexpr bool PERM = true, AFTER_DRAIN = false;
    bf16_t* XB; float* PS;
    __device__ __forceinline__ void operator()(const f32x4 (&acc)[2][2][4][2], const Unit& u, int wr, int wc, int fr, int fq) const {
        const int row0 = u.pm * BM + wr * 64 + fr, col0 = u.pn * BM + wc * 32 + 8 * fq;
#pragma unroll
        for (int ai = 0; ai < 2; ++ai) { u32x4 bb[4][2];
#pragma unroll
            for (int m = 0; m < 4; ++m)
#pragma unroll
                for (int bj = 0; bj < 2; ++bj) bb[m][bj] = *(const u32x4*)(XB + (size_t)(row0 + ai * HALF + m * 16) * 1024 + col0 + bj * HALF);
#pragma unroll
            for (int m = 0; m < 4; ++m) { const size_t row = (size_t)(row0 + ai * HALF + m * 16); float ss = 0.f;
#pragma unroll
                for (int bj = 0; bj < 2; ++bj) { const u32x4 b = bb[m][bj]; const f32x4 a0 = acc[ai][bj][m][0], a1 = acc[ai][bj][m][1];
                    const f32x4 v0 = {__uint_as_float(b.x << 16) + a0[0], __uint_as_float(b.x & 0xffff0000u) + a0[1], __uint_as_float(b.y << 16) + a0[2], __uint_as_float(b.y & 0xffff0000u) + a0[3]};
                    const f32x4 v1 = {__uint_as_float(b.z << 16) + a1[0], __uint_as_float(b.z & 0xffff0000u) + a1[1], __uint_as_float(b.w << 16) + a1[2], __uint_as_float(b.w & 0xffff0000u) + a1[3]};
                    ss += ((v0[0] * v0[0] + v0[1] * v0[1]) + (v0[2] * v0[2] + v0[3] * v0[3])) + ((v1[0] * v1[0] + v1[1] * v1[1]) + (v1[2] * v1[2] + v1[3] * v1[3]));
                    u32x4 w; w.x = cvt_pk_bf16(v0[0], v0[1]); w.y = cvt_pk_bf16(v0[2], v0[3]); w.z = cvt_pk_bf16(v1[0], v1[1]); w.w = cvt_pk_bf16(v1[2], v1[3]);
                    *(u32x4*)(XB + row * 1024 + col0 + bj * HALF) = w; }
                ss += __shfl_xor(ss, 16); ss += __shfl_xor(ss, 32);
                if (fq == 0) PS[row * 16 + u.pn * 4 + wc] = ss; } }
    }
};

template <class Epi, class Sched, bool ALIGN_EPI = false, bool SP2 = false>
__device__ __forceinline__ void gemm_phase(PG8_LAS unsigned char* lds, const Gemm g, const Sched& S, const Epi& E) {
    const int tid = threadIdx.x, wid = __builtin_amdgcn_readfirstlane(tid >> 6), lane = tid & 63, wr = wid >> 2, wc = wid & 3, fr = lane & 15, fq = lane >> 4;
    const int K = g.K, nt = K / BK;
    unsigned voffA[2], voffB[2];
#pragma unroll
    for (int i = 0; i < 2; ++i) { int R, C; stage_rc(tid * 16 + i * 8192, R, C); const int Rb = Epi::PERM ? ((R & ~31) + perm32(R & 31)) : R;
        voffA[i] = (unsigned)(R * K + C) * 2u; voffB[i] = (unsigned)(Rb * K + C) * 2u; }
    const size_t kstep = (size_t)(BK * 2);
    const size_t hstep = (size_t)HALF * K * 2;
    const size_t tstep = 2 * hstep;
    const unsigned ldsw = (unsigned)wid * 1024u;
    const int aoff = lds_byte(wr * 64 + fr, fq * 8), boff = lds_byte(wc * 32 + fr, fq * 8);
#define PG8_SA(b, h) (((b) * 2 + (h)) * HTB)
#define PG8_SB(b, h) ((4 + (b) * 2 + (h)) * HTB)
#define PG8_STAGE(bufoff, gbase, voff) do { _Pragma("unroll") for (int _i = 0; _i < 2; ++_i) \
        __builtin_amdgcn_global_load_lds((const unsigned*)((const char*)(gbase) + (voff)[_i]), (PG8_LAS unsigned*)(lds + (bufoff) + ldsw + _i * 8192), 16, 0, 0); } while (0)
#define PG8_LDA(dst, b, h) do { _Pragma("unroll") for (int m = 0; m < 4; ++m) _Pragma("unroll") for (int k = 0; k < 2; ++k) dst[m][k] = *(const PG8_LAS bf16x8*)(lds + PG8_SA(b, h) + aoff + m * 2048 + k * 1024); } while (0)
#define PG8_LDB(dst, b, h) do { _Pragma("unroll") for (int n = 0; n < 2; ++n) _Pragma("unroll") for (int k = 0; k < 2; ++k) dst[n][k] = *(const PG8_LAS bf16x8*)(lds + PG8_SB(b, h) + boff + n * 2048 + k * 1024); } while (0)
#define PG8_MMA(ai, bj, At, Bt) do { __builtin_amdgcn_s_setprio(1); _Pragma("unroll") for (int m = 0; m < 4; ++m) _Pragma("unroll") for (int n = 0; n < 2; ++n) _Pragma("unroll") for (int k = 0; k < 2; ++k) \
        acc[ai][bj][m][n] = __builtin_amdgcn_mfma_f32_16x16x32_bf16(Bt[n][k], At[m][k], acc[ai][bj][m][n], 0, 0, 0); __builtin_amdgcn_s_setprio(0); } while (0)
#define PG8_WAIT_V(n) asm volatile("s_waitcnt vmcnt(" #n ")" ::: "memory")
#define PG8_WAIT_L(n) asm volatile("s_waitcnt lgkmcnt(" #n ")" ::: "memory")
#define PG8_BAR __builtin_amdgcn_s_barrier()
#define PG8_SCHED __builtin_amdgcn_sched_barrier(0)
    Unit cur, nxt; int ui = 0;
    if (!S.next(0, cur)) return;
    f32x4 acc[2][2][4][2];
#pragma unroll
    for (int a = 0; a < 2; ++a)
#pragma unroll
        for (int b = 0; b < 2; ++b)
#pragma unroll
            for (int m = 0; m < 4; ++m)
#pragma unroll
                for (int n = 0; n < 2; ++n) acc[a][b][m][n] = (f32x4){0.f, 0.f, 0.f, 0.f};
    bf16x8 At[4][2], B0[2][2], B1[2][2];
    const char* cA = (const char*)g.A + (size_t)cur.pm * tstep; const char* cB = (const char*)g.Bt + (size_t)cur.pn * tstep;
    S.a_ready(cur);
    if constexpr (SP2) {
        PG8_STAGE(PG8_SB(0, 0), cB, voffB); PG8_STAGE(PG8_SB(0, 1), cB + hstep, voffB); PG8_STAGE(PG8_SA(0, 0), cA, voffA); PG8_STAGE(PG8_SA(0, 1), cA + hstep, voffA);
        if (wr == 1) PG8_BAR;
        PG8_WAIT_V(2); PG8_BAR;
        PG8_STAGE(PG8_SB(1, 0), cB + kstep, voffB); PG8_STAGE(PG8_SA(1, 0), cA + kstep, voffA); PG8_STAGE(PG8_SB(1, 1), cB + hstep + kstep, voffB);
        PG8_WAIT_V(6); PG8_BAR;
    } else {
        PG8_STAGE(PG8_SB(0, 0), cB, voffB); PG8_STAGE(PG8_SA(0, 0), cA, voffA); PG8_STAGE(PG8_SB(0, 1), cB + hstep, voffB); PG8_STAGE(PG8_SA(0, 1), cA + hstep, voffA);
        if (wr == 1) PG8_BAR;
        PG8_WAIT_V(4); PG8_BAR;
        PG8_STAGE(PG8_SB(1, 0), cB + kstep, voffB); PG8_STAGE(PG8_SA(1, 0), cA + kstep, voffA); PG8_STAGE(PG8_SB(1, 1), cB + hstep + kstep, voffB);
        PG8_WAIT_V(6); PG8_BAR;
    }
    for (;;) {
        const bool has_next = S.next(ui + 1, nxt);
        const char* nA = has_next ? (const char*)g.A + (size_t)nxt.pm * tstep : cA; const char* nB = has_next ? (const char*)g.Bt + (size_t)nxt.pn * tstep : cB;
        for (int t = 0; t < nt; t += 2) {
            const bool last = (t == nt - 2);
            const char* a1 = cA + (size_t)(t + 1) * kstep;
            const char* a2 = last ? nA : cA + (size_t)(t + 2) * kstep; const char* b2 = last ? nB : cB + (size_t)(t + 2) * kstep;
            const char* a3 = a2 + kstep; const char* b3 = b2 + kstep;
            if (last && has_next) S.a_ready(nxt);
            if constexpr (SP2) {
            PG8_LDB(B0, 0, 0); PG8_LDB(B1, 0, 1); PG8_SCHED; PG8_LDA(At, 0, 0); PG8_STAGE(PG8_SA(1, 1), a1 + hstep, voffA);
            PG8_WAIT_V(8); PG8_WAIT_L(0); PG8_BAR; PG8_MMA(0, 0, At, B0); PG8_MMA(0, 1, At, B1); PG8_BAR; PG8_SCHED;
            PG8_LDA(At, 0, 1); PG8_STAGE(PG8_SB(0, 0), b2, voffB); PG8_STAGE(PG8_SB(0, 1), b2 + hstep, voffB); PG8_STAGE(PG8_SA(0, 0), a2, voffA);
            PG8_WAIT_V(8); PG8_WAIT_L(0); PG8_BAR; PG8_MMA(1, 0, At, B0); PG8_MMA(1, 1, At, B1); PG8_BAR; PG8_SCHED;
            PG8_LDB(B0, 1, 0); PG8_LDB(B1, 1, 1); PG8_SCHED; PG8_LDA(At, 1, 0); PG8_STAGE(PG8_SA(0, 1), a2 + hstep, voffA);
            PG8_WAIT_V(8); PG8_WAIT_L(0); PG8_BAR; PG8_MMA(0, 0, At, B0); PG8_MMA(0, 1, At, B1); PG8_BAR; PG8_SCHED;
            PG8_LDA(At, 1, 1); PG8_STAGE(PG8_SB(1, 0), b3, voffB); PG8_STAGE(PG8_SB(1, 1), b3 + hstep, voffB); PG8_STAGE(PG8_SA(1, 0), a3, voffA);
            PG8_WAIT_V(8); PG8_WAIT_L(0); PG8_BAR; PG8_MMA(1, 0, At, B0); PG8_MMA(1, 1, At, B1); PG8_BAR; PG8_SCHED;
            } else {
            PG8_LDB(B0, 0, 0); PG8_SCHED; PG8_LDA(At, 0, 0); PG8_STAGE(PG8_SA(1, 1), a1 + hstep, voffA);
            PG8_WAIT_L(8); PG8_BAR; PG8_WAIT_L(0); PG8_MMA(0, 0, At, B0); PG8_BAR; PG8_SCHED;
            PG8_LDB(B1, 0, 1); PG8_STAGE(PG8_SB(0, 0), b2, voffB);
            PG8_BAR; PG8_WAIT_L(0); PG8_MMA(0, 1, At, B1); PG8_BAR;
            PG8_LDA(At, 0, 1); PG8_STAGE(PG8_SA(0, 0), a2, voffA);
            PG8_BAR; PG8_WAIT_L(0); PG8_MMA(1, 0, At, B0); PG8_BAR; PG8_SCHED;
            PG8_STAGE(PG8_SB(0, 1), b2 + hstep, voffB);
            PG8_WAIT_V(6); PG8_BAR; PG8_MMA(1, 1, At, B1); PG8_BAR;
            PG8_LDB(B0, 1, 0); PG8_SCHED; PG8_LDA(At, 1, 0); PG8_STAGE(PG8_SA(0, 1), a2 + hstep, voffA);
            PG8_WAIT_L(8); PG8_BAR; PG8_WAIT_L(0); PG8_MMA(0, 0, At, B0); PG8_BAR; PG8_SCHED;
            PG8_LDB(B1, 1, 1); PG8_STAGE(PG8_SB(1, 0), b3, voffB);
            PG8_BAR; PG8_WAIT_L(0); PG8_MMA(0, 1, At, B1); PG8_BAR;
            PG8_LDA(At, 1, 1); PG8_STAGE(PG8_SA(1, 0), a3, voffA);
            PG8_BAR; PG8_WAIT_L(0); PG8_MMA(1, 0, At, B0); PG8_BAR; PG8_SCHED;
            PG8_STAGE(PG8_SB(1, 1), b3 + hstep, voffB);
            PG8_WAIT_V(6); PG8_BAR; PG8_MMA(1, 1, At, B1); PG8_BAR;
            }
        }
        if constexpr (ALIGN_EPI) { if (wr == 0) PG8_BAR; }
        if constexpr (!Epi::AFTER_DRAIN) { E(acc, cur, wr, wc, fr, fq); S.done(cur); }
        if (!has_next) break;
#pragma unroll
        for (int a = 0; a < 2; ++a)
#pragma unroll
            for (int b = 0; b < 2; ++b)
#pragma unroll
                for (int m = 0; m < 4; ++m)
#pragma unroll
                    for (int n = 0; n < 2; ++n) acc[a][b][m][n] = (f32x4){0.f, 0.f, 0.f, 0.f};
        cur = nxt; cA = nA; cB = nB; ++ui;
        if constexpr (ALIGN_EPI) { if (wr == 1) PG8_BAR; }
    }
    PG8_WAIT_V(0);
    if constexpr (!ALIGN_EPI) { if (wr == 0) PG8_BAR; }
    PG8_BAR;
    if constexpr (Epi::AFTER_DRAIN) { E.fused(acc, cur, wr, wc, fr, fq, lds, wid, lane); S.done(cur); }
#undef PG8_SA
#undef PG8_SB
#undef PG8_STAGE
#undef PG8_LDA
#undef PG8_LDB
#undef PG8_MMA
#undef PG8_WAIT_V
#undef PG8_WAIT_L
#undef PG8_BAR
#undef PG8_SCHED
}
}
#define LAS __attribute__((address_space(3)))
typedef unsigned short bf16;
typedef float f32x4 __attribute__((ext_vector_type(4)));
typedef unsigned v4u __attribute__((ext_vector_type(4)));
typedef unsigned v2u __attribute__((ext_vector_type(2)));
__device__ __forceinline__ unsigned f2bf(float f) { unsigned u = __builtin_bit_cast(unsigned, f); return (u + 0x7fffu + ((u >> 16) & 1u)) >> 16; }
__device__ __forceinline__ unsigned pk2(float lo, float hi) { return f2bf(lo) | (f2bf(hi) << 16); }
__device__ __forceinline__ float bflo(unsigned w) { return __builtin_bit_cast(float, w << 16); }
__device__ __forceinline__ float bfhi(unsigned w) { return __builtin_bit_cast(float, w & 0xffff0000u); }
__device__ __forceinline__ float wave_sum(float v) {
#pragma unroll
    for (int o = 1; o < 64; o <<= 1) v += __shfl_xor(v, o);
    return v;
}
__device__ __forceinline__ float wave_max(float v) {
#pragma unroll
    for (int o = 1; o < 64; o <<= 1) v = fmaxf(v, __shfl_xor(v, o));
    return v;
}
__device__ __forceinline__ int t5_bucket(int rel) {
    const int ret = rel < 0 ? 16 : 0; const int n = rel < 0 ? -rel : rel;
    int v;
    if (n < 8) v = n; else if (n < 12) v = 8; else if (n < 16) v = 9; else if (n < 23) v = 10; else if (n < 32) v = 11; else if (n < 46) v = 12; else if (n < 64) v = 13; else if (n < 91) v = 14; else v = 15;
    return ret + v;
}

__device__ __forceinline__ void transpose_item(const float* W, int K, int N, int Npad, bf16* WT, LAS float* scr, int item, int lane, const float* gk = nullptr  , bool uzv = false  ) {
    const int nblk = Npad / 32, kb = item / nblk, nb = item % nblk, k0 = 64 * kb, n0 = 32 * nb;
    const int nn = n0 + (lane & 31);
    const int d0 = !uzv ? n0 : n0 < 2048 ? 256 * (n0 >> 7) + (n0 & 127) : n0 < 4096 ? n0 + 2048 : 256 * ((n0 - 4096) >> 7) + 128 + (n0 & 127);
#pragma unroll 8
    for (int i = 0; i < 32; ++i) { const int kk = 2 * i + (lane >> 5); scr[kk * 33 + (lane & 31)] = nn < N ? W[(size_t)(k0 + kk) * N + nn] * (gk ? gk[k0 + kk] : 1.f) : 0.f; }
    asm volatile("s_waitcnt lgkmcnt(0)" ::: "memory");
    const int c = lane & 7;
#pragma unroll
    for (int j = 0; j < 4; ++j) { const int n = (lane >> 3) + 8 * j; const LAS float* s = scr + (8 * c) * 33 + n;
        v4u o; o.x = pk2(s[0 * 33], s[1 * 33]); o.y = pk2(s[2 * 33], s[3 * 33]); o.z = pk2(s[4 * 33], s[5 * 33]); o.w = pk2(s[6 * 33], s[7 * 33]);
        *(v4u*)(WT + (size_t)(d0 + n) * K + k0 + 8 * c) = o; }
    asm volatile("s_waitcnt lgkmcnt(0)" ::: "memory");
}
__device__ __forceinline__ void rms_row_to_bf16(const float* xrow, const float* g, bf16* orow, int lane) {
    const f32x4* xr = (const f32x4*)xrow + lane; const f32x4* gr = (const f32x4*)g + lane;
    f32x4 v[4]; float s = 0.f;
#pragma unroll
    for (int j = 0; j < 4; ++j) { v[j] = xr[64 * j]; s += (v[j].x * v[j].x + v[j].y * v[j].y) + (v[j].z * v[j].z + v[j].w * v[j].w); }
    const float rs = 1.0f / sqrtf(wave_sum(s) * (1.f / 1024.f) + RMS_EPS);
    v2u* o8 = (v2u*)orow + lane;
#pragma unroll
    for (int j = 0; j < 4; ++j) { const f32x4 gg = gr[64 * j]; v2u o; o.x = pk2(v[j].x * rs * gg.x, v[j].y * rs * gg.y); o.y = pk2(v[j].z * rs * gg.z, v[j].w * rs * gg.w); o8[64 * j] = o; }
}
__device__ __forceinline__ void rms_row_f32(const float* xrow, const float* g, float* orow, int lane) {
    const f32x4* xr = (const f32x4*)xrow + lane; const f32x4* gr = (const f32x4*)g + lane;
    f32x4 v[4]; float s = 0.f;
#pragma unroll
    for (int j = 0; j < 4; ++j) { v[j] = xr[64 * j]; s += (v[j].x * v[j].x + v[j].y * v[j].y) + (v[j].z * v[j].z + v[j].w * v[j].w); }
    const float rs = 1.0f / sqrtf(wave_sum(s) * (1.f / 1024.f) + RMS_EPS);
    f32x4* o = (f32x4*)orow + lane;
#pragma unroll
    for (int j = 0; j < 4; ++j) { const f32x4 gg = gr[64 * j]; o[64 * j] = v[j] * rs * gg; }
}


__device__ __forceinline__ void rms_row_bf16_to_f32(const bf16* xrow, const float* g, float* orow, int lane) {
    typedef unsigned u32x4_ __attribute__((ext_vector_type(4)));
    float v[2][8]; float s = 0.f;
#pragma unroll
    for (int j = 0; j < 2; ++j) { const u32x4_ b = *((const u32x4_*)xrow + 64 * j + lane);
        v[j][0] = __uint_as_float(b.x << 16); v[j][1] = __uint_as_float(b.x & 0xffff0000u); v[j][2] = __uint_as_float(b.y << 16); v[j][3] = __uint_as_float(b.y & 0xffff0000u);
        v[j][4] = __uint_as_float(b.z << 16); v[j][5] = __uint_as_float(b.z & 0xffff0000u); v[j][6] = __uint_as_float(b.w << 16); v[j][7] = __uint_as_float(b.w & 0xffff0000u);
#pragma unroll
        for (int e = 0; e < 8; ++e) s += v[j][e] * v[j][e]; }
    const float rs = 1.0f / sqrtf(wave_sum(s) * (1.f / 1024.f) + RMS_EPS);
#pragma unroll
    for (int j = 0; j < 2; ++j) { const f32x4* gr = (const f32x4*)g + 128 * j + 2 * lane; f32x4* o = (f32x4*)orow + 128 * j + 2 * lane; const f32x4 g0 = gr[0], g1 = gr[1];
        o[0] = (f32x4){v[j][0] * rs * g0.x, v[j][1] * rs * g0.y, v[j][2] * rs * g0.z, v[j][3] * rs * g0.w};
        o[1] = (f32x4){v[j][4] * rs * g1.x, v[j][5] * rs * g1.y, v[j][6] * rs * g1.z, v[j][7] * rs * g1.w}; }
}

__device__ __forceinline__ void row_to_bf16_rs(const float* xrow, bf16* orow, float* rs_out, int lane) {
    const f32x4* xr = (const f32x4*)xrow + lane;
    f32x4 v[4]; float s = 0.f;
#pragma unroll
    for (int j = 0; j < 4; ++j) { v[j] = xr[64 * j]; s += (v[j].x * v[j].x + v[j].y * v[j].y) + (v[j].z * v[j].z + v[j].w * v[j].w); }
    v2u* o8 = (v2u*)orow + lane;
#pragma unroll
    for (int j = 0; j < 4; ++j) { v2u o; o.x = pk2(v[j].x, v[j].y); o.y = pk2(v[j].z, v[j].w); o8[64 * j] = o; }
    const float rs = 1.0f / sqrtf(wave_sum(s) * (1.f / 1024.f) + RMS_EPS);
    if (lane == 0) *rs_out = rs;
}
namespace idx {
typedef unsigned short bf16;
typedef short bf16x8 __attribute__((ext_vector_type(8)));
typedef float f32x16 __attribute__((ext_vector_type(16)));
typedef unsigned long long u64;
constexpr int NBINS = 256, HSTR = 257, CAP = 512, FCAP = 2048;
constexpr int OFF_HIST = 0;
constexpr int OFF_QL = 66048;
constexpr int OFF_STAT = 64 * 513 * 4 + 128;
constexpr int OFF_QPAR = OFF_STAT + 2048;
constexpr int OFF_BSTAR = OFF_QPAR + 512, OFF_NEED = OFF_BSTAR + 256, OFF_BCNT = OFF_NEED + 256;
constexpr int OFF_FB = OFF_BCNT + 256;
constexpr int OFF_FBH = OFF_FB + 512;
constexpr int OFF_QF = OFF_FBH + 1024 + 64;
constexpr int OFF_WV = OFF_QF + 2048;
constexpr int OFF_FLAT = OFF_WV + 2048;
constexpr int IDX_LDS_BYTES = OFF_FLAT + 2 * FCAP * 4;
#ifndef IDX_REPS
#define IDX_REPS 1
#endif
#ifndef DBG_FORCE_FB
#define DBG_FORCE_FB 0
#endif

__device__ __forceinline__ int crow(int r, int hi) { return (r & 3) + 8 * (r >> 2) + 4 * hi; }
__device__ __forceinline__ float z_upper(float p) {
    const bool flip = p > 0.5f; const float pp = flip ? 1.f - p : p; const float t = sqrtf(-2.f * logf(pp));
    float num = 2.515517f + t * (0.802853f + t * 0.010328f); asm volatile("" : "+v"(num));
    const float den = 1.f + t * (1.432788f + t * (0.189269f + t * 0.001308f));
    const float z = t - num / den;
    return flip ? -z : z;
}
typedef float f32x4_t __attribute__((ext_vector_type(4)));
__device__ __forceinline__ void load_a16(bf16x8 (&a)[2][2], const char* kib, int j, int l15, int kq) {
    const char* kp = kib + (size_t)(unsigned)((j * 32 + l15) * 128 + kq * 16);
#pragma unroll
    for (int rb = 0; rb < 2; ++rb)
#pragma unroll
        for (int ks = 0; ks < 2; ++ks) a[rb][ks] = *reinterpret_cast<const bf16x8*>(kp + rb * 2048 + ks * 64);
}
template <bool PF>
__device__ __forceinline__ void tile_scores16(bf16x8 (&a)[2][2], const bf16x8 (&qreg)[8][2][2], const char* qlp  , const float* wv0, const float* wv1, float (&sc)[16], const char* kib, int jn, int l15, int kq) {
    f32x4_t dl[2][2]; bf16x8 qL[2][2];
#pragma unroll
    for (int cb = 0; cb < 2; ++cb)
#pragma unroll
        for (int ks = 0; ks < 2; ++ks) qL[cb][ks] = *reinterpret_cast<const bf16x8*>(qlp + (cb * 2 + ks) * 8192);
#pragma unroll
    for (int rb = 0; rb < 2; ++rb)
#pragma unroll
        for (int cb = 0; cb < 2; ++cb) { f32x4_t t = {0.f, 0.f, 0.f, 0.f};
#pragma unroll
            for (int ks = 0; ks < 2; ++ks) t = __builtin_amdgcn_mfma_f32_16x16x32_bf16(a[rb][ks], qL[cb][ks], t, 0, 0, 0);
            dl[rb][cb] = t; }
#pragma unroll
    for (int h = 0; h < 8; ++h) { f32x4_t d[2][2];
#pragma unroll
        for (int rb = 0; rb < 2; ++rb)
#pragma unroll
            for (int cb = 0; cb < 2; ++cb) { f32x4_t t = {0.f, 0.f, 0.f, 0.f};
#pragma unroll
                for (int ks = 0; ks < 2; ++ks) t = __builtin_amdgcn_mfma_f32_16x16x32_bf16(a[rb][ks], qreg[h][cb][ks], t, 0, 0, 0);
                d[rb][cb] = t; }
        asm volatile("" ::: "memory");
        if (PF && h == 7) load_a16(a, kib, jn, l15, kq);
        const float w0 = wv0[h], w1 = wv1[h];
#pragma unroll
        for (int rb = 0; rb < 2; ++rb)
#pragma unroll
            for (int cb = 0; cb < 2; ++cb)
#pragma unroll
                for (int r = 0; r < 4; ++r) { const int i = (2 * rb + cb) * 4 + r; sc[i] = fmaf(cb ? w1 : w0, __builtin_fabsf(d[rb][cb][r]), h == 0 ? dl[rb][cb][r] : sc[i]); } }
}
__device__ __forceinline__ unsigned fkey(float f) { const unsigned u = __builtin_bit_cast(unsigned, f); return (u & 0x80000000u) ? ~u : (u | 0x80000000u); }

__device__ __forceinline__ void mask_or_bit(u64* mwq, int qc, int s) {
    const int kk = s & 31, hk = (kk >> 2) & 1, r = (kk & 3) + 4 * (kk >> 3);
    __hip_atomic_fetch_or(mwq + (size_t)(s >> 5) * 16 + r, 1ull << (qc + 32 * hk), __ATOMIC_RELAXED, __HIP_MEMORY_SCOPE_AGENT);
}

__device__ __forceinline__ void fallback_query(char* lds, int tid, int tg  , int qc, int n, const bf16* QI, const char* kib, const float* WI, u64* mwq) {
    asm volatile("" : "+v"(tid));
    float* sc = (float*)(lds + OFF_HIST); unsigned* hist = (unsigned*)(lds + OFF_FBH); unsigned* misc = hist + 256; float* qf = (float*)(lds + OFF_QF);
    __syncthreads();
    if (tid < 256) { const unsigned w = ((const unsigned*)(QI + (size_t)tg * 512))[tid]; qf[2 * tid] = __builtin_bit_cast(float, w << 16); qf[2 * tid + 1] = __builtin_bit_cast(float, w & 0xffff0000u); }
    __syncthreads();
    for (int s = tid; s < n; s += 1024) {
        const int s2 = s + 512 < n ? s + 512 : s;
        const uint4* kp0 = (const uint4*)(kib + (size_t)s * 128); const uint4* kp1 = (const uint4*)(kib + (size_t)s2 * 128);
        float kf0[64], kf1[64];
#pragma unroll
        for (int c = 0; c < 8; ++c) { const uint4 w = kp0[c], x = kp1[c];
            kf0[8 * c] = __builtin_bit_cast(float, w.x << 16); kf0[8 * c + 1] = __builtin_bit_cast(float, w.x & 0xffff0000u); kf0[8 * c + 2] = __builtin_bit_cast(float, w.y << 16); kf0[8 * c + 3] = __builtin_bit_cast(float, w.y & 0xffff0000u);
            kf0[8 * c + 4] = __builtin_bit_cast(float, w.z << 16); kf0[8 * c + 5] = __builtin_bit_cast(float, w.z & 0xffff0000u); kf0[8 * c + 6] = __builtin_bit_cast(float, w.w << 16); kf0[8 * c + 7] = __builtin_bit_cast(float, w.w & 0xffff0000u);
            kf1[8 * c] = __builtin_bit_cast(float, x.x << 16); kf1[8 * c + 1] = __builtin_bit_cast(float, x.x & 0xffff0000u); kf1[8 * c + 2] = __builtin_bit_cast(float, x.y << 16); kf1[8 * c + 3] = __builtin_bit_cast(float, x.y & 0xffff0000u);
            kf1[8 * c + 4] = __builtin_bit_cast(float, x.z << 16); kf1[8 * c + 5] = __builtin_bit_cast(float, x.z & 0xffff0000u); kf1[8 * c + 6] = __builtin_bit_cast(float, x.w << 16); kf1[8 * c + 7] = __builtin_bit_cast(float, x.w & 0xffff0000u); }
        float sc0 = 0.f, sc1 = 0.f;
#pragma unroll 1
        for (int h = 0; h < 8; ++h) { float d0 = 0.f, d1 = 0.f;
#pragma unroll
            for (int j = 0; j < 64; ++j) { const float qv = qf[h * 64 + j]; d0 = fmaf(qv, kf0[j], d0); d1 = fmaf(qv, kf1[j], d1); }
            const float w = WI[(size_t)tg * 8 + h]; sc0 = fmaf(w, fmaxf(d0, 0.f), sc0); sc1 = fmaf(w, fmaxf(d1, 0.f), sc1); }
        sc[s] = sc0; sc[s2] = sc1;
    }
    __syncthreads();
    unsigned prefix = 0u, need = TOPK, eq_total = 0u;
    for (int pass = 0; pass < 4; ++pass) {
        const int shift = 24 - 8 * pass; const unsigned mask = pass == 0 ? 0u : (0xFFFFFFFFu << (shift + 8));
        if (tid < 256) hist[tid] = 0u;
        __syncthreads();
        for (int s = tid; s < n; s += 512) { const unsigned k = fkey(sc[s]); if ((k & mask) == (prefix & mask)) atomicAdd(&hist[(k >> shift) & 255u], 1u); }
        __syncthreads();
        if (tid == 0) { unsigned c = 0u; int bin = 255; for (; bin > 0; --bin) { if (c + hist[bin] >= need) break; c += hist[bin]; }
            misc[0] = (unsigned)bin; misc[1] = need - c; misc[2] = hist[bin]; }
        __syncthreads();
        prefix |= misc[0] << shift; need = misc[1]; eq_total = misc[2];
        __syncthreads();
    }
    const int nw = (n >> 5) * 16; const u64 clr = ~((1ull << qc) | (1ull << (qc + 32)));
    for (int i = tid; i < nw; i += 512) __hip_atomic_fetch_and(mwq + i, clr, __ATOMIC_RELAXED, __HIP_MEMORY_SCOPE_AGENT);
    asm volatile("s_waitcnt vmcnt(0)" ::: "memory");
    __syncthreads();
    const bool take_all_eq = (eq_total == need);
    for (int s = tid; s < n; s += 512) { const unsigned k = fkey(sc[s]); if (k > prefix || (take_all_eq && k == prefix)) mask_or_bit(mwq, qc, s); }
    if (!take_all_eq) {
        const int per = (n + 511) >> 9, s0 = tid * per, s1 = (s0 + per < n) ? s0 + per : n; unsigned* ce = (unsigned*)qf;
        unsigned mine = 0u; for (int s = s0; s < s1; ++s) mine += fkey(sc[s]) == prefix;
        __syncthreads(); ce[tid] = mine; __syncthreads();
        unsigned before = 0u; for (int t2 = 0; t2 < tid; ++t2) before += ce[t2];
        for (int s = s0; s < s1 && before < need; ++s) if (fkey(sc[s]) == prefix) { mask_or_bit(mwq, qc, s); ++before; }
    }
    __syncthreads();
}

__device__ __forceinline__ void indexer_unit(char* lds, int b, int c, const bf16* QI, const bf16* KI, const float* WI, u64* MASKW, char* codes  ) {
    int tid_ = threadIdx.x; asm volatile("" : "+v"(tid_));
    const int tid = tid_, wid = __builtin_amdgcn_readfirstlane(tid >> 6), lane = tid & 63, r32 = lane & 31, hi = lane >> 5, qg = wid & 1, ks = wid >> 1;
    const int n = 64 * (c + 1), ntile = n >> 5, jend = 2 * ((c | 3) + 1);
    const int row0 = b * S + 64 * c;
    u64* mw = MASKW + ((size_t)(b * (S / 32) + 2 * c + qg) * (S / 32)) * 16;
    const char* kib = (const char*)(KI + (size_t)b * S * 64);
    if (n <= TOPK) {
        for (int j = ks; j < jend; j += 4) if (lane < 16) __hip_atomic_store(mw + (size_t)j * 16 + lane, j < ntile ? ~0ull : 0ull, __ATOMIC_RELAXED, __HIP_MEMORY_SCOPE_AGENT);
        return;
    }
    unsigned* hist = (unsigned*)(lds + OFF_HIST);
    float2* stat = (float2*)(lds + OFF_STAT); float2* qpar = (float2*)(lds + OFF_QPAR);
    int* bstar = (int*)(lds + OFF_BSTAR); int* needv = (int*)(lds + OFF_NEED); unsigned* bcnt = (unsigned*)(lds + OFF_BCNT); unsigned* fb = (unsigned*)(lds + OFF_FB);
    unsigned* fl = (unsigned*)(lds + OFF_FLAT);
    const int ql = qg * 32 + r32;
    {
    int ln_ = lane; asm volatile("" : "+v"(ln_));
    const int l15 = ln_ & 15, kq = ln_ >> 4; const int q0 = qg * 32 + l15, q1 = q0 + 16;
    bf16x8 qreg[8][2][2]; const float* wv0 = (const float*)(lds + OFF_WV) + q0 * 8; const float* wv1 = wv0 + 16 * 8;
    { const char* qp = (const char*)QI + (size_t)(unsigned)(row0 + q0) * 1024 + kq * 16;
#pragma unroll
        for (int h = 0; h < 8; ++h)
#pragma unroll
            for (int cb = 0; cb < 2; ++cb)
#pragma unroll
                for (int ks = 0; ks < 2; ++ks) qreg[h][cb][ks] = *reinterpret_cast<const bf16x8*>(qp + cb * 16 * 1024 + h * 128 + ks * 64);
        { unsigned to_ = (unsigned)tid; asm volatile("" : "+v"(to_)); if (to_ < 128u) { float4 w4 = *(const float4*)((const char*)(WI + (size_t)row0 * 8) + (size_t)(to_ * 16u)); w4.x *= 0.5f; w4.y *= 0.5f; w4.z *= 0.5f; w4.w *= 0.5f; *(float4*)(lds + OFF_WV + to_ * 16u) = w4; } } }
    char* qlp = lds + OFF_QL + tid * 16;
#pragma unroll
    for (int cb = 0; cb < 2; ++cb) { const float* wp = WI + (size_t)(row0 + q0 + 16 * cb) * 8; const float4 w0 = *(const float4*)wp, w1 = *(const float4*)(wp + 4);
        const float wh[8] = {0.5f * w0.x, 0.5f * w0.y, 0.5f * w0.z, 0.5f * w0.w, 0.5f * w1.x, 0.5f * w1.y, 0.5f * w1.z, 0.5f * w1.w};
#pragma unroll
        for (int ks = 0; ks < 2; ++ks) { float acc8[8] = {0.f, 0.f, 0.f, 0.f, 0.f, 0.f, 0.f, 0.f};
#pragma unroll
            for (int h = 0; h < 8; ++h) { const bf16x8 q = qreg[h][cb][ks];
#pragma unroll
                for (int e = 0; e < 8; ++e) acc8[e] = fmaf(wh[h], __builtin_bit_cast(float, (unsigned)(unsigned short)q[e] << 16), acc8[e]); }
            bf16x8 o;
#pragma unroll
            for (int e = 0; e < 8; ++e) { const unsigned u = __builtin_bit_cast(unsigned, acc8[e]); o[e] = (short)((u + 0x7fffu + ((u >> 16) & 1u)) >> 16); }
            *reinterpret_cast<bf16x8*>(qlp + (cb * 2 + ks) * 8192) = o; } }
    float sc[16];
    { unsigned z0; asm volatile("v_mov_b32 %0, 0" : "=v"(z0)); const uint4 z4 = make_uint4(z0, z0, z0, z0);
        unsigned zoff = (unsigned)tid * 16u; asm volatile("" : "+v"(zoff));
#pragma unroll 1
        for (int i = 0; i < 8; ++i) { *(uint4*)((char*)hist + zoff) = z4; zoff += 8192u; }
        if (tid < 16) *(uint4*)((char*)hist + zoff) = z4; }
    __syncthreads();
    { float s1a = 0.f, s2a = 0.f, s1b = 0.f, s2b = 0.f;
#pragma unroll 1
        for (int u = 0; u < 2; ++u) { const int j = ((ks + 4 * u) * ntile) >> 3; bf16x8 a[2][2]; load_a16(a, kib, j, l15, kq); tile_scores16<false>(a, qreg, qlp, wv0, wv1, sc, kib, 0, l15, kq);
#pragma unroll
            for (int i = 0; i < 16; ++i) { if ((i >> 2) & 1) { s1b += sc[i]; s2b = fmaf(sc[i], sc[i], s2b); } else { s1a += sc[i]; s2a = fmaf(sc[i], sc[i], s2a); } } }
        s1a += __shfl_xor(s1a, 16); s2a += __shfl_xor(s2a, 16); s1b += __shfl_xor(s1b, 16); s2b += __shfl_xor(s2b, 16);
        s1a += __shfl_xor(s1a, 32); s2a += __shfl_xor(s2a, 32); s1b += __shfl_xor(s1b, 32); s2b += __shfl_xor(s2b, 32);
        { int qo_ = q0; asm volatile("" : "+v"(qo_)); if (kq == 0) { stat[ks * 64 + qo_] = make_float2(s1a, s2a); stat[ks * 64 + qo_ + 16] = make_float2(s1b, s2b); } } }
    __syncthreads();
    { int tq_ = tid; asm volatile("" : "+v"(tq_));
    if (tq_ < 64) { float s1 = 0.f, s2 = 0.f;
#pragma unroll
        for (int k = 0; k < 4; ++k) { const float2 v = stat[k * 64 + tq_]; s1 += v.x; s2 += v.y; }
        const float mu = s1 * (1.f / 256.f); float var = s2 * (1.f / 256.f) - mu * mu; var = var > 0.f ? var : 0.f;
        const float sg = fmaxf(sqrtf(var), 1e-30f); const float zp = z_upper(256.f / (float)n);
        const float lo = mu + (zp - 2.0f) * sg, a = (float)(NBINS - 2) / (4.0f * sg); float bb = 1.f - lo * a;
        float aa = a; if (!(aa < 3.0e38f) || !(fabsf(bb) < 3.0e38f)) { aa = 0.f; bb = 1.f; }
        qpar[tq_] = make_float2(aa, bb); bcnt[tq_] = 0u; if (tq_ == 0) { fb[0] = 0u; fb[100] = 0u; } } }
    __syncthreads();
    { unsigned* hq0 = hist + q0 * HSTR; unsigned* hq1 = hq0 + 16 * HSTR; bf16x8 aC[2][2]; load_a16(aC, kib, ks, l15, kq);
        unsigned cso = (unsigned)(qg * 1024 + (l15 + 32 * (kq & 1)) * 16 + (kq >> 1) * 4); asm volatile("" : "+v"(cso));
#pragma unroll 1
        for (int j = ks; j < ntile; j += 4) {
            tile_scores16<true>(aC, qreg, qlp, wv0, wv1, sc, kib, j + 4 < ntile ? j + 4 : j, l15, kq);
            const float2 ab0 = qpar[q0], ab1 = qpar[q1];
            char* cp = codes + (size_t)(unsigned)(j * 2048) + cso;
#pragma unroll
            for (int rb = 0; rb < 2; ++rb)
#pragma unroll
                for (int cb = 0; cb < 2; ++cb) { unsigned w = 0u;
#pragma unroll
                    for (int r = 3; r >= 0; --r) { const float v = sc[(2 * rb + cb) * 4 + r];
                        const unsigned bin = (unsigned)__builtin_amdgcn_fmed3f(cb ? fmaf(v, ab1.x, ab1.y) : fmaf(v, ab0.x, ab0.y), 0.f, (float)(NBINS - 1));
                        __hip_atomic_fetch_add((cb ? hq1 : hq0) + bin, 1u, __ATOMIC_RELAXED, __HIP_MEMORY_SCOPE_WORKGROUP); w = (w << 8) | bin; }
                    *(unsigned*)(cp + cb * 256 + rb * 8) = w; } } }
    }
    __syncthreads();
#pragma unroll 1
    for (int qq = 0; qq < 8; ++qq) { const int q = wid * 8 + qq; int lo_ = lane; asm volatile("" : "+v"(lo_)); const unsigned* hp = hist + q * HSTR + 4 * lo_; const unsigned hb[4] = {hp[0], hp[1], hp[2], hp[3]};
        const unsigned ls = (hb[0] + hb[1]) + (hb[2] + hb[3]);
        unsigned T = ls;
#pragma unroll
        for (int o = 1; o < 64; o <<= 1) { const unsigned v = __shfl_down(T, o); if (lane + o < 64) T += v; }
        const u64 bal = __ballot(T >= (unsigned)TOPK); const int lstar = 63 - __builtin_clzll(bal);
        if (lane == lstar) { unsigned acc = T - ls; int bsel = 0;
#pragma unroll
            for (int i = 3; i >= 0; --i) { if (acc + hb[i] >= (unsigned)TOPK) { bsel = i; break; } acc += hb[i]; }
            bstar[q] = 4 * lane + bsel; needv[q] = (int)(TOPK - acc); } }
    __syncthreads();
    { unsigned cso = (unsigned)(qg * 1024 + lane * 16); asm volatile("" : "+v"(cso));
        const unsigned bs = (unsigned)bstar[ql]; const unsigned bsx = bs * 0x01010101u; const unsigned qtag = (unsigned)ql << 14;
#define IDX_LDC(jj) (*(const uint4*)(codes + (size_t)(unsigned)(((jj) < ntile ? (jj) : ks) * 2048) + cso))
#define IDX_SEL(D, K) asm volatile("v_cmp_gt_u32_sdwa vcc, %2, %3 src0_sel:BYTE_" #K " src1_sel:DWORD\n\ts_nop 3\n\tv_writelane_b32 %0, vcc_lo, %4\n\tv_writelane_b32 %1, vcc_hi, %4" \
                : "+v"(mlo), "+v"(mhi) : "v"(cwd[D]), "v"(bs), "n"(4 * (D) + (K)) : "vcc")
#define IDX_PROC(CUR, jj) do { const int j_ = (jj); const unsigned cwd[4] = {CUR.x, CUR.y, CUR.z, CUR.w}; unsigned mlo = 0u, mhi = 0u;                                  \
            IDX_SEL(0, 0); IDX_SEL(0, 1); IDX_SEL(0, 2); IDX_SEL(0, 3); IDX_SEL(1, 0); IDX_SEL(1, 1); IDX_SEL(1, 2); IDX_SEL(1, 3);                                       \
            IDX_SEL(2, 0); IDX_SEL(2, 1); IDX_SEL(2, 2); IDX_SEL(2, 3); IDX_SEL(3, 0); IDX_SEL(3, 1); IDX_SEL(3, 2); IDX_SEL(3, 3);                                       \
            if (lane < 16) mw[(size_t)j_ * 16 + lane] = ((u64)mhi << 32) | mlo;                  \
                                     \
            _Pragma("unroll") for (int d = 0; d < 4; ++d) { const unsigned x = cwd[d] ^ bsx; const unsigned hz = (x - 0x01010101u) & ~x & 0x80808080u;                   \
                if (__ballot(hz != 0u)) {                                                                                                                                \
                    _Pragma("unroll") for (int k = 0; k < 4; ++k) { const bool eq = ((cwd[d] >> (8 * k)) & 255u) == bs;                                                  \
                        if (eq) { const unsigned pos = __hip_atomic_fetch_add(&fb[100], 1u, __ATOMIC_RELAXED, __HIP_MEMORY_SCOPE_WORKGROUP);                             \
                            if (pos < (unsigned)FCAP) fl[pos] = qtag | (unsigned)(j_ * 32 + crow(4 * d + k, hi)); } } } } } while (0)
        uint4 cA = IDX_LDC(ks), cB = IDX_LDC(ks + 4), cC = IDX_LDC(ks + 8), cD = IDX_LDC(ks + 12);
#pragma unroll 1
        for (int j = ks; j < ntile; j += 16) {
            IDX_PROC(cA, j); cA = IDX_LDC(j + 16);
            if (j + 4 < ntile) { IDX_PROC(cB, j + 4); cB = IDX_LDC(j + 20); }
            if (j + 8 < ntile) { IDX_PROC(cC, j + 8); cC = IDX_LDC(j + 24); }
            if (j + 12 < ntile) { IDX_PROC(cD, j + 12); cD = IDX_LDC(j + 28); }
        }
#undef IDX_PROC
#undef IDX_SEL
#undef IDX_LDC
        for (int j = ntile + ks; j < jend; j += 4) if (lane < 16) mw[(size_t)j * 16 + lane] = 0ull; }
    __syncthreads();
    { const unsigned nfl = fb[100] < (unsigned)FCAP ? fb[100] : (unsigned)FCAP; const float* wv = (const float*)(lds + OFF_WV); unsigned* blq = (unsigned*)(lds + OFF_HIST);
        unsigned ti_ = (unsigned)tid; asm volatile("" : "+v"(ti_));
#pragma unroll 1
        for (unsigned i = ti_; i < nfl; i += 512u) { const unsigned e = fl[i]; const int q = (int)(e >> 14), key = (int)(e & 16383u);
            const uint4* kp = (const uint4*)(kib + (size_t)key * 128); float kf[64];
#pragma unroll
            for (int cc = 0; cc < 8; ++cc) { const uint4 w = kp[cc];
                kf[8 * cc] = __builtin_bit_cast(float, w.x << 16); kf[8 * cc + 1] = __builtin_bit_cast(float, w.x & 0xffff0000u); kf[8 * cc + 2] = __builtin_bit_cast(float, w.y << 16); kf[8 * cc + 3] = __builtin_bit_cast(float, w.y & 0xffff0000u);
                kf[8 * cc + 4] = __builtin_bit_cast(float, w.z << 16); kf[8 * cc + 5] = __builtin_bit_cast(float, w.z & 0xffff0000u); kf[8 * cc + 6] = __builtin_bit_cast(float, w.w << 16); kf[8 * cc + 7] = __builtin_bit_cast(float, w.w & 0xffff0000u); }
            const char* qp = (const char*)QI + (size_t)(unsigned)(row0 + q) * 1024; float s = 0.f;
#pragma unroll 4
            for (int h = 0; h < 8; ++h) { float d = 0.f; const uint4* qh = (const uint4*)(qp + h * 128);
#pragma unroll
                for (int cc = 0; cc < 8; ++cc) { const uint4 w = qh[cc];
                    d = fmaf(__builtin_bit_cast(float, w.x << 16), kf[8 * cc], d); d = fmaf(__builtin_bit_cast(float, w.x & 0xffff0000u), kf[8 * cc + 1], d);
                    d = fmaf(__builtin_bit_cast(float, w.y << 16), kf[8 * cc + 2], d); d = fmaf(__builtin_bit_cast(float, w.y & 0xffff0000u), kf[8 * cc + 3], d);
                    d = fmaf(__builtin_bit_cast(float, w.z << 16), kf[8 * cc + 4], d); d = fmaf(__builtin_bit_cast(float, w.z & 0xffff0000u), kf[8 * cc + 5], d);
                    d = fmaf(__builtin_bit_cast(float, w.w << 16), kf[8 * cc + 6], d); d = fmaf(__builtin_bit_cast(float, w.w & 0xffff0000u), kf[8 * cc + 7], d); }
                s = fmaf(2.f * wv[q * 8 + h], fmaxf(d, 0.f), s); }
            const float2 ab = qpar[q]; const float u = fmaf(s, ab.x, ab.y);
            const unsigned fine = (unsigned)__builtin_amdgcn_fmed3f((u - (float)bstar[q]) * 262144.f, 0.f, 262143.f);
            const unsigned pos = __hip_atomic_fetch_add(&bcnt[q], 1u, __ATOMIC_RELAXED, __HIP_MEMORY_SCOPE_WORKGROUP);
            const unsigned word = (fine << 14) | (16383u - (unsigned)key); fl[FCAP + i] = word;
            if (pos < (unsigned)CAP) blq[q * CAP + pos] = word; } }
    asm volatile("s_waitcnt vmcnt(0)" ::: "memory");
    __syncthreads();
    { const bool flat_over = fb[100] > (unsigned)FCAP; const unsigned nfl = flat_over ? (unsigned)FCAP : fb[100]; const unsigned* blq = (const unsigned*)(lds + OFF_HIST);
        unsigned ti_ = (unsigned)tid; asm volatile("" : "+v"(ti_));
        if (ti_ < 64u) { const int q = (int)ti_; if (flat_over || bcnt[q] > (unsigned)CAP || bstar[q] <= 0 || bstar[q] >= NBINS - 1 || (DBG_FORCE_FB && (q & 15) == 3)) {
            const unsigned p = __hip_atomic_fetch_add(&fb[0], 1u, __ATOMIC_RELAXED, __HIP_MEMORY_SCOPE_WORKGROUP); fb[1 + p] = (unsigned)q; } }
        if (!flat_over) {
#pragma unroll 1
        for (unsigned i = ti_; i < nfl; i += 512u) { const unsigned ef = fl[i]; const int q = (int)(ef >> 14); const unsigned cnt = bcnt[q];
            if (cnt > (unsigned)CAP || bstar[q] <= 0 || bstar[q] >= NBINS - 1 || (DBG_FORCE_FB && (q & 15) == 3)) continue;
            const unsigned mine = fl[FCAP + i];
            const unsigned* bl = blq + q * CAP; int rk = 0;
            for (unsigned m = 0; m < cnt; ++m) rk += bl[m] > mine;
            if (rk < needv[q]) mask_or_bit(MASKW + ((size_t)(b * (S / 32) + 2 * c + (q >> 5)) * (S / 32)) * 16, q & 31, (int)(16383u - (mine & 16383u))); } } }
    __syncthreads();
    { const int nfb = (int)fb[0];
        for (int f = 0; f < nfb; ++f) { const int q = (int)fb[1 + f];
            fallback_query(lds, tid, row0 + q, q & 31, n, QI, kib, WI, MASKW + ((size_t)(b * (S / 32) + 2 * c + (q >> 5)) * (S / 32)) * 16); } }
    __syncthreads();
}
__device__ __forceinline__ void indexer_phase(char* lds, int vcu, int G, const bf16* QI, const bf16* KI, const float* WI, u64* MASKW, char* area_out, char* area_tail, char* area_gap, char* area_wai) {
    for (int item = vcu; item < 256; item += G) { const int b = (item >> 7) & 1, x = item & 127;
        const unsigned cum = (unsigned)(256 * x - x * (x - 1) / 2);
        char* codes = b == 0 ? area_out + (size_t)cum * 4096 : x < 33 ? area_out + (size_t)(24640u + cum) * 4096 : x < 73 ? area_tail + (size_t)(cum - 7920u) * 4096 : x < 115 ? area_gap + (size_t)(cum - 16060u) * 4096 : area_wai + (size_t)(cum - 22885u) * 4096;
#pragma unroll 1
        for (int pass = 0; pass < 2; ++pass) indexer_unit(lds, b, pass ? 255 - x : x, QI, KI, WI, MASKW, codes); }
}
}
namespace att {
typedef unsigned short bf16;
typedef short bf16x8 __attribute__((ext_vector_type(8)));
typedef short s16x4 __attribute__((ext_vector_type(4)));
typedef float f32x16 __attribute__((ext_vector_type(16)));
typedef float f32x4 __attribute__((ext_vector_type(4)));
typedef unsigned u32x4 __attribute__((ext_vector_type(4)));
typedef unsigned long long u64;
typedef const __attribute__((address_space(4))) u64* cu64p;
typedef float f32x2_t __attribute__((ext_vector_type(2))); typedef __bf16 bf16x2_t __attribute__((ext_vector_type(2)));
__device__ __forceinline__ unsigned cvtpk_s(float lo, float hi) { f32x2_t v = {lo, hi}; bf16x2_t b = __builtin_convertvector(v, bf16x2_t); return __builtin_bit_cast(unsigned, b); }
constexpr int D = 128, PITCH = 1024, NW = 8, QBLK = 32, KVBLK = 64, QB = NW * QBLK;
constexpr int SHM_V = KVBLK * D * 2, SHM_K = KVBLK * D * 2;
constexpr int NBUF = 4;
constexpr int OFF_WS = NBUF * SHM_V + NBUF * SHM_K;
constexpr int OFF_TAB = OFF_WS + NW * 64 * 4;
constexpr int OFF_EP = 0;
constexpr int EP_PITCH = 272, EP_WAVE = 32 * EP_PITCH;
constexpr int ATTN_LDS_BYTES = OFF_TAB + 448 * 4;
static_assert(NW * EP_WAVE <= OFF_WS, "epilogue staging fits the ring");
constexpr float THR2 = 11.5f;
constexpr int MW_PER_QB = (S / 32) * 16;

#define KSWZ(row, colB) ((row) * 256 + ((colB) ^ (((row) & 7) << 4)))
#define SBAR() __builtin_amdgcn_sched_barrier(0)
__device__ __forceinline__ int v_st(int k, int c) { const int kk = (k & ~0xC) | ((k & 4) << 1) | ((k & 8) >> 1); return ((kk >> 3) * 4 + (c >> 5)) * 512 + ((kk & 7) * 32 + (c & 31)) * 2; }
__device__ __forceinline__ int v_st_nat(int k, int c) { return ((k >> 3) * 4 + (c >> 5)) * 512 + ((k & 7) * 32 + (c & 31)) * 2; }
__device__ __forceinline__ int v_rd_base(int lane) { return ((lane & 3) << 3) | (((lane >> 2) & 3) << 6) | (((lane >> 4) & 1) << 5) | (((lane >> 5) & 1) << 8); }
constexpr int v_rd_off(int d0, int ks, int half) { return d0 * 512 + ks * 4096 + half * 2048; }
__device__ __forceinline__ int crow(int r, int hi) { return (r & 3) + 8 * (r >> 2) + 4 * hi; }
__device__ __forceinline__ unsigned cvtpk(float lo, float hi) { unsigned r; asm volatile("v_cvt_pk_bf16_f32 %0, %1, %2" : "=v"(r) : "v"(lo), "v"(hi)); return r; }

template <bool NEAR>
__device__ __forceinline__ void init_tile(f32x16& p0, f32x16& p1, cu64p w, float cb  , const float* tabp, float mcur) {
    const float NEG = -__builtin_inff();
    u64 m0[16], m1[16];
#pragma unroll
    for (int r = 0; r < 16; ++r) { m0[r] = w[r]; m1[r] = w[16 + r]; }
#pragma unroll
    for (int r = 0; r < 16; ++r) { float bv = cb; if (NEAR) bv = tabp[59 - ((r & 3) + 8 * (r >> 2))] - mcur;
        float o; asm volatile("v_cndmask_b32_e64 %0, %1, %2, %3" : "=v"(o) : "v"(NEG), "v"(bv), "s"(m0[r])); p0[r] = o; }
#pragma unroll
    for (int r = 0; r < 16; ++r) { float bv = cb; if (NEAR) bv = tabp[27 - ((r & 3) + 8 * (r >> 2))] - mcur;
        float o; asm volatile("v_cndmask_b32_e64 %0, %1, %2, %3" : "=v"(o) : "v"(NEG), "v"(bv), "s"(m1[r])); p1[r] = o; }
}
__device__ __forceinline__ void partialSM(f32x16& p0, f32x16& p1, float& m_reg, float& alpha, float l_cur, float pmax_in) {
    float pmax = pmax_in;
    { auto rr = __builtin_amdgcn_permlane32_swap(__float_as_uint(pmax), __float_as_uint(pmax), false, false);
      pmax = fmaxf(__uint_as_float(rr[0]), __uint_as_float(rr[1])); }
    const bool low = pmax < -64.f && pmax > -__builtin_inff();
    alpha = 1.f;
    if (__builtin_expect(__any(pmax > THR2 || low), 0)) {
        float delta = 0.f;
        if (pmax > THR2) { delta = pmax; alpha = __builtin_amdgcn_exp2f(-delta); }
        else if (low && l_cur == 0.f) delta = pmax;
        m_reg += delta;
#pragma unroll
        for (int r = 0; r < 16; ++r) p0[r] = p0[r] - delta;
#pragma unroll
        for (int r = 0; r < 16; ++r) p1[r] = p1[r] - delta; }
#pragma unroll
    for (int r = 0; r < 16; ++r) p0[r] = __builtin_amdgcn_exp2f(p0[r]);
}
__device__ __forceinline__ void finishSM(f32x16& p0, f32x16& p1, float alpha, float& l_reg, bf16x8& pa0, bf16x8& pa1, bf16x8& pa2, bf16x8& pa3) {
#pragma unroll
    for (int r = 0; r < 16; ++r) p1[r] = __builtin_amdgcn_exp2f(p1[r]);
    float ps = 0;
#pragma unroll
    for (int r = 0; r < 16; ++r) ps += p0[r];
#pragma unroll
    for (int r = 0; r < 16; ++r) ps += p1[r];
    { auto rr = __builtin_amdgcn_permlane32_swap(__float_as_uint(ps), __float_as_uint(ps), false, false);
      ps = __uint_as_float(rr[0]) + __uint_as_float(rr[1]); }
    l_reg = l_reg * alpha + ps;
#define PK4(P, B_, OUT) do { u32x4 w = {cvtpk(P[B_+0], P[B_+1]), cvtpk(P[B_+2], P[B_+3]), cvtpk(P[B_+4], P[B_+5]), cvtpk(P[B_+6], P[B_+7])};   \
        OUT = *reinterpret_cast<bf16x8*>(&w); } while (0)
    PK4(p0, 0, pa0); PK4(p0, 8, pa1); PK4(p1, 0, pa2); PK4(p1, 8, pa3);
#undef PK4
}
template <int KB>
__device__ __forceinline__ void qkt(f32x16& p0, f32x16& p1, const char* K_lds, int r32, int hi, const bf16x8* qr) {
    const char* kb[4];
#pragma unroll
    for (int dd = 0; dd < 4; ++dd) kb[dd] = K_lds + KB * SHM_K + KSWZ(r32, (dd * 16 + hi * 8) * 2);
#pragma unroll
    for (int d0 = 0; d0 < 8; ++d0) { const char* a = kb[d0 & 3] + (d0 >> 2) * 128;
        bf16x8 b0 = *reinterpret_cast<const bf16x8*>(a);
        bf16x8 b1 = *reinterpret_cast<const bf16x8*>(a + 32 * 256);
        p0 = __builtin_amdgcn_mfma_f32_32x32x16_bf16(b0, qr[d0], p0, 0, 0, 0);
        p1 = __builtin_amdgcn_mfma_f32_32x32x16_bf16(b1, qr[d0], p1, 0, 0, 0); }
}
template <int VB>
__device__ __forceinline__ void pv_tile(f32x16* o, int vb0, bf16x8 pa0, bf16x8 pa1, bf16x8 pa2, bf16x8 pa3) {
#define TRRD(dst, off) asm volatile("ds_read_b64_tr_b16 %0, %1 offset:%2" : "=&v"(dst) : "v"(vb0), "i"(off) : "memory")
#define PV_D0(d0) do { s16x4 l0, l1, l2, l3, h0, h1, h2, h3; constexpr int b_ = VB * SHM_V + v_rd_off(d0, 0, 0); \
        TRRD(l0, b_); TRRD(h0, b_ + 2048); TRRD(l1, b_ + 4096); TRRD(h1, b_ + 6144); TRRD(l2, b_ + 8192); TRRD(h2, b_ + 10240); TRRD(l3, b_ + 12288); TRRD(h3, b_ + 14336); \
        asm volatile("s_waitcnt lgkmcnt(0)" ::: "memory"); SBAR();   \
        o[d0] = __builtin_amdgcn_mfma_f32_32x32x16_bf16(pa0, (bf16x8){l0[0], l0[1], l0[2], l0[3], h0[0], h0[1], h0[2], h0[3]}, o[d0], 0, 0, 0);   \
        o[d0] = __builtin_amdgcn_mfma_f32_32x32x16_bf16(pa1, (bf16x8){l1[0], l1[1], l1[2], l1[3], h1[0], h1[1], h1[2], h1[3]}, o[d0], 0, 0, 0);   \
        o[d0] = __builtin_amdgcn_mfma_f32_32x32x16_bf16(pa2, (bf16x8){l2[0], l2[1], l2[2], l2[3], h2[0], h2[1], h2[2], h2[3]}, o[d0], 0, 0, 0);   \
        o[d0] = __builtin_amdgcn_mfma_f32_32x32x16_bf16(pa3, (bf16x8){l3[0], l3[1], l3[2], l3[3], h3[0], h3[1], h3[2], h3[3]}, o[d0], 0, 0, 0); } while (0)
    PV_D0(0); PV_D0(1); PV_D0(2); PV_D0(3);
#undef PV_D0
#undef TRRD
}

template <int VB>
__device__ __forceinline__ float pv_tile_max(f32x16* o, int vb0, bf16x8 pa0, bf16x8 pa1, bf16x8 pa2, bf16x8 pa3, const f32x16& p0, const f32x16& p1) {
#define TRRD(dst, off) asm volatile("ds_read_b64_tr_b16 %0, %1 offset:%2" : "=&v"(dst) : "v"(vb0), "i"(off) : "memory")
#define MX3(a, b, c) fmaxf(fmaxf(a, b), c)
#define PV_D0(d0, HOOK) do { s16x4 l0, l1, l2, l3, h0, h1, h2, h3; constexpr int b_ = VB * SHM_V + v_rd_off(d0, 0, 0); \
        TRRD(l0, b_); TRRD(h0, b_ + 2048); TRRD(l1, b_ + 4096); TRRD(h1, b_ + 6144); TRRD(l2, b_ + 8192); TRRD(h2, b_ + 10240); TRRD(l3, b_ + 12288); TRRD(h3, b_ + 14336); \
        HOOK; asm volatile("s_waitcnt lgkmcnt(0)" ::: "memory"); SBAR();   \
        o[d0] = __builtin_amdgcn_mfma_f32_32x32x16_bf16(pa0, (bf16x8){l0[0], l0[1], l0[2], l0[3], h0[0], h0[1], h0[2], h0[3]}, o[d0], 0, 0, 0);   \
        o[d0] = __builtin_amdgcn_mfma_f32_32x32x16_bf16(pa1, (bf16x8){l1[0], l1[1], l1[2], l1[3], h1[0], h1[1], h1[2], h1[3]}, o[d0], 0, 0, 0);   \
        o[d0] = __builtin_amdgcn_mfma_f32_32x32x16_bf16(pa2, (bf16x8){l2[0], l2[1], l2[2], l2[3], h2[0], h2[1], h2[2], h2[3]}, o[d0], 0, 0, 0);   \
        o[d0] = __builtin_amdgcn_mfma_f32_32x32x16_bf16(pa3, (bf16x8){l3[0], l3[1], l3[2], l3[3], h3[0], h3[1], h3[2], h3[3]}, o[d0], 0, 0, 0); } while (0)
    float m;
    PV_D0(0, m = MX3(p0[0], p0[1], p0[2]); m = MX3(m, p0[3], p0[4]); m = MX3(m, p0[5], p0[6]); m = MX3(m, p0[7], p0[8]));
    PV_D0(1, m = MX3(m, p0[9], p0[10]); m = MX3(m, p0[11], p0[12]); m = MX3(m, p0[13], p0[14]); m = MX3(m, p0[15], p1[0]));
    PV_D0(2, m = MX3(m, p1[1], p1[2]); m = MX3(m, p1[3], p1[4]); m = MX3(m, p1[5], p1[6]); m = MX3(m, p1[7], p1[8]));
    PV_D0(3, m = MX3(m, p1[9], p1[10]); m = MX3(m, p1[11], p1[12]); m = MX3(m, p1[13], p1[14]); m = fmaxf(m, p1[15]));
#undef PV_D0
#undef MX3
#undef TRRD
    return m;
}

struct BlockRef { const bf16* Q; const bf16* K; const bf16* V; const bf16* ZS; bf16* O; const u64* MW; const float* bias; int P0; };
struct Seam { bf16x8 qr[8]; bf16x8 st_v0, st_v1, st_k0, st_k1; };
#define ROW(p, k0, rr) ((const bf16*)((const char*)(p) + (size_t)(unsigned)(((k0) + (rr)) * (PITCH * 2) + sc * 2)))
#define VMW() asm volatile("s_waitcnt vmcnt(0)" ::: "memory")
#define VMWN(n) asm volatile("s_waitcnt vmcnt(%0)" :: "i"(n) : "memory")
#define LD8(p) (*reinterpret_cast<const bf16x8*>(p))
#define SLOAD_H(Kp, Vp, k0) do { S.st_v0 = LD8(ROW(Vp, k0, sr)); S.st_v1 = LD8(ROW(Vp, k0, 32 + sr)); S.st_k0 = LD8(ROW(Kp, k0, sr)); S.st_k1 = LD8(ROW(Kp, k0, 32 + sr)); } while (0)
#define SWRITE_HK(bf) do { *(bf16x8*)(K_lds + (bf) * SHM_K + kws) = S.st_k0; *(bf16x8*)(K_lds + (bf) * SHM_K + kws + 32 * 256) = S.st_k1; } while (0)
#define SWRITE_HV(bf) do { *(bf16x8*)(V_lds + (bf) * SHM_V + vst0) = S.st_v0; *(bf16x8*)(V_lds + (bf) * SHM_V + vst1) = S.st_v1; } while (0)
#define SWRITE_H(bf) do { SWRITE_HV(bf); SWRITE_HK(bf); } while (0)
__device__ __forceinline__ void attn_block(const BlockRef& cur, char* lds) {
    Seam S;
    int tid_ = threadIdx.x; asm volatile("" : "+v"(tid_));
    const int tid = tid_, wid = __builtin_amdgcn_readfirstlane(tid >> 6), lane = tid & 63, r32 = lane & 31, hi = lane >> 5;
    const int NT = (cur.P0 + QB) / KVBLK;
    const int qlo = cur.P0 + wid * QBLK;
    char* V_lds = lds; char* K_lds = lds + NBUF * SHM_V;
    float* ws = (float*)(lds + OFF_WS) + wid * 64; float* li_l = ws, * al_l = ws + 32;
    float* tab = (float*)(lds + OFF_TAB);
    float m_reg = 0.f, l_reg = 0; f32x16 o[4] = {};
    const int sr = tid >> 4, sc = (tid & 15) * 8, vst0 = v_st_nat(sr, sc), vst1 = v_st_nat(32 + sr, sc), kws = KSWZ(sr, sc * 2);
    const int vb0 = (int)(uintptr_t)V_lds + v_rd_base(lane);
    const bf16* Kh = cur.K; const bf16* Vh = cur.V;
    { int tq_ = tid; asm volatile("" : "+v"(tq_));
    if (tq_ < 448) { const int rel = tq_ - 256; const int ret = rel < 0 ? 16 : 0; const int n = rel < 0 ? -rel : rel; int v;
        if (n < 8) v = n; else if (n < 12) v = 8; else if (n < 16) v = 9; else if (n < 23) v = 10; else if (n < 32) v = 11; else if (n < 46) v = 12; else if (n < 64) v = 13; else if (n < 91) v = 14; else v = 15;
        tab[tq_] = cur.bias[(ret + v) * 8] * 1.4426950408889634f; } }
    const float cbfar = cur.bias[15 * 8] * 1.4426950408889634f;
    const cu64p mwv = (cu64p)(uintptr_t)(cur.MW + (size_t)wid * MW_PER_QB);
#define RESC(a) do { if (__any((a) < 1.f)) { if (hi == 0) al_l[r32] = (a); asm volatile("s_waitcnt lgkmcnt(0)" ::: "memory");              \
                     for (int d_ = 0; d_ < 4; ++d_) for (int r = 0; r < 16; ++r) o[d_][r] *= al_l[crow(r, hi)]; } } while (0)
#define KBASE(t) ((t) * KVBLK)
#define INIT(P0_, P1_, t) do { const int kb_ = KBASE(t); const cu64p w_ = mwv + (size_t)(t) * 32;                              \
        if (kb_ + 154 <= qlo) init_tile<false>(P0_, P1_, w_, cbfar - m_reg, tab, m_reg);                                        \
        else init_tile<true>(P0_, P1_, w_, cbfar - m_reg, tab + (qlo + r32 - kb_ - 4 * hi + 197), m_reg); } while (0)
    unsigned pm0 = 0u, pm1 = 0u, pm2 = 0u, pm3 = 0u;
#define MPREF(t) do { const __attribute__((address_space(4))) unsigned* w_ = (const __attribute__((address_space(4))) unsigned*)(mwv + (size_t)(t) * 32); pm0 = w_[0]; pm1 = w_[16]; pm2 = w_[32]; pm3 = w_[48]; SBAR(); } while (0)
#define MUSE() asm volatile("" :: "s"(pm0), "s"(pm1), "s"(pm2), "s"(pm3))
    f32x16 pA0, pA1, pB0, pB1; float alA, alB; bf16x8 pa0, pa1, pa2, pa3;
#pragma unroll
    for (int d0 = 0; d0 < 8; ++d0) S.qr[d0] = LD8((const char*)cur.Q + (size_t)(unsigned)((wid * QBLK + r32) * (PITCH * 2) + d0 * 32 + hi * 16));
    SLOAD_H(Kh, Vh, 0); VMW(); SWRITE_H(0); SBAR();
    if (NT > 1) SLOAD_H(Kh, Vh, KBASE(1));
    __syncthreads();
    INIT(pA0, pA1, 0);
    SBAR(); qkt<0>(pA0, pA1, K_lds, r32, hi, S.qr);
    MPREF(1);
    { float pm_ = pA0[0];
#pragma unroll
      for (int r = 1; r < 16; ++r) pm_ = fmaxf(pm_, pA0[r]);
#pragma unroll
      for (int r = 0; r < 16; ++r) pm_ = fmaxf(pm_, pA1[r]);
      partialSM(pA0, pA1, m_reg, alA, l_reg, pm_); }
    if (NT > 1) { VMW(); SWRITE_H(1); }
    __syncthreads();
#define HALF_STEP(PX0, PX1, alX, PY0, PY1, alY, t, KB, VB, SB) do {                                                           \
        MUSE(); INIT(PX0, PX1, (t)); SBAR(); qkt<KB>(PX0, PX1, K_lds, r32, hi, S.qr);                                        \
        finishSM(PY0, PY1, alY, l_reg, pa0, pa1, pa2, pa3); SBAR();                                                           \
        SLOAD_H(Kh, Vh, KBASE((t) + 1)); SBAR();                                                                              \
        { const float pm_ = pv_tile_max<VB>(o, vb0, pa0, pa1, pa2, pa3, PX0, PX1); MPREF((t) + 1); partialSM(PX0, PX1, m_reg, alX, l_reg, pm_); }   \
        VMW(); SWRITE_H(SB);                                                                                                  \
        RESC(alX); __syncthreads(); } while (0)
    int t = 1;
    for (; t + 4 < NT; t += 4) {
        HALF_STEP(pB0, pB1, alB, pA0, pA1, alA, t, 1, 0, 2);
        HALF_STEP(pA0, pA1, alA, pB0, pB1, alB, t + 1, 2, 1, 3);
        HALF_STEP(pB0, pB1, alB, pA0, pA1, alA, t + 2, 3, 2, 0);
        HALF_STEP(pA0, pA1, alA, pB0, pB1, alB, t + 3, 0, 3, 1);
    }
    HALF_STEP(pB0, pB1, alB, pA0, pA1, alA, NT - 3, 1, 0, 2);
    HALF_STEP(pA0, pA1, alA, pB0, pB1, alB, NT - 2, 2, 1, 3);
    MUSE(); INIT(pB0, pB1, NT - 1); SBAR(); qkt<3>(pB0, pB1, K_lds, r32, hi, S.qr); SBAR();
    finishSM(pA0, pA1, alA, l_reg, pa0, pa1, pa2, pa3); SBAR();
    { const float pm_ = pv_tile_max<2>(o, vb0, pa0, pa1, pa2, pa3, pB0, pB1); partialSM(pB0, pB1, m_reg, alB, l_reg, pm_); } RESC(alB);
    finishSM(pB0, pB1, alB, l_reg, pa0, pa1, pa2, pa3); SBAR(); pv_tile<3>(o, vb0, pa0, pa1, pa2, pa3);
    SBAR();
    __syncthreads();
    if (hi == 0) li_l[r32] = l_reg; asm volatile("s_waitcnt lgkmcnt(0)" ::: "memory");
    float rli[16];
#pragma unroll
    for (int r = 0; r < 16; ++r) rli[r] = __builtin_amdgcn_rcpf(li_l[crow(r, hi)]);
    {
        char* ep = lds + OFF_EP + wid * EP_WAVE; unsigned ew_off = (unsigned)(4 * hi * EP_PITCH + r32 * 2); asm volatile("" : "+v"(ew_off));
#pragma unroll
        for (int r = 0; r < 16; ++r) { const int rw = (r & 3) + 8 * (r >> 2);
#pragma unroll
            for (int d0 = 0; d0 < 4; ++d0) *(unsigned short*)(ep + ew_off + rw * EP_PITCH + d0 * 64) = (unsigned short)(cvtpk_s(o[d0][r] * rli[r], 0.f) & 0xffffu); }
        asm volatile("s_waitcnt lgkmcnt(0)" ::: "memory");
        unsigned lane_off = (unsigned)((wid * QBLK + (lane >> 4)) * PITCH + (lane & 15) * 8) * 2u;
        asm volatile("" : "+v"(lane_off));
        unsigned er_off = (unsigned)((lane >> 4) * EP_PITCH + (lane & 15) * 16); asm volatile("" : "+v"(er_off));
        char* op = (char*)cur.O + (size_t)lane_off; const char* zp = (const char*)cur.ZS + (size_t)lane_off; const char* er = ep + er_off;
#pragma unroll
        for (int ph = 0; ph < 2; ++ph) {
            asm volatile("" ::: "memory");
            uint4 zz[4];
#pragma unroll
            for (int p4 = 0; p4 < 4; ++p4) zz[p4] = *(const uint4*)(zp + (ph * 4 + p4) * 4 * PITCH * 2);
#pragma unroll
            for (int p4 = 0; p4 < 4; ++p4) { const int p = ph * 4 + p4; const uint4 m = *(const uint4*)(er + p * 4 * EP_PITCH); const uint4 z = zz[p4]; uint4 y;
                y.x = cvtpk_s(__uint_as_float(m.x << 16) * __uint_as_float(z.x << 16), __uint_as_float(m.x & 0xffff0000u) * __uint_as_float(z.x & 0xffff0000u));
                y.y = cvtpk_s(__uint_as_float(m.y << 16) * __uint_as_float(z.y << 16), __uint_as_float(m.y & 0xffff0000u) * __uint_as_float(z.y & 0xffff0000u));
                y.z = cvtpk_s(__uint_as_float(m.z << 16) * __uint_as_float(z.z << 16), __uint_as_float(m.z & 0xffff0000u) * __uint_as_float(z.z & 0xffff0000u));
                y.w = cvtpk_s(__uint_as_float(m.w << 16) * __uint_as_float(z.w << 16), __uint_as_float(m.w & 0xffff0000u) * __uint_as_float(z.w & 0xffff0000u));
                *(uint4*)(op + p * 4 * PITCH * 2) = y; } }
    }
    __syncthreads();
#undef RESC
#undef KBASE
#undef INIT
#undef MPREF
#undef MUSE
#undef HALF_STEP
}
#undef ROW
#undef VMW
#undef VMWN
#undef LD8
#undef SLOAD_H
#undef SWRITE_HK
#undef SWRITE_HV
#undef SWRITE_H

__device__ __forceinline__ BlockRef make_ref(int L, int pass, const bf16* Q, const bf16* K, const bf16* V, const bf16* ZS, bf16* O, const u64* MASKW, const float* rel_bias) {
    const int bh = L >> 5, x = L & 31, b = bh >> 3, h = bh & 7, qb = pass ? 63 - x : x;
    BlockRef r; const size_t row0 = (size_t)b * S + (size_t)qb * QB;
    r.Q = Q + row0 * PITCH + h * D; r.O = O + row0 * PITCH + h * D; r.ZS = ZS + row0 * PITCH + h * D;
    r.K = K + (size_t)b * S * PITCH + h * D; r.V = V + (size_t)b * S * PITCH + h * D;
    r.MW = MASKW + ((size_t)b * (S / 32) + (size_t)qb * 8) * MW_PER_QB; r.bias = rel_bias + h; r.P0 = qb * QB;
    return r;
}
__device__ __forceinline__ void attn_phase(char* lds, int vcu, int G, const bf16* Q, const bf16* K, const bf16* V, const bf16* ZS, bf16* O, const u64* MASKW, const float* rel_bias) {
    constexpr int TOTAL = 512;
    for (int L = vcu; L < TOTAL; L += G)
#pragma unroll 1
        for (int pass = 0; pass < 2; ++pass) { const BlockRef cur = make_ref(L, pass, Q, K, V, ZS, O, MASKW, rel_bias); attn_block(cur, lds); }
}
}

namespace sgu {
typedef unsigned short bf16;
typedef short bf16x8 __attribute__((ext_vector_type(8)));
typedef short s16x4 __attribute__((ext_vector_type(4)));
typedef float f32x16 __attribute__((ext_vector_type(16)));
typedef float f32x2_t __attribute__((ext_vector_type(2))); typedef __bf16 bf16x2_t __attribute__((ext_vector_type(2)));
__device__ __forceinline__ unsigned cvtpk_s(float lo, float hi) { f32x2_t v = {lo, hi}; bf16x2_t b = __builtin_convertvector(v, bf16x2_t); return __builtin_bit_cast(unsigned, b); }
constexpr int OFF_B = 0;
constexpr int OFF_ST = 65536;
constexpr int OFF_EP = 66560;
constexpr int EP_PITCH = 80, EP_WAVE = 128 * EP_PITCH;
constexpr int SGU_LDS_BYTES = OFF_EP + 8 * EP_WAVE;

template <bool WRITE>
__device__ __forceinline__ void sgu_phase(char* lds, int vcu, int G, bf16* U  , const bf16* Vb, const float* LNP, const bf16* WS16, const float* ln_g, const float* ln_b, const float* b_s) {
    const int tid = threadIdx.x, wid = __builtin_amdgcn_readfirstlane(tid >> 6), lane = tid & 63, r32 = lane & 31, hi = lane >> 5;
    float2* stats = (float2*)(lds + OFF_ST);
    for (int chunk = vcu; chunk < M / 128; chunk += G) {
        const size_t row0 = (size_t)chunk * 128;
        { int tq_ = tid; asm volatile("" : "+v"(tq_));
          if (tq_ < 128) { const float4* pp = (const float4*)(LNP + (row0 + tq_) * 64); float s1 = 0.f, s2 = 0.f;
#pragma unroll
            for (int j = 0; j < 16; ++j) { const float4 q = pp[j]; s1 += q.x + q.z; s2 += q.y + q.w; }
            const float mean = s1 * (1.f / BW); const float var = fmaxf(s2 * (1.f / BW) - mean * mean, 0.f);
            stats[tq_] = make_float2(mean, 1.0f / sqrtf(var + LN_EPS)); } }
        __syncthreads();
#pragma unroll 1
        for (int g = 0; g < 8; ++g) {
            bf16x8 A0[2], A1[4], A2[6], A3[8];
            uint4 ug[8];
            { const size_t gb_ = (row0 * BW + (size_t)(g * 256 + (wid >> 2) * 128 + (wid & 3) * 32 + (lane & 3) * 8)) * 2;
#pragma unroll
                for (int p = 0; p < 8; ++p) ug[p] = *(const uint4*)((const char*)U + gb_ + (size_t)(16 * p + (lane >> 2)) * (BW * 2)); }
            { const char* ap = (const char*)WS16 + (size_t)(unsigned)(((g * 128 + r32) * 128 + 8 * hi) * 2);
#pragma unroll
                for (int kk = 0; kk < 2; ++kk) A0[kk] = *reinterpret_cast<const bf16x8*>(ap + kk * 32);
#pragma unroll
                for (int kk = 0; kk < 4; ++kk) A1[kk] = *reinterpret_cast<const bf16x8*>(ap + 32 * 256 + kk * 32);
#pragma unroll
                for (int kk = 0; kk < 6; ++kk) A2[kk] = *reinterpret_cast<const bf16x8*>(ap + 64 * 256 + kk * 32);
#pragma unroll
                for (int kk = 0; kk < 8; ++kk) A3[kk] = *reinterpret_cast<const bf16x8*>(ap + 96 * 256 + kk * 32); }
            { const int e8 = (tid & 31) * 8, ch = g * 256 + e8;
                const float4 g0 = *(const float4*)(ln_g + ch), g1 = *(const float4*)(ln_g + ch + 4), b0 = *(const float4*)(ln_b + ch), b1 = *(const float4*)(ln_b + ch + 4);
#pragma unroll
                for (int i = 0; i < 8; ++i) { const int s = (tid >> 5) + 16 * i; const uint4 w = *(const uint4*)(Vb + (row0 + s) * BW + ch); const float2 st = stats[s];
                    const float x0 = (bflo(w.x) - st.x) * st.y * g0.x + b0.x, x1 = (bfhi(w.x) - st.x) * st.y * g0.y + b0.y, x2 = (bflo(w.y) - st.x) * st.y * g0.z + b0.z, x3 = (bfhi(w.y) - st.x) * st.y * g0.w + b0.w;
                    const float x4 = (bflo(w.z) - st.x) * st.y * g1.x + b1.x, x5 = (bfhi(w.z) - st.x) * st.y * g1.y + b1.y, x6 = (bflo(w.w) - st.x) * st.y * g1.z + b1.z, x7 = (bfhi(w.w) - st.x) * st.y * g1.w + b1.w;
                    uint4 o; o.x = att::cvtpk(x0, x1); o.y = att::cvtpk(x2, x3); o.z = att::cvtpk(x4, x5); o.w = att::cvtpk(x6, x7);
                    *(uint4*)(lds + OFF_B + ((s >> 6) * 2 + (e8 >> 7)) * 16384 + att::v_st(s & 63, e8 & 127)) = o; } }
            __syncthreads();
            f32x16 acc[4] = {};
            { const int eh = wid >> 2, d0 = wid & 3;
                const int vb0 = (int)(uintptr_t)(lds + OFF_B) + att::v_rd_base(lane) + eh * 16384 + d0 * 512;
#define TRRD(dst, off) asm volatile("ds_read_b64_tr_b16 %0, %1 offset:%2" : "=&v"(dst) : "v"(vb0), "i"(off) : "memory")
#define BFRAG(dst, sh, ks) do { s16x4 l_, h_; TRRD(l_, (sh) * 32768 + (ks) * 4096); TRRD(h_, (sh) * 32768 + (ks) * 4096 + 2048); asm volatile("s_waitcnt lgkmcnt(0)" ::: "memory"); \
                dst = (bf16x8){l_[0], l_[1], l_[2], l_[3], h_[0], h_[1], h_[2], h_[3]}; } while (0)
                bf16x8 Bf[8];
                BFRAG(Bf[0], 0, 0); BFRAG(Bf[1], 0, 1); BFRAG(Bf[2], 0, 2); BFRAG(Bf[3], 0, 3); BFRAG(Bf[4], 1, 0); BFRAG(Bf[5], 1, 1); BFRAG(Bf[6], 1, 2); BFRAG(Bf[7], 1, 3);
#undef BFRAG
#undef TRRD
#pragma unroll
                for (int kk = 0; kk < 2; ++kk) acc[0] = __builtin_amdgcn_mfma_f32_32x32x16_bf16(A0[kk], Bf[kk], acc[0], 0, 0, 0);
#pragma unroll
                for (int kk = 0; kk < 4; ++kk) acc[1] = __builtin_amdgcn_mfma_f32_32x32x16_bf16(A1[kk], Bf[kk], acc[1], 0, 0, 0);
#pragma unroll
                for (int kk = 0; kk < 6; ++kk) acc[2] = __builtin_amdgcn_mfma_f32_32x32x16_bf16(A2[kk], Bf[kk], acc[2], 0, 0, 0);
#pragma unroll
                for (int kk = 0; kk < 8; ++kk) acc[3] = __builtin_amdgcn_mfma_f32_32x32x16_bf16(A3[kk], Bf[kk], acc[3], 0, 0, 0);
                char* ep = lds + OFF_EP + wid * EP_WAVE;
#pragma unroll
                for (int tb = 0; tb < 4; ++tb)
#pragma unroll
                    for (int r = 0; r < 16; ++r) { const int tl = 32 * tb + (r & 3) + 8 * (r >> 2) + 4 * hi;
                        *(unsigned short*)(ep + tl * EP_PITCH + r32 * 2) = (unsigned short)(cvtpk_s(acc[tb][r], 0.f) & 0xffffu); }
                asm volatile("s_waitcnt lgkmcnt(0)" ::: "memory");
                const int rq = lane >> 2, cq = (lane & 3) * 8;
                const size_t gbase = (row0 * BW + (size_t)(g * 256 + eh * 128 + d0 * 32 + cq)) * 2;
#pragma unroll
                for (int ph = 0; ph < 2; ++ph) {
                    uint4 uu[4], mm[4]; float bs[4];
#pragma unroll
                    for (int p = 0; p < 4; ++p) { const int t = 16 * (ph * 4 + p) + rq; const size_t o = gbase + (size_t)t * (BW * 2);
                        uu[p] = ug[ph * 4 + p]; bs[p] = b_s[g * 128 + t]; mm[p] = *(const uint4*)(ep + t * EP_PITCH + cq * 2); }
#pragma unroll
                    for (int p = 0; p < 4; ++p) { const int t = 16 * (ph * 4 + p) + rq; const size_t o = gbase + (size_t)t * (BW * 2);
                        uint4 y;
                        y.x = att::cvtpk(bflo(uu[p].x) * (bflo(mm[p].x) + bs[p]), bfhi(uu[p].x) * (bfhi(mm[p].x) + bs[p]));
                        y.y = att::cvtpk(bflo(uu[p].y) * (bflo(mm[p].y) + bs[p]), bfhi(uu[p].y) * (bfhi(mm[p].y) + bs[p]));
                        y.z = att::cvtpk(bflo(uu[p].z) * (bflo(mm[p].z) + bs[p]), bfhi(uu[p].z) * (bfhi(mm[p].z) + bs[p]));
                        y.w = att::cvtpk(bflo(uu[p].w) * (bflo(mm[p].w) + bs[p]), bfhi(uu[p].w) * (bfhi(mm[p].w) + bs[p]));
                        if (WRITE || y.x == 0x12345678u) *(uint4*)((char*)U + o) = y; } } }
            __syncthreads();
        }
    }
}
}

constexpr size_t MiB = 1u << 20;
constexpr size_t WS_CTL = 0, CTL_ZERO_BYTES = 64 * 1024;
constexpr size_t WS_WAI = 2 * MiB, WS_WAO = 12 * MiB, WS_WBI = 14 * MiB, WS_WBO = 26 * MiB;
constexpr size_t WS_WS16 = 1 * MiB;
constexpr size_t WS_RS0 = 1 * MiB + 512 * 1024;
constexpr size_t WS_H = 32 * MiB;
constexpr size_t WS_Q = 96 * MiB, WS_K = 160 * MiB, WS_V = 224 * MiB, WS_ZS = 288 * MiB;
constexpr size_t WS_QI = 352 * MiB, WS_KI = 384 * MiB, WS_WI = 388 * MiB;
constexpr size_t WS_MASK = 416 * MiB;
constexpr size_t WS_PS = 30 * MiB;
constexpr size_t WS_XB = 32 * MiB;
constexpr size_t WS_OG = 352 * MiB;
constexpr size_t WS_U = 96 * MiB, WS_VB = 224 * MiB, WS_ZB = 352 * MiB;
constexpr size_t WS_LNP = 352 * MiB;
constexpr size_t WS_TAIL = 480 * MiB;
constexpr size_t WS_END = 512 * MiB;
constexpr int CW_BAR = 1024;
constexpr int LDS_BYTES = 162816;
constexpr int MISC_OFF = 160000;
static_assert(att::ATTN_LDS_BYTES <= MISC_OFF && idx::IDX_LDS_BYTES <= MISC_OFF && sgu::SGU_LDS_BYTES <= MISC_OFF, "LDS map");

#define XB_TMO      128
#define XB_XCNT(j)  (256  + 64 * (j))
#define XB_XSUB(j)  (1280 + 64 * (j))
#define XB_XGEN(j)  (2304 + 64 * (j))
#define XB_TOP      3328
#define XB_TOPGEN   3392
#define XCD_BAR_WORDS 3456
#define XB_SPIN_CAP (1u << 18)
__device__ __forceinline__ unsigned xb_ld(unsigned* p)              { return __hip_atomic_load(p, __ATOMIC_RELAXED, __HIP_MEMORY_SCOPE_AGENT); }
__device__ __forceinline__ unsigned xb_add(unsigned* p, unsigned v) { return __hip_atomic_fetch_add(p, v, __ATOMIC_RELAXED, __HIP_MEMORY_SCOPE_AGENT); }
__device__ __forceinline__ unsigned xb_xcc_id() { return (unsigned)__builtin_amdgcn_s_getreg((3 << 11) | 20) & 0xFu; }
#define XB_SPIN(cond, bar) do { unsigned _sp = 0; while (cond) { __builtin_amdgcn_s_sleep(1); \
    if ((++_sp & 255u) == 0u) { if (xb_ld(&(bar)[XB_TMO])) break; if (_sp > XB_SPIN_CAP) { atomicAdd(&(bar)[XB_TMO], 1u); break; } } } } while (0)
struct XcdBarrier { unsigned* bar; unsigned x; volatile LAS unsigned* st; };
__device__ __forceinline__ XcdBarrier xcd_barrier_post(unsigned* bar, volatile LAS unsigned* st) {
    XcdBarrier b; b.bar = bar; b.x = xb_xcc_id(); b.st = st;
    if (threadIdx.x == 0) (void)xb_add(&bar[XB_XCNT(b.x)], 1u);
    return b;
}
__device__ __forceinline__ void xcd_barrier_complete(unsigned* bar, unsigned x, unsigned& nloc, unsigned& nx) {
    const unsigned G = gridDim.x * gridDim.y * gridDim.z;
    unsigned sum, cnt, mine, sp = 0u;
    for (;;) {
        sum = 0u; cnt = 0u; mine = 0u;
#pragma unroll
        for (unsigned j = 0; j < 16; ++j) { const unsigned c = xb_ld(&bar[XB_XCNT(j)]); sum += c; cnt += (c > 0u) ? 1u : 0u; mine = (j == x) ? c : mine; }
        if (sum == G) break;
        __builtin_amdgcn_s_sleep(1);
        if ((++sp & 255u) == 0u) { if (xb_ld(&bar[XB_TMO])) break; if (sp > XB_SPIN_CAP) { atomicAdd(&bar[XB_TMO], 1u); break; } }
    }
    nloc = mine > 0u ? mine : 1u; nx = cnt > 0u ? cnt : 1u;
}
__device__ __forceinline__ void xcd_barrier(const XcdBarrier& b) {
    asm volatile("s_waitcnt vmcnt(0)" ::: "memory");
    __syncthreads();
    if (threadIdx.x == 0) {
        unsigned* bar = b.bar;
        __builtin_amdgcn_s_waitcnt(0);
        unsigned nloc = b.st[0], nx = b.st[1];
        if (nloc == 0u) { xcd_barrier_complete(bar, b.x, nloc, nx); b.st[0] = nloc; b.st[1] = nx; }
        const unsigned old = xb_add(&bar[XB_XSUB(b.x)], 1u);
        const unsigned gen = old / nloc;
        if (old + 1u == (gen + 1u) * nloc) {
            __builtin_amdgcn_fence(__ATOMIC_RELEASE, "agent");
            asm volatile("s_waitcnt vmcnt(0)" ::: "memory");
            const unsigned og = xb_add(&bar[XB_TOP], 1u);
            const unsigned tg = og / nx;
            if (og + 1u == (tg + 1u) * nx) xb_add(&bar[XB_TOPGEN], 1u);
            else XB_SPIN(xb_ld(&bar[XB_TOPGEN]) == tg, bar);
            __builtin_amdgcn_fence(__ATOMIC_ACQUIRE, "agent");
            xb_add(&bar[XB_XGEN(b.x)], 1u);
            asm volatile("s_waitcnt vmcnt(0)" ::: "memory");
        } else {
            XB_SPIN(xb_ld(&bar[XB_XGEN(b.x)]) == gen, bar);
            __builtin_amdgcn_fence(__ATOMIC_ACQUIRE, "agent");
            asm volatile("s_waitcnt vmcnt(0)" ::: "memory");
        }
    }
    __syncthreads();
}

#ifndef MK_PER_PHASE
#define MK_PER_PHASE 0
#endif
constexpr int NPHASES = 10;
struct Args { const float* in[12]; float* out; unsigned char* ws; int ph_lo, ph_hi; };
__global__ void __launch_bounds__(512, 2) fwd(Args args) {
    extern __shared__ __attribute__((aligned(16))) unsigned char lds[];
    LAS unsigned char* ldsl = (LAS unsigned char*)lds;
    volatile LAS unsigned* MISC = (volatile LAS unsigned*)(ldsl + MISC_OFF);
    const int tid = threadIdx.x, lane = tid & 63, wave = __builtin_amdgcn_readfirstlane(tid >> 6);
    const int G = gridDim.x; const int bx = blockIdx.x; const int vcu = (G % 8 == 0) ? (bx % 8) * (G / 8) + bx / 8 : bx;
    const int gw = vcu * 8 + wave, NGW = G * 8;
    unsigned char* ws = args.ws;
    const float* x = args.in[0]; const float* norm_g = args.in[1]; const float* final_g = args.in[2]; const float* rel_bias = args.in[3];
    const float* a_w_in = args.in[4]; const float* a_w_out = args.in[5]; const float* b_w_in = args.in[6];
    const float* b_ln_g = args.in[7]; const float* b_ln_b = args.in[8]; const float* b_w_s = args.in[9]; const float* b_b_s = args.in[10]; const float* b_w_out = args.in[11];
    float* out = args.out;
    bf16 *WAI = (bf16*)(ws + WS_WAI), *WAO = (bf16*)(ws + WS_WAO), *WBI = (bf16*)(ws + WS_WBI), *WBO = (bf16*)(ws + WS_WBO), *H = (bf16*)(ws + WS_H);
    bf16 *Qb = (bf16*)(ws + WS_Q), *Kb = (bf16*)(ws + WS_K), *Vb = (bf16*)(ws + WS_V), *ZS = (bf16*)(ws + WS_ZS), *QI = (bf16*)(ws + WS_QI), *KI = (bf16*)(ws + WS_KI);
    float* WI = (float*)(ws + WS_WI); bf16* WS16 = (bf16*)(ws + WS_WS16);
    bf16 *U = (bf16*)(ws + WS_U), *V1 = (bf16*)(ws + WS_VB), *Z1 = (bf16*)(ws + WS_ZB), *XB = (bf16*)(ws + WS_XB); float* PS = (float*)(ws + WS_PS);
    if (tid < 32) MISC[tid] = 0u;
    __syncthreads();
    XcdBarrier bar; bar.bar = (unsigned*)(ws + WS_CTL) + CW_BAR; bar.x = 0; bar.st = nullptr;
    if (!MK_PER_PHASE) bar = xcd_barrier_post((unsigned*)(ws + WS_CTL) + CW_BAR, MISC + 8);
    const int lo = args.ph_lo, hi = args.ph_hi;
#ifdef DBG_SKIP
#define IN(k) (((DBG_SKIP >> (k)) & 1) == 0 && lo <= (k) && (k) < hi)
#else
#define IN(k) (lo <= (k) && (k) < hi)
#endif
#ifndef DBG_REPEAT
#define DBG_REPEAT 0
#endif
#define REP(k) _Pragma("unroll 1") for (int rep_ = 0; rep_ < 1 + ((DBG_REPEAT >> (k)) & 1); ++rep_)
#define SEAM(k) do { if (IN(k) && IN((k) + 1)) xcd_barrier(bar); } while (0)

    if (IN(0)) REP(0) {
        LAS float* scr = (LAS float*)ldsl + wave * 64 * 33;
        constexpr int I_AI = 16 * (A_NPAD / 32), I_AO = 16 * 32, I_BI = 16 * (B_COLS / 32), I_BO = 32 * 32;
        for (int it = gw; it < I_AI + I_AO + I_BI + I_BO; it += NGW) {
            int r = it;
            if (r < I_AI) { transpose_item(a_w_in, 1024, A_COLS, A_NPAD, WAI, scr, r, lane, norm_g); continue; } r -= I_AI;
            if (r < I_AO) { transpose_item(a_w_out, 1024, 1024, 1024, WAO, scr, r, lane); continue; } r -= I_AO;
            if (r < I_BI) { transpose_item(b_w_in, 1024, B_COLS, B_COLS, WBI, scr, r, lane, norm_g + DM, true); continue; } r -= I_BI;
            transpose_item(b_w_out, 2048, 1024, 1024, WBO, scr, r, lane);
        }
        for (int i = vcu * 512 + tid; i < 8 * 128 * 128; i += G * 512) WS16[i] = (i & 127) <= ((i >> 7) & 127) ? (bf16)f2bf(b_w_s[i]) : (bf16)0;
        for (int m = gw; m < M; m += NGW) row_to_bf16_rs(x + (size_t)m * DM, H + (size_t)m * DM, (float*)(ws + WS_RS0) + m, lane);
        __syncthreads();
    }
    SEAM(0);
    if (IN(1)) REP(1) {
        pg8::Gemm g{H, WAI, M, A_NPAD, 1024}; pg8::StaticOrder So; So.init(M, A_NPAD, G, bx);
        pg8::EpiA E{Qb, Kb, Vb, ZS, QI, KI, WI, (const float*)(ws + WS_RS0)};
        pg8::gemm_phase<pg8::EpiA, pg8::StaticOrder, true, true>(ldsl, g, So, E);
    }
    SEAM(1);
    if (IN(2)) REP(2) idx::indexer_phase((char*)lds, vcu, G, QI, KI, WI, (idx::u64*)(ws + WS_MASK), (char*)out, (char*)(ws + WS_TAIL), (char*)(ws + WS_WI + 1 * MiB), (char*)(ws + WS_WAI));
    SEAM(2);
    if (IN(3)) REP(3) {
        att::attn_phase((char*)lds, vcu, G, Qb, Kb, Vb, ZS, (bf16*)(ws + WS_OG), (const att::u64*)(ws + WS_MASK), rel_bias); }
    SEAM(3);
    if (IN(4)) REP(4) {
        pg8::Gemm g{(const bf16*)(ws + WS_OG), WAO, M, 1024, 1024}; pg8::StaticOrder So; So.init(M, 1024, G, bx);
        pg8::EpiRes1 E{XB, PS};
        pg8::gemm_phase<pg8::EpiRes1, pg8::StaticOrder, true, true>(ldsl, g, So, E);
    }
    if (IN(4) && IN(6)) xcd_barrier(bar);
    if (IN(6)) REP(6) {
        pg8::Gemm g{XB, WBI, M, B_COLS, 1024}; pg8::StaticOrder So; So.init(M, B_COLS, G, bx);
        pg8::EpiB E{U, V1, PS, (float*)(ws + WS_LNP)};
        pg8::gemm_phase<pg8::EpiB, pg8::StaticOrder, true, true>(ldsl, g, So, E);
    }
    SEAM(6);
#ifdef DBG_SGU2
    if (IN(7)) sgu::sgu_phase<false>((char*)lds, vcu, G, U, V1, (const float*)(ws + WS_LNP), WS16, b_ln_g, b_ln_b, b_b_s);
#endif
    if (IN(7)) sgu::sgu_phase<true>((char*)lds, vcu, G, U, V1, (const float*)(ws + WS_LNP), WS16, b_ln_g, b_ln_b, b_b_s);
    SEAM(7);
    if (IN(8)) REP(8) {
        pg8::Gemm g{U, WBO, M, 1024, 2048}; pg8::StaticOrder So; So.init(M, 1024, G, bx);
        pg8::EpiRes2 E{XB};
        pg8::gemm_phase<pg8::EpiRes2, pg8::StaticOrder, true, true>(ldsl, g, So, E);
    }
    SEAM(8);
    if (IN(9)) REP(9) { for (int m = gw; m < M; m += NGW) rms_row_bf16_to_f32(XB + (size_t)m * DM, final_g, out + (size_t)m * DM, lane); }
#undef IN
#undef SEAM
}

extern "C" void kernel_launch(void* const* d_in, const int* in_sizes, int n_in, void* d_out, int out_size, void* d_ws, size_t ws_size, hipStream_t stream) {
    static int grid = 0;
    if (grid == 0) {
        if (n_in != 12 || in_sizes[0] != M * DM || out_size != M * DM || ws_size < WS_END) { fprintf(stderr, "kernel_launch: unexpected shapes (n_in %d, in0 %d, out %d, ws %zu)\n", n_in, n_in > 0 ? in_sizes[0] : -1, out_size, ws_size); grid = -1; return; }
        int dev = 0, cus = 0, per_cu = 0;
        if (hipGetDevice(&dev) != hipSuccess || hipDeviceGetAttribute(&cus, hipDeviceAttributeMultiprocessorCount, dev) != hipSuccess) { fprintf(stderr, "kernel_launch: device query failed\n"); grid = -1; return; }
        if (hipFuncSetAttribute((const void*)fwd, hipFuncAttributeMaxDynamicSharedMemorySize, LDS_BYTES) != hipSuccess) { fprintf(stderr, "kernel_launch: hipFuncSetAttribute failed\n"); grid = -1; return; }
        if (hipOccupancyMaxActiveBlocksPerMultiprocessor(&per_cu, (const void*)fwd, 512, LDS_BYTES) != hipSuccess || per_cu < 1) { fprintf(stderr, "kernel_launch: occupancy query says %d workgroups per CU\n", per_cu); }
        (void)hipGetLastError();
        grid = cus;
    }
    if (grid < 0) return;
    if (hipMemsetAsync((char*)d_ws + WS_CTL, 0, CTL_ZERO_BYTES, stream) != hipSuccess) { fprintf(stderr, "kernel_launch: memset failed\n"); return; }
    Args a{};
    for (int i = 0; i < 12; ++i) a.in[i] = (const float*)d_in[i];
    a.out = (float*)d_out; a.ws = (unsigned char*)d_ws;
#if MK_PER_PHASE
    for (int p = 0; p < NPHASES; ++p) { a.ph_lo = p; a.ph_hi = p + 1; hipLaunchKernelGGL(fwd, dim3(grid), dim3(512), LDS_BYTES, stream, a); }
#else
    a.ph_lo = 0; a.ph_hi = NPHASES;
    hipLaunchKernelGGL(fwd, dim3(grid), dim3(512), LDS_BYTES, stream, a);
#endif
    const hipError_t le = hipPeekAtLastError();
    if (le != hipSuccess) fprintf(stderr, "kernel_launch: launch failed: %s\n", hipGetErrorName(le));
}
```

```cpp
#include <hip/hip_runtime.h>
#include <cstdio>
#include <cstdint>

constexpr int NB = 2, S = 16384, DM = 1024, M = NB * S;
constexpr int A_COLS = 4680, A_NPAD = 4864;
constexpr int BW = 2048, B_COLS = 3 * BW;
constexpr float RMS_EPS = 1e-6f, LN_EPS = 1e-5f;
constexpr float LOG2E = 1.4426950408889634f;
constexpr float QSCALE = 0.08838834764831845f * LOG2E;
constexpr float WI_SCALE = 0.35355339059327373f;
constexpr float QI_SCALE = 0.125f;
constexpr int TOPK = 256;

namespace pg8 {
#define PG8_LAS __attribute__((address_space(3)))
typedef unsigned short bf16_t;
typedef short bf16x8 __attribute__((ext_vector_type(8)));
typedef float f32x4 __attribute__((ext_vector_type(4)));
typedef unsigned u32x4 __attribute__((ext_vector_type(4)));
constexpr int BM = 256, BK = 64, HALF = 128, HTB = HALF * BK * 2  , STAGE_BYTES = 8 * HTB, NXCD = 8, WGM = 8;

__host__ __device__ __forceinline__ int lds_byte(int r, int c) { const int st = (r >> 4) * 2 + (c >> 5), rr = r & 15, cc = c & 31, ob = rr * 64 + cc * 2; return st * 1024 + (ob ^ (((ob >> 9) & 1) << 5)); }
__host__ __device__ __forceinline__ void stage_rc(int b, int& R, int& C) { const int st = b / 1024, sb = b % 1024, swz = sb ^ (((sb >> 9) & 1) << 5); R = (st >> 1) * 16 + swz / 64; C = (st & 1) * 32 + (swz % 64) / 2; }
__host__ __device__ __forceinline__ int perm32(int rho) { const int n = rho >> 4, i = rho & 15; return 8 * (i >> 2) + 4 * n + (i & 3); }

struct Unit { int pm, pn; };
struct Gemm { const bf16_t* A; const bf16_t* Bt; int M, N, K; };

struct StaticOrder {
    int nM, nN, nwg, G, c;
    __host__ __device__ void init(int M, int N, int G_, int c_) { nM = M / BM; nN = N / BM; nwg = nM * nN; G = G_; c = c_; }
    __host__ __device__ bool next(int i, Unit& u) const {
        const long L = (long)i * G + c; if (L >= nwg) return false;
        int wgid = (int)L; { const int q = nwg / NXCD, r = nwg % NXCD, xcd = wgid % NXCD, off = wgid / NXCD; wgid = (xcd < r ? xcd * (q + 1) : r * (q + 1) + (xcd - r) * q) + off; }
        const int nig = WGM * nN, gid = wgid / nig, fm = gid * WGM, gsz = (nM - fm) < WGM ? (nM - fm) : WGM;
        u.pm = fm + ((wgid % nig) % gsz); u.pn = (wgid % nig) / gsz; return true;
    }
    __device__ __forceinline__ void a_ready(const Unit&) const {}
    __device__ __forceinline__ void done(const Unit&) const {}
};

__device__ __forceinline__ unsigned cvt_pk_bf16(float lo, float hi) { unsigned r; asm volatile("v_cvt_pk_bf16_f32 %0, %1, %2" : "=v"(r) : "v"(lo), "v"(hi)); return r; }
typedef float f32x2 __attribute__((ext_vector_type(2)));
__device__ __forceinline__ float silu_f(float z) { return z * __builtin_amdgcn_rcpf(1.0f + __builtin_amdgcn_exp2f(-z * 1.4426950408889634f)); }

struct EpiA {
    static constexpr bool PERM = true, AFTER_DRAIN = false;
    bf16_t *Q, *K, *V, *ZS, *QI, *KI; float* WI; const float* RS;
    __device__ __forceinline__ void operator()(const f32x4 (&acc)[2][2][4][2], const Unit& u, int wr, int wc, int fr, int fq) const {
        const int pn = u.pn, row0 = u.pm * BM + wr * 64 + fr;
        if (pn < 18) {
            bf16_t* base; int ldc, colt; float sc = 1.f; bool act = false;
            if (pn < 4) { base = Q; ldc = 1024; colt = pn * 256; sc = 0.08838834764831845f * 1.4426950408889634f; }
            else if (pn < 8) { base = K; ldc = 1024; colt = (pn - 4) * 256; }
            else if (pn < 12) { base = V; ldc = 1024; colt = (pn - 8) * 256; }
            else if (pn < 16) { base = ZS; ldc = 1024; colt = (pn - 12) * 256; act = true; }
            else { base = QI; ldc = 512; colt = (pn - 16) * 256; sc = 0.125f; }
            const int col0 = colt + wc * 32 + 8 * fq;
#pragma unroll
            for (int ai = 0; ai < 2; ++ai)
#pragma unroll
                for (int m = 0; m < 4; ++m) { bf16_t* rowp = base + (size_t)(row0 + ai * HALF + m * 16) * ldc + col0; const float rs = RS[row0 + ai * HALF + m * 16] * sc;
#pragma unroll
                    for (int bj = 0; bj < 2; ++bj) { f32x4 v0 = acc[ai][bj][m][0] * rs, v1 = acc[ai][bj][m][1] * rs;
                        if (act) { v0 = (f32x4){silu_f(v0[0]), silu_f(v0[1]), silu_f(v0[2]), silu_f(v0[3])}; v1 = (f32x4){silu_f(v1[0]), silu_f(v1[1]), silu_f(v1[2]), silu_f(v1[3])}; }
                        u32x4 w; w.x = cvt_pk_bf16(v0[0], v0[1]); w.y = cvt_pk_bf16(v0[2], v0[3]); w.z = cvt_pk_bf16(v1[0], v1[1]); w.w = cvt_pk_bf16(v1[2], v1[3]);
                        *(u32x4*)(rowp + bj * HALF) = w; } }
        } else {
#pragma unroll
            for (int ai = 0; ai < 2; ++ai)
#pragma unroll
                for (int m = 0; m < 4; ++m) { const size_t row = (size_t)(row0 + ai * HALF + m * 16);
                    const float rs = RS[row]; const f32x4 v0 = acc[ai][0][m][0] * rs, v1 = acc[ai][0][m][1] * rs;
                    if (wc < 2) { u32x4 w; w.x = cvt_pk_bf16(v0[0], v0[1]); w.y = cvt_pk_bf16(v0[2], v0[3]); w.z = cvt_pk_bf16(v1[0], v1[1]); w.w = cvt_pk_bf16(v1[2], v1[3]);
                        *(u32x4*)(KI + row * 64 + wc * 32 + 8 * fq) = w; }
                    else if (wc == 2 && fq == 0) { const float s = 0.35355339059327373f; *(f32x4*)(WI + row * 8) = v0 * s; *(f32x4*)(WI + row * 8 + 4) = v1 * s; } }
        }
    }
};

struct EpiB {
    static constexpr bool PERM = true, AFTER_DRAIN = false;
    bf16_t* Gt; bf16_t* Vt;
    const float* PS;
    float* LNP;
    __device__ __forceinline__ float rowscale(const float* psrow) const {
        const f32x4* pp = (const f32x4*)psrow; const f32x4 q0 = pp[0], q1 = pp[1], q2 = pp[2], q3 = pp[3];
        const float ss = ((q0[0] + q0[1]) + (q0[2] + q0[3])) + ((q1[0] + q1[1]) + (q1[2] + q1[3])) + ((q2[0] + q2[1]) + (q2[2] + q2[3])) + ((q3[0] + q3[1]) + (q3[2] + q3[3]));
        return 1.0f / sqrtf(ss * (1.f / 1024.f) + 1e-6f); }
    __device__ __forceinline__ void operator()(const f32x4 (&acc)[2][2][4][2], const Unit& u, int wr, int wc, int fr, int fq) const {
        const int pn = u.pn, row0 = u.pm * BM + wr * 64 + fr;
        const float* psrow = PS + (size_t)row0 * 16;
        if (pn < 16) {
            bf16_t* p = Gt + (size_t)row0 * 2048 + pn * 128 + wc * 32 + 8 * fq;
#pragma unroll
            for (int ai = 0; ai < 2; ++ai)
#pragma unroll
                for (int m = 0; m < 4; ++m) { const float rs = rowscale(psrow + (size_t)(ai * HALF + m * 16) * 16);
                    const f32x4 u0 = acc[ai][0][m][0] * rs, u1 = acc[ai][0][m][1] * rs, z0 = acc[ai][1][m][0] * rs, z1 = acc[ai][1][m][1] * rs;
                    u32x4 w; w.x = cvt_pk_bf16(u0[0] * silu_f(z0[0]), u0[1] * silu_f(z0[1])); w.y = cvt_pk_bf16(u0[2] * silu_f(z0[2]), u0[3] * silu_f(z0[3]));
                    w.z = cvt_pk_bf16(u1[0] * silu_f(z1[0]), u1[1] * silu_f(z1[1])); w.w = cvt_pk_bf16(u1[2] * silu_f(z1[2]), u1[3] * silu_f(z1[3]));
                    *(u32x4*)(p + (size_t)(ai * HALF + m * 16) * 2048) = w; }
        } else {
            const int tv = pn - 16; bf16_t* p = Vt + (size_t)row0 * 2048 + tv * 256 + wc * 32 + 8 * fq;
#pragma unroll
            for (int ai = 0; ai < 2; ++ai)
#pragma unroll
                for (int m = 0; m < 4; ++m) { const int ro = ai * HALF + m * 16; const float rs = rowscale(psrow + (size_t)ro * 16); float s1 = 0.f, s2 = 0.f;
#pragma unroll
                    for (int bj = 0; bj < 2; ++bj) { const f32x4 v0 = acc[ai][bj][m][0] * rs, v1 = acc[ai][bj][m][1] * rs;
                        s1 += ((v0[0] + v0[1]) + (v0[2] + v0[3])) + ((v1[0] + v1[1]) + (v1[2] + v1[3]));
                        s2 += ((v0[0] * v0[0] + v0[1] * v0[1]) + (v0[2] * v0[2] + v0[3] * v0[3])) + ((v1[0] * v1[0] + v1[1] * v1[1]) + (v1[2] * v1[2] + v1[3] * v1[3]));
                        u32x4 w; w.x = cvt_pk_bf16(v0[0], v0[1]); w.y = cvt_pk_bf16(v0[2], v0[3]); w.z = cvt_pk_bf16(v1[0], v1[1]); w.w = cvt_pk_bf16(v1[2], v1[3]);
                        *(u32x4*)(p + (size_t)ro * 2048 + bj * HALF) = w; }
                    s1 += __shfl_xor(s1, 16); s1 += __shfl_xor(s1, 32); s2 += __shfl_xor(s2, 16); s2 += __shfl_xor(s2, 32);
                    if (fq == 0) { typedef float f32x2_ __attribute__((ext_vector_type(2))); *(f32x2_*)(LNP + ((size_t)(row0 + ro) * 32 + tv * 4 + wc) * 2) = (f32x2_){s1, s2}; } }
        }
    }
};

struct EpiRes2 {
    static constexpr bool PERM = true, AFTER_DRAIN = false;
    bf16_t* XB;
    __device__ __forceinline__ void operator()(const f32x4 (&acc)[2][2][4][2], const Unit& u, int wr, int wc, int fr, int fq) const {
        const int row0 = u.pm * BM + wr * 64 + fr, col0 = u.pn * BM + wc * 32 + 8 * fq;
#pragma unroll
        for (int ai = 0; ai < 2; ++ai) { u32x4 bb[4][2];
#pragma unroll
            for (int m = 0; m < 4; ++m)
#pragma unroll
                for (int bj = 0; bj < 2; ++bj) bb[m][bj] = *(const u32x4*)(XB + (size_t)(row0 + ai * HALF + m * 16) * 1024 + col0 + bj * HALF);
#pragma unroll
            for (int m = 0; m < 4; ++m)
#pragma unroll
                for (int bj = 0; bj < 2; ++bj) { const u32x4 b = bb[m][bj]; const f32x4 a0 = acc[ai][bj][m][0], a1 = acc[ai][bj][m][1]; u32x4 w;
                    w.x = cvt_pk_bf16(__uint_as_float(b.x << 16) + a0[0], __uint_as_float(b.x & 0xffff0000u) + a0[1]);
                    w.y = cvt_pk_bf16(__uint_as_float(b.y << 16) + a0[2], __uint_as_float(b.y & 0xffff0000u) + a0[3]);
                    w.z = cvt_pk_bf16(__uint_as_float(b.z << 16) + a1[0], __uint_as_float(b.z & 0xffff0000u) + a1[1]);
                    w.w = cvt_pk_bf16(__uint_as_float(b.w << 16) + a1[2], __uint_as_float(b.w & 0xffff0000u) + a1[3]);
                    *(u32x4*)(XB + (size_t)(row0 + ai * HALF + m * 16) * 1024 + col0 + bj * HALF) = w; } }
    }
};

struct EpiRes1 {
    static constexpr bool PERM = true, AFTER_DRAIN = false;
    bf16_t* XB; float* PS;
    __device__ __forceinline__ void operator()(const f32x4 (&acc)[2][2][4][2], const Unit& u, int wr, int wc, int fr, int fq) const {
        const int row0 = u.pm * BM + wr * 64 + fr, col0 = u.pn * BM + wc * 32 + 8 * fq;
#pragma unroll
        for (int ai = 0; ai < 2; ++ai) { u32x4 bb[4][2];
#pragma unroll
            for (int m = 0; m < 4; ++m)
#pragma unroll
                for (int bj = 0; bj < 2; ++bj) bb[m][bj] = *(const u32x4*)(XB + (size_t)(row0 + ai * HALF + m * 16) * 1024 + col0 + bj * HALF);
#pragma unroll
            for (int m = 0; m < 4; ++m) { const size_t row = (size_t)(row0 + ai * HALF + m * 16); float ss = 0.f;
#pragma unroll
                for (int bj = 0; bj < 2; ++bj) { const u32x4 b = bb[m][bj]; const f32x4 a0 = acc[ai][bj][m][0], a1 = acc[ai][bj][m][1];
                    const f32x4 v0 = {__uint_as_float(b.x << 16) + a0[0], __uint_as_float(b.x & 0xffff0000u) + a0[1], __uint_as_float(b.y << 16) + a0[2], __uint_as_float(b.y & 0xffff0000u) + a0[3]};
                    const f32x4 v1 = {__uint_as_float(b.z << 16) + a1[0], __uint_as_float(b.z & 0xffff0000u) + a1[1], __uint_as_float(b.w << 16) + a1[2], __uint_as_float(b.w & 0xffff0000u) + a1[3]};
                    ss += ((v0[0] * v0[0] + v0[1] * v0[1]) + (v0[2] * v0[2] + v0[3] * v0[3])) + ((v1[0] * v1[0] + v1[1] * v1[1]) + (v1[2] * v1[2] + v1[3] * v1[3]));
                    u32x4 w; w.x = cvt_pk_bf16(v0[0], v0[1]); w.y = cvt_pk_bf16(v0[2], v0[3]); w.z = cvt_pk_bf16(v1[0], v1[1]); w.w = cvt_pk_bf16(v1[2], v1[3]);
                    *(u32x4*)(XB + row * 1024 + col0 + bj * HALF) = w; }
                ss += __shfl_xor(ss, 16); ss += __shfl_xor(ss, 32);
                if (fq == 0) PS[row * 16 + u.pn * 4 + wc] = ss; } }
    }
};

template <class Epi, class Sched, bool ALIGN_EPI = false, bool SP2 = false>
__device__ __forceinline__ void gemm_phase(PG8_LAS unsigned char* lds, const Gemm g, const Sched& S, const Epi& E) {
    const int tid = threadIdx.x, wid = __builtin_amdgcn_readfirstlane(tid >> 6), lane = tid & 63, wr = wid >> 2, wc = wid & 3, fr = lane & 15, fq = lane >> 4;
    const int K = g.K, nt = K / BK;
    unsigned voffA[2], voffB[2];
#pragma unroll
    for (int i = 0; i < 2; ++i) { int R, C; stage_rc(tid * 16 + i * 8192, R, C); const int Rb = Epi::PERM ? ((R & ~31) + perm32(R & 31)) : R;
        voffA[i] = (unsigned)(R * K + C) * 2u; voffB[i] = (unsigned)(Rb * K + C) * 2u; }
    const size_t kstep = (size_t)(BK * 2);
    const size_t hstep = (size_t)HALF * K * 2;
    const size_t tstep = 2 * hstep;
    const unsigned ldsw = (unsigned)wid * 1024u;
    const int aoff = lds_byte(wr * 64 + fr, fq * 8), boff = lds_byte(wc * 32 + fr, fq * 8);
#define PG8_SA(b, h) (((b) * 2 + (h)) * HTB)
#define PG8_SB(b, h) ((4 + (b) * 2 + (h)) * HTB)
#define PG8_STAGE(bufoff, gbase, voff) do { _Pragma("unroll") for (int _i = 0; _i < 2; ++_i) \
        __builtin_amdgcn_global_load_lds((const unsigned*)((const char*)(gbase) + (voff)[_i]), (PG8_LAS unsigned*)(lds + (bufoff) + ldsw + _i * 8192), 16, 0, 0); } while (0)
#define PG8_LDA(dst, b, h) do { _Pragma("unroll") for (int m = 0; m < 4; ++m) _Pragma("unroll") for (int k = 0; k < 2; ++k) dst[m][k] = *(const PG8_LAS bf16x8*)(lds + PG8_SA(b, h) + aoff + m * 2048 + k * 1024); } while (0)
#define PG8_LDB(dst, b, h) do { _Pragma("unroll") for (int n = 0; n < 2; ++n) _Pragma("unroll") for (int k = 0; k < 2; ++k) dst[n][k] = *(const PG8_LAS bf16x8*)(lds + PG8_SB(b, h) + boff + n * 2048 + k * 1024); } while (0)
#define PG8_MMA(ai, bj, At, Bt) do { __builtin_amdgcn_s_setprio(1); _Pragma("unroll") for (int m = 0; m < 4; ++m) _Pragma("unroll") for (int n = 0; n < 2; ++n) _Pragma("unroll") for (int k = 0; k < 2; ++k) \
        acc[ai][bj][m][n] = __builtin_amdgcn_mfma_f32_16x16x32_bf16(Bt[n][k], At[m][k], acc[ai][bj][m][n], 0, 0, 0); __builtin_amdgcn_s_setprio(0); } while (0)
#define PG8_WAIT_V(n) asm volatile("s_waitcnt vmcnt(" #n ")" ::: "memory")
#define PG8_WAIT_L(n) asm volatile("s_waitcnt lgkmcnt(" #n ")" ::: "memory")
#define PG8_BAR __builtin_amdgcn_s_barrier()
#define PG8_SCHED __builtin_amdgcn_sched_barrier(0)
    Unit cur, nxt; int ui = 0;
    if (!S.next(0, cur)) return;
    f32x4 acc[2][2][4][2];
#pragma unroll
    for (int a = 0; a < 2; ++a)
#pragma unroll
        for (int b = 0; b < 2; ++b)
#pragma unroll
            for (int m = 0; m < 4; ++m)
#pragma unroll
                for (int n = 0; n < 2; ++n) acc[a][b][m][n] = (f32x4){0.f, 0.f, 0.f, 0.f};
    bf16x8 At[4][2], B0[2][2], B1[2][2];
    const char* cA = (const char*)g.A + (size_t)cur.pm * tstep; const char* cB = (const char*)g.Bt + (size_t)cur.pn * tstep;
    S.a_ready(cur);
    if constexpr (SP2) {
        PG8_STAGE(PG8_SB(0, 0), cB, voffB); PG8_STAGE(PG8_SB(0, 1), cB + hstep, voffB); PG8_STAGE(PG8_SA(0, 0), cA, voffA); PG8_STAGE(PG8_SA(0, 1), cA + hstep, voffA);
        if (wr == 1) PG8_BAR;
        PG8_WAIT_V(2); PG8_BAR;
        PG8_STAGE(PG8_SB(1, 0), cB + kstep, voffB); PG8_STAGE(PG8_SA(1, 0), cA + kstep, voffA); PG8_STAGE(PG8_SB(1, 1), cB + hstep + kstep, voffB);
        PG8_WAIT_V(6); PG8_BAR;
    } else {
        PG8_STAGE(PG8_SB(0, 0), cB, voffB); PG8_STAGE(PG8_SA(0, 0), cA, voffA); PG8_STAGE(PG8_SB(0, 1), cB + hstep, voffB); PG8_STAGE(PG8_SA(0, 1), cA + hstep, voffA);
        if (wr == 1) PG8_BAR;
        PG8_WAIT_V(4); PG8_BAR;
        PG8_STAGE(PG8_SB(1, 0), cB + kstep, voffB); PG8_STAGE(PG8_SA(1, 0), cA + kstep, voffA); PG8_STAGE(PG8_SB(1, 1), cB + hstep + kstep, voffB);
        PG8_WAIT_V(6); PG8_BAR;
    }
    for (;;) {
        const bool has_next = S.next(ui + 1, nxt);
        const char* nA = has_next ? (const char*)g.A + (size_t)nxt.pm * tstep : cA; const char* nB = has_next ? (const char*)g.Bt + (size_t)nxt.pn * tstep : cB;
        for (int t = 0; t < nt; t += 2) {
            const bool last = (t == nt - 2);
            const char* a1 = cA + (size_t)(t + 1) * kstep;
            const char* a2 = last ? nA : cA + (size_t)(t + 2) * kstep; const char* b2 = last ? nB : cB + (size_t)(t + 2) * kstep;
            const char* a3 = a2 + kstep; const char* b3 = b2 + kstep;
            if (last && has_next) S.a_ready(nxt);
            if constexpr (SP2) {
            PG8_LDB(B0, 0, 0); PG8_LDB(B1, 0, 1); PG8_SCHED; PG8_LDA(At, 0, 0); PG8_STAGE(PG8_SA(1, 1), a1 + hstep, voffA);
            PG8_WAIT_V(8); PG8_WAIT_L(0); PG8_BAR; PG8_MMA(0, 0, At, B0); PG8_MMA(0, 1, At, B1); PG8_BAR; PG8_SCHED;
            PG8_LDA(At, 0, 1); PG8_STAGE(PG8_SB(0, 0), b2, voffB); PG8_STAGE(PG8_SB(0, 1), b2 + hstep, voffB); PG8_STAGE(PG8_SA(0, 0), a2, voffA);
            PG8_WAIT_V(8); PG8_WAIT_L(0); PG8_BAR; PG8_MMA(1, 0, At, B0); PG8_MMA(1, 1, At, B1); PG8_BAR; PG8_SCHED;
            PG8_LDB(B0, 1, 0); PG8_LDB(B1, 1, 1); PG8_SCHED; PG8_LDA(At, 1, 0); PG8_STAGE(PG8_SA(0, 1), a2 + hstep, voffA);
            PG8_WAIT_V(8); PG8_WAIT_L(0); PG8_BAR; PG8_MMA(0, 0, At, B0); PG8_MMA(0, 1, At, B1); PG8_BAR; PG8_SCHED;
            PG8_LDA(At, 1, 1); PG8_STAGE(PG8_SB(1, 0), b3, voffB); PG8_STAGE(PG8_SB(1, 1), b3 + hstep, voffB); PG8_STAGE(PG8_SA(1, 0), a3, voffA);
            PG8_WAIT_V(8); PG8_WAIT_L(0); PG8_BAR; PG8_MMA(1, 0, At, B0); PG8_MMA(1, 1, At, B1); PG8_BAR; PG8_SCHED;
            } else {
            PG8_LDB(B0, 0, 0); PG8_SCHED; PG8_LDA(At, 0, 0); PG8_STAGE(PG8_SA(1, 1), a1 + hstep, voffA);
            PG8_WAIT_L(8); PG8_BAR; PG8_WAIT_L(0); PG8_MMA(0, 0, At, B0); PG8_BAR; PG8_SCHED;
            PG8_LDB(B1, 0, 1); PG8_STAGE(PG8_SB(0, 0), b2, voffB);
            PG8_BAR; PG8_WAIT_L(0); PG8_MMA(0, 1, At, B1); PG8_BAR;
            PG8_LDA(At, 0, 1); PG8_STAGE(PG8_SA(0, 0), a2, voffA);
            PG8_BAR; PG8_WAIT_L(0); PG8_MMA(1, 0, At, B0); PG8_BAR; PG8_SCHED;
            PG8_STAGE(PG8_SB(0, 1), b2 + hstep, voffB);
            PG8_WAIT_V(6); PG8_BAR; PG8_MMA(1, 1, At, B1); PG8_BAR;
            PG8_LDB(B0, 1, 0); PG8_SCHED; PG8_LDA(At, 1, 0); PG8_STAGE(PG8_SA(0, 1), a2 + hstep, voffA);
            PG8_WAIT_L(8); PG8_BAR; PG8_WAIT_L(0); PG8_MMA(0, 0, At, B0); PG8_BAR; PG8_SCHED;
            PG8_LDB(B1, 1, 1); PG8_STAGE(PG8_SB(1, 0), b3, voffB);
            PG8_BAR; PG8_WAIT_L(0); PG8_MMA(0, 1, At, B1); PG8_BAR;
            PG8_LDA(At, 1, 1); PG8_STAGE(PG8_SA(1, 0), a3, voffA);
            PG8_BAR; PG8_WAIT_L(0); PG8_MMA(1, 0, At, B0); PG8_BAR; PG8_SCHED;
            PG8_STAGE(PG8_SB(1, 1), b3 + hstep, voffB);
            PG8_WAIT_V(6); PG8_BAR; PG8_MMA(1, 1, At, B1); PG8_BAR;
            }
        }
        if constexpr (ALIGN_EPI) { if (wr == 0) PG8_BAR; }
        if constexpr (!Epi::AFTER_DRAIN) { E(acc, cur, wr, wc, fr, fq); S.done(cur); }
        if (!has_next) break;
#pragma unroll
        for (int a = 0; a < 2; ++a)
#pragma unroll
            for (int b = 0; b < 2; ++b)
#pragma unroll
                for (int m = 0; m < 4; ++m)
#pragma unroll
                    for (int n = 0; n < 2; ++n) acc[a][b][m][n] = (f32x4){0.f, 0.f, 0.f, 0.f};
        cur = nxt; cA = nA; cB = nB; ++ui;
        if constexpr (ALIGN_EPI) { if (wr == 1) PG8_BAR; }
    }
    PG8_WAIT_V(0);
    if constexpr (!ALIGN_EPI) { if (wr == 0) PG8_BAR; }
    PG8_BAR;
    if constexpr (Epi::AFTER_DRAIN) { E.fused(acc, cur, wr, wc, fr, fq, lds, wid, lane); S.done(cur); }
#undef PG8_SA
#undef PG8_SB
#undef PG8_STAGE
#undef PG8_LDA
#undef PG8_LDB
#undef PG8_MMA
#undef PG8_WAIT_V
#undef PG8_WAIT_L
#undef PG8_BAR
#undef PG8_SCHED
}
}
#define LAS __attribute__((address_space(3)))
typedef unsigned short bf16;
typedef float f32x4 __attribute__((ext_vector_type(4)));
typedef unsigned v4u __attribute__((ext_vector_type(4)));
typedef unsigned v2u __attribute__((ext_vector_type(2)));
__device__ __forceinline__ unsigned f2bf(float f) { unsigned u = __builtin_bit_cast(unsigned, f); return (u + 0x7fffu + ((u >> 16) & 1u)) >> 16; }
__device__ __forceinline__ unsigned pk2(float lo, float hi) { return f2bf(lo) | (f2bf(hi) << 16); }
__device__ __forceinline__ float bflo(unsigned w) { return __builtin_bit_cast(float, w << 16); }
__device__ __forceinline__ float bfhi(unsigned w) { return __builtin_bit_cast(float, w & 0xffff0000u); }
__device__ __forceinline__ float wave_sum(float v) {
#pragma unroll
    for (int o = 1; o < 64; o <<= 1) v += __shfl_xor(v, o);
    return v;
}
__device__ __forceinline__ float wave_max(float v) {
#pragma unroll
    for (int o = 1; o < 64; o <<= 1) v = fmaxf(v, __shfl_xor(v, o));
    return v;
}
__device__ __forceinline__ int t5_bucket(int rel) {
    const int ret = rel < 0 ? 16 : 0; const int n = rel < 0 ? -rel : rel;
    int v;
    if (n < 8) v = n; else if (n < 12) v = 8; else if (n < 16) v = 9; else if (n < 23) v = 10; else if (n < 32) v = 11; else if (n < 46) v = 12; else if (n < 64) v = 13; else if (n < 91) v = 14; else v = 15;
    return ret + v;
}

__device__ __forceinline__ void transpose_item(const float* W, int K, int N, int Npad, bf16* WT, LAS float* scr, int item, int lane, const float* gk = nullptr  , bool uzv = false  ) {
    const int nblk = Npad / 32, kb = item / nblk, nb = item % nblk, k0 = 64 * kb, n0 = 32 * nb;
    const int nn = n0 + (lane & 31);
    const int d0 = !uzv ? n0 : n0 < 2048 ? 256 * (n0 >> 7) + (n0 & 127) : n0 < 4096 ? n0 + 2048 : 256 * ((n0 - 4096) >> 7) + 128 + (n0 & 127);
#pragma unroll 8
    for (int i = 0; i < 32; ++i) { const int kk = 2 * i + (lane >> 5); scr[kk * 33 + (lane & 31)] = nn < N ? W[(size_t)(k0 + kk) * N + nn] * (gk ? gk[k0 + kk] : 1.f) : 0.f; }
    asm volatile("s_waitcnt lgkmcnt(0)" ::: "memory");
    const int c = lane & 7;
#pragma unroll
    for (int j = 0; j < 4; ++j) { const int n = (lane >> 3) + 8 * j; const LAS float* s = scr + (8 * c) * 33 + n;
        v4u o; o.x = pk2(s[0 * 33], s[1 * 33]); o.y = pk2(s[2 * 33], s[3 * 33]); o.z = pk2(s[4 * 33], s[5 * 33]); o.w = pk2(s[6 * 33], s[7 * 33]);
        *(v4u*)(WT + (size_t)(d0 + n) * K + k0 + 8 * c) = o; }
    asm volatile("s_waitcnt lgkmcnt(0)" ::: "memory");
}
__device__ __forceinline__ void rms_row_to_bf16(const float* xrow, const float* g, bf16* orow, int lane) {
    const f32x4* xr = (const f32x4*)xrow + lane; const f32x4* gr = (const f32x4*)g + lane;
    f32x4 v[4]; float s = 0.f;
#pragma unroll
    for (int j = 0; j < 4; ++j) { v[j] = xr[64 * j]; s += (v[j].x * v[j].x + v[j].y * v[j].y) + (v[j].z * v[j].z + v[j].w * v[j].w); }
    const float rs = 1.0f / sqrtf(wave_sum(s) * (1.f / 1024.f) + RMS_EPS);
    v2u* o8 = (v2u*)orow + lane;
#pragma unroll
    for (int j = 0; j < 4; ++j) { const f32x4 gg = gr[64 * j]; v2u o; o.x = pk2(v[j].x * rs * gg.x, v[j].y * rs * gg.y); o.y = pk2(v[j].z * rs * gg.z, v[j].w * rs * gg.w); o8[64 * j] = o; }
}
__device__ __forceinline__ void rms_row_f32(const float* xrow, const float* g, float* orow, int lane) {
    const f32x4* xr = (const f32x4*)xrow + lane; const f32x4* gr = (const f32x4*)g + lane;
    f32x4 v[4]; float s = 0.f;
#pragma unroll
    for (int j = 0; j < 4; ++j) { v[j] = xr[64 * j]; s += (v[j].x * v[j].x + v[j].y * v[j].y) + (v[j].z * v[j].z + v[j].w * v[j].w); }
    const float rs = 1.0f / sqrtf(wave_sum(s) * (1.f / 1024.f) + RMS_EPS);
    f32x4* o = (f32x4*)orow + lane;
#pragma unroll
    for (int j = 0; j < 4; ++j) { const f32x4 gg = gr[64 * j]; o[64 * j] = v[j] * rs * gg; }
}


__device__ __forceinline__ void rms_row_bf16_to_f32(const bf16* xrow, const float* g, float* orow, int lane) {
    typedef unsigned u32x4_ __attribute__((ext_vector_type(4)));
    float v[2][8]; float s = 0.f;
#pragma unroll
    for (int j = 0; j < 2; ++j) { const u32x4_ b = *((const u32x4_*)xrow + 64 * j + lane);
        v[j][0] = __uint_as_float(b.x << 16); v[j][1] = __uint_as_float(b.x & 0xffff0000u); v[j][2] = __uint_as_float(b.y << 16); v[j][3] = __uint_as_float(b.y & 0xffff0000u);
        v[j][4] = __uint_as_float(b.z << 16); v[j][5] = __uint_as_float(b.z & 0xffff0000u); v[j][6] = __uint_as_float(b.w << 16); v[j][7] = __uint_as_float(b.w & 0xffff0000u);
#pragma unroll
        for (int e = 0; e < 8; ++e) s += v[j][e] * v[j][e]; }
    const float rs = 1.0f / sqrtf(wave_sum(s) * (1.f / 1024.f) + RMS_EPS);
#pragma unroll
    for (int j = 0; j < 2; ++j) { const f32x4* gr = (const f32x4*)g + 128 * j + 2 * lane; f32x4* o = (f32x4*)orow + 128 * j + 2 * lane; const f32x4 g0 = gr[0], g1 = gr[1];
        o[0] = (f32x4){v[j][0] * rs * g0.x, v[j][1] * rs * g0.y, v[j][2] * rs * g0.z, v[j][3] * rs * g0.w};
        o[1] = (f32x4){v[j][4] * rs * g1.x, v[j][5] * rs * g1.y, v[j][6] * rs * g1.z, v[j][7] * rs * g1.w}; }
}

__device__ __forceinline__ void row_to_bf16_rs(const float* xrow, bf16* orow, float* rs_out, int lane) {
    const f32x4* xr = (const f32x4*)xrow + lane;
    f32x4 v[4]; float s = 0.f;
#pragma unroll
    for (int j = 0; j < 4; ++j) { v[j] = xr[64 * j]; s += (v[j].x * v[j].x + v[j].y * v[j].y) + (v[j].z * v[j].z + v[j].w * v[j].w); }
    v2u* o8 = (v2u*)orow + lane;
#pragma unroll
    for (int j = 0; j < 4; ++j) { v2u o; o.x = pk2(v[j].x, v[j].y); o.y = pk2(v[j].z, v[j].w); o8[64 * j] = o; }
    const float rs = 1.0f / sqrtf(wave_sum(s) * (1.f / 1024.f) + RMS_EPS);
    if (lane == 0) *rs_out = rs;
}
namespace idx {
typedef unsigned short bf16;
typedef short bf16x8 __attribute__((ext_vector_type(8)));
typedef float f32x16 __attribute__((ext_vector_type(16)));
typedef unsigned long long u64;
constexpr int NBINS = 256, HSTR = 257, CAP = 512, FCAP = 2048;
constexpr int OFF_HIST = 0;
constexpr int OFF_QL = 66048;
constexpr int OFF_STAT = 64 * 513 * 4 + 128;
constexpr int OFF_QPAR = OFF_STAT + 2048;
constexpr int OFF_BSTAR = OFF_QPAR + 512, OFF_NEED = OFF_BSTAR + 256, OFF_BCNT = OFF_NEED + 256;
constexpr int OFF_FB = OFF_BCNT + 256;
constexpr int OFF_FBH = OFF_FB + 512;
constexpr int OFF_QF = OFF_FBH + 1024 + 64;
constexpr int OFF_WV = OFF_QF + 2048;
constexpr int OFF_FLAT = OFF_WV + 2048;
constexpr int IDX_LDS_BYTES = OFF_FLAT + 2 * FCAP * 4;
#ifndef IDX_REPS
#define IDX_REPS 1
#endif
#ifndef DBG_FORCE_FB
#define DBG_FORCE_FB 0
#endif

__device__ __forceinline__ int crow(int r, int hi) { return (r & 3) + 8 * (r >> 2) + 4 * hi; }
__device__ __forceinline__ float z_upper(float p) {
    const bool flip = p > 0.5f; const float pp = flip ? 1.f - p : p; const float t = sqrtf(-2.f * logf(pp));
    float num = 2.515517f + t * (0.802853f + t * 0.010328f); asm volatile("" : "+v"(num));
    const float den = 1.f + t * (1.432788f + t * (0.189269f + t * 0.001308f));
    const float z = t - num / den;
    return flip ? -z : z;
}
typedef float f32x4_t __attribute__((ext_vector_type(4)));
__device__ __forceinline__ void load_a16(bf16x8 (&a)[2][2], const char* kib, int j, int l15, int kq) {
    const char* kp = kib + (size_t)(unsigned)((j * 32 + l15) * 128 + kq * 16);
#pragma unroll
    for (int rb = 0; rb < 2; ++rb)
#pragma unroll
        for (int ks = 0; ks < 2; ++ks) a[rb][ks] = *reinterpret_cast<const bf16x8*>(kp + rb * 2048 + ks * 64);
}
template <bool PF>
__device__ __forceinline__ void tile_scores16(bf16x8 (&a)[2][2], const bf16x8 (&qreg)[8][2][2], const char* qlp  , const float* wv0, const float* wv1, float (&sc)[16], const char* kib, int jn, int l15, int kq) {
    f32x4_t dl[2][2]; bf16x8 qL[2][2];
#pragma unroll
    for (int cb = 0; cb < 2; ++cb)
#pragma unroll
        for (int ks = 0; ks < 2; ++ks) qL[cb][ks] = *reinterpret_cast<const bf16x8*>(qlp + (cb * 2 + ks) * 8192);
#pragma unroll
    for (int rb = 0; rb < 2; ++rb)
#pragma unroll
        for (int cb = 0; cb < 2; ++cb) { f32x4_t t = {0.f, 0.f, 0.f, 0.f};
#pragma unroll
            for (int ks = 0; ks < 2; ++ks) t = __builtin_amdgcn_mfma_f32_16x16x32_bf16(a[rb][ks], qL[cb][ks], t, 0, 0, 0);
            dl[rb][cb] = t; }
#pragma unroll
    for (int h = 0; h < 8; ++h) { f32x4_t d[2][2];
#pragma unroll
        for (int rb = 0; rb < 2; ++rb)
#pragma unroll
            for (int cb = 0; cb < 2; ++cb) { f32x4_t t = {0.f, 0.f, 0.f, 0.f};
#pragma unroll
                for (int ks = 0; ks < 2; ++ks) t = __builtin_amdgcn_mfma_f32_16x16x32_bf16(a[rb][ks], qreg[h][cb][ks], t, 0, 0, 0);
                d[rb][cb] = t; }
        asm volatile("" ::: "memory");
        if (PF && h == 7) load_a16(a, kib, jn, l15, kq);
        const float w0 = wv0[h], w1 = wv1[h];
#pragma unroll
        for (int rb = 0; rb < 2; ++rb)
#pragma unroll
            for (int cb = 0; cb < 2; ++cb)
#pragma unroll
                for (int r = 0; r < 4; ++r) { const int i = (2 * rb + cb) * 4 + r; sc[i] = fmaf(cb ? w1 : w0, __builtin_fabsf(d[rb][cb][r]), h == 0 ? dl[rb][cb][r] : sc[i]); } }
}
__device__ __forceinline__ unsigned fkey(float f) { const unsigned u = __builtin_bit_cast(unsigned, f); return (u & 0x80000000u) ? ~u : (u | 0x80000000u); }

__device__ __forceinline__ void mask_or_bit(u64* mwq, int qc, int s) {
    const int kk = s & 31, hk = (kk >> 2) & 1, r = (kk & 3) + 4 * (kk >> 3);
    __hip_atomic_fetch_or(mwq + (size_t)(s >> 5) * 16 + r, 1ull << (qc + 32 * hk), __ATOMIC_RELAXED, __HIP_MEMORY_SCOPE_AGENT);
}

__device__ __forceinline__ void fallback_query(char* lds, int tid, int tg  , int qc, int n, const bf16* QI, const char* kib, const float* WI, u64* mwq) {
    asm volatile("" : "+v"(tid));
    float* sc = (float*)(lds + OFF_HIST); unsigned* hist = (unsigned*)(lds + OFF_FBH); unsigned* misc = hist + 256; float* qf = (float*)(lds + OFF_QF);
    __syncthreads();
    if (tid < 256) { const unsigned w = ((const unsigned*)(QI + (size_t)tg * 512))[tid]; qf[2 * tid] = __builtin_bit_cast(float, w << 16); qf[2 * tid + 1] = __builtin_bit_cast(float, w & 0xffff0000u); }
    __syncthreads();
    for (int s = tid; s < n; s += 1024) {
        const int s2 = s + 512 < n ? s + 512 : s;
        const uint4* kp0 = (const uint4*)(kib + (size_t)s * 128); const uint4* kp1 = (const uint4*)(kib + (size_t)s2 * 128);
        float kf0[64], kf1[64];
#pragma unroll
        for (int c = 0; c < 8; ++c) { const uint4 w = kp0[c], x = kp1[c];
            kf0[8 * c] = __builtin_bit_cast(float, w.x << 16); kf0[8 * c + 1] = __builtin_bit_cast(float, w.x & 0xffff0000u); kf0[8 * c + 2] = __builtin_bit_cast(float, w.y << 16); kf0[8 * c + 3] = __builtin_bit_cast(float, w.y & 0xffff0000u);
            kf0[8 * c + 4] = __builtin_bit_cast(float, w.z << 16); kf0[8 * c + 5] = __builtin_bit_cast(float, w.z & 0xffff0000u); kf0[8 * c + 6] = __builtin_bit_cast(float, w.w << 16); kf0[8 * c + 7] = __builtin_bit_cast(float, w.w & 0xffff0000u);
            kf1[8 * c] = __builtin_bit_cast(float, x.x << 16); kf1[8 * c + 1] = __builtin_bit_cast(float, x.x & 0xffff0000u); kf1[8 * c + 2] = __builtin_bit_cast(float, x.y << 16); kf1[8 * c + 3] = __builtin_bit_cast(float, x.y & 0xffff0000u);
            kf1[8 * c + 4] = __builtin_bit_cast(float, x.z << 16); kf1[8 * c + 5] = __builtin_bit_cast(float, x.z & 0xffff0000u); kf1[8 * c + 6] = __builtin_bit_cast(float, x.w << 16); kf1[8 * c + 7] = __builtin_bit_cast(float, x.w & 0xffff0000u); }
        float sc0 = 0.f, sc1 = 0.f;
#pragma unroll 1
        for (int h = 0; h < 8; ++h) { float d0 = 0.f, d1 = 0.f;
#pragma unroll
            for (int j = 0; j < 64; ++j) { const float qv = qf[h * 64 + j]; d0 = fmaf(qv, kf0[j], d0); d1 = fmaf(qv, kf1[j], d1); }
            const float w = WI[(size_t)tg * 8 + h]; sc0 = fmaf(w, fmaxf(d0, 0.f), sc0); sc1 = fmaf(w, fmaxf(d1, 0.f), sc1); }
        sc[s] = sc0; sc[s2] = sc1;
    }
    __syncthreads();
    unsigned prefix = 0u, need = TOPK, eq_total = 0u;
    for (int pass = 0; pass < 4; ++pass) {
        const int shift = 24 - 8 * pass; const unsigned mask = pass == 0 ? 0u : (0xFFFFFFFFu << (shift + 8));
        if (tid < 256) hist[tid] = 0u;
        __syncthreads();
        for (int s = tid; s < n; s += 512) { const unsigned k = fkey(sc[s]); if ((k & mask) == (prefix & mask)) atomicAdd(&hist[(k >> shift) & 255u], 1u); }
        __syncthreads();
        if (tid == 0) { unsigned c = 0u; int bin = 255; for (; bin > 0; --bin) { if (c + hist[bin] >= need) break; c += hist[bin]; }
            misc[0] = (unsigned)bin; misc[1] = need - c; misc[2] = hist[bin]; }
        __syncthreads();
        prefix |= misc[0] << shift; need = misc[1]; eq_total = misc[2];
        __syncthreads();
    }
    const int nw = (n >> 5) * 16; const u64 clr = ~((1ull << qc) | (1ull << (qc + 32)));
    for (int i = tid; i < nw; i += 512) __hip_atomic_fetch_and(mwq + i, clr, __ATOMIC_RELAXED, __HIP_MEMORY_SCOPE_AGENT);
    asm volatile("s_waitcnt vmcnt(0)" ::: "memory");
    __syncthreads();
    const bool take_all_eq = (eq_total == need);
    for (int s = tid; s < n; s += 512) { const unsigned k = fkey(sc[s]); if (k > prefix || (take_all_eq && k == prefix)) mask_or_bit(mwq, qc, s); }
    if (!take_all_eq) {
        const int per = (n + 511) >> 9, s0 = tid * per, s1 = (s0 + per < n) ? s0 + per : n; unsigned* ce = (unsigned*)qf;
        unsigned mine = 0u; for (int s = s0; s < s1; ++s) mine += fkey(sc[s]) == prefix;
        __syncthreads(); ce[tid] = mine; __syncthreads();
        unsigned before = 0u; for (int t2 = 0; t2 < tid; ++t2) before += ce[t2];
        for (int s = s0; s < s1 && before < need; ++s) if (fkey(sc[s]) == prefix) { mask_or_bit(mwq, qc, s); ++before; }
    }
    __syncthreads();
}

__device__ __forceinline__ void indexer_unit(char* lds, int b, int c, const bf16* QI, const bf16* KI, const float* WI, u64* MASKW, char* codes  ) {
    int tid_ = threadIdx.x; asm volatile("" : "+v"(tid_));
    const int tid = tid_, wid = __builtin_amdgcn_readfirstlane(tid >> 6), lane = tid & 63, r32 = lane & 31, hi = lane >> 5, qg = wid & 1, ks = wid >> 1;
    const int n = 64 * (c + 1), ntile = n >> 5, jend = 2 * ((c | 3) + 1);
    const int row0 = b * S + 64 * c;
    u64* mw = MASKW + ((size_t)(b * (S / 32) + 2 * c + qg) * (S / 32)) * 16;
    const char* kib = (const char*)(KI + (size_t)b * S * 64);
    if (n <= TOPK) {
        for (int j = ks; j < jend; j += 4) if (lane < 16) __hip_atomic_store(mw + (size_t)j * 16 + lane, j < ntile ? ~0ull : 0ull, __ATOMIC_RELAXED, __HIP_MEMORY_SCOPE_AGENT);
        return;
    }
    unsigned* hist = (unsigned*)(lds + OFF_HIST);
    float2* stat = (float2*)(lds + OFF_STAT); float2* qpar = (float2*)(lds + OFF_QPAR);
    int* bstar = (int*)(lds + OFF_BSTAR); int* needv = (int*)(lds + OFF_NEED); unsigned* bcnt = (unsigned*)(lds + OFF_BCNT); unsigned* fb = (unsigned*)(lds + OFF_FB);
    unsigned* fl = (unsigned*)(lds + OFF_FLAT);
    const int ql = qg * 32 + r32;
    {
    int ln_ = lane; asm volatile("" : "+v"(ln_));
    const int l15 = ln_ & 15, kq = ln_ >> 4; const int q0 = qg * 32 + l15, q1 = q0 + 16;
    bf16x8 qreg[8][2][2]; const float* wv0 = (const float*)(lds + OFF_WV) + q0 * 8; const float* wv1 = wv0 + 16 * 8;
    { const char* qp = (const char*)QI + (size_t)(unsigned)(row0 + q0) * 1024 + kq * 16;
#pragma unroll
        for (int h = 0; h < 8; ++h)
#pragma unroll
            for (int cb = 0; cb < 2; ++cb)
#pragma unroll
                for (int ks = 0; ks < 2; ++ks) qreg[h][cb][ks] = *reinterpret_cast<const bf16x8*>(qp + cb * 16 * 1024 + h * 128 + ks * 64);
        { unsigned to_ = (unsigned)tid; asm volatile("" : "+v"(to_)); if (to_ < 128u) { float4 w4 = *(const float4*)((const char*)(WI + (size_t)row0 * 8) + (size_t)(to_ * 16u)); w4.x *= 0.5f; w4.y *= 0.5f; w4.z *= 0.5f; w4.w *= 0.5f; *(float4*)(lds + OFF_WV + to_ * 16u) = w4; } } }
    char* qlp = lds + OFF_QL + tid * 16;
#pragma unroll
    for (int cb = 0; cb < 2; ++cb) { const float* wp = WI + (size_t)(row0 + q0 + 16 * cb) * 8; const float4 w0 = *(const float4*)wp, w1 = *(const float4*)(wp + 4);
        const float wh[8] = {0.5f * w0.x, 0.5f * w0.y, 0.5f * w0.z, 0.5f * w0.w, 0.5f * w1.x, 0.5f * w1.y, 0.5f * w1.z, 0.5f * w1.w};
#pragma unroll
        for (int ks = 0; ks < 2; ++ks) { float acc8[8] = {0.f, 0.f, 0.f, 0.f, 0.f, 0.f, 0.f, 0.f};
#pragma unroll
            for (int h = 0; h < 8; ++h) { const bf16x8 q = qreg[h][cb][ks];
#pragma unroll
                for (int e = 0; e < 8; ++e) acc8[e] = fmaf(wh[h], __builtin_bit_cast(float, (unsigned)(unsigned short)q[e] << 16), acc8[e]); }
            bf16x8 o;
#pragma unroll
            for (int e = 0; e < 8; ++e) { const unsigned u = __builtin_bit_cast(unsigned, acc8[e]); o[e] = (short)((u + 0x7fffu + ((u >> 16) & 1u)) >> 16); }
            *reinterpret_cast<bf16x8*>(qlp + (cb * 2 + ks) * 8192) = o; } }
    float sc[16];
    { unsigned z0; asm volatile("v_mov_b32 %0, 0" : "=v"(z0)); const uint4 z4 = make_uint4(z0, z0, z0, z0);
        unsigned zoff = (unsigned)tid * 16u; asm volatile("" : "+v"(zoff));
#pragma unroll 1
        for (int i = 0; i < 8; ++i) { *(uint4*)((char*)hist + zoff) = z4; zoff += 8192u; }
        if (tid < 16) *(uint4*)((char*)hist + zoff) = z4; }
    __syncthreads();
    { float s1a = 0.f, s2a = 0.f, s1b = 0.f, s2b = 0.f;
#pragma unroll 1
        for (int u = 0; u < 2; ++u) { const int j = ((ks + 4 * u) * ntile) >> 3; bf16x8 a[2][2]; load_a16(a, kib, j, l15, kq); tile_scores16<false>(a, qreg, qlp, wv0, wv1, sc, kib, 0, l15, kq);
#pragma unroll
            for (int i = 0; i < 16; ++i) { if ((i >> 2) & 1) { s1b += sc[i]; s2b = fmaf(sc[i], sc[i], s2b); } else { s1a += sc[i]; s2a = fmaf(sc[i], sc[i], s2a); } } }
        s1a += __shfl_xor(s1a, 16); s2a += __shfl_xor(s2a, 16); s1b += __shfl_xor(s1b, 16); s2b += __shfl_xor(s2b, 16);
        s1a += __shfl_xor(s1a, 32); s2a += __shfl_xor(s2a, 32); s1b += __shfl_xor(s1b, 32); s2b += __shfl_xor(s2b, 32);
        { int qo_ = q0; asm volatile("" : "+v"(qo_)); if (kq == 0) { stat[ks * 64 + qo_] = make_float2(s1a, s2a); stat[ks * 64 + qo_ + 16] = make_float2(s1b, s2b); } } }
    __syncthreads();
    { int tq_ = tid; asm volatile("" : "+v"(tq_));
    if (tq_ < 64) { float s1 = 0.f, s2 = 0.f;
#pragma unroll
        for (int k = 0; k < 4; ++k) { const float2 v = stat[k * 64 + tq_]; s1 += v.x; s2 += v.y; }
        const float mu = s1 * (1.f / 256.f); float var = s2 * (1.f / 256.f) - mu * mu; var = var > 0.f ? var : 0.f;
        const float sg = fmaxf(sqrtf(var), 1e-30f); const float zp = z_upper(256.f / (float)n);
        const float lo = mu + (zp - 2.0f) * sg, a = (float)(NBINS - 2) / (4.0f * sg); float bb = 1.f - lo * a;
        float aa = a; if (!(aa < 3.0e38f) || !(fabsf(bb) < 3.0e38f)) { aa = 0.f; bb = 1.f; }
        qpar[tq_] = make_float2(aa, bb); bcnt[tq_] = 0u; if (tq_ == 0) { fb[0] = 0u; fb[100] = 0u; } } }
    __syncthreads();
    { unsigned* hq0 = hist + q0 * HSTR; unsigned* hq1 = hq0 + 16 * HSTR; bf16x8 aC[2][2]; load_a16(aC, kib, ks, l15, kq);
        unsigned cso = (unsigned)(qg * 1024 + (l15 + 32 * (kq & 1)) * 16 + (kq >> 1) * 4); asm volatile("" : "+v"(cso));
#pragma unroll 1
        for (int j = ks; j < ntile; j += 4) {
            tile_scores16<true>(aC, qreg, qlp, wv0, wv1, sc, kib, j + 4 < ntile ? j + 4 : j, l15, kq);
            const float2 ab0 = qpar[q0], ab1 = qpar[q1];
            char* cp = codes + (size_t)(unsigned)(j * 2048) + cso;
#pragma unroll
            for (int rb = 0; rb < 2; ++rb)
#pragma unroll
                for (int cb = 0; cb < 2; ++cb) { unsigned w = 0u;
#pragma unroll
                    for (int r = 3; r >= 0; --r) { const float v = sc[(2 * rb + cb) * 4 + r];
                        const unsigned bin = (unsigned)__builtin_amdgcn_fmed3f(cb ? fmaf(v, ab1.x, ab1.y) : fmaf(v, ab0.x, ab0.y), 0.f, (float)(NBINS - 1));
                        __hip_atomic_fetch_add((cb ? hq1 : hq0) + bin, 1u, __ATOMIC_RELAXED, __HIP_MEMORY_SCOPE_WORKGROUP); w = (w << 8) | bin; }
                    *(unsigned*)(cp + cb * 256 + rb * 8) = w; } } }
    }
    __syncthreads();
#pragma unroll 1
    for (int qq = 0; qq < 8; ++qq) { const int q = wid * 8 + qq; int lo_ = lane; asm volatile("" : "+v"(lo_)); const unsigned* hp = hist + q * HSTR + 4 * lo_; const unsigned hb[4] = {hp[0], hp[1], hp[2], hp[3]};
        const unsigned ls = (hb[0] + hb[1]) + (hb[2] + hb[3]);
        unsigned T = ls;
#pragma unroll
        for (int o = 1; o < 64; o <<= 1) { const unsigned v = __shfl_down(T, o); if (lane + o < 64) T += v; }
        const u64 bal = __ballot(T >= (unsigned)TOPK); const int lstar = 63 - __builtin_clzll(bal);
        if (lane == lstar) { unsigned acc = T - ls; int bsel = 0;
#pragma unroll
            for (int i = 3; i >= 0; --i) { if (acc + hb[i] >= (unsigned)TOPK) { bsel = i; break; } acc += hb[i]; }
            bstar[q] = 4 * lane + bsel; needv[q] = (int)(TOPK - acc); } }
    __syncthreads();
    { unsigned cso = (unsigned)(qg * 1024 + lane * 16); asm volatile("" : "+v"(cso));
        const unsigned bs = (unsigned)bstar[ql]; const unsigned bsx = bs * 0x01010101u; const unsigned qtag = (unsigned)ql << 14;
#define IDX_LDC(jj) (*(const uint4*)(codes + (size_t)(unsigned)(((jj) < ntile ? (jj) : ks) * 2048) + cso))
#define IDX_SEL(D, K) asm volatile("v_cmp_gt_u32_sdwa vcc, %2, %3 src0_sel:BYTE_" #K " src1_sel:DWORD\n\ts_nop 3\n\tv_writelane_b32 %0, vcc_lo, %4\n\tv_writelane_b32 %1, vcc_hi, %4" \
                : "+v"(mlo), "+v"(mhi) : "v"(cwd[D]), "v"(bs), "n"(4 * (D) + (K)) : "vcc")
#define IDX_PROC(CUR, jj) do { const int j_ = (jj); const unsigned cwd[4] = {CUR.x, CUR.y, CUR.z, CUR.w}; unsigned mlo = 0u, mhi = 0u;                                  \
            IDX_SEL(0, 0); IDX_SEL(0, 1); IDX_SEL(0, 2); IDX_SEL(0, 3); IDX_SEL(1, 0); IDX_SEL(1, 1); IDX_SEL(1, 2); IDX_SEL(1, 3);                                       \
            IDX_SEL(2, 0); IDX_SEL(2, 1); IDX_SEL(2, 2); IDX_SEL(2, 3); IDX_SEL(3, 0); IDX_SEL(3, 1); IDX_SEL(3, 2); IDX_SEL(3, 3);                                       \
            if (lane < 16) mw[(size_t)j_ * 16 + lane] = ((u64)mhi << 32) | mlo;                  \
                                     \
            _Pragma("unroll") for (int d = 0; d < 4; ++d) { const unsigned x = cwd[d] ^ bsx; const unsigned hz = (x - 0x01010101u) & ~x & 0x80808080u;                   \
                if (__ballot(hz != 0u)) {                                                                                                                                \
                    _Pragma("unroll") for (int k = 0; k < 4; ++k) { const bool eq = ((cwd[d] >> (8 * k)) & 255u) == bs;                                                  \
                        if (eq) { const unsigned pos = __hip_atomic_fetch_add(&fb[100], 1u, __ATOMIC_RELAXED, __HIP_MEMORY_SCOPE_WORKGROUP);                             \
                            if (pos < (unsigned)FCAP) fl[pos] = qtag | (unsigned)(j_ * 32 + crow(4 * d + k, hi)); } } } } } while (0)
        uint4 cA = IDX_LDC(ks), cB = IDX_LDC(ks + 4), cC = IDX_LDC(ks + 8), cD = IDX_LDC(ks + 12);
#pragma unroll 1
        for (int j = ks; j < ntile; j += 16) {
            IDX_PROC(cA, j); cA = IDX_LDC(j + 16);
            if (j + 4 < ntile) { IDX_PROC(cB, j + 4); cB = IDX_LDC(j + 20); }
            if (j + 8 < ntile) { IDX_PROC(cC, j + 8); cC = IDX_LDC(j + 24); }
            if (j + 12 < ntile) { IDX_PROC(cD, j + 12); cD = IDX_LDC(j + 28); }
        }
#undef IDX_PROC
#undef IDX_SEL
#undef IDX_LDC
        for (int j = ntile + ks; j < jend; j += 4) if (lane < 16) mw[(size_t)j * 16 + lane] = 0ull; }
    __syncthreads();
    { const unsigned nfl = fb[100] < (unsigned)FCAP ? fb[100] : (unsigned)FCAP; const float* wv = (const float*)(lds + OFF_WV); unsigned* blq = (unsigned*)(lds + OFF_HIST);
        unsigned ti_ = (unsigned)tid; asm volatile("" : "+v"(ti_));
#pragma unroll 1
        for (unsigned i = ti_; i < nfl; i += 512u) { const unsigned e = fl[i]; const int q = (int)(e >> 14), key = (int)(e & 16383u);
            const uint4* kp = (const uint4*)(kib + (size_t)key * 128); float kf[64];
#pragma unroll
            for (int cc = 0; cc < 8; ++cc) { const uint4 w = kp[cc];
                kf[8 * cc] = __builtin_bit_cast(float, w.x << 16); kf[8 * cc + 1] = __builtin_bit_cast(float, w.x & 0xffff0000u); kf[8 * cc + 2] = __builtin_bit_cast(float, w.y << 16); kf[8 * cc + 3] = __builtin_bit_cast(float, w.y & 0xffff0000u);
                kf[8 * cc + 4] = __builtin_bit_cast(float, w.z << 16); kf[8 * cc + 5] = __builtin_bit_cast(float, w.z & 0xffff0000u); kf[8 * cc + 6] = __builtin_bit_cast(float, w.w << 16); kf[8 * cc + 7] = __builtin_bit_cast(float, w.w & 0xffff0000u); }
            const char* qp = (const char*)QI + (size_t)(unsigned)(row0 + q) * 1024; float s = 0.f;
#pragma unroll 4
            for (int h = 0; h < 8; ++h) { float d = 0.f; const uint4* qh = (const uint4*)(qp + h * 128);
#pragma unroll
                for (int cc = 0; cc < 8; ++cc) { const uint4 w = qh[cc];
                    d = fmaf(__builtin_bit_cast(float, w.x << 16), kf[8 * cc], d); d = fmaf(__builtin_bit_cast(float, w.x & 0xffff0000u), kf[8 * cc + 1], d);
                    d = fmaf(__builtin_bit_cast(float, w.y << 16), kf[8 * cc + 2], d); d = fmaf(__builtin_bit_cast(float, w.y & 0xffff0000u), kf[8 * cc + 3], d);
                    d = fmaf(__builtin_bit_cast(float, w.z << 16), kf[8 * cc + 4], d); d = fmaf(__builtin_bit_cast(float, w.z & 0xffff0000u), kf[8 * cc + 5], d);
                    d = fmaf(__builtin_bit_cast(float, w.w << 16), kf[8 * cc + 6], d); d = fmaf(__builtin_bit_cast(float, w.w & 0xffff0000u), kf[8 * cc + 7], d); }
                s = fmaf(2.f * wv[q * 8 + h], fmaxf(d, 0.f), s); }
            const float2 ab = qpar[q]; const float u = fmaf(s, ab.x, ab.y);
            const unsigned fine = (unsigned)__builtin_amdgcn_fmed3f((u - (float)bstar[q]) * 262144.f, 0.f, 262143.f);
            const unsigned pos = __hip_atomic_fetch_add(&bcnt[q], 1u, __ATOMIC_RELAXED, __HIP_MEMORY_SCOPE_WORKGROUP);
            const unsigned word = (fine << 14) | (16383u - (unsigned)key); fl[FCAP + i] = word;
            if (pos < (unsigned)CAP) blq[q * CAP + pos] = word; } }
    asm volatile("s_waitcnt vmcnt(0)" ::: "memory");
    __syncthreads();
    { const bool flat_over = fb[100] > (unsigned)FCAP; const unsigned nfl = flat_over ? (unsigned)FCAP : fb[100]; const unsigned* blq = (const unsigned*)(lds + OFF_HIST);
        unsigned ti_ = (unsigned)tid; asm volatile("" : "+v"(ti_));
        if (ti_ < 64u) { const int q = (int)ti_; if (flat_over || bcnt[q] > (unsigned)CAP || bstar[q] <= 0 || bstar[q] >= NBINS - 1 || (DBG_FORCE_FB && (q & 15) == 3)) {
            const unsigned p = __hip_atomic_fetch_add(&fb[0], 1u, __ATOMIC_RELAXED, __HIP_MEMORY_SCOPE_WORKGROUP); fb[1 + p] = (unsigned)q; } }
        if (!flat_over) {
#pragma unroll 1
        for (unsigned i = ti_; i < nfl; i += 512u) { const unsigned ef = fl[i]; const int q = (int)(ef >> 14); const unsigned cnt = bcnt[q];
            if (cnt > (unsigned)CAP || bstar[q] <= 0 || bstar[q] >= NBINS - 1 || (DBG_FORCE_FB && (q & 15) == 3)) continue;
            const unsigned mine = fl[FCAP + i];
            const unsigned* bl = blq + q * CAP; int rk = 0;
            for (unsigned m = 0; m < cnt; ++m) rk += bl[m] > mine;
            if (rk < needv[q]) mask_or_bit(MASKW + ((size_t)(b * (S / 32) + 2 * c + (q >> 5)) * (S / 32)) * 16, q & 31, (int)(16383u - (mine & 16383u))); } } }
    __syncthreads();
    { const int nfb = (int)fb[0];
        for (int f = 0; f < nfb; ++f) { const int q = (int)fb[1 + f];
            fallback_query(lds, tid, row0 + q, q & 31, n, QI, kib, WI, MASKW + ((size_t)(b * (S / 32) + 2 * c + (q >> 5)) * (S / 32)) * 16); } }
    __syncthreads();
}
__device__ __forceinline__ void indexer_phase(char* lds, int vcu, int G, const bf16* QI, const bf16* KI, const float* WI, u64* MASKW, char* area_out, char* area_tail, char* area_gap, char* area_wai) {
    for (int item = vcu; item < 256; item += G) { const int b = (item >> 7) & 1, x = item & 127;
        const unsigned cum = (unsigned)(256 * x - x * (x - 1) / 2);
        char* codes = b == 0 ? area_out + (size_t)cum * 4096 : x < 33 ? area_out + (size_t)(24640u + cum) * 4096 : x < 73 ? area_tail + (size_t)(cum - 7920u) * 4096 : x < 115 ? area_gap + (size_t)(cum - 16060u) * 4096 : area_wai + (size_t)(cum - 22885u) * 4096;
#pragma unroll 1
        for (int pass = 0; pass < 2; ++pass) indexer_unit(lds, b, pass ? 255 - x : x, QI, KI, WI, MASKW, codes); }
}
}
namespace att {
typedef unsigned short bf16;
typedef short bf16x8 __attribute__((ext_vector_type(8)));
typedef short s16x4 __attribute__((ext_vector_type(4)));
typedef float f32x16 __attribute__((ext_vector_type(16)));
typedef float f32x4 __attribute__((ext_vector_type(4)));
typedef unsigned u32x4 __attribute__((ext_vector_type(4)));
typedef unsigned long long u64;
typedef const __attribute__((address_space(4))) u64* cu64p;
typedef float f32x2_t __attribute__((ext_vector_type(2))); typedef __bf16 bf16x2_t __attribute__((ext_vector_type(2)));
__device__ __forceinline__ unsigned cvtpk_s(float lo, float hi) { f32x2_t v = {lo, hi}; bf16x2_t b = __builtin_convertvector(v, bf16x2_t); return __builtin_bit_cast(unsigned, b); }
constexpr int D = 128, PITCH = 1024, NW = 8, QBLK = 32, KVBLK = 64, QB = NW * QBLK;
constexpr int SHM_V = KVBLK * D * 2, SHM_K = KVBLK * D * 2;
constexpr int NBUF = 4;
constexpr int OFF_WS = NBUF * SHM_V + NBUF * SHM_K;
constexpr int OFF_TAB = OFF_WS + NW * 64 * 4;
constexpr int OFF_EP = 0;
constexpr int EP_PITCH = 272, EP_WAVE = 32 * EP_PITCH;
constexpr int ATTN_LDS_BYTES = OFF_TAB + 448 * 4;
static_assert(NW * EP_WAVE <= OFF_WS, "epilogue staging fits the ring");
constexpr float THR2 = 11.5f;
constexpr int MW_PER_QB = (S / 32) * 16;

#define KSWZ(row, colB) ((row) * 256 + ((colB) ^ (((row) & 7) << 4)))
#define SBAR() __builtin_amdgcn_sched_barrier(0)
__device__ __forceinline__ int v_st(int k, int c) { const int kk = (k & ~0xC) | ((k & 4) << 1) | ((k & 8) >> 1); return ((kk >> 3) * 4 + (c >> 5)) * 512 + ((kk & 7) * 32 + (c & 31)) * 2; }
__device__ __forceinline__ int v_st_nat(int k, int c) { return ((k >> 3) * 4 + (c >> 5)) * 512 + ((k & 7) * 32 + (c & 31)) * 2; }
__device__ __forceinline__ int v_rd_base(int lane) { return ((lane & 3) << 3) | (((lane >> 2) & 3) << 6) | (((lane >> 4) & 1) << 5) | (((lane >> 5) & 1) << 8); }
constexpr int v_rd_off(int d0, int ks, int half) { return d0 * 512 + ks * 4096 + half * 2048; }
__device__ __forceinline__ int crow(int r, int hi) { return (r & 3) + 8 * (r >> 2) + 4 * hi; }
__device__ __forceinline__ unsigned cvtpk(float lo, float hi) { unsigned r; asm volatile("v_cvt_pk_bf16_f32 %0, %1, %2" : "=v"(r) : "v"(lo), "v"(hi)); return r; }

template <bool NEAR>
__device__ __forceinline__ void init_tile(f32x16& p0, f32x16& p1, cu64p w, float cb  , const float* tabp, float mcur) {
    const float NEG = -__builtin_inff();
    u64 m0[16], m1[16];
#pragma unroll
    for (int r = 0; r < 16; ++r) { m0[r] = w[r]; m1[r] = w[16 + r]; }
#pragma unroll
    for (int r = 0; r < 16; ++r) { float bv = cb; if (NEAR) bv = tabp[59 - ((r & 3) + 8 * (r >> 2))] - mcur;
        float o; asm volatile("v_cndmask_b32_e64 %0, %1, %2, %3" : "=v"(o) : "v"(NEG), "v"(bv), "s"(m0[r])); p0[r] = o; }
#pragma unroll
    for (int r = 0; r < 16; ++r) { float bv = cb; if (NEAR) bv = tabp[27 - ((r & 3) + 8 * (r >> 2))] - mcur;
        float o; asm volatile("v_cndmask_b32_e64 %0, %1, %2, %3" : "=v"(o) : "v"(NEG), "v"(bv), "s"(m1[r])); p1[r] = o; }
}
__device__ __forceinline__ void partialSM(f32x16& p0, f32x16& p1, float& m_reg, float& alpha, float l_cur, float pmax_in) {
    float pmax = pmax_in;
    { auto rr = __builtin_amdgcn_permlane32_swap(__float_as_uint(pmax), __float_as_uint(pmax), false, false);
      pmax = fmaxf(__uint_as_float(rr[0]), __uint_as_float(rr[1])); }
    const bool low = pmax < -64.f && pmax > -__builtin_inff();
    alpha = 1.f;
    if (__builtin_expect(__any(pmax > THR2 || low), 0)) {
        float delta = 0.f;
        if (pmax > THR2) { delta = pmax; alpha = __builtin_amdgcn_exp2f(-delta); }
        else if (low && l_cur == 0.f) delta = pmax;
        m_reg += delta;
#pragma unroll
        for (int r = 0; r < 16; ++r) p0[r] = p0[r] - delta;
#pragma unroll
        for (int r = 0; r < 16; ++r) p1[r] = p1[r] - delta; }
#pragma unroll
    for (int r = 0; r < 16; ++r) p0[r] = __builtin_amdgcn_exp2f(p0[r]);
}
__device__ __forceinline__ void finishSM(f32x16& p0, f32x16& p1, float alpha, float& l_reg, bf16x8& pa0, bf16x8& pa1, bf16x8& pa2, bf16x8& pa3) {
#pragma unroll
    for (int r = 0; r < 16; ++r) p1[r] = __builtin_amdgcn_exp2f(p1[r]);
    float ps = 0;
#pragma unroll
    for (int r = 0; r < 16; ++r) ps += p0[r];
#pragma unroll
    for (int r = 0; r < 16; ++r) ps += p1[r];
    { auto rr = __builtin_amdgcn_permlane32_swap(__float_as_uint(ps), __float_as_uint(ps), false, false);
      ps = __uint_as_float(rr[0]) + __uint_as_float(rr[1]); }
    l_reg = l_reg * alpha + ps;
#define PK4(P, B_, OUT) do { u32x4 w = {cvtpk(P[B_+0], P[B_+1]), cvtpk(P[B_+2], P[B_+3]), cvtpk(P[B_+4], P[B_+5]), cvtpk(P[B_+6], P[B_+7])};   \
        OUT = *reinterpret_cast<bf16x8*>(&w); } while (0)
    PK4(p0, 0, pa0); PK4(p0, 8, pa1); PK4(p1, 0, pa2); PK4(p1, 8, pa3);
#undef PK4
}
template <int KB>
__device__ __forceinline__ void qkt(f32x16& p0, f32x16& p1, const char* K_lds, int r32, int hi, const bf16x8* qr) {
    const char* kb[4];
#pragma unroll
    for (int dd = 0; dd < 4; ++dd) kb[dd] = K_lds + KB * SHM_K + KSWZ(r32, (dd * 16 + hi * 8) * 2);
    bf16x8 c0 = *reinterpret_cast<const bf16x8*>(kb[0]), c1 = *reinterpret_cast<const bf16x8*>(kb[0] + 32 * 256);
#pragma unroll
    for (int d0 = 0; d0 < 8; ++d0) { bf16x8 n0 = c0, n1 = c1;
        if (d0 < 7) { const char* a = kb[(d0 + 1) & 3] + ((d0 + 1) >> 2) * 128; n0 = *reinterpret_cast<const bf16x8*>(a); n1 = *reinterpret_cast<const bf16x8*>(a + 32 * 256); }
        p0 = __builtin_amdgcn_mfma_f32_32x32x16_bf16(c0, qr[d0], p0, 0, 0, 0);
        p1 = __builtin_amdgcn_mfma_f32_32x32x16_bf16(c1, qr[d0], p1, 0, 0, 0);
        c0 = n0; c1 = n1; }
}
template <int VB>
__device__ __forceinline__ void pv_tile(f32x16* o, int vb0, bf16x8 pa0, bf16x8 pa1, bf16x8 pa2, bf16x8 pa3) {
#define TRRD(dst, off) asm volatile("ds_read_b64_tr_b16 %0, %1 offset:%2" : "=&v"(dst) : "v"(vb0), "i"(off) : "memory")
#define PV_D0(d0) do { s16x4 l0, l1, l2, l3, h0, h1, h2, h3; constexpr int b_ = VB * SHM_V + v_rd_off(d0, 0, 0); \
        TRRD(l0, b_); TRRD(h0, b_ + 2048); TRRD(l1, b_ + 4096); TRRD(h1, b_ + 6144); TRRD(l2, b_ + 8192); TRRD(h2, b_ + 10240); TRRD(l3, b_ + 12288); TRRD(h3, b_ + 14336); \
        asm volatile("s_waitcnt lgkmcnt(0)" ::: "memory"); SBAR();   \
        o[d0] = __builtin_amdgcn_mfma_f32_32x32x16_bf16(pa0, (bf16x8){l0[0], l0[1], l0[2], l0[3], h0[0], h0[1], h0[2], h0[3]}, o[d0], 0, 0, 0);   \
        o[d0] = __builtin_amdgcn_mfma_f32_32x32x16_bf16(pa1, (bf16x8){l1[0], l1[1], l1[2], l1[3], h1[0], h1[1], h1[2], h1[3]}, o[d0], 0, 0, 0);   \
        o[d0] = __builtin_amdgcn_mfma_f32_32x32x16_bf16(pa2, (bf16x8){l2[0], l2[1], l2[2], l2[3], h2[0], h2[1], h2[2], h2[3]}, o[d0], 0, 0, 0);   \
        o[d0] = __builtin_amdgcn_mfma_f32_32x32x16_bf16(pa3, (bf16x8){l3[0], l3[1], l3[2], l3[3], h3[0], h3[1], h3[2], h3[3]}, o[d0], 0, 0, 0); } while (0)
    PV_D0(0); PV_D0(1); PV_D0(2); PV_D0(3);
#undef PV_D0
#undef TRRD
}

template <int VB>
__device__ __forceinline__ float pv_tile_max(f32x16* o, int vb0, bf16x8 pa0, bf16x8 pa1, bf16x8 pa2, bf16x8 pa3, const f32x16& p0, const f32x16& p1) {
#define TRRD(dst, off) asm volatile("ds_read_b64_tr_b16 %0, %1 offset:%2" : "=&v"(dst) : "v"(vb0), "i"(off) : "memory")
#define MX3(a, b, c) fmaxf(fmaxf(a, b), c)
#define PV_D0(d0, HOOK) do { s16x4 l0, l1, l2, l3, h0, h1, h2, h3; constexpr int b_ = VB * SHM_V + v_rd_off(d0, 0, 0); \
        TRRD(l0, b_); TRRD(h0, b_ + 2048); TRRD(l1, b_ + 4096); TRRD(h1, b_ + 6144); TRRD(l2, b_ + 8192); TRRD(h2, b_ + 10240); TRRD(l3, b_ + 12288); TRRD(h3, b_ + 14336); \
        HOOK; asm volatile("s_waitcnt lgkmcnt(0)" ::: "memory"); SBAR();   \
        o[d0] = __builtin_amdgcn_mfma_f32_32x32x16_bf16(pa0, (bf16x8){l0[0], l0[1], l0[2], l0[3], h0[0], h0[1], h0[2], h0[3]}, o[d0], 0, 0, 0);   \
        o[d0] = __builtin_amdgcn_mfma_f32_32x32x16_bf16(pa1, (bf16x8){l1[0], l1[1], l1[2], l1[3], h1[0], h1[1], h1[2], h1[3]}, o[d0], 0, 0, 0);   \
        o[d0] = __builtin_amdgcn_mfma_f32_32x32x16_bf16(pa2, (bf16x8){l2[0], l2[1], l2[2], l2[3], h2[0], h2[1], h2[2], h2[3]}, o[d0], 0, 0, 0);   \
        o[d0] = __builtin_amdgcn_mfma_f32_32x32x16_bf16(pa3, (bf16x8){l3[0], l3[1], l3[2], l3[3], h3[0], h3[1], h3[2], h3[3]}, o[d0], 0, 0, 0); } while (0)
    float m;
    PV_D0(0, m = MX3(p0[0], p0[1], p0[2]); m = MX3(m, p0[3], p0[4]); m = MX3(m, p0[5], p0[6]); m = MX3(m, p0[7], p0[8]));
    PV_D0(1, m = MX3(m, p0[9], p0[10]); m = MX3(m, p0[11], p0[12]); m = MX3(m, p0[13], p0[14]); m = MX3(m, p0[15], p1[0]));
    PV_D0(2, m = MX3(m, p1[1], p1[2]); m = MX3(m, p1[3], p1[4]); m = MX3(m, p1[5], p1[6]); m = MX3(m, p1[7], p1[8]));
    PV_D0(3, m = MX3(m, p1[9], p1[10]); m = MX3(m, p1[11], p1[12]); m = MX3(m, p1[13], p1[14]); m = fmaxf(m, p1[15]));
#undef PV_D0
#undef MX3
#undef TRRD
    return m;
}

struct BlockRef { const bf16* Q; const bf16* K; const bf16* V; const bf16* ZS; bf16* O; const u64* MW; const float* bias; int P0; };
struct Seam { bf16x8 qr[8]; bf16x8 st_v0, st_v1, st_k0, st_k1; };
#define ROW(p, k0, rr) ((const bf16*)((const char*)(p) + (size_t)(unsigned)(((k0) + (rr)) * (PITCH * 2) + sc * 2)))
#define VMW() asm volatile("s_waitcnt vmcnt(0)" ::: "memory")
#define VMWN(n) asm volatile("s_waitcnt vmcnt(%0)" :: "i"(n) : "memory")
#define LD8(p) (*reinterpret_cast<const bf16x8*>(p))
#define SLOAD_H(Kp, Vp, k0) do { S.st_v0 = LD8(ROW(Vp, k0, sr)); S.st_v1 = LD8(ROW(Vp, k0, 32 + sr)); S.st_k0 = LD8(ROW(Kp, k0, sr)); S.st_k1 = LD8(ROW(Kp, k0, 32 + sr)); } while (0)
#define SWRITE_HK(bf) do { *(bf16x8*)(K_lds + (bf) * SHM_K + kws) = S.st_k0; *(bf16x8*)(K_lds + (bf) * SHM_K + kws + 32 * 256) = S.st_k1; } while (0)
#define SWRITE_HV(bf) do { *(bf16x8*)(V_lds + (bf) * SHM_V + vst0) = S.st_v0; *(bf16x8*)(V_lds + (bf) * SHM_V + vst1) = S.st_v1; } while (0)
#define SWRITE_H(bf) do { SWRITE_HV(bf); SWRITE_HK(bf); } while (0)
__device__ __forceinline__ void attn_block(const BlockRef& cur, char* lds) {
    Seam S;
    int tid_ = threadIdx.x; asm volatile("" : "+v"(tid_));
    const int tid = tid_, wid = __builtin_amdgcn_readfirstlane(tid >> 6), lane = tid & 63, r32 = lane & 31, hi = lane >> 5;
    const int NT = (cur.P0 + QB) / KVBLK;
    const int qlo = cur.P0 + wid * QBLK;
    char* V_lds = lds; char* K_lds = lds + NBUF * SHM_V;
    float* ws = (float*)(lds + OFF_WS) + wid * 64; float* li_l = ws, * al_l = ws + 32;
    float* tab = (float*)(lds + OFF_TAB);
    float m_reg = 0.f, l_reg = 0; f32x16 o[4] = {};
    const int sr = tid >> 4, sc = (tid & 15) * 8, vst0 = v_st_nat(sr, sc), vst1 = v_st_nat(32 + sr, sc), kws = KSWZ(sr, sc * 2);
    const int vb0 = (int)(uintptr_t)V_lds + v_rd_base(lane);
    const bf16* Kh = cur.K; const bf16* Vh = cur.V;
    { int tq_ = tid; asm volatile("" : "+v"(tq_));
    if (tq_ < 448) { const int rel = tq_ - 256; const int ret = rel < 0 ? 16 : 0; const int n = rel < 0 ? -rel : rel; int v;
        if (n < 8) v = n; else if (n < 12) v = 8; else if (n < 16) v = 9; else if (n < 23) v = 10; else if (n < 32) v = 11; else if (n < 46) v = 12; else if (n < 64) v = 13; else if (n < 91) v = 14; else v = 15;
        tab[tq_] = cur.bias[(ret + v) * 8] * 1.4426950408889634f; } }
    const float cbfar = cur.bias[15 * 8] * 1.4426950408889634f;
    const cu64p mwv = (cu64p)(uintptr_t)(cur.MW + (size_t)wid * MW_PER_QB);
#define RESC(a) do { if (__any((a) < 1.f)) { if (hi == 0) al_l[r32] = (a); asm volatile("s_waitcnt lgkmcnt(0)" ::: "memory");              \
                     for (int d_ = 0; d_ < 4; ++d_) for (int r = 0; r < 16; ++r) o[d_][r] *= al_l[crow(r, hi)]; } } while (0)
#define KBASE(t) ((t) * KVBLK)
#define INIT(P0_, P1_, t) do { const int kb_ = KBASE(t); const cu64p w_ = mwv + (size_t)(t) * 32;                              \
        if (kb_ + 154 <= qlo) init_tile<false>(P0_, P1_, w_, cbfar - m_reg, tab, m_reg);                                        \
        else init_tile<true>(P0_, P1_, w_, cbfar - m_reg, tab + (qlo + r32 - kb_ - 4 * hi + 197), m_reg); } while (0)
    unsigned pm0 = 0u, pm1 = 0u, pm2 = 0u, pm3 = 0u;
#define MPREF(t) do { const __attribute__((address_space(4))) unsigned* w_ = (const __attribute__((address_space(4))) unsigned*)(mwv + (size_t)(t) * 32); pm0 = w_[0]; pm1 = w_[16]; pm2 = w_[32]; pm3 = w_[48]; SBAR(); } while (0)
#define MUSE() asm volatile("" :: "s"(pm0), "s"(pm1), "s"(pm2), "s"(pm3))
    f32x16 pA0, pA1, pB0, pB1; float alA, alB; bf16x8 pa0, pa1, pa2, pa3;
#pragma unroll
    for (int d0 = 0; d0 < 8; ++d0) S.qr[d0] = LD8((const char*)cur.Q + (size_t)(unsigned)((wid * QBLK + r32) * (PITCH * 2) + d0 * 32 + hi * 16));
    SLOAD_H(Kh, Vh, 0); VMW(); SWRITE_H(0); SBAR();
    if (NT > 1) SLOAD_H(Kh, Vh, KBASE(1));
    __syncthreads();
    INIT(pA0, pA1, 0);
    SBAR(); qkt<0>(pA0, pA1, K_lds, r32, hi, S.qr);
    MPREF(1);
    { float pm_ = pA0[0];
#pragma unroll
      for (int r = 1; r < 16; ++r) pm_ = fmaxf(pm_, pA0[r]);
#pragma unroll
      for (int r = 0; r < 16; ++r) pm_ = fmaxf(pm_, pA1[r]);
      partialSM(pA0, pA1, m_reg, alA, l_reg, pm_); }
    if (NT > 1) { VMW(); SWRITE_H(1); }
    __syncthreads();
#define HALF_STEP(PX0, PX1, alX, PY0, PY1, alY, t, KB, VB, SB) do {                                                           \
        MUSE(); INIT(PX0, PX1, (t)); SBAR(); qkt<KB>(PX0, PX1, K_lds, r32, hi, S.qr);                                        \
        finishSM(PY0, PY1, alY, l_reg, pa0, pa1, pa2, pa3); SBAR();                                                           \
        SLOAD_H(Kh, Vh, KBASE((t) + 1)); SBAR();                                                                              \
        { const float pm_ = pv_tile_max<VB>(o, vb0, pa0, pa1, pa2, pa3, PX0, PX1); MPREF((t) + 1); partialSM(PX0, PX1, m_reg, alX, l_reg, pm_); }   \
        VMW(); SWRITE_H(SB);                                                                                                  \
        RESC(alX); __syncthreads(); } while (0)
    int t = 1;
    for (; t + 4 < NT; t += 4) {
        HALF_STEP(pB0, pB1, alB, pA0, pA1, alA, t, 1, 0, 2);
        HALF_STEP(pA0, pA1, alA, pB0, pB1, alB, t + 1, 2, 1, 3);
        HALF_STEP(pB0, pB1, alB, pA0, pA1, alA, t + 2, 3, 2, 0);
        HALF_STEP(pA0, pA1, alA, pB0, pB1, alB, t + 3, 0, 3, 1);
    }
    HALF_STEP(pB0, pB1, alB, pA0, pA1, alA, NT - 3, 1, 0, 2);
    HALF_STEP(pA0, pA1, alA, pB0, pB1, alB, NT - 2, 2, 1, 3);
    MUSE(); INIT(pB0, pB1, NT - 1); SBAR(); qkt<3>(pB0, pB1, K_lds, r32, hi, S.qr); SBAR();
    finishSM(pA0, pA1, alA, l_reg, pa0, pa1, pa2, pa3); SBAR();
    { const float pm_ = pv_tile_max<2>(o, vb0, pa0, pa1, pa2, pa3, pB0, pB1); partialSM(pB0, pB1, m_reg, alB, l_reg, pm_); } RESC(alB);
    finishSM(pB0, pB1, alB, l_reg, pa0, pa1, pa2, pa3); SBAR(); pv_tile<3>(o, vb0, pa0, pa1, pa2, pa3);
    SBAR();
    __syncthreads();
    if (hi == 0) li_l[r32] = l_reg; asm volatile("s_waitcnt lgkmcnt(0)" ::: "memory");
    float rli[16];
#pragma unroll
    for (int r = 0; r < 16; ++r) rli[r] = __builtin_amdgcn_rcpf(li_l[crow(r, hi)]);
    {
        char* ep = lds + OFF_EP + wid * EP_WAVE; unsigned ew_off = (unsigned)(4 * hi * EP_PITCH + r32 * 2); asm volatile("" : "+v"(ew_off));
#pragma unroll
        for (int r = 0; r < 16; ++r) { const int rw = (r & 3) + 8 * (r >> 2);
#pragma unroll
            for (int d0 = 0; d0 < 4; ++d0) *(unsigned short*)(ep + ew_off + rw * EP_PITCH + d0 * 64) = (unsigned short)(cvtpk_s(o[d0][r] * rli[r], 0.f) & 0xffffu); }
        asm volatile("s_waitcnt lgkmcnt(0)" ::: "memory");
        unsigned lane_off = (unsigned)((wid * QBLK + (lane >> 4)) * PITCH + (lane & 15) * 8) * 2u;
        asm volatile("" : "+v"(lane_off));
        unsigned er_off = (unsigned)((lane >> 4) * EP_PITCH + (lane & 15) * 16); asm volatile("" : "+v"(er_off));
        char* op = (char*)cur.O + (size_t)lane_off; const char* zp = (const char*)cur.ZS + (size_t)lane_off; const char* er = ep + er_off;
#pragma unroll
        for (int ph = 0; ph < 2; ++ph) {
            asm volatile("" ::: "memory");
            uint4 zz[4];
#pragma unroll
            for (int p4 = 0; p4 < 4; ++p4) zz[p4] = *(const uint4*)(zp + (ph * 4 + p4) * 4 * PITCH * 2);
#pragma unroll
            for (int p4 = 0; p4 < 4; ++p4) { const int p = ph * 4 + p4; const uint4 m = *(const uint4*)(er + p * 4 * EP_PITCH); const uint4 z = zz[p4]; uint4 y;
                y.x = cvtpk_s(__uint_as_float(m.x << 16) * __uint_as_float(z.x << 16), __uint_as_float(m.x & 0xffff0000u) * __uint_as_float(z.x & 0xffff0000u));
                y.y = cvtpk_s(__uint_as_float(m.y << 16) * __uint_as_float(z.y << 16), __uint_as_float(m.y & 0xffff0000u) * __uint_as_float(z.y & 0xffff0000u));
                y.z = cvtpk_s(__uint_as_float(m.z << 16) * __uint_as_float(z.z << 16), __uint_as_float(m.z & 0xffff0000u) * __uint_as_float(z.z & 0xffff0000u));
                y.w = cvtpk_s(__uint_as_float(m.w << 16) * __uint_as_float(z.w << 16), __uint_as_float(m.w & 0xffff0000u) * __uint_as_float(z.w & 0xffff0000u));
                *(uint4*)(op + p * 4 * PITCH * 2) = y; } }
    }
    __syncthreads();
#undef RESC
#undef KBASE
#undef INIT
#undef MPREF
#undef MUSE
#undef HALF_STEP
}
#undef ROW
#undef VMW
#undef VMWN
#undef LD8
#undef SLOAD_H
#undef SWRITE_HK
#undef SWRITE_HV
#undef SWRITE_H

__device__ __forceinline__ BlockRef make_ref(int L, int pass, const bf16* Q, const bf16* K, const bf16* V, const bf16* ZS, bf16* O, const u64* MASKW, const float* rel_bias) {
    const int bh = L >> 5, x = L & 31, b = bh >> 3, h = bh & 7, qb = pass ? 63 - x : x;
    BlockRef r; const size_t row0 = (size_t)b * S + (size_t)qb * QB;
    r.Q = Q + row0 * PITCH + h * D; r.O = O + row0 * PITCH + h * D; r.ZS = ZS + row0 * PITCH + h * D;
    r.K = K + (size_t)b * S * PITCH + h * D; r.V = V + (size_t)b * S * PITCH + h * D;
    r.MW = MASKW + ((size_t)b * (S / 32) + (size_t)qb * 8) * MW_PER_QB; r.bias = rel_bias + h; r.P0 = qb * QB;
    return r;
}
__device__ __forceinline__ void attn_phase(char* lds, int vcu, int G, const bf16* Q, const bf16* K, const bf16* V, const bf16* ZS, bf16* O, const u64* MASKW, const float* rel_bias) {
    constexpr int TOTAL = 512;
    for (int L = vcu; L < TOTAL; L += G)
#pragma unroll 1
        for (int pass = 0; pass < 2; ++pass) { const BlockRef cur = make_ref(L, pass, Q, K, V, ZS, O, MASKW, rel_bias); attn_block(cur, lds); }
}
}

namespace sgu {
typedef unsigned short bf16;
typedef short bf16x8 __attribute__((ext_vector_type(8)));
typedef short s16x4 __attribute__((ext_vector_type(4)));
typedef float f32x16 __attribute__((ext_vector_type(16)));
typedef float f32x2_t __attribute__((ext_vector_type(2))); typedef __bf16 bf16x2_t __attribute__((ext_vector_type(2)));
__device__ __forceinline__ unsigned cvtpk_s(float lo, float hi) { f32x2_t v = {lo, hi}; bf16x2_t b = __builtin_convertvector(v, bf16x2_t); return __builtin_bit_cast(unsigned, b); }
constexpr int OFF_B = 0;
constexpr int OFF_ST = 65536;
constexpr int OFF_EP = 66560;
constexpr int EP_PITCH = 80, EP_WAVE = 128 * EP_PITCH;
constexpr int SGU_LDS_BYTES = OFF_EP + 8 * EP_WAVE;

template <bool WRITE>
__device__ __forceinline__ void sgu_phase(char* lds, int vcu, int G, bf16* U  , const bf16* Vb, const float* LNP, const bf16* WS16, const float* ln_g, const float* ln_b, const float* b_s) {
    const int tid = threadIdx.x, wid = __builtin_amdgcn_readfirstlane(tid >> 6), lane = tid & 63, r32 = lane & 31, hi = lane >> 5;
    float2* stats = (float2*)(lds + OFF_ST);
    for (int chunk = vcu; chunk < M / 128; chunk += G) {
        const size_t row0 = (size_t)chunk * 128;
        { int tq_ = tid; asm volatile("" : "+v"(tq_));
          if (tq_ < 128) { const float4* pp = (const float4*)(LNP + (row0 + tq_) * 64); float s1 = 0.f, s2 = 0.f;
#pragma unroll
            for (int j = 0; j < 16; ++j) { const float4 q = pp[j]; s1 += q.x + q.z; s2 += q.y + q.w; }
            const float mean = s1 * (1.f / BW); const float var = fmaxf(s2 * (1.f / BW) - mean * mean, 0.f);
            stats[tq_] = make_float2(mean, 1.0f / sqrtf(var + LN_EPS)); } }
        __syncthreads();
#pragma unroll 1
        for (int g = 0; g < 8; ++g) {
            bf16x8 A0[2], A1[4], A2[6], A3[8];
            uint4 ug[8];
            { const size_t gb_ = (row0 * BW + (size_t)(g * 256 + (wid >> 2) * 128 + (wid & 3) * 32 + (lane & 3) * 8)) * 2;
#pragma unroll
                for (int p = 0; p < 8; ++p) ug[p] = *(const uint4*)((const char*)U + gb_ + (size_t)(16 * p + (lane >> 2)) * (BW * 2)); }
            { const char* ap = (const char*)WS16 + (size_t)(unsigned)(((g * 128 + r32) * 128 + 8 * hi) * 2);
#pragma unroll
                for (int kk = 0; kk < 2; ++kk) A0[kk] = *reinterpret_cast<const bf16x8*>(ap + kk * 32);
#pragma unroll
                for (int kk = 0; kk < 4; ++kk) A1[kk] = *reinterpret_cast<const bf16x8*>(ap + 32 * 256 + kk * 32);
#pragma unroll
                for (int kk = 0; kk < 6; ++kk) A2[kk] = *reinterpret_cast<const bf16x8*>(ap + 64 * 256 + kk * 32);
#pragma unroll
                for (int kk = 0; kk < 8; ++kk) A3[kk] = *reinterpret_cast<const bf16x8*>(ap + 96 * 256 + kk * 32); }
            { const int e8 = (tid & 31) * 8, ch = g * 256 + e8;
                const float4 g0 = *(const float4*)(ln_g + ch), g1 = *(const float4*)(ln_g + ch + 4), b0 = *(const float4*)(ln_b + ch), b1 = *(const float4*)(ln_b + ch + 4);
#pragma unroll
                for (int i = 0; i < 8; ++i) { const int s = (tid >> 5) + 16 * i; const uint4 w = *(const uint4*)(Vb + (row0 + s) * BW + ch); const float2 st = stats[s];
                    const float x0 = (bflo(w.x) - st.x) * st.y * g0.x + b0.x, x1 = (bfhi(w.x) - st.x) * st.y * g0.y + b0.y, x2 = (bflo(w.y) - st.x) * st.y * g0.z + b0.z, x3 = (bfhi(w.y) - st.x) * st.y * g0.w + b0.w;
                    const float x4 = (bflo(w.z) - st.x) * st.y * g1.x + b1.x, x5 = (bfhi(w.z) - st.x) * st.y * g1.y + b1.y, x6 = (bflo(w.w) - st.x) * st.y * g1.z + b1.z, x7 = (bfhi(w.w) - st.x) * st.y * g1.w + b1.w;
                    uint4 o; o.x = att::cvtpk(x0, x1); o.y = att::cvtpk(x2, x3); o.z = att::cvtpk(x4, x5); o.w = att::cvtpk(x6, x7);
                    *(uint4*)(lds + OFF_B + ((s >> 6) * 2 + (e8 >> 7)) * 16384 + att::v_st(s & 63, e8 & 127)) = o; } }
            __syncthreads();
            f32x16 acc[4] = {};
            { const int eh = wid >> 2, d0 = wid & 3;
                const int vb0 = (int)(uintptr_t)(lds + OFF_B) + att::v_rd_base(lane) + eh * 16384 + d0 * 512;
#define TRRD(dst, off) asm volatile("ds_read_b64_tr_b16 %0, %1 offset:%2" : "=&v"(dst) : "v"(vb0), "i"(off) : "memory")
#define BFRAG(dst, sh, ks) do { s16x4 l_, h_; TRRD(l_, (sh) * 32768 + (ks) * 4096); TRRD(h_, (sh) * 32768 + (ks) * 4096 + 2048); asm volatile("s_waitcnt lgkmcnt(0)" ::: "memory"); \
                dst = (bf16x8){l_[0], l_[1], l_[2], l_[3], h_[0], h_[1], h_[2], h_[3]}; } while (0)
                bf16x8 Bf[8];
                BFRAG(Bf[0], 0, 0); BFRAG(Bf[1], 0, 1); BFRAG(Bf[2], 0, 2); BFRAG(Bf[3], 0, 3); BFRAG(Bf[4], 1, 0); BFRAG(Bf[5], 1, 1); BFRAG(Bf[6], 1, 2); BFRAG(Bf[7], 1, 3);
#undef BFRAG
#undef TRRD
#pragma unroll
                for (int kk = 0; kk < 2; ++kk) acc[0] = __builtin_amdgcn_mfma_f32_32x32x16_bf16(A0[kk], Bf[kk], acc[0], 0, 0, 0);
#pragma unroll
                for (int kk = 0; kk < 4; ++kk) acc[1] = __builtin_amdgcn_mfma_f32_32x32x16_bf16(A1[kk], Bf[kk], acc[1], 0, 0, 0);
#pragma unroll
                for (int kk = 0; kk < 6; ++kk) acc[2] = __builtin_amdgcn_mfma_f32_32x32x16_bf16(A2[kk], Bf[kk], acc[2], 0, 0, 0);
#pragma unroll
                for (int kk = 0; kk < 8; ++kk) acc[3] = __builtin_amdgcn_mfma_f32_32x32x16_bf16(A3[kk], Bf[kk], acc[3], 0, 0, 0);
                char* ep = lds + OFF_EP + wid * EP_WAVE;
#pragma unroll
                for (int tb = 0; tb < 4; ++tb)
#pragma unroll
                    for (int r = 0; r < 16; ++r) { const int tl = 32 * tb + (r & 3) + 8 * (r >> 2) + 4 * hi;
                        *(unsigned short*)(ep + tl * EP_PITCH + r32 * 2) = (unsigned short)(cvtpk_s(acc[tb][r], 0.f) & 0xffffu); }
                asm volatile("s_waitcnt lgkmcnt(0)" ::: "memory");
                const int rq = lane >> 2, cq = (lane & 3) * 8;
                const size_t gbase = (row0 * BW + (size_t)(g * 256 + eh * 128 + d0 * 32 + cq)) * 2;
#pragma unroll
                for (int ph = 0; ph < 2; ++ph) {
                    uint4 uu[4], mm[4]; float bs[4];
#pragma unroll
                    for (int p = 0; p < 4; ++p) { const int t = 16 * (ph * 4 + p) + rq; const size_t o = gbase + (size_t)t * (BW * 2);
                        uu[p] = ug[ph * 4 + p]; bs[p] = b_s[g * 128 + t]; mm[p] = *(const uint4*)(ep + t * EP_PITCH + cq * 2); }
#pragma unroll
                    for (int p = 0; p < 4; ++p) { const int t = 16 * (ph * 4 + p) + rq; const size_t o = gbase + (size_t)t * (BW * 2);
                        uint4 y;
                        y.x = att::cvtpk(bflo(uu[p].x) * (bflo(mm[p].x) + bs[p]), bfhi(uu[p].x) * (bfhi(mm[p].x) + bs[p]));
                        y.y = att::cvtpk(bflo(uu[p].y) * (bflo(mm[p].y) + bs[p]), bfhi(uu[p].y) * (bfhi(mm[p].y) + bs[p]));
                        y.z = att::cvtpk(bflo(uu[p].z) * (bflo(mm[p].z) + bs[p]), bfhi(uu[p].z) * (bfhi(mm[p].z) + bs[p]));
                        y.w = att::cvtpk(bflo(uu[p].w) * (bflo(mm[p].w) + bs[p]), bfhi(uu[p].w) * (bfhi(mm[p].w) + bs[p]));
                        if (WRITE || y.x == 0x12345678u) *(uint4*)((char*)U + o) = y; } } }
            __syncthreads();
        }
    }
}
}

constexpr size_t MiB = 1u << 20;
constexpr size_t WS_CTL = 0, CTL_ZERO_BYTES = 64 * 1024;
constexpr size_t WS_WAI = 2 * MiB, WS_WAO = 12 * MiB, WS_WBI = 14 * MiB, WS_WBO = 26 * MiB;
constexpr size_t WS_WS16 = 1 * MiB;
constexpr size_t WS_RS0 = 1 * MiB + 512 * 1024;
constexpr size_t WS_H = 32 * MiB;
constexpr size_t WS_Q = 96 * MiB, WS_K = 160 * MiB, WS_V = 224 * MiB, WS_ZS = 288 * MiB;
constexpr size_t WS_QI = 352 * MiB, WS_KI = 384 * MiB, WS_WI = 388 * MiB;
constexpr size_t WS_MASK = 416 * MiB;
constexpr size_t WS_PS = 30 * MiB;
constexpr size_t WS_XB = 32 * MiB;
constexpr size_t WS_OG = 352 * MiB;
constexpr size_t WS_U = 96 * MiB, WS_VB = 224 * MiB, WS_ZB = 352 * MiB;
constexpr size_t WS_LNP = 352 * MiB;
constexpr size_t WS_TAIL = 480 * MiB;
constexpr size_t WS_END = 512 * MiB;
constexpr int CW_BAR = 1024;
constexpr int LDS_BYTES = 162816;
constexpr int MISC_OFF = 160000;
static_assert(att::ATTN_LDS_BYTES <= MISC_OFF && idx::IDX_LDS_BYTES <= MISC_OFF && sgu::SGU_LDS_BYTES <= MISC_OFF, "LDS map");

#define XB_TMO      128
#define XB_XCNT(j)  (256  + 64 * (j))
#define XB_XSUB(j)  (1280 + 64 * (j))
#define XB_XGEN(j)  (2304 + 64 * (j))
#define XB_TOP      3328
#define XB_TOPGEN   3392
#define XCD_BAR_WORDS 3456
#define XB_SPIN_CAP (1u << 18)
__device__ __forceinline__ unsigned xb_ld(unsigned* p)              { return __hip_atomic_load(p, __ATOMIC_RELAXED, __HIP_MEMORY_SCOPE_AGENT); }
__device__ __forceinline__ unsigned xb_add(unsigned* p, unsigned v) { return __hip_atomic_fetch_add(p, v, __ATOMIC_RELAXED, __HIP_MEMORY_SCOPE_AGENT); }
__device__ __forceinline__ unsigned xb_xcc_id() { return (unsigned)__builtin_amdgcn_s_getreg((3 << 11) | 20) & 0xFu; }
#define XB_SPIN(cond, bar) do { unsigned _sp = 0; while (cond) { __builtin_amdgcn_s_sleep(1); \
    if ((++_sp & 255u) == 0u) { if (xb_ld(&(bar)[XB_TMO])) break; if (_sp > XB_SPIN_CAP) { atomicAdd(&(bar)[XB_TMO], 1u); break; } } } } while (0)
struct XcdBarrier { unsigned* bar; unsigned x; volatile LAS unsigned* st; };
__device__ __forceinline__ XcdBarrier xcd_barrier_post(unsigned* bar, volatile LAS unsigned* st) {
    XcdBarrier b; b.bar = bar; b.x = xb_xcc_id(); b.st = st;
    if (threadIdx.x == 0) (void)xb_add(&bar[XB_XCNT(b.x)], 1u);
    return b;
}
__device__ __forceinline__ void xcd_barrier_complete(unsigned* bar, unsigned x, unsigned& nloc, unsigned& nx) {
    const unsigned G = gridDim.x * gridDim.y * gridDim.z;
    unsigned sum, cnt, mine, sp = 0u;
    for (;;) {
        sum = 0u; cnt = 0u; mine = 0u;
#pragma unroll
        for (unsigned j = 0; j < 16; ++j) { const unsigned c = xb_ld(&bar[XB_XCNT(j)]); sum += c; cnt += (c > 0u) ? 1u : 0u; mine = (j == x) ? c : mine; }
        if (sum == G) break;
        __builtin_amdgcn_s_sleep(1);
        if ((++sp & 255u) == 0u) { if (xb_ld(&bar[XB_TMO])) break; if (sp > XB_SPIN_CAP) { atomicAdd(&bar[XB_TMO], 1u); break; } }
    }
    nloc = mine > 0u ? mine : 1u; nx = cnt > 0u ? cnt : 1u;
}
__device__ __forceinline__ void xcd_barrier(const XcdBarrier& b) {
    asm volatile("s_waitcnt vmcnt(0)" ::: "memory");
    __syncthreads();
    if (threadIdx.x == 0) {
        unsigned* bar = b.bar;
        __builtin_amdgcn_s_waitcnt(0);
        unsigned nloc = b.st[0], nx = b.st[1];
        if (nloc == 0u) { xcd_barrier_complete(bar, b.x, nloc, nx); b.st[0] = nloc; b.st[1] = nx; }
        const unsigned old = xb_add(&bar[XB_XSUB(b.x)], 1u);
        const unsigned gen = old / nloc;
        if (old + 1u == (gen + 1u) * nloc) {
            __builtin_amdgcn_fence(__ATOMIC_RELEASE, "agent");
            asm volatile("s_waitcnt vmcnt(0)" ::: "memory");
            const unsigned og = xb_add(&bar[XB_TOP], 1u);
            const unsigned tg = og / nx;
            if (og + 1u == (tg + 1u) * nx) xb_add(&bar[XB_TOPGEN], 1u);
            else XB_SPIN(xb_ld(&bar[XB_TOPGEN]) == tg, bar);
            __builtin_amdgcn_fence(__ATOMIC_ACQUIRE, "agent");
            xb_add(&bar[XB_XGEN(b.x)], 1u);
            asm volatile("s_waitcnt vmcnt(0)" ::: "memory");
        } else {
            XB_SPIN(xb_ld(&bar[XB_XGEN(b.x)]) == gen, bar);
            __builtin_amdgcn_fence(__ATOMIC_ACQUIRE, "agent");
            asm volatile("s_waitcnt vmcnt(0)" ::: "memory");
        }
    }
    __syncthreads();
}

#ifndef MK_PER_PHASE
#define MK_PER_PHASE 0
#endif
constexpr int NPHASES = 10;
struct Args { const float* in[12]; float* out; unsigned char* ws; int ph_lo, ph_hi; };
__global__ void __launch_bounds__(512, 2) fwd(Args args) {
    extern __shared__ __attribute__((aligned(16))) unsigned char lds[];
    LAS unsigned char* ldsl = (LAS unsigned char*)lds;
    volatile LAS unsigned* MISC = (volatile LAS unsigned*)(ldsl + MISC_OFF);
    const int tid = threadIdx.x, lane = tid & 63, wave = __builtin_amdgcn_readfirstlane(tid >> 6);
    const int G = gridDim.x; const int bx = blockIdx.x; const int vcu = (G % 8 == 0) ? (bx % 8) * (G / 8) + bx / 8 : bx;
    const int gw = vcu * 8 + wave, NGW = G * 8;
    unsigned char* ws = args.ws;
    const float* x = args.in[0]; const float* norm_g = args.in[1]; const float* final_g = args.in[2]; const float* rel_bias = args.in[3];
    const float* a_w_in = args.in[4]; const float* a_w_out = args.in[5]; const float* b_w_in = args.in[6];
    const float* b_ln_g = args.in[7]; const float* b_ln_b = args.in[8]; const float* b_w_s = args.in[9]; const float* b_b_s = args.in[10]; const float* b_w_out = args.in[11];
    float* out = args.out;
    bf16 *WAI = (bf16*)(ws + WS_WAI), *WAO = (bf16*)(ws + WS_WAO), *WBI = (bf16*)(ws + WS_WBI), *WBO = (bf16*)(ws + WS_WBO), *H = (bf16*)(ws + WS_H);
    bf16 *Qb = (bf16*)(ws + WS_Q), *Kb = (bf16*)(ws + WS_K), *Vb = (bf16*)(ws + WS_V), *ZS = (bf16*)(ws + WS_ZS), *QI = (bf16*)(ws + WS_QI), *KI = (bf16*)(ws + WS_KI);
    float* WI = (float*)(ws + WS_WI); bf16* WS16 = (bf16*)(ws + WS_WS16);
    bf16 *U = (bf16*)(ws + WS_U), *V1 = (bf16*)(ws + WS_VB), *Z1 = (bf16*)(ws + WS_ZB), *XB = (bf16*)(ws + WS_XB); float* PS = (float*)(ws + WS_PS);
    if (tid < 32) MISC[tid] = 0u;
    __syncthreads();
    XcdBarrier bar; bar.bar = (unsigned*)(ws + WS_CTL) + CW_BAR; bar.x = 0; bar.st = nullptr;
    if (!MK_PER_PHASE) bar = xcd_barrier_post((unsigned*)(ws + WS_CTL) + CW_BAR, MISC + 8);
    const int lo = args.ph_lo, hi = args.ph_hi;
#ifdef DBG_SKIP
#define IN(k) (((DBG_SKIP >> (k)) & 1) == 0 && lo <= (k) && (k) < hi)
#else
#define IN(k) (lo <= (k) && (k) < hi)
#endif
#ifndef DBG_REPEAT
#define DBG_REPEAT 0
#endif
#define REP(k) _Pragma("unroll 1") for (int rep_ = 0; rep_ < 1 + ((DBG_REPEAT >> (k)) & 1); ++rep_)
#define SEAM(k) do { if (IN(k) && IN((k) + 1)) xcd_barrier(bar); } while (0)

    if (IN(0)) REP(0) {
        LAS float* scr = (LAS float*)ldsl + wave * 64 * 33;
        constexpr int I_AI = 16 * (A_NPAD / 32), I_AO = 16 * 32, I_BI = 16 * (B_COLS / 32), I_BO = 32 * 32;
        for (int it = gw; it < I_AI + I_AO + I_BI + I_BO; it += NGW) {
            int r = it;
            if (r < I_AI) { transpose_item(a_w_in, 1024, A_COLS, A_NPAD, WAI, scr, r, lane, norm_g); continue; } r -= I_AI;
            if (r < I_AO) { transpose_item(a_w_out, 1024, 1024, 1024, WAO, scr, r, lane); continue; } r -= I_AO;
            if (r < I_BI) { transpose_item(b_w_in, 1024, B_COLS, B_COLS, WBI, scr, r, lane, norm_g + DM, true); continue; } r -= I_BI;
            transpose_item(b_w_out, 2048, 1024, 1024, WBO, scr, r, lane);
        }
        for (int i = vcu * 512 + tid; i < 8 * 128 * 128; i += G * 512) WS16[i] = (i & 127) <= ((i >> 7) & 127) ? (bf16)f2bf(b_w_s[i]) : (bf16)0;
        for (int m = gw; m < M; m += NGW) row_to_bf16_rs(x + (size_t)m * DM, H + (size_t)m * DM, (float*)(ws + WS_RS0) + m, lane);
        __syncthreads();
    }
    SEAM(0);
    if (IN(1)) REP(1) {
        pg8::Gemm g{H, WAI, M, A_NPAD, 1024}; pg8::StaticOrder So; So.init(M, A_NPAD, G, bx);
        pg8::EpiA E{Qb, Kb, Vb, ZS, QI, KI, WI, (const float*)(ws + WS_RS0)};
        pg8::gemm_phase<pg8::EpiA, pg8::StaticOrder, true, true>(ldsl, g, So, E);
    }
    SEAM(1);
    if (IN(2)) REP(2) idx::indexer_phase((char*)lds, vcu, G, QI, KI, WI, (idx::u64*)(ws + WS_MASK), (char*)out, (char*)(ws + WS_TAIL), (char*)(ws + WS_WI + 1 * MiB), (char*)(ws + WS_WAI));
    SEAM(2);
    if (IN(3)) REP(3) {
        att::attn_phase((char*)lds, vcu, G, Qb, Kb, Vb, ZS, (bf16*)(ws + WS_OG), (const att::u64*)(ws + WS_MASK), rel_bias); }
    SEAM(3);
    if (IN(4)) REP(4) {
        pg8::Gemm g{(const bf16*)(ws + WS_OG), WAO, M, 1024, 1024}; pg8::StaticOrder So; So.init(M, 1024, G, bx);
        pg8::EpiRes1 E{XB, PS};
        pg8::gemm_phase<pg8::EpiRes1, pg8::StaticOrder, true, true>(ldsl, g, So, E);
    }
    if (IN(4) && IN(6)) xcd_barrier(bar);
    if (IN(6)) REP(6) {
        pg8::Gemm g{XB, WBI, M, B_COLS, 1024}; pg8::StaticOrder So; So.init(M, B_COLS, G, bx);
        pg8::EpiB E{U, V1, PS, (float*)(ws + WS_LNP)};
        pg8::gemm_phase<pg8::EpiB, pg8::StaticOrder, true, true>(ldsl, g, So, E);
    }
    SEAM(6);
#ifdef DBG_SGU2
    if (IN(7)) sgu::sgu_phase<false>((char*)lds, vcu, G, U, V1, (const float*)(ws + WS_LNP), WS16, b_ln_g, b_ln_b, b_b_s);
#endif
    if (IN(7)) sgu::sgu_phase<true>((char*)lds, vcu, G, U, V1, (const float*)(ws + WS_LNP), WS16, b_ln_g, b_ln_b, b_b_s);
    SEAM(7);
    if (IN(8)) REP(8) {
        pg8::Gemm g{U, WBO, M, 1024, 2048}; pg8::StaticOrder So; So.init(M, 1024, G, bx);
        pg8::EpiRes2 E{XB};
        pg8::gemm_phase<pg8::EpiRes2, pg8::StaticOrder, true, true>(ldsl, g, So, E);
    }
    SEAM(8);
    if (IN(9)) REP(9) { for (int m = gw; m < M; m += NGW) rms_row_bf16_to_f32(XB + (size_t)m * DM, final_g, out + (size_t)m * DM, lane); }
#undef IN
#undef SEAM
}

extern "C" void kernel_launch(void* const* d_in, const int* in_sizes, int n_in, void* d_out, int out_size, void* d_ws, size_t ws_size, hipStream_t stream) {
    static int grid = 0;
    if (grid == 0) {
        if (n_in != 12 || in_sizes[0] != M * DM || out_size != M * DM || ws_size < WS_END) { fprintf(stderr, "kernel_launch: unexpected shapes (n_in %d, in0 %d, out %d, ws %zu)\n", n_in, n_in > 0 ? in_sizes[0] : -1, out_size, ws_size); grid = -1; return; }
        int dev = 0, cus = 0, per_cu = 0;
        if (hipGetDevice(&dev) != hipSuccess || hipDeviceGetAttribute(&cus, hipDeviceAttributeMultiprocessorCount, dev) != hipSuccess) { fprintf(stderr, "kernel_launch: device query failed\n"); grid = -1; return; }
        if (hipFuncSetAttribute((const void*)fwd, hipFuncAttributeMaxDynamicSharedMemorySize, LDS_BYTES) != hipSuccess) { fprintf(stderr, "kernel_launch: hipFuncSetAttribute failed\n"); grid = -1; return; }
        if (hipOccupancyMaxActiveBlocksPerMultiprocessor(&per_cu, (const void*)fwd, 512, LDS_BYTES) != hipSuccess || per_cu < 1) { fprintf(stderr, "kernel_launch: occupancy query says %d workgroups per CU\n", per_cu); }
        (void)hipGetLastError();
        grid = cus;
    }
    if (grid < 0) return;
    if (hipMemsetAsync((char*)d_ws + WS_CTL, 0, CTL_ZERO_BYTES, stream) != hipSuccess) { fprintf(stderr, "kernel_launch: memset failed\n"); return; }
    Args a{};
    for (int i = 0; i < 12; ++i) a.in[i] = (const float*)d_in[i];
    a.out = (float*)d_out; a.ws = (unsigned char*)d_ws;
#if MK_PER_PHASE
    for (int p = 0; p < NPHASES; ++p) { a.ph_lo = p; a.ph_hi = p + 1; hipLaunchKernelGGL(fwd, dim3(grid), dim3(512), LDS_BYTES, stream, a); }
#else
    a.ph_lo = 0; a.ph_hi = NPHASES;
    hipLaunchKernelGGL(fwd, dim3(grid), dim3(512), LDS_BYTES, stream, a);
#endif
    const hipError_t le = hipPeekAtLastError();
    if (le != hipSuccess) fprintf(stderr, "kernel_launch: launch failed: %s\n", hipGetErrorName(le));
}
```

```cpp
#include <hip/hip_runtime.h>
#include <cstdio>
#include <cstdint>

constexpr int NB = 2, S = 16384, DM = 1024, M = NB * S;
constexpr int A_COLS = 4680, A_NPAD = 4864;
constexpr int BW = 2048, B_COLS = 3 * BW;
constexpr float RMS_EPS = 1e-6f, LN_EPS = 1e-5f;
constexpr float LOG2E = 1.4426950408889634f;
constexpr float QSCALE = 0.08838834764831845f * LOG2E;
constexpr float WI_SCALE = 0.35355339059327373f;
constexpr float QI_SCALE = 0.125f;
constexpr int TOPK = 256;

namespace pg8 {
#define PG8_LAS __attribute__((address_space(3)))
typedef unsigned short bf16_t;
typedef short bf16x8 __attribute__((ext_vector_type(8)));
typedef float f32x4 __attribute__((ext_vector_type(4)));
typedef unsigned u32x4 __attribute__((ext_vector_type(4)));
constexpr int BM = 256, BK = 64, HALF = 128, HTB = HALF * BK * 2  , STAGE_BYTES = 8 * HTB, NXCD = 8, WGM = 8;

__host__ __device__ __forceinline__ int lds_byte(int r, int c) { const int st = (r >> 4) * 2 + (c >> 5), rr = r & 15, cc = c & 31, ob = rr * 64 + cc * 2; return st * 1024 + (ob ^ (((ob >> 9) & 1) << 5)); }
__host__ __device__ __forceinline__ void stage_rc(int b, int& R, int& C) { const int st = b / 1024, sb = b % 1024, swz = sb ^ (((sb >> 9) & 1) << 5); R = (st >> 1) * 16 + swz / 64; C = (st & 1) * 32 + (swz % 64) / 2; }
__host__ __device__ __forceinline__ int perm32(int rho) { const int n = rho >> 4, i = rho & 15; return 8 * (i >> 2) + 4 * n + (i & 3); }

struct Unit { int pm, pn; };
struct Gemm { const bf16_t* A; const bf16_t* Bt; int M, N, K; };

struct StaticOrder {
    int nM, nN, nwg, G, c;
    __host__ __device__ void init(int M, int N, int G_, int c_) { nM = M / BM; nN = N / BM; nwg = nM * nN; G = G_; c = c_; }
    __host__ __device__ bool next(int i, Unit& u) const {
        const long L = (long)i * G + c; if (L >= nwg) return false;
        int wgid = (int)L; { const int q = nwg / NXCD, r = nwg % NXCD, xcd = wgid % NXCD, off = wgid / NXCD; wgid = (xcd < r ? xcd * (q + 1) : r * (q + 1) + (xcd - r) * q) + off; }
        const int nig = WGM * nN, gid = wgid / nig, fm = gid * WGM, gsz = (nM - fm) < WGM ? (nM - fm) : WGM;
        u.pm = fm + ((wgid % nig) % gsz); u.pn = (wgid % nig) / gsz; return true;
    }
    __device__ __forceinline__ void a_ready(const Unit&) const {}
    __device__ __forceinline__ void done(const Unit&) const {}
};

__device__ __forceinline__ unsigned cvt_pk_bf16(float lo, float hi) { unsigned r; asm volatile("v_cvt_pk_bf16_f32 %0, %1, %2" : "=v"(r) : "v"(lo), "v"(hi)); return r; }
typedef float f32x2 __attribute__((ext_vector_type(2)));
__device__ __forceinline__ float silu_f(float z) { return z * __builtin_amdgcn_rcpf(1.0f + __builtin_amdgcn_exp2f(-z * 1.4426950408889634f)); }

struct EpiA {
    static constexpr bool PERM = true, AFTER_DRAIN = false;
    bf16_t *Q, *K, *V, *ZS, *QI, *KI; float* WI; const float* RS;
    __device__ __forceinline__ void operator()(const f32x4 (&acc)[2][2][4][2], const Unit& u, int wr, int wc, int fr, int fq) const {
        const int pn = u.pn, row0 = u.pm * BM + wr * 64 + fr;
        if (pn < 18) {
            bf16_t* base; int ldc, colt; float sc = 1.f; bool act = false;
            if (pn < 4) { base = Q; ldc = 1024; colt = pn * 256; sc = 0.08838834764831845f * 1.4426950408889634f; }
            else if (pn < 8) { base = K; ldc = 1024; colt = (pn - 4) * 256; }
            else if (pn < 12) { base = V; ldc = 1024; colt = (pn - 8) * 256; }
            else if (pn < 16) { base = ZS; ldc = 1024; colt = (pn - 12) * 256; act = true; }
            else { base = QI; ldc = 512; colt = (pn - 16) * 256; sc = 0.125f; }
            const int col0 = colt + wc * 32 + 8 * fq;
#pragma unroll
            for (int ai = 0; ai < 2; ++ai)
#pragma unroll
                for (int m = 0; m < 4; ++m) { bf16_t* rowp = base + (size_t)(row0 + ai * HALF + m * 16) * ldc + col0; const float rs = RS[row0 + ai * HALF + m * 16] * sc;
#pragma unroll
                    for (int bj = 0; bj < 2; ++bj) { f32x4 v0 = acc[ai][bj][m][0] * rs, v1 = acc[ai][bj][m][1] * rs;
                        if (act) { v0 = (f32x4){silu_f(v0[0]), silu_f(v0[1]), silu_f(v0[2]), silu_f(v0[3])}; v1 = (f32x4){silu_f(v1[0]), silu_f(v1[1]), silu_f(v1[2]), silu_f(v1[3])}; }
                        u32x4 w; w.x = cvt_pk_bf16(v0[0], v0[1]); w.y = cvt_pk_bf16(v0[2], v0[3]); w.z = cvt_pk_bf16(v1[0], v1[1]); w.w = cvt_pk_bf16(v1[2], v1[3]);
                        *(u32x4*)(rowp + bj * HALF) = w; } }
        } else {
#pragma unroll
            for (int ai = 0; ai < 2; ++ai)
#pragma unroll
                for (int m = 0; m < 4; ++m) { const size_t row = (size_t)(row0 + ai * HALF + m * 16);
                    const float rs = RS[row]; const f32x4 v0 = acc[ai][0][m][0] * rs, v1 = acc[ai][0][m][1] * rs;
                    if (wc < 2) { u32x4 w; w.x = cvt_pk_bf16(v0[0], v0[1]); w.y = cvt_pk_bf16(v0[2], v0[3]); w.z = cvt_pk_bf16(v1[0], v1[1]); w.w = cvt_pk_bf16(v1[2], v1[3]);
                        *(u32x4*)(KI + row * 64 + wc * 32 + 8 * fq) = w; }
                    else if (wc == 2 && fq == 0) { const float s = 0.35355339059327373f; *(f32x4*)(WI + row * 8) = v0 * s; *(f32x4*)(WI + row * 8 + 4) = v1 * s; } }
        }
    }
};

struct EpiB {
    static constexpr bool PERM = true, AFTER_DRAIN = false;
    bf16_t* Gt; bf16_t* Vt;
    const float* PS;
    float* LNP;
    __device__ __forceinline__ float rowscale(const float* psrow) const {
        const f32x4* pp = (const f32x4*)psrow; const f32x4 q0 = pp[0], q1 = pp[1], q2 = pp[2], q3 = pp[3];
        const float ss = ((q0[0] + q0[1]) + (q0[2] + q0[3])) + ((q1[0] + q1[1]) + (q1[2] + q1[3])) + ((q2[0] + q2[1]) + (q2[2] + q2[3])) + ((q3[0] + q3[1]) + (q3[2] + q3[3]));
        return 1.0f / sqrtf(ss * (1.f / 1024.f) + 1e-6f); }
    __device__ __forceinline__ void operator()(const f32x4 (&acc)[2][2][4][2], const Unit& u, int wr, int wc, int fr, int fq) const {
        const int pn = u.pn, row0 = u.pm * BM + wr * 64 + fr;
        const float* psrow = PS + (size_t)row0 * 16;
        if (pn < 16) {
            bf16_t* p = Gt + (size_t)row0 * 2048 + pn * 128 + wc * 32 + 8 * fq;
#pragma unroll
            for (int ai = 0; ai < 2; ++ai)
#pragma unroll
                for (int m = 0; m < 4; ++m) { const float rs = rowscale(psrow + (size_t)(ai * HALF + m * 16) * 16);
                    const f32x4 u0 = acc[ai][0][m][0] * rs, u1 = acc[ai][0][m][1] * rs, z0 = acc[ai][1][m][0] * rs, z1 = acc[ai][1][m][1] * rs;
                    u32x4 w; w.x = cvt_pk_bf16(u0[0] * silu_f(z0[0]), u0[1] * silu_f(z0[1])); w.y = cvt_pk_bf16(u0[2] * silu_f(z0[2]), u0[3] * silu_f(z0[3]));
                    w.z = cvt_pk_bf16(u1[0] * silu_f(z1[0]), u1[1] * silu_f(z1[1])); w.w = cvt_pk_bf16(u1[2] * silu_f(z1[2]), u1[3] * silu_f(z1[3]));
                    *(u32x4*)(p + (size_t)(ai * HALF + m * 16) * 2048) = w; }
        } else {
            const int tv = pn - 16; bf16_t* p = Vt + (size_t)row0 * 2048 + tv * 256 + wc * 32 + 8 * fq;
#pragma unroll
            for (int ai = 0; ai < 2; ++ai)
#pragma unroll
                for (int m = 0; m < 4; ++m) { const int ro = ai * HALF + m * 16; const float rs = rowscale(psrow + (size_t)ro * 16); float s1 = 0.f, s2 = 0.f;
#pragma unroll
                    for (int bj = 0; bj < 2; ++bj) { const f32x4 v0 = acc[ai][bj][m][0] * rs, v1 = acc[ai][bj][m][1] * rs;
                        s1 += ((v0[0] + v0[1]) + (v0[2] + v0[3])) + ((v1[0] + v1[1]) + (v1[2] + v1[3]));
                        s2 += ((v0[0] * v0[0] + v0[1] * v0[1]) + (v0[2] * v0[2] + v0[3] * v0[3])) + ((v1[0] * v1[0] + v1[1] * v1[1]) + (v1[2] * v1[2] + v1[3] * v1[3]));
                        u32x4 w; w.x = cvt_pk_bf16(v0[0], v0[1]); w.y = cvt_pk_bf16(v0[2], v0[3]); w.z = cvt_pk_bf16(v1[0], v1[1]); w.w = cvt_pk_bf16(v1[2], v1[3]);
                        *(u32x4*)(p + (size_t)ro * 2048 + bj * HALF) = w; }
                    s1 += __shfl_xor(s1, 16); s1 += __shfl_xor(s1, 32); s2 += __shfl_xor(s2, 16); s2 += __shfl_xor(s2, 32);
                    if (fq == 0) { typedef float f32x2_ __attribute__((ext_vector_type(2))); *(f32x2_*)(LNP + ((size_t)(row0 + ro) * 32 + tv * 4 + wc) * 2) = (f32x2_){s1, s2}; } }
        }
    }
};

struct EpiRes2 {
    static constexpr bool PERM = true, AFTER_DRAIN = false;
    bf16_t* XB;
    __device__ __forceinline__ void operator()(const f32x4 (&acc)[2][2][4][2], const Unit& u, int wr, int wc, int fr, int fq) const {
        const int row0 = u.pm * BM + wr * 64 + fr, col0 = u.pn * BM + wc * 32 + 8 * fq;
#pragma unroll
        for (int ai = 0; ai < 2; ++ai) { u32x4 bb[4][2];
#pragma unroll
            for (int m = 0; m < 4; ++m)
#pragma unroll
                for (int bj = 0; bj < 2; ++bj) bb[m][bj] = *(const u32x4*)(XB + (size_t)(row0 + ai * HALF + m * 16) * 1024 + col0 + bj * HALF);
#pragma unroll
            for (int m = 0; m < 4; ++m)
#pragma unroll
                for (int bj = 0; bj < 2; ++bj) { const u32x4 b = bb[m][bj]; const f32x4 a0 = acc[ai][bj][m][0], a1 = acc[ai][bj][m][1]; u32x4 w;
                    w.x = cvt_pk_bf16(__uint_as_float(b.x << 16) + a0[0], __uint_as_float(b.x & 0xffff0000u) + a0[1]);
                    w.y = cvt_pk_bf16(__uint_as_float(b.y << 16) + a0[2], __uint_as_float(b.y & 0xffff0000u) + a0[3]);
                    w.z = cvt_pk_bf16(__uint_as_float(b.z << 16) + a1[0], __uint_as_float(b.z & 0xffff0000u) + a1[1]);
                    w.w = cvt_pk_bf16(__uint_as_float(b.w << 16) + a1[2], __uint_as_float(b.w & 0xffff0000u) + a1[3]);
                    *(u32x4*)(XB + (size_t)(row0 + ai * HALF + m * 16) * 1024 + col0 + bj * HALF) = w; } }
    }
};

struct EpiRes1 {
    static constexpr bool PERM = true, AFTER_DRAIN = false;
    bf16_t* XB; float* PS;
    __device__ __forceinline__ void operator()(const f32x4 (&acc)[2][2][4][2], const Unit& u, int wr, int wc, int fr, int fq) const {
        const int row0 = u.pm * BM + wr * 64 + fr, col0 = u.pn * BM + wc * 32 + 8 * fq;
#pragma unroll
        for (int ai = 0; ai < 2; ++ai) { u32x4 bb[4][2];
#pragma unroll
            for (int m = 0; m < 4; ++m)
#pragma unroll
                for (int bj = 0; bj < 2; ++bj) bb[m][bj] = *(const u32x4*)(XB + (size_t)(row0 + ai * HALF + m * 16) * 1024 + col0 + bj * HALF);
#pragma unroll
            for (int m = 0; m < 4; ++m) { const size_t row = (size_t)(row0 + ai * HALF + m * 16); float ss = 0.f;
#pragma unroll
                for (int bj = 0; bj < 2; ++bj) { const u32x4 b = bb[m][bj]; const f32x4 a0 = acc[ai][bj][m][0], a1 = acc[ai][bj][m][1];
                    const f32x4 v0 = {__uint_as_float(b.x << 16) + a0[0], __uint_as_float(b.x & 0xffff0000u) + a0[1], __uint_as_float(b.y << 16) + a0[2], __uint_as_float(b.y & 0xffff0000u) + a0[3]};
                    const f32x4 v1 = {__uint_as_float(b.z << 16) + a1[0], __uint_as_float(b.z & 0xffff0000u) + a1[1], __uint_as_float(b.w << 16) + a1[2], __uint_as_float(b.w & 0xffff0000u) + a1[3]};
                    ss += ((v0[0] * v0[0] + v0[1] * v0[1]) + (v0[2] * v0[2] + v0[3] * v0[3])) + ((v1[0] * v1[0] + v1[1] * v1[1]) + (v1[2] * v1[2] + v1[3] * v1[3]));
                    u32x4 w; w.x = cvt_pk_bf16(v0[0], v0[1]); w.y = cvt_pk_bf16(v0[2], v0[3]); w.z = cvt_pk_bf16(v1[0], v1[1]); w.w = cvt_pk_bf16(v1[2], v1[3]);
                    *(u32x4*)(XB + row * 1024 + col0 + bj * HALF) = w; }
                ss += __shfl_xor(ss, 16); ss += __shfl_xor(ss, 32);
                if (fq == 0) PS[row * 16 + u.pn * 4 + wc] = ss; } }
    }
};

template <class Epi, class Sched, bool ALIGN_EPI = false, bool SP2 = false>
__device__ __forceinline__ void gemm_phase(PG8_LAS unsigned char* lds, const Gemm g, const Sched& S, const Epi& E) {
    const int tid = threadIdx.x, wid = __builtin_amdgcn_readfirstlane(tid >> 6), lane = tid & 63, wr = wid >> 2, wc = wid & 3, fr = lane & 15, fq = lane >> 4;
    const int K = g.K, nt = K / BK;
    unsigned voffA[2], voffB[2];
#pragma unroll
    for (int i = 0; i < 2; ++i) { int R, C; stage_rc(tid * 16 + i * 8192, R, C); const int Rb = Epi::PERM ? ((R & ~31) + perm32(R & 31)) : R;
        voffA[i] = (unsigned)(R * K + C) * 2u; voffB[i] = (unsigned)(Rb * K + C) * 2u; }
    const size_t kstep = (size_t)(BK * 2);
    const size_t hstep = (size_t)HALF * K * 2;
    const size_t tstep = 2 * hstep;
    const unsigned ldsw = (unsigned)wid * 1024u;
    const int aoff = lds_byte(wr * 64 + fr, fq * 8), boff = lds_byte(wc * 32 + fr, fq * 8);
#define PG8_SA(b, h) (((b) * 2 + (h)) * HTB)
#define PG8_SB(b, h) ((4 + (b) * 2 + (h)) * HTB)
#define PG8_STAGE(bufoff, gbase, voff) do { _Pragma("unroll") for (int _i = 0; _i < 2; ++_i) \
        __builtin_amdgcn_global_load_lds((const unsigned*)((const char*)(gbase) + (voff)[_i]), (PG8_LAS unsigned*)(lds + (bufoff) + ldsw + _i * 8192), 16, 0, 0); } while (0)
#define PG8_LDA(dst, b, h) do { _Pragma("unroll") for (int m = 0; m < 4; ++m) _Pragma("unroll") for (int k = 0; k < 2; ++k) dst[m][k] = *(const PG8_LAS bf16x8*)(lds + PG8_SA(b, h) + aoff + m * 2048 + k * 1024); } while (0)
#define PG8_LDB(dst, b, h) do { _Pragma("unroll") for (int n = 0; n < 2; ++n) _Pragma("unroll") for (int k = 0; k < 2; ++k) dst[n][k] = *(const PG8_LAS bf16x8*)(lds + PG8_SB(b, h) + boff + n * 2048 + k * 1024); } while (0)
#define PG8_MMA(ai, bj, At, Bt) do { __builtin_amdgcn_s_setprio(1); _Pragma("unroll") for (int m = 0; m < 4; ++m) _Pragma("unroll") for (int n = 0; n < 2; ++n) _Pragma("unroll") for (int k = 0; k < 2; ++k) \
        acc[ai][bj][m][n] = __builtin_amdgcn_mfma_f32_16x16x32_bf16(Bt[n][k], At[m][k], acc[ai][bj][m][n], 0, 0, 0); __builtin_amdgcn_s_setprio(0); } while (0)
#define PG8_WAIT_V(n) asm volatile("s_waitcnt vmcnt(" #n ")" ::: "memory")
#define PG8_WAIT_L(n) asm volatile("s_waitcnt lgkmcnt(" #n ")" ::: "memory")
#define PG8_BAR __builtin_amdgcn_s_barrier()
#define PG8_SCHED __builtin_amdgcn_sched_barrier(0)
    Unit cur, nxt; int ui = 0;
    if (!S.next(0, cur)) return;
    f32x4 acc[2][2][4][2];
#pragma unroll
    for (int a = 0; a < 2; ++a)
#pragma unroll
        for (int b = 0; b < 2; ++b)
#pragma unroll
            for (int m = 0; m < 4; ++m)
#pragma unroll
                for (int n = 0; n < 2; ++n) acc[a][b][m][n] = (f32x4){0.f, 0.f, 0.f, 0.f};
    bf16x8 At[4][2], B0[2][2], B1[2][2];
    const char* cA = (const char*)g.A + (size_t)cur.pm * tstep; const char* cB = (const char*)g.Bt + (size_t)cur.pn * tstep;
    S.a_ready(cur);
    if constexpr (SP2) {
        PG8_STAGE(PG8_SB(0, 0), cB, voffB); PG8_STAGE(PG8_SB(0, 1), cB + hstep, voffB); PG8_STAGE(PG8_SA(0, 0), cA, voffA); PG8_STAGE(PG8_SA(0, 1), cA + hstep, voffA);
        if (wr == 1) PG8_BAR;
        PG8_WAIT_V(2); PG8_BAR;
        PG8_STAGE(PG8_SB(1, 0), cB + kstep, voffB); PG8_STAGE(PG8_SA(1, 0), cA + kstep, voffA); PG8_STAGE(PG8_SB(1, 1), cB + hstep + kstep, voffB);
        PG8_WAIT_V(6); PG8_BAR;
    } else {
        PG8_STAGE(PG8_SB(0, 0), cB, voffB); PG8_STAGE(PG8_SA(0, 0), cA, voffA); PG8_STAGE(PG8_SB(0, 1), cB + hstep, voffB); PG8_STAGE(PG8_SA(0, 1), cA + hstep, voffA);
        if (wr == 1) PG8_BAR;
        PG8_WAIT_V(4); PG8_BAR;
        PG8_STAGE(PG8_SB(1, 0), cB + kstep, voffB); PG8_STAGE(PG8_SA(1, 0), cA + kstep, voffA); PG8_STAGE(PG8_SB(1, 1), cB + hstep + kstep, voffB);
        PG8_WAIT_V(6); PG8_BAR;
    }
    for (;;) {
        const bool has_next = S.next(ui + 1, nxt);
        const char* nA = has_next ? (const char*)g.A + (size_t)nxt.pm * tstep : cA; const char* nB = has_next ? (const char*)g.Bt + (size_t)nxt.pn * tstep : cB;
        for (int t = 0; t < nt; t += 2) {
            const bool last = (t == nt - 2);
            const char* a1 = cA + (size_t)(t + 1) * kstep;
            const char* a2 = last ? nA : cA + (size_t)(t + 2) * kstep; const char* b2 = last ? nB : cB + (size_t)(t + 2) * kstep;
            const char* a3 = a2 + kstep; const char* b3 = b2 + kstep;
            if (last && has_next) S.a_ready(nxt);
            if constexpr (SP2) {
            PG8_LDB(B0, 0, 0); PG8_LDB(B1, 0, 1); PG8_SCHED; PG8_LDA(At, 0, 0); PG8_STAGE(PG8_SA(1, 1), a1 + hstep, voffA);
            PG8_WAIT_V(8); PG8_WAIT_L(0); PG8_BAR; PG8_MMA(0, 0, At, B0); PG8_MMA(0, 1, At, B1); PG8_BAR; PG8_SCHED;
            PG8_LDA(At, 0, 1); PG8_STAGE(PG8_SB(0, 0), b2, voffB); PG8_STAGE(PG8_SB(0, 1), b2 + hstep, voffB); PG8_STAGE(PG8_SA(0, 0), a2, voffA);
            PG8_WAIT_V(8); PG8_WAIT_L(0); PG8_BAR; PG8_MMA(1, 0, At, B0); PG8_MMA(1, 1, At, B1); PG8_BAR; PG8_SCHED;
            PG8_LDB(B0, 1, 0); PG8_LDB(B1, 1, 1); PG8_SCHED; PG8_LDA(At, 1, 0); PG8_STAGE(PG8_SA(0, 1), a2 + hstep, voffA);
            PG8_WAIT_V(8); PG8_WAIT_L(0); PG8_BAR; PG8_MMA(0, 0, At, B0); PG8_MMA(0, 1, At, B1); PG8_BAR; PG8_SCHED;
            PG8_LDA(At, 1, 1); PG8_STAGE(PG8_SB(1, 0), b3, voffB); PG8_STAGE(PG8_SB(1, 1), b3 + hstep, voffB); PG8_STAGE(PG8_SA(1, 0), a3, voffA);
            PG8_WAIT_V(8); PG8_WAIT_L(0); PG8_BAR; PG8_MMA(1, 0, At, B0); PG8_MMA(1, 1, At, B1); PG8_BAR; PG8_SCHED;
            } else {
            PG8_LDB(B0, 0, 0); PG8_SCHED; PG8_LDA(At, 0, 0); PG8_STAGE(PG8_SA(1, 1), a1 + hstep, voffA);
            PG8_WAIT_L(8); PG8_BAR; PG8_WAIT_L(0); PG8_MMA(0, 0, At, B0); PG8_BAR; PG8_SCHED;
            PG8_LDB(B1, 0, 1); PG8_STAGE(PG8_SB(0, 0), b2, voffB);
            PG8_BAR; PG8_WAIT_L(0); PG8_MMA(0, 1, At, B1); PG8_BAR;
            PG8_LDA(At, 0, 1); PG8_STAGE(PG8_SA(0, 0), a2, voffA);
            PG8_BAR; PG8_WAIT_L(0); PG8_MMA(1, 0, At, B0); PG8_BAR; PG8_SCHED;
            PG8_STAGE(PG8_SB(0, 1), b2 + hstep, voffB);
            PG8_WAIT_V(6); PG8_BAR; PG8_MMA(1, 1, At, B1); PG8_BAR;
            PG8_LDB(B0, 1, 0); PG8_SCHED; PG8_LDA(At, 1, 0); PG8_STAGE(PG8_SA(0, 1), a2 + hstep, voffA);
            PG8_WAIT_L(8); PG8_BAR; PG8_WAIT_L(0); PG8_MMA(0, 0, At, B0); PG8_BAR; PG8_SCHED;
            PG8_LDB(B1, 1, 1); PG8_STAGE(PG8_SB(1, 0), b3, voffB);
            PG8_BAR; PG8_WAIT_L(0); PG8_MMA(0, 1, At, B1); PG8_BAR;
            PG8_LDA(At, 1, 1); PG8_STAGE(PG8_SA(1, 0), a3, voffA);
            PG8_BAR; PG8_WAIT_L(0); PG8_MMA(1, 0, At, B0); PG8_BAR; PG8_SCHED;
            PG8_STAGE(PG8_SB(1, 1), b3 + hstep, voffB);
            PG8_WAIT_V(6); PG8_BAR; PG8_MMA(1, 1, At, B1); PG8_BAR;
            }
        }
        if constexpr (ALIGN_EPI) { if (wr == 0) PG8_BAR; }
        if constexpr (!Epi::AFTER_DRAIN) { E(acc, cur, wr, wc, fr, fq); S.done(cur); }
        if (!has_next) break;
#pragma unroll
        for (int a = 0; a < 2; ++a)
#pragma unroll
            for (int b = 0; b < 2; ++b)
#pragma unroll
                for (int m = 0; m < 4; ++m)
#pragma unroll
                    for (int n = 0; n < 2; ++n) acc[a][b][m][n] = (f32x4){0.f, 0.f, 0.f, 0.f};
        cur = nxt; cA = nA; cB = nB; ++ui;
        if constexpr (ALIGN_EPI) { if (wr == 1) PG8_BAR; }
    }
    PG8_WAIT_V(0);
    if constexpr (!ALIGN_EPI) { if (wr == 0) PG8_BAR; }
    PG8_BAR;
    if constexpr (Epi::AFTER_DRAIN) { E.fused(acc, cur, wr, wc, fr, fq, lds, wid, lane); S.done(cur); }
#undef PG8_SA
#undef PG8_SB
#undef PG8_STAGE
#undef PG8_LDA
#undef PG8_LDB
#undef PG8_MMA
#undef PG8_WAIT_V
#undef PG8_WAIT_L
#undef PG8_BAR
#undef PG8_SCHED
}
}
#define LAS __attribute__((address_space(3)))
typedef unsigned short bf16;
typedef float f32x4 __attribute__((ext_vector_type(4)));
typedef unsigned v4u __attribute__((ext_vector_type(4)));
typedef unsigned v2u __attribute__((ext_vector_type(2)));
__device__ __forceinline__ unsigned f2bf(float f) { unsigned u = __builtin_bit_cast(unsigned, f); return (u + 0x7fffu + ((u >> 16) & 1u)) >> 16; }
__device__ __forceinline__ unsigned pk2(float lo, float hi) { return f2bf(lo) | (f2bf(hi) << 16); }
__device__ __forceinline__ float bflo(unsigned w) { return __builtin_bit_cast(float, w << 16); }
__device__ __forceinline__ float bfhi(unsigned w) { return __builtin_bit_cast(float, w & 0xffff0000u); }
__device__ __forceinline__ float wave_sum(float v) {
#pragma unroll
    for (int o = 1; o < 64; o <<= 1) v += __shfl_xor(v, o);
    return v;
}
__device__ __forceinline__ float wave_max(float v) {
#pragma unroll
    for (int o = 1; o < 64; o <<= 1) v = fmaxf(v, __shfl_xor(v, o));
    return v;
}
__device__ __forceinline__ int t5_bucket(int rel) {
    const int ret = rel < 0 ? 16 : 0; const int n = rel < 0 ? -rel : rel;
    int v;
    if (n < 8) v = n; else if (n < 12) v = 8; else if (n < 16) v = 9; else if (n < 23) v = 10; else if (n < 32) v = 11; else if (n < 46) v = 12; else if (n < 64) v = 13; else if (n < 91) v = 14; else v = 15;
    return ret + v;
}

__device__ __forceinline__ void transpose_item(const float* W, int K, int N, int Npad, bf16* WT, LAS float* scr, int item, int lane, const float* gk = nullptr  , bool uzv = false  ) {
    const int nblk = Npad / 32, kb = item / nblk, nb = item % nblk, k0 = 64 * kb, n0 = 32 * nb;
    const int nn = n0 + (lane & 31);
    const int d0 = !uzv ? n0 : n0 < 2048 ? 256 * (n0 >> 7) + (n0 & 127) : n0 < 4096 ? n0 + 2048 : 256 * ((n0 - 4096) >> 7) + 128 + (n0 & 127);
#pragma unroll 8
    for (int i = 0; i < 32; ++i) { const int kk = 2 * i + (lane >> 5); scr[kk * 33 + (lane & 31)] = nn < N ? W[(size_t)(k0 + kk) * N + nn] * (gk ? gk[k0 + kk] : 1.f) : 0.f; }
    asm volatile("s_waitcnt lgkmcnt(0)" ::: "memory");
    const int c = lane & 7;
#pragma unroll
    for (int j = 0; j < 4; ++j) { const int n = (lane >> 3) + 8 * j; const LAS float* s = scr + (8 * c) * 33 + n;
        v4u o; o.x = pk2(s[0 * 33], s[1 * 33]); o.y = pk2(s[2 * 33], s[3 * 33]); o.z = pk2(s[4 * 33], s[5 * 33]); o.w = pk2(s[6 * 33], s[7 * 33]);
        *(v4u*)(WT + (size_t)(d0 + n) * K + k0 + 8 * c) = o; }
    asm volatile("s_waitcnt lgkmcnt(0)" ::: "memory");
}
__device__ __forceinline__ void rms_row_to_bf16(const float* xrow, const float* g, bf16* orow, int lane) {
    const f32x4* xr = (const f32x4*)xrow + lane; const f32x4* gr = (const f32x4*)g + lane;
    f32x4 v[4]; float s = 0.f;
#pragma unroll
    for (int j = 0; j < 4; ++j) { v[j] = xr[64 * j]; s += (v[j].x * v[j].x + v[j].y * v[j].y) + (v[j].z * v[j].z + v[j].w * v[j].w); }
    const float rs = 1.0f / sqrtf(wave_sum(s) * (1.f / 1024.f) + RMS_EPS);
    v2u* o8 = (v2u*)orow + lane;
#pragma unroll
    for (int j = 0; j < 4; ++j) { const f32x4 gg = gr[64 * j]; v2u o; o.x = pk2(v[j].x * rs * gg.x, v[j].y * rs * gg.y); o.y = pk2(v[j].z * rs * gg.z, v[j].w * rs * gg.w); o8[64 * j] = o; }
}
__device__ __forceinline__ void rms_row_f32(const float* xrow, const float* g, float* orow, int lane) {
    const f32x4* xr = (const f32x4*)xrow + lane; const f32x4* gr = (const f32x4*)g + lane;
    f32x4 v[4]; float s = 0.f;
#pragma unroll
    for (int j = 0; j < 4; ++j) { v[j] = xr[64 * j]; s += (v[j].x * v[j].x + v[j].y * v[j].y) + (v[j].z * v[j].z + v[j].w * v[j].w); }
    const float rs = 1.0f / sqrtf(wave_sum(s) * (1.f / 1024.f) + RMS_EPS);
    f32x4* o = (f32x4*)orow + lane;
#pragma unroll
    for (int j = 0; j < 4; ++j) { const f32x4 gg = gr[64 * j]; o[64 * j] = v[j] * rs * gg; }
}


__device__ __forceinline__ void rms_row_bf16_to_f32(const bf16* xrow, const float* g, float* orow, int lane) {
    typedef unsigned u32x4_ __attribute__((ext_vector_type(4)));
    float v[2][8]; float s = 0.f;
#pragma unroll
    for (int j = 0; j < 2; ++j) { const u32x4_ b = *((const u32x4_*)xrow + 64 * j + lane);
        v[j][0] = __uint_as_float(b.x << 16); v[j][1] = __uint_as_float(b.x & 0xffff0000u); v[j][2] = __uint_as_float(b.y << 16); v[j][3] = __uint_as_float(b.y & 0xffff0000u);
        v[j][4] = __uint_as_float(b.z << 16); v[j][5] = __uint_as_float(b.z & 0xffff0000u); v[j][6] = __uint_as_float(b.w << 16); v[j][7] = __uint_as_float(b.w & 0xffff0000u);
#pragma unroll
        for (int e = 0; e < 8; ++e) s += v[j][e] * v[j][e]; }
    const float rs = 1.0f / sqrtf(wave_sum(s) * (1.f / 1024.f) + RMS_EPS);
#pragma unroll
    for (int j = 0; j < 2; ++j) { const f32x4* gr = (const f32x4*)g + 128 * j + 2 * lane; f32x4* o = (f32x4*)orow + 128 * j + 2 * lane; const f32x4 g0 = gr[0], g1 = gr[1];
        o[0] = (f32x4){v[j][0] * rs * g0.x, v[j][1] * rs * g0.y, v[j][2] * rs * g0.z, v[j][3] * rs * g0.w};
        o[1] = (f32x4){v[j][4] * rs * g1.x, v[j][5] * rs * g1.y, v[j][6] * rs * g1.z, v[j][7] * rs * g1.w}; }
}

__device__ __forceinline__ void row_to_bf16_rs(const float* xrow, bf16* orow, float* rs_out, int lane) {
    const f32x4* xr = (const f32x4*)xrow + lane;
    f32x4 v[4]; float s = 0.f;
#pragma unroll
    for (int j = 0; j < 4; ++j) { v[j] = xr[64 * j]; s += (v[j].x * v[j].x + v[j].y * v[j].y) + (v[j].z * v[j].z + v[j].w * v[j].w); }
    v2u* o8 = (v2u*)orow + lane;
#pragma unroll
    for (int j = 0; j < 4; ++j) { v2u o; o.x = pk2(v[j].x, v[j].y); o.y = pk2(v[j].z, v[j].w); o8[64 * j] = o; }
    const float rs = 1.0f / sqrtf(wave_sum(s) * (1.f / 1024.f) + RMS_EPS);
    if (lane == 0) *rs_out = rs;
}
namespace idx {
typedef unsigned short bf16;
typedef short bf16x8 __attribute__((ext_vector_type(8)));
typedef float f32x16 __attribute__((ext_vector_type(16)));
typedef unsigned long long u64;
constexpr int NBINS = 256, HSTR = 257, CAP = 512, FCAP = 2048;
constexpr int OFF_HIST = 0;
constexpr int OFF_QL = 66048;
constexpr int OFF_STAT = 64 * 513 * 4 + 128;
constexpr int OFF_QPAR = OFF_STAT + 2048;
constexpr int OFF_BSTAR = OFF_QPAR + 512, OFF_NEED = OFF_BSTAR + 256, OFF_BCNT = OFF_NEED + 256;
constexpr int OFF_FB = OFF_BCNT + 256;
constexpr int OFF_FBH = OFF_FB + 512;
constexpr int OFF_QF = OFF_FBH + 1024 + 64;
constexpr int OFF_WV = OFF_QF + 2048;
constexpr int OFF_FLAT = OFF_WV + 2048;
constexpr int IDX_LDS_BYTES = OFF_FLAT + 2 * FCAP * 4;
#ifndef IDX_REPS
#define IDX_REPS 1
#endif
#ifndef DBG_FORCE_FB
#define DBG_FORCE_FB 0
#endif

__device__ __forceinline__ int crow(int r, int hi) { return (r & 3) + 8 * (r >> 2) + 4 * hi; }
__device__ __forceinline__ float z_upper(float p) {
    const bool flip = p > 0.5f; const float pp = flip ? 1.f - p : p; const float t = sqrtf(-2.f * logf(pp));
    float num = 2.515517f + t * (0.802853f + t * 0.010328f); asm volatile("" : "+v"(num));
    const float den = 1.f + t * (1.432788f + t * (0.189269f + t * 0.001308f));
    const float z = t - num / den;
    return flip ? -z : z;
}
typedef float f32x4_t __attribute__((ext_vector_type(4)));
__device__ __forceinline__ void load_a16(bf16x8 (&a)[2][2], const char* kib, int j, int l15, int kq) {
    const char* kp = kib + (size_t)(unsigned)((j * 32 + l15) * 128 + kq * 16);
#pragma unroll
    for (int rb = 0; rb < 2; ++rb)
#pragma unroll
        for (int ks = 0; ks < 2; ++ks) a[rb][ks] = *reinterpret_cast<const bf16x8*>(kp + rb * 2048 + ks * 64);
}
template <bool PF>
__device__ __forceinline__ void tile_scores16(bf16x8 (&a)[2][2], const bf16x8 (&qreg)[8][2][2], const char* qlp  , const float* wv0, const float* wv1, float (&sc)[16], const char* kib, int jn, int l15, int kq) {
    f32x4_t dl[2][2]; bf16x8 qL[2][2];
#pragma unroll
    for (int cb = 0; cb < 2; ++cb)
#pragma unroll
        for (int ks = 0; ks < 2; ++ks) qL[cb][ks] = *reinterpret_cast<const bf16x8*>(qlp + (cb * 2 + ks) * 8192);
#pragma unroll
    for (int rb = 0; rb < 2; ++rb)
#pragma unroll
        for (int cb = 0; cb < 2; ++cb) { f32x4_t t = {0.f, 0.f, 0.f, 0.f};
#pragma unroll
            for (int ks = 0; ks < 2; ++ks) t = __builtin_amdgcn_mfma_f32_16x16x32_bf16(a[rb][ks], qL[cb][ks], t, 0, 0, 0);
            dl[rb][cb] = t; }
#pragma unroll
    for (int h = 0; h < 8; ++h) { f32x4_t d[2][2];
#pragma unroll
        for (int rb = 0; rb < 2; ++rb)
#pragma unroll
            for (int cb = 0; cb < 2; ++cb) { f32x4_t t = {0.f, 0.f, 0.f, 0.f};
#pragma unroll
                for (int ks = 0; ks < 2; ++ks) t = __builtin_amdgcn_mfma_f32_16x16x32_bf16(a[rb][ks], qreg[h][cb][ks], t, 0, 0, 0);
                d[rb][cb] = t; }
        asm volatile("" ::: "memory");
        if (PF && h == 7) load_a16(a, kib, jn, l15, kq);
        const float w0 = wv0[h], w1 = wv1[h];
#pragma unroll
        for (int rb = 0; rb < 2; ++rb)
#pragma unroll
            for (int cb = 0; cb < 2; ++cb)
#pragma unroll
                for (int r = 0; r < 4; ++r) { const int i = (2 * rb + cb) * 4 + r; sc[i] = fmaf(cb ? w1 : w0, __builtin_fabsf(d[rb][cb][r]), h == 0 ? dl[rb][cb][r] : sc[i]); } }
}
__device__ __forceinline__ unsigned fkey(float f) { const unsigned u = __builtin_bit_cast(unsigned, f); return (u & 0x80000000u) ? ~u : (u | 0x80000000u); }

__device__ __forceinline__ void mask_or_bit(u64* mwq, int qc, int s) {
    const int kk = s & 31, hk = (kk >> 2) & 1, r = (kk & 3) + 4 * (kk >> 3);
    __hip_atomic_fetch_or(mwq + (size_t)(s >> 5) * 16 + r, 1ull << (qc + 32 * hk), __ATOMIC_RELAXED, __HIP_MEMORY_SCOPE_AGENT);
}

__device__ __forceinline__ void fallback_query(char* lds, int tid, int tg  , int qc, int n, const bf16* QI, const char* kib, const float* WI, u64* mwq) {
    asm volatile("" : "+v"(tid));
    float* sc = (float*)(lds + OFF_HIST); unsigned* hist = (unsigned*)(lds + OFF_FBH); unsigned* misc = hist + 256; float* qf = (float*)(lds + OFF_QF);
    __syncthreads();
    if (tid < 256) { const unsigned w = ((const unsigned*)(QI + (size_t)tg * 512))[tid]; qf[2 * tid] = __builtin_bit_cast(float, w << 16); qf[2 * tid + 1] = __builtin_bit_cast(float, w & 0xffff0000u); }
    __syncthreads();
    for (int s = tid; s < n; s += 1024) {
        const int s2 = s + 512 < n ? s + 512 : s;
        const uint4* kp0 = (const uint4*)(kib + (size_t)s * 128); const uint4* kp1 = (const uint4*)(kib + (size_t)s2 * 128);
        float kf0[64], kf1[64];
#pragma unroll
        for (int c = 0; c < 8; ++c) { const uint4 w = kp0[c], x = kp1[c];
            kf0[8 * c] = __builtin_bit_cast(float, w.x << 16); kf0[8 * c + 1] = __builtin_bit_cast(float, w.x & 0xffff0000u); kf0[8 * c + 2] = __builtin_bit_cast(float, w.y << 16); kf0[8 * c + 3] = __builtin_bit_cast(float, w.y & 0xffff0000u);
            kf0[8 * c + 4] = __builtin_bit_cast(float, w.z << 16); kf0[8 * c + 5] = __builtin_bit_cast(float, w.z & 0xffff0000u); kf0[8 * c + 6] = __builtin_bit_cast(float, w.w << 16); kf0[8 * c + 7] = __builtin_bit_cast(float, w.w & 0xffff0000u);
            kf1[8 * c] = __builtin_bit_cast(float, x.x << 16); kf1[8 * c + 1] = __builtin_bit_cast(float, x.x & 0xffff0000u); kf1[8 * c + 2] = __builtin_bit_cast(float, x.y << 16); kf1[8 * c + 3] = __builtin_bit_cast(float, x.y & 0xffff0000u);
            kf1[8 * c + 4] = __builtin_bit_cast(float, x.z << 16); kf1[8 * c + 5] = __builtin_bit_cast(float, x.z & 0xffff0000u); kf1[8 * c + 6] = __builtin_bit_cast(float, x.w << 16); kf1[8 * c + 7] = __builtin_bit_cast(float, x.w & 0xffff0000u); }
        float sc0 = 0.f, sc1 = 0.f;
#pragma unroll 1
        for (int h = 0; h < 8; ++h) { float d0 = 0.f, d1 = 0.f;
#pragma unroll
            for (int j = 0; j < 64; ++j) { const float qv = qf[h * 64 + j]; d0 = fmaf(qv, kf0[j], d0); d1 = fmaf(qv, kf1[j], d1); }
            const float w = WI[(size_t)tg * 8 + h]; sc0 = fmaf(w, fmaxf(d0, 0.f), sc0); sc1 = fmaf(w, fmaxf(d1, 0.f), sc1); }
        sc[s] = sc0; sc[s2] = sc1;
    }
    __syncthreads();
    unsigned prefix = 0u, need = TOPK, eq_total = 0u;
    for (int pass = 0; pass < 4; ++pass) {
        const int shift = 24 - 8 * pass; const unsigned mask = pass == 0 ? 0u : (0xFFFFFFFFu << (shift + 8));
        if (tid < 256) hist[tid] = 0u;
        __syncthreads();
        for (int s = tid; s < n; s += 512) { const unsigned k = fkey(sc[s]); if ((k & mask) == (prefix & mask)) atomicAdd(&hist[(k >> shift) & 255u], 1u); }
        __syncthreads();
        if (tid == 0) { unsigned c = 0u; int bin = 255; for (; bin > 0; --bin) { if (c + hist[bin] >= need) break; c += hist[bin]; }
            misc[0] = (unsigned)bin; misc[1] = need - c; misc[2] = hist[bin]; }
        __syncthreads();
        prefix |= misc[0] << shift; need = misc[1]; eq_total = misc[2];
        __syncthreads();
    }
    const int nw = (n >> 5) * 16; const u64 clr = ~((1ull << qc) | (1ull << (qc + 32)));
    for (int i = tid; i < nw; i += 512) __hip_atomic_fetch_and(mwq + i, clr, __ATOMIC_RELAXED, __HIP_MEMORY_SCOPE_AGENT);
    asm volatile("s_waitcnt vmcnt(0)" ::: "memory");
    __syncthreads();
    const bool take_all_eq = (eq_total == need);
    for (int s = tid; s < n; s += 512) { const unsigned k = fkey(sc[s]); if (k > prefix || (take_all_eq && k == prefix)) mask_or_bit(mwq, qc, s); }
    if (!take_all_eq) {
        const int per = (n + 511) >> 9, s0 = tid * per, s1 = (s0 + per < n) ? s0 + per : n; unsigned* ce = (unsigned*)qf;
        unsigned mine = 0u; for (int s = s0; s < s1; ++s) mine += fkey(sc[s]) == prefix;
        __syncthreads(); ce[tid] = mine; __syncthreads();
        unsigned before = 0u; for (int t2 = 0; t2 < tid; ++t2) before += ce[t2];
        for (int s = s0; s < s1 && before < need; ++s) if (fkey(sc[s]) == prefix) { mask_or_bit(mwq, qc, s); ++before; }
    }
    __syncthreads();
}

__device__ __forceinline__ void indexer_unit(char* lds, int b, int c, const bf16* QI, const bf16* KI, const float* WI, u64* MASKW, char* codes  ) {
    int tid_ = threadIdx.x; asm volatile("" : "+v"(tid_));
    const int tid = tid_, wid = __builtin_amdgcn_readfirstlane(tid >> 6), lane = tid & 63, r32 = lane & 31, hi = lane >> 5, qg = wid & 1, ks = wid >> 1;
    const int n = 64 * (c + 1), ntile = n >> 5, jend = 2 * ((c | 3) + 1);
    const int row0 = b * S + 64 * c;
    u64* mw = MASKW + ((size_t)(b * (S / 32) + 2 * c + qg) * (S / 32)) * 16;
    const char* kib = (const char*)(KI + (size_t)b * S * 64);
    if (n <= TOPK) {
        for (int j = ks; j < jend; j += 4) if (lane < 16) __hip_atomic_store(mw + (size_t)j * 16 + lane, j < ntile ? ~0ull : 0ull, __ATOMIC_RELAXED, __HIP_MEMORY_SCOPE_AGENT);
        return;
    }
    unsigned* hist = (unsigned*)(lds + OFF_HIST);
    float2* stat = (float2*)(lds + OFF_STAT); float2* qpar = (float2*)(lds + OFF_QPAR);
    int* bstar = (int*)(lds + OFF_BSTAR); int* needv = (int*)(lds + OFF_NEED); unsigned* bcnt = (unsigned*)(lds + OFF_BCNT); unsigned* fb = (unsigned*)(lds + OFF_FB);
    unsigned* fl = (unsigned*)(lds + OFF_FLAT);
    const int ql = qg * 32 + r32;
    {
    int ln_ = lane; asm volatile("" : "+v"(ln_));
    const int l15 = ln_ & 15, kq = ln_ >> 4; const int q0 = qg * 32 + l15, q1 = q0 + 16;
    bf16x8 qreg[8][2][2]; const float* wv0 = (const float*)(lds + OFF_WV) + q0 * 8; const float* wv1 = wv0 + 16 * 8;
    { const char* qp = (const char*)QI + (size_t)(unsigned)(row0 + q0) * 1024 + kq * 16;
#pragma unroll
        for (int h = 0; h < 8; ++h)
#pragma unroll
            for (int cb = 0; cb < 2; ++cb)
#pragma unroll
                for (int ks = 0; ks < 2; ++ks) qreg[h][cb][ks] = *reinterpret_cast<const bf16x8*>(qp + cb * 16 * 1024 + h * 128 + ks * 64);
        { unsigned to_ = (unsigned)tid; asm volatile("" : "+v"(to_)); if (to_ < 128u) { float4 w4 = *(const float4*)((const char*)(WI + (size_t)row0 * 8) + (size_t)(to_ * 16u)); w4.x *= 0.5f; w4.y *= 0.5f; w4.z *= 0.5f; w4.w *= 0.5f; *(float4*)(lds + OFF_WV + to_ * 16u) = w4; } } }
    char* qlp = lds + OFF_QL + tid * 16;
#pragma unroll
    for (int cb = 0; cb < 2; ++cb) { const float* wp = WI + (size_t)(row0 + q0 + 16 * cb) * 8; const float4 w0 = *(const float4*)wp, w1 = *(const float4*)(wp + 4);
        const float wh[8] = {0.5f * w0.x, 0.5f * w0.y, 0.5f * w0.z, 0.5f * w0.w, 0.5f * w1.x, 0.5f * w1.y, 0.5f * w1.z, 0.5f * w1.w};
#pragma unroll
        for (int ks = 0; ks < 2; ++ks) { float acc8[8] = {0.f, 0.f, 0.f, 0.f, 0.f, 0.f, 0.f, 0.f};
#pragma unroll
            for (int h = 0; h < 8; ++h) { const bf16x8 q = qreg[h][cb][ks];
#pragma unroll
                for (int e = 0; e < 8; ++e) acc8[e] = fmaf(wh[h], __builtin_bit_cast(float, (unsigned)(unsigned short)q[e] << 16), acc8[e]); }
            bf16x8 o;
#pragma unroll
            for (int e = 0; e < 8; ++e) { const unsigned u = __builtin_bit_cast(unsigned, acc8[e]); o[e] = (short)((u + 0x7fffu + ((u >> 16) & 1u)) >> 16); }
            *reinterpret_cast<bf16x8*>(qlp + (cb * 2 + ks) * 8192) = o; } }
    float sc[16];
    { unsigned z0; asm volatile("v_mov_b32 %0, 0" : "=v"(z0)); const uint4 z4 = make_uint4(z0, z0, z0, z0);
        unsigned zoff = (unsigned)tid * 16u; asm volatile("" : "+v"(zoff));
#pragma unroll 1
        for (int i = 0; i < 8; ++i) { *(uint4*)((char*)hist + zoff) = z4; zoff += 8192u; }
        if (tid < 16) *(uint4*)((char*)hist + zoff) = z4; }
    __syncthreads();
    { float s1a = 0.f, s2a = 0.f, s1b = 0.f, s2b = 0.f;
#pragma unroll 1
        for (int u = 0; u < 2; ++u) { const int j = ((ks + 4 * u) * ntile) >> 3; bf16x8 a[2][2]; load_a16(a, kib, j, l15, kq); tile_scores16<false>(a, qreg, qlp, wv0, wv1, sc, kib, 0, l15, kq);
#pragma unroll
            for (int i = 0; i < 16; ++i) { if ((i >> 2) & 1) { s1b += sc[i]; s2b = fmaf(sc[i], sc[i], s2b); } else { s1a += sc[i]; s2a = fmaf(sc[i], sc[i], s2a); } } }
        s1a += __shfl_xor(s1a, 16); s2a += __shfl_xor(s2a, 16); s1b += __shfl_xor(s1b, 16); s2b += __shfl_xor(s2b, 16);
        s1a += __shfl_xor(s1a, 32); s2a += __shfl_xor(s2a, 32); s1b += __shfl_xor(s1b, 32); s2b += __shfl_xor(s2b, 32);
        { int qo_ = q0; asm volatile("" : "+v"(qo_)); if (kq == 0) { stat[ks * 64 + qo_] = make_float2(s1a, s2a); stat[ks * 64 + qo_ + 16] = make_float2(s1b, s2b); } } }
    __syncthreads();
    { int tq_ = tid; asm volatile("" : "+v"(tq_));
    if (tq_ < 64) { float s1 = 0.f, s2 = 0.f;
#pragma unroll
        for (int k = 0; k < 4; ++k) { const float2 v = stat[k * 64 + tq_]; s1 += v.x; s2 += v.y; }
        const float mu = s1 * (1.f / 256.f); float var = s2 * (1.f / 256.f) - mu * mu; var = var > 0.f ? var : 0.f;
        const float sg = fmaxf(sqrtf(var), 1e-30f); const float zp = z_upper(256.f / (float)n);
        const float lo = mu + (zp - 2.0f) * sg, a = (float)(NBINS - 2) / (4.0f * sg); float bb = 1.f - lo * a;
        float aa = a; if (!(aa < 3.0e38f) || !(fabsf(bb) < 3.0e38f)) { aa = 0.f; bb = 1.f; }
        qpar[tq_] = make_float2(aa, bb); bcnt[tq_] = 0u; if (tq_ == 0) { fb[0] = 0u; fb[100] = 0u; } } }
    __syncthreads();
    { unsigned* hq0 = hist + q0 * HSTR; unsigned* hq1 = hq0 + 16 * HSTR; bf16x8 aC[2][2]; load_a16(aC, kib, ks, l15, kq);
        unsigned cso = (unsigned)(qg * 1024 + (l15 + 32 * (kq & 1)) * 16 + (kq >> 1) * 4); asm volatile("" : "+v"(cso));
#pragma unroll 1
        for (int j = ks; j < ntile; j += 4) {
            tile_scores16<true>(aC, qreg, qlp, wv0, wv1, sc, kib, j + 4 < ntile ? j + 4 : j, l15, kq);
            const float2 ab0 = qpar[q0], ab1 = qpar[q1];
            char* cp = codes + (size_t)(unsigned)(j * 2048) + cso;
#pragma unroll
            for (int rb = 0; rb < 2; ++rb)
#pragma unroll
                for (int cb = 0; cb < 2; ++cb) { unsigned w = 0u;
#pragma unroll
                    for (int r = 3; r >= 0; --r) { const float v = sc[(2 * rb + cb) * 4 + r];
                        const unsigned bin = (unsigned)__builtin_amdgcn_fmed3f(cb ? fmaf(v, ab1.x, ab1.y) : fmaf(v, ab0.x, ab0.y), 0.f, (float)(NBINS - 1));
                        __hip_atomic_fetch_add((cb ? hq1 : hq0) + bin, 1u, __ATOMIC_RELAXED, __HIP_MEMORY_SCOPE_WORKGROUP); w = (w << 8) | bin; }
                    *(unsigned*)(cp + cb * 256 + rb * 8) = w; } } }
    }
    __syncthreads();
#pragma unroll 1
    for (int qq = 0; qq < 8; ++qq) { const int q = wid * 8 + qq; int lo_ = lane; asm volatile("" : "+v"(lo_)); const unsigned* hp = hist + q * HSTR + 4 * lo_; const unsigned hb[4] = {hp[0], hp[1], hp[2], hp[3]};
        const unsigned ls = (hb[0] + hb[1]) + (hb[2] + hb[3]);
        unsigned T = ls;
#pragma unroll
        for (int o = 1; o < 64; o <<= 1) { const unsigned v = __shfl_down(T, o); if (lane + o < 64) T += v; }
        const u64 bal = __ballot(T >= (unsigned)TOPK); const int lstar = 63 - __builtin_clzll(bal);
        if (lane == lstar) { unsigned acc = T - ls; int bsel = 0;
#pragma unroll
            for (int i = 3; i >= 0; --i) { if (acc + hb[i] >= (unsigned)TOPK) { bsel = i; break; } acc += hb[i]; }
            bstar[q] = 4 * lane + bsel; needv[q] = (int)(TOPK - acc); } }
    __syncthreads();
    { unsigned cso = (unsigned)(qg * 1024 + lane * 16); asm volatile("" : "+v"(cso));
        const unsigned bs = (unsigned)bstar[ql]; const unsigned bsx = bs * 0x01010101u; const unsigned qtag = (unsigned)ql << 14;
#define IDX_LDC(jj) (*(const uint4*)(codes + (size_t)(unsigned)(((jj) < ntile ? (jj) : ks) * 2048) + cso))
#define IDX_SEL(D, K) asm volatile("v_cmp_gt_u32_sdwa vcc, %2, %3 src0_sel:BYTE_" #K " src1_sel:DWORD\n\ts_nop 3\n\tv_writelane_b32 %0, vcc_lo, %4\n\tv_writelane_b32 %1, vcc_hi, %4" \
                : "+v"(mlo), "+v"(mhi) : "v"(cwd[D]), "v"(bs), "n"(4 * (D) + (K)) : "vcc")
#define IDX_PROC(CUR, jj) do { const int j_ = (jj); const unsigned cwd[4] = {CUR.x, CUR.y, CUR.z, CUR.w}; unsigned mlo = 0u, mhi = 0u;                                  \
            IDX_SEL(0, 0); IDX_SEL(0, 1); IDX_SEL(0, 2); IDX_SEL(0, 3); IDX_SEL(1, 0); IDX_SEL(1, 1); IDX_SEL(1, 2); IDX_SEL(1, 3);                                       \
            IDX_SEL(2, 0); IDX_SEL(2, 1); IDX_SEL(2, 2); IDX_SEL(2, 3); IDX_SEL(3, 0); IDX_SEL(3, 1); IDX_SEL(3, 2); IDX_SEL(3, 3);                                       \
            if (lane < 16) mw[(size_t)j_ * 16 + lane] = ((u64)mhi << 32) | mlo;                  \
                                     \
            _Pragma("unroll") for (int d = 0; d < 4; ++d) { const unsigned x = cwd[d] ^ bsx; const unsigned hz = (x - 0x01010101u) & ~x & 0x80808080u;                   \
                if (__ballot(hz != 0u)) {                                                                                                                                \
                    _Pragma("unroll") for (int k = 0; k < 4; ++k) { const bool eq = ((cwd[d] >> (8 * k)) & 255u) == bs;                                                  \
                        if (eq) { const unsigned pos = __hip_atomic_fetch_add(&fb[100], 1u, __ATOMIC_RELAXED, __HIP_MEMORY_SCOPE_WORKGROUP);                             \
                            if (pos < (unsigned)FCAP) fl[pos] = qtag | (unsigned)(j_ * 32 + crow(4 * d + k, hi)); } } } } } while (0)
        uint4 cA = IDX_LDC(ks), cB = IDX_LDC(ks + 4), cC = IDX_LDC(ks + 8), cD = IDX_LDC(ks + 12);
#pragma unroll 1
        for (int j = ks; j < ntile; j += 16) {
            IDX_PROC(cA, j); cA = IDX_LDC(j + 16);
            if (j + 4 < ntile) { IDX_PROC(cB, j + 4); cB = IDX_LDC(j + 20); }
            if (j + 8 < ntile) { IDX_PROC(cC, j + 8); cC = IDX_LDC(j + 24); }
            if (j + 12 < ntile) { IDX_PROC(cD, j + 12); cD = IDX_LDC(j + 28); }
        }
#undef IDX_PROC
#undef IDX_SEL
#undef IDX_LDC
        for (int j = ntile + ks; j < jend; j += 4) if (lane < 16) mw[(size_t)j * 16 + lane] = 0ull; }
    __syncthreads();
    { const unsigned nfl = fb[100] < (unsigned)FCAP ? fb[100] : (unsigned)FCAP; const float* wv = (const float*)(lds + OFF_WV); unsigned* blq = (unsigned*)(lds + OFF_HIST);
        unsigned ti_ = (unsigned)tid; asm volatile("" : "+v"(ti_));
#pragma unroll 1
        for (unsigned i = ti_; i < nfl; i += 512u) { const unsigned e = fl[i]; const int q = (int)(e >> 14), key = (int)(e & 16383u);
            const uint4* kp = (const uint4*)(kib + (size_t)key * 128); float kf[64];
#pragma unroll
            for (int cc = 0; cc < 8; ++cc) { const uint4 w = kp[cc];
                kf[8 * cc] = __builtin_bit_cast(float, w.x << 16); kf[8 * cc + 1] = __builtin_bit_cast(float, w.x & 0xffff0000u); kf[8 * cc + 2] = __builtin_bit_cast(float, w.y << 16); kf[8 * cc + 3] = __builtin_bit_cast(float, w.y & 0xffff0000u);
                kf[8 * cc + 4] = __builtin_bit_cast(float, w.z << 16); kf[8 * cc + 5] = __builtin_bit_cast(float, w.z & 0xffff0000u); kf[8 * cc + 6] = __builtin_bit_cast(float, w.w << 16); kf[8 * cc + 7] = __builtin_bit_cast(float, w.w & 0xffff0000u); }
            const char* qp = (const char*)QI + (size_t)(unsigned)(row0 + q) * 1024; float s = 0.f;
#pragma unroll 4
            for (int h = 0; h < 8; ++h) { float d = 0.f; const uint4* qh = (const uint4*)(qp + h * 128);
#pragma unroll
                for (int cc = 0; cc < 8; ++cc) { const uint4 w = qh[cc];
                    d = fmaf(__builtin_bit_cast(float, w.x << 16), kf[8 * cc], d); d = fmaf(__builtin_bit_cast(float, w.x & 0xffff0000u), kf[8 * cc + 1], d);
                    d = fmaf(__builtin_bit_cast(float, w.y << 16), kf[8 * cc + 2], d); d = fmaf(__builtin_bit_cast(float, w.y & 0xffff0000u), kf[8 * cc + 3], d);
                    d = fmaf(__builtin_bit_cast(float, w.z << 16), kf[8 * cc + 4], d); d = fmaf(__builtin_bit_cast(float, w.z & 0xffff0000u), kf[8 * cc + 5], d);
                    d = fmaf(__builtin_bit_cast(float, w.w << 16), kf[8 * cc + 6], d); d = fmaf(__builtin_bit_cast(float, w.w & 0xffff0000u), kf[8 * cc + 7], d); }
                s = fmaf(2.f * wv[q * 8 + h], fmaxf(d, 0.f), s); }
            const float2 ab = qpar[q]; const float u = fmaf(s, ab.x, ab.y);
            const unsigned fine = (unsigned)__builtin_amdgcn_fmed3f((u - (float)bstar[q]) * 262144.f, 0.f, 262143.f);
            const unsigned pos = __hip_atomic_fetch_add(&bcnt[q], 1u, __ATOMIC_RELAXED, __HIP_MEMORY_SCOPE_WORKGROUP);
            const unsigned word = (fine << 14) | (16383u - (unsigned)key); fl[FCAP + i] = word;
            if (pos < (unsigned)CAP) blq[q * CAP + pos] = word; } }
    asm volatile("s_waitcnt vmcnt(0)" ::: "memory");
    __syncthreads();
    { const bool flat_over = fb[100] > (unsigned)FCAP; const unsigned nfl = flat_over ? (unsigned)FCAP : fb[100]; const unsigned* blq = (const unsigned*)(lds + OFF_HIST);
        unsigned ti_ = (unsigned)tid; asm volatile("" : "+v"(ti_));
        if (ti_ < 64u) { const int q = (int)ti_; if (flat_over || bcnt[q] > (unsigned)CAP || bstar[q] <= 0 || bstar[q] >= NBINS - 1 || (DBG_FORCE_FB && (q & 15) == 3)) {
            const unsigned p = __hip_atomic_fetch_add(&fb[0], 1u, __ATOMIC_RELAXED, __HIP_MEMORY_SCOPE_WORKGROUP); fb[1 + p] = (unsigned)q; } }
        if (!flat_over) {
#pragma unroll 1
        for (unsigned i = ti_; i < nfl; i += 512u) { const unsigned ef = fl[i]; const int q = (int)(ef >> 14); const unsigned cnt = bcnt[q];
            if (cnt > (unsigned)CAP || bstar[q] <= 0 || bstar[q] >= NBINS - 1 || (DBG_FORCE_FB && (q & 15) == 3)) continue;
            const unsigned mine = fl[FCAP + i];
            const unsigned* bl = blq + q * CAP; int rk = 0;
            for (unsigned m = 0; m < cnt; ++m) rk += bl[m] > mine;
            if (rk < needv[q]) mask_or_bit(MASKW + ((size_t)(b * (S / 32) + 2 * c + (q >> 5)) * (S / 32)) * 16, q & 31, (int)(16383u - (mine & 16383u))); } } }
    __syncthreads();
    { const int nfb = (int)fb[0];
        for (int f = 0; f < nfb; ++f) { const int q = (int)fb[1 + f];
            fallback_query(lds, tid, row0 + q, q & 31, n, QI, kib, WI, MASKW + ((size_t)(b * (S / 32) + 2 * c + (q >> 5)) * (S / 32)) * 16); } }
    __syncthreads();
}
__device__ __forceinline__ void indexer_phase(char* lds, int vcu, int G, const bf16* QI, const bf16* KI, const float* WI, u64* MASKW, char* area_out, char* area_tail, char* area_gap, char* area_wai) {
    for (int item = vcu; item < 256; item += G) { const int b = (item >> 7) & 1, x = item & 127;
        const unsigned cum = (unsigned)(256 * x - x * (x - 1) / 2);
        char* codes = b == 0 ? area_out + (size_t)cum * 4096 : x < 33 ? area_out + (size_t)(24640u + cum) * 4096 : x < 73 ? area_tail + (size_t)(cum - 7920u) * 4096 : x < 115 ? area_gap + (size_t)(cum - 16060u) * 4096 : area_wai + (size_t)(cum - 22885u) * 4096;
#pragma unroll 1
        for (int pass = 0; pass < 2; ++pass) indexer_unit(lds, b, pass ? 255 - x : x, QI, KI, WI, MASKW, codes); }
}
}
namespace att {
typedef unsigned short bf16;
typedef short bf16x8 __attribute__((ext_vector_type(8)));
typedef short s16x4 __attribute__((ext_vector_type(4)));
typedef float f32x16 __attribute__((ext_vector_type(16)));
typedef float f32x4 __attribute__((ext_vector_type(4)));
typedef unsigned u32x4 __attribute__((ext_vector_type(4)));
typedef unsigned long long u64;
typedef const __attribute__((address_space(4))) u64* cu64p;
typedef float f32x2_t __attribute__((ext_vector_type(2))); typedef __bf16 bf16x2_t __attribute__((ext_vector_type(2)));
__device__ __forceinline__ unsigned cvtpk_s(float lo, float hi) { f32x2_t v = {lo, hi}; bf16x2_t b = __builtin_convertvector(v, bf16x2_t); return __builtin_bit_cast(unsigned, b); }
constexpr int D = 128, PITCH = 1024, NW = 8, QBLK = 32, KVBLK = 64, QB = NW * QBLK;
constexpr int SHM_V = KVBLK * D * 2, SHM_K = KVBLK * D * 2;
constexpr int NBUF = 4;
constexpr int OFF_WS = NBUF * SHM_V + NBUF * SHM_K;
constexpr int OFF_TAB = OFF_WS + NW * 64 * 4;
constexpr int OFF_EP = 0;
constexpr int EP_PITCH = 272, EP_WAVE = 32 * EP_PITCH;
constexpr int ATTN_LDS_BYTES = OFF_TAB + 448 * 4;
static_assert(NW * EP_WAVE <= OFF_WS, "epilogue staging fits the ring");
constexpr float THR2 = 11.5f;
constexpr int MW_PER_QB = (S / 32) * 16;

#define KSWZ(row, colB) ((row) * 256 + ((colB) ^ (((row) & 7) << 4)))
#define SBAR() __builtin_amdgcn_sched_barrier(0)
__device__ __forceinline__ int v_st(int k, int c) { const int kk = (k & ~0xC) | ((k & 4) << 1) | ((k & 8) >> 1); return ((kk >> 3) * 4 + (c >> 5)) * 512 + ((kk & 7) * 32 + (c & 31)) * 2; }
__device__ __forceinline__ int v_st_nat(int k, int c) { return ((k >> 3) * 4 + (c >> 5)) * 512 + ((k & 7) * 32 + (c & 31)) * 2; }
__device__ __forceinline__ int v_rd_base(int lane) { return ((lane & 3) << 3) | (((lane >> 2) & 3) << 6) | (((lane >> 4) & 1) << 5) | (((lane >> 5) & 1) << 8); }
constexpr int v_rd_off(int d0, int ks, int half) { return d0 * 512 + ks * 4096 + half * 2048; }
__device__ __forceinline__ int crow(int r, int hi) { return (r & 3) + 8 * (r >> 2) + 4 * hi; }
__device__ __forceinline__ unsigned cvtpk(float lo, float hi) { unsigned r; asm volatile("v_cvt_pk_bf16_f32 %0, %1, %2" : "=v"(r) : "v"(lo), "v"(hi)); return r; }

template <bool NEAR>
__device__ __forceinline__ void init_tile(f32x16& p0, f32x16& p1, cu64p w, float cb  , const float* tabp, float mcur) {
    const float NEG = -__builtin_inff();
    u64 m0[16], m1[16];
#pragma unroll
    for (int r = 0; r < 16; ++r) { m0[r] = w[r]; m1[r] = w[16 + r]; }
#pragma unroll
    for (int r = 0; r < 16; ++r) { float bv = cb; if (NEAR) bv = tabp[59 - ((r & 3) + 8 * (r >> 2))] - mcur;
        float o; asm volatile("v_cndmask_b32_e64 %0, %1, %2, %3" : "=v"(o) : "v"(NEG), "v"(bv), "s"(m0[r])); p0[r] = o; }
#pragma unroll
    for (int r = 0; r < 16; ++r) { float bv = cb; if (NEAR) bv = tabp[27 - ((r & 3) + 8 * (r >> 2))] - mcur;
        float o; asm volatile("v_cndmask_b32_e64 %0, %1, %2, %3" : "=v"(o) : "v"(NEG), "v"(bv), "s"(m1[r])); p1[r] = o; }
}
__device__ __forceinline__ void partialSM(f32x16& p0, f32x16& p1, float& m_reg, float& alpha, float l_cur, float pmax_in) {
    float pmax = pmax_in;
    { auto rr = __builtin_amdgcn_permlane32_swap(__float_as_uint(pmax), __float_as_uint(pmax), false, false);
      pmax = fmaxf(__uint_as_float(rr[0]), __uint_as_float(rr[1])); }
    const bool low = pmax < -64.f && pmax > -__builtin_inff();
    alpha = 1.f;
    if (__builtin_expect(__any(pmax > THR2 || low), 0)) {
        float delta = 0.f;
        if (pmax > THR2) { delta = pmax; alpha = __builtin_amdgcn_exp2f(-delta); }
        else if (low && l_cur == 0.f) delta = pmax;
        m_reg += delta;
#pragma unroll
        for (int r = 0; r < 16; ++r) p0[r] = p0[r] - delta;
#pragma unroll
        for (int r = 0; r < 16; ++r) p1[r] = p1[r] - delta; }
#pragma unroll
    for (int r = 0; r < 16; ++r) p0[r] = __builtin_amdgcn_exp2f(p0[r]);
}
__device__ __forceinline__ void finishSM(f32x16& p0, f32x16& p1, float alpha, float& l_reg, bf16x8& pa0, bf16x8& pa1, bf16x8& pa2, bf16x8& pa3) {
#pragma unroll
    for (int r = 0; r < 16; ++r) p1[r] = __builtin_amdgcn_exp2f(p1[r]);
    float ps = 0;
#pragma unroll
    for (int r = 0; r < 16; ++r) ps += p0[r];
#pragma unroll
    for (int r = 0; r < 16; ++r) ps += p1[r];
    { auto rr = __builtin_amdgcn_permlane32_swap(__float_as_uint(ps), __float_as_uint(ps), false, false);
      ps = __uint_as_float(rr[0]) + __uint_as_float(rr[1]); }
    l_reg = l_reg * alpha + ps;
#define PK4(P, B_, OUT) do { u32x4 w = {cvtpk(P[B_+0], P[B_+1]), cvtpk(P[B_+2], P[B_+3]), cvtpk(P[B_+4], P[B_+5]), cvtpk(P[B_+6], P[B_+7])};   \
        OUT = *reinterpret_cast<bf16x8*>(&w); } while (0)
    PK4(p0, 0, pa0); PK4(p0, 8, pa1); PK4(p1, 0, pa2); PK4(p1, 8, pa3);
#undef PK4
}
template <int KB>
__device__ __forceinline__ void qkt(f32x16& p0, f32x16& p1, const char* K_lds, int r32, int hi, const bf16x8* qr) {
    const char* kb[4];
#pragma unroll
    for (int dd = 0; dd < 4; ++dd) kb[dd] = K_lds + KB * SHM_K + KSWZ(r32, (dd * 16 + hi * 8) * 2);
#pragma unroll
    for (int d0 = 0; d0 < 8; ++d0) { const char* a = kb[d0 & 3] + (d0 >> 2) * 128;
        bf16x8 b0 = *reinterpret_cast<const bf16x8*>(a);
        bf16x8 b1 = *reinterpret_cast<const bf16x8*>(a + 32 * 256);
        p0 = __builtin_amdgcn_mfma_f32_32x32x16_bf16(b0, qr[d0], p0, 0, 0, 0);
        p1 = __builtin_amdgcn_mfma_f32_32x32x16_bf16(b1, qr[d0], p1, 0, 0, 0); }
}
template <int VB>
__device__ __forceinline__ void pv_tile(f32x16* o, int vb0, bf16x8 pa0, bf16x8 pa1, bf16x8 pa2, bf16x8 pa3) {
#define TRRD(dst, off) asm volatile("ds_read_b64_tr_b16 %0, %1 offset:%2" : "=&v"(dst) : "v"(vb0), "i"(off) : "memory")
#define PV_D0(d0) do { s16x4 l0, l1, l2, l3, h0, h1, h2, h3; constexpr int b_ = VB * SHM_V + v_rd_off(d0, 0, 0); \
        TRRD(l0, b_); TRRD(h0, b_ + 2048); TRRD(l1, b_ + 4096); TRRD(h1, b_ + 6144); TRRD(l2, b_ + 8192); TRRD(h2, b_ + 10240); TRRD(l3, b_ + 12288); TRRD(h3, b_ + 14336); \
        asm volatile("s_waitcnt lgkmcnt(0)" ::: "memory"); SBAR();   \
        o[d0] = __builtin_amdgcn_mfma_f32_32x32x16_bf16(pa0, (bf16x8){l0[0], l0[1], l0[2], l0[3], h0[0], h0[1], h0[2], h0[3]}, o[d0], 0, 0, 0);   \
        o[d0] = __builtin_amdgcn_mfma_f32_32x32x16_bf16(pa1, (bf16x8){l1[0], l1[1], l1[2], l1[3], h1[0], h1[1], h1[2], h1[3]}, o[d0], 0, 0, 0);   \
        o[d0] = __builtin_amdgcn_mfma_f32_32x32x16_bf16(pa2, (bf16x8){l2[0], l2[1], l2[2], l2[3], h2[0], h2[1], h2[2], h2[3]}, o[d0], 0, 0, 0);   \
        o[d0] = __builtin_amdgcn_mfma_f32_32x32x16_bf16(pa3, (bf16x8){l3[0], l3[1], l3[2], l3[3], h3[0], h3[1], h3[2], h3[3]}, o[d0], 0, 0, 0); } while (0)
    PV_D0(0); PV_D0(1); PV_D0(2); PV_D0(3);
#undef PV_D0
#undef TRRD
}

template <int VB>
__device__ __forceinline__ float pv_tile_max(f32x16* o, int vb0, bf16x8 pa0, bf16x8 pa1, bf16x8 pa2, bf16x8 pa3, const f32x16& p0, const f32x16& p1) {
#define TRRD(dst, off) asm volatile("ds_read_b64_tr_b16 %0, %1 offset:%2" : "=&v"(dst) : "v"(vb0), "i"(off) : "memory")
#define MX3(a, b, c) fmaxf(fmaxf(a, b), c)
#define PV_D0(d0, HOOK) do { s16x4 l0, l1, l2, l3, h0, h1, h2, h3; constexpr int b_ = VB * SHM_V + v_rd_off(d0, 0, 0); \
        TRRD(l0, b_); TRRD(h0, b_ + 2048); TRRD(l1, b_ + 4096); TRRD(h1, b_ + 6144); TRRD(l2, b_ + 8192); TRRD(h2, b_ + 10240); TRRD(l3, b_ + 12288); TRRD(h3, b_ + 14336); \
        HOOK; asm volatile("s_waitcnt lgkmcnt(0)" ::: "memory"); SBAR();   \
        o[d0] = __builtin_amdgcn_mfma_f32_32x32x16_bf16(pa0, (bf16x8){l0[0], l0[1], l0[2], l0[3], h0[0], h0[1], h0[2], h0[3]}, o[d0], 0, 0, 0);   \
        o[d0] = __builtin_amdgcn_mfma_f32_32x32x16_bf16(pa1, (bf16x8){l1[0], l1[1], l1[2], l1[3], h1[0], h1[1], h1[2], h1[3]}, o[d0], 0, 0, 0);   \
        o[d0] = __builtin_amdgcn_mfma_f32_32x32x16_bf16(pa2, (bf16x8){l2[0], l2[1], l2[2], l2[3], h2[0], h2[1], h2[2], h2[3]}, o[d0], 0, 0, 0);   \
        o[d0] = __builtin_amdgcn_mfma_f32_32x32x16_bf16(pa3, (bf16x8){l3[0], l3[1], l3[2], l3[3], h3[0], h3[1], h3[2], h3[3]}, o[d0], 0, 0, 0); } while (0)
    float m;
    PV_D0(0, m = MX3(p0[0], p0[1], p0[2]); m = MX3(m, p0[3], p0[4]); m = MX3(m, p0[5], p0[6]); m = MX3(m, p0[7], p0[8]));
    PV_D0(1, m = MX3(m, p0[9], p0[10]); m = MX3(m, p0[11], p0[12]); m = MX3(m, p0[13], p0[14]); m = MX3(m, p0[15], p1[0]));
    PV_D0(2, m = MX3(m, p1[1], p1[2]); m = MX3(m, p1[3], p1[4]); m = MX3(m, p1[5], p1[6]); m = MX3(m, p1[7], p1[8]));
    PV_D0(3, m = MX3(m, p1[9], p1[10]); m = MX3(m, p1[11], p1[12]); m = MX3(m, p1[13], p1[14]); m = fmaxf(m, p1[15]));
#undef PV_D0
#undef MX3
#undef TRRD
    return m;
}

struct BlockRef { const bf16* Q; const bf16* K; const bf16* V; const bf16* ZS; bf16* O; const u64* MW; const float* bias; int P0; };
struct Seam { bf16x8 qr[8]; bf16x8 st_v0, st_v1, st_k0, st_k1; };
#define ROW(p, k0, rr) ((const bf16*)((const char*)(p) + (size_t)(unsigned)(((k0) + (rr)) * (PITCH * 2) + sc * 2)))
#define VMW() asm volatile("s_waitcnt vmcnt(0)" ::: "memory")
#define VMWN(n) asm volatile("s_waitcnt vmcnt(%0)" :: "i"(n) : "memory")
#define LD8(p) (*reinterpret_cast<const bf16x8*>(p))
#define SLOAD_H(Kp, Vp, k0) do { S.st_v0 = LD8(ROW(Vp, k0, sr)); S.st_v1 = LD8(ROW(Vp, k0, 32 + sr)); S.st_k0 = LD8(ROW(Kp, k0, sr)); S.st_k1 = LD8(ROW(Kp, k0, 32 + sr)); } while (0)
#define SWRITE_HK(bf) do { *(bf16x8*)(K_lds + (bf) * SHM_K + kws) = S.st_k0; *(bf16x8*)(K_lds + (bf) * SHM_K + kws + 32 * 256) = S.st_k1; } while (0)
#define SWRITE_HV(bf) do { *(bf16x8*)(V_lds + (bf) * SHM_V + vst0) = S.st_v0; *(bf16x8*)(V_lds + (bf) * SHM_V + vst1) = S.st_v1; } while (0)
#define SWRITE_H(bf) do { SWRITE_HV(bf); SWRITE_HK(bf); } while (0)
__device__ __forceinline__ void attn_block(const BlockRef& cur, char* lds) {
    Seam S;
    int tid_ = threadIdx.x; asm volatile("" : "+v"(tid_));
    const int tid = tid_, wid = __builtin_amdgcn_readfirstlane(tid >> 6), lane = tid & 63, r32 = lane & 31, hi = lane >> 5;
    const bool grpA = wid < 4;
    const int NT = (cur.P0 + QB) / KVBLK;
    const int qlo = cur.P0 + wid * QBLK;
    char* V_lds = lds; char* K_lds = lds + NBUF * SHM_V;
    float* ws = (float*)(lds + OFF_WS) + wid * 64; float* li_l = ws, * al_l = ws + 32;
    float* tab = (float*)(lds + OFF_TAB);
    float m_reg = 0.f, l_reg = 0; f32x16 o[4] = {};
    const int sr = tid >> 4, sc = (tid & 15) * 8, vst0 = v_st_nat(sr, sc), vst1 = v_st_nat(32 + sr, sc), kws = KSWZ(sr, sc * 2);
    const int vb0 = (int)(uintptr_t)V_lds + v_rd_base(lane);
    const bf16* Kh = cur.K; const bf16* Vh = cur.V;
    { int tq_ = tid; asm volatile("" : "+v"(tq_));
    if (tq_ < 448) { const int rel = tq_ - 256; const int ret = rel < 0 ? 16 : 0; const int n = rel < 0 ? -rel : rel; int v;
        if (n < 8) v = n; else if (n < 12) v = 8; else if (n < 16) v = 9; else if (n < 23) v = 10; else if (n < 32) v = 11; else if (n < 46) v = 12; else if (n < 64) v = 13; else if (n < 91) v = 14; else v = 15;
        tab[tq_] = cur.bias[(ret + v) * 8] * 1.4426950408889634f; } }
    const float cbfar = cur.bias[15 * 8] * 1.4426950408889634f;
    const cu64p mwv = (cu64p)(uintptr_t)(cur.MW + (size_t)wid * MW_PER_QB);
#define RESC(a) do { if (__any((a) < 1.f)) { if (hi == 0) al_l[r32] = (a); asm volatile("s_waitcnt lgkmcnt(0)" ::: "memory");              \
                     for (int d_ = 0; d_ < 4; ++d_) for (int r = 0; r < 16; ++r) o[d_][r] *= al_l[crow(r, hi)]; } } while (0)
#define KBASE(t) ((t) * KVBLK)
#define INIT(P0_, P1_, t) do { const int kb_ = KBASE(t); const cu64p w_ = mwv + (size_t)(t) * 32;                              \
        if (kb_ + 154 <= qlo) init_tile<false>(P0_, P1_, w_, cbfar - m_reg, tab, m_reg);                                        \
        else init_tile<true>(P0_, P1_, w_, cbfar - m_reg, tab + (qlo + r32 - kb_ - 4 * hi + 197), m_reg); } while (0)
    unsigned pm0 = 0u, pm1 = 0u, pm2 = 0u, pm3 = 0u;
#define MPREF(t) do { const __attribute__((address_space(4))) unsigned* w_ = (const __attribute__((address_space(4))) unsigned*)(mwv + (size_t)(t) * 32); pm0 = w_[0]; pm1 = w_[16]; pm2 = w_[32]; pm3 = w_[48]; SBAR(); } while (0)
#define MUSE() asm volatile("" :: "s"(pm0), "s"(pm1), "s"(pm2), "s"(pm3))
    f32x16 pA0, pA1, pB0, pB1; float alA, alB; bf16x8 pa0, pa1, pa2, pa3;
#pragma unroll
    for (int d0 = 0; d0 < 8; ++d0) S.qr[d0] = LD8((const char*)cur.Q + (size_t)(unsigned)((wid * QBLK + r32) * (PITCH * 2) + d0 * 32 + hi * 16));
    SLOAD_H(Kh, Vh, 0); VMW(); SWRITE_H(0); SBAR();
    if (NT > 1) SLOAD_H(Kh, Vh, KBASE(1));
    __syncthreads();
    INIT(pA0, pA1, 0);
    SBAR(); qkt<0>(pA0, pA1, K_lds, r32, hi, S.qr);
    MPREF(1);
    { float pm_ = pA0[0];
#pragma unroll
      for (int r = 1; r < 16; ++r) pm_ = fmaxf(pm_, pA0[r]);
#pragma unroll
      for (int r = 0; r < 16; ++r) pm_ = fmaxf(pm_, pA1[r]);
      partialSM(pA0, pA1, m_reg, alA, l_reg, pm_); }
    if (!grpA) { MUSE(); INIT(pB0, pB1, 1); SBAR(); }
    if (NT > 1) { VMW(); SWRITE_H(1); }
    __syncthreads();
#define HALF_STEP(PX0, PX1, alX, PY0, PY1, alY, t, KB, VB, SB) do {                                                           \
        if (grpA) { MUSE(); INIT(PX0, PX1, (t)); SBAR(); }                                                                    \
        qkt<KB>(PX0, PX1, K_lds, r32, hi, S.qr);                                                                              \
        finishSM(PY0, PY1, alY, l_reg, pa0, pa1, pa2, pa3); SBAR();                                                           \
        SLOAD_H(Kh, Vh, KBASE((t) + 1)); SBAR();                                                                              \
        { const float pm_ = pv_tile_max<VB>(o, vb0, pa0, pa1, pa2, pa3, PX0, PX1); MPREF((t) + 1); partialSM(PX0, PX1, m_reg, alX, l_reg, pm_); }   \
        VMW(); SWRITE_H(SB);                                                                                                  \
        RESC(alX);                                                                                                            \
        if (!grpA) { MUSE(); INIT(PY0, PY1, (t) + 1); SBAR(); }     \
        __syncthreads(); } while (0)
    int t = 1;
    for (; t + 4 < NT; t += 4) {
        HALF_STEP(pB0, pB1, alB, pA0, pA1, alA, t, 1, 0, 2);
        HALF_STEP(pA0, pA1, alA, pB0, pB1, alB, t + 1, 2, 1, 3);
        HALF_STEP(pB0, pB1, alB, pA0, pA1, alA, t + 2, 3, 2, 0);
        HALF_STEP(pA0, pA1, alA, pB0, pB1, alB, t + 3, 0, 3, 1);
    }
    HALF_STEP(pB0, pB1, alB, pA0, pA1, alA, NT - 3, 1, 0, 2);
    HALF_STEP(pA0, pA1, alA, pB0, pB1, alB, NT - 2, 2, 1, 3);
    if (grpA) { MUSE(); INIT(pB0, pB1, NT - 1); SBAR(); }
    qkt<3>(pB0, pB1, K_lds, r32, hi, S.qr); SBAR();
    finishSM(pA0, pA1, alA, l_reg, pa0, pa1, pa2, pa3); SBAR();
    { const float pm_ = pv_tile_max<2>(o, vb0, pa0, pa1, pa2, pa3, pB0, pB1); partialSM(pB0, pB1, m_reg, alB, l_reg, pm_); } RESC(alB);
    finishSM(pB0, pB1, alB, l_reg, pa0, pa1, pa2, pa3); SBAR(); pv_tile<3>(o, vb0, pa0, pa1, pa2, pa3);
    SBAR();
    __syncthreads();
    if (hi == 0) li_l[r32] = l_reg; asm volatile("s_waitcnt lgkmcnt(0)" ::: "memory");
    float rli[16];
#pragma unroll
    for (int r = 0; r < 16; ++r) rli[r] = __builtin_amdgcn_rcpf(li_l[crow(r, hi)]);
    {
        char* ep = lds + OFF_EP + wid * EP_WAVE; unsigned ew_off = (unsigned)(4 * hi * EP_PITCH + r32 * 2); asm volatile("" : "+v"(ew_off));
#pragma unroll
        for (int r = 0; r < 16; ++r) { const int rw = (r & 3) + 8 * (r >> 2);
#pragma unroll
            for (int d0 = 0; d0 < 4; ++d0) *(unsigned short*)(ep + ew_off + rw * EP_PITCH + d0 * 64) = (unsigned short)(cvtpk_s(o[d0][r] * rli[r], 0.f) & 0xffffu); }
        asm volatile("s_waitcnt lgkmcnt(0)" ::: "memory");
        unsigned lane_off = (unsigned)((wid * QBLK + (lane >> 4)) * PITCH + (lane & 15) * 8) * 2u;
        asm volatile("" : "+v"(lane_off));
        unsigned er_off = (unsigned)((lane >> 4) * EP_PITCH + (lane & 15) * 16); asm volatile("" : "+v"(er_off));
        char* op = (char*)cur.O + (size_t)lane_off; const char* zp = (const char*)cur.ZS + (size_t)lane_off; const char* er = ep + er_off;
#pragma unroll
        for (int ph = 0; ph < 2; ++ph) {
            asm volatile("" ::: "memory");
            uint4 zz[4];
#pragma unroll
            for (int p4 = 0; p4 < 4; ++p4) zz[p4] = *(const uint4*)(zp + (ph * 4 + p4) * 4 * PITCH * 2);
#pragma unroll
            for (int p4 = 0; p4 < 4; ++p4) { const int p = ph * 4 + p4; const uint4 m = *(const uint4*)(er + p * 4 * EP_PITCH); const uint4 z = zz[p4]; uint4 y;
                y.x = cvtpk_s(__uint_as_float(m.x << 16) * __uint_as_float(z.x << 16), __uint_as_float(m.x & 0xffff0000u) * __uint_as_float(z.x & 0xffff0000u));
                y.y = cvtpk_s(__uint_as_float(m.y << 16) * __uint_as_float(z.y << 16), __uint_as_float(m.y & 0xffff0000u) * __uint_as_float(z.y & 0xffff0000u));
                y.z = cvtpk_s(__uint_as_float(m.z << 16) * __uint_as_float(z.z << 16), __uint_as_float(m.z & 0xffff0000u) * __uint_as_float(z.z & 0xffff0000u));
                y.w = cvtpk_s(__uint_as_float(m.w << 16) * __uint_as_float(z.w << 16), __uint_as_float(m.w & 0xffff0000u) * __uint_as_float(z.w & 0xffff0000u));
                *(uint4*)(op + p * 4 * PITCH * 2) = y; } }
    }
    __syncthreads();
#undef RESC
#undef KBASE
#undef INIT
#undef MPREF
#undef MUSE
#undef HALF_STEP
}
#undef ROW
#undef VMW
#undef VMWN
#undef LD8
#undef SLOAD_H
#undef SWRITE_HK
#undef SWRITE_HV
#undef SWRITE_H

__device__ __forceinline__ BlockRef make_ref(int L, int pass, const bf16* Q, const bf16* K, const bf16* V, const bf16* ZS, bf16* O, const u64* MASKW, const float* rel_bias) {
    const int bh = L >> 5, x = L & 31, b = bh >> 3, h = bh & 7, qb = pass ? 63 - x : x;
    BlockRef r; const size_t row0 = (size_t)b * S + (size_t)qb * QB;
    r.Q = Q + row0 * PITCH + h * D; r.O = O + row0 * PITCH + h * D; r.ZS = ZS + row0 * PITCH + h * D;
    r.K = K + (size_t)b * S * PITCH + h * D; r.V = V + (size_t)b * S * PITCH + h * D;
    r.MW = MASKW + ((size_t)b * (S / 32) + (size_t)qb * 8) * MW_PER_QB; r.bias = rel_bias + h; r.P0 = qb * QB;
    return r;
}
__device__ __forceinline__ void attn_phase(char* lds, int vcu, int G, const bf16* Q, const bf16* K, const bf16* V, const bf16* ZS, bf16* O, const u64* MASKW, const float* rel_bias) {
    constexpr int TOTAL = 512;
    for (int L = vcu; L < TOTAL; L += G)
#pragma unroll 1
        for (int pass = 0; pass < 2; ++pass) { const BlockRef cur = make_ref(L, pass, Q, K, V, ZS, O, MASKW, rel_bias); attn_block(cur, lds); }
}
}

namespace sgu {
typedef unsigned short bf16;
typedef short bf16x8 __attribute__((ext_vector_type(8)));
typedef short s16x4 __attribute__((ext_vector_type(4)));
typedef float f32x16 __attribute__((ext_vector_type(16)));
typedef float f32x2_t __attribute__((ext_vector_type(2))); typedef __bf16 bf16x2_t __attribute__((ext_vector_type(2)));
__device__ __forceinline__ unsigned cvtpk_s(float lo, float hi) { f32x2_t v = {lo, hi}; bf16x2_t b = __builtin_convertvector(v, bf16x2_t); return __builtin_bit_cast(unsigned, b); }
constexpr int OFF_B = 0;
constexpr int OFF_ST = 65536;
constexpr int OFF_EP = 66560;
constexpr int EP_PITCH = 80, EP_WAVE = 128 * EP_PITCH;
constexpr int SGU_LDS_BYTES = OFF_EP + 8 * EP_WAVE;

template <bool WRITE>
__device__ __forceinline__ void sgu_phase(char* lds, int vcu, int G, bf16* U  , const bf16* Vb, const float* LNP, const bf16* WS16, const float* ln_g, const float* ln_b, const float* b_s) {
    const int tid = threadIdx.x, wid = __builtin_amdgcn_readfirstlane(tid >> 6), lane = tid & 63, r32 = lane & 31, hi = lane >> 5;
    float2* stats = (float2*)(lds + OFF_ST);
    for (int chunk = vcu; chunk < M / 128; chunk += G) {
        const size_t row0 = (size_t)chunk * 128;
        { int tq_ = tid; asm volatile("" : "+v"(tq_));
          if (tq_ < 128) { const float4* pp = (const float4*)(LNP + (row0 + tq_) * 64); float s1 = 0.f, s2 = 0.f;
#pragma unroll
            for (int j = 0; j < 16; ++j) { const float4 q = pp[j]; s1 += q.x + q.z; s2 += q.y + q.w; }
            const float mean = s1 * (1.f / BW); const float var = fmaxf(s2 * (1.f / BW) - mean * mean, 0.f);
            stats[tq_] = make_float2(mean, 1.0f / sqrtf(var + LN_EPS)); } }
        __syncthreads();
#pragma unroll 1
        for (int g = 0; g < 8; ++g) {
            bf16x8 A0[2], A1[4], A2[6], A3[8];
            uint4 ug[8];
            { const size_t gb_ = (row0 * BW + (size_t)(g * 256 + (wid >> 2) * 128 + (wid & 3) * 32 + (lane & 3) * 8)) * 2;
#pragma unroll
                for (int p = 0; p < 8; ++p) ug[p] = *(const uint4*)((const char*)U + gb_ + (size_t)(16 * p + (lane >> 2)) * (BW * 2)); }
            { const char* ap = (const char*)WS16 + (size_t)(unsigned)(((g * 128 + r32) * 128 + 8 * hi) * 2);
#pragma unroll
                for (int kk = 0; kk < 2; ++kk) A0[kk] = *reinterpret_cast<const bf16x8*>(ap + kk * 32);
#pragma unroll
                for (int kk = 0; kk < 4; ++kk) A1[kk] = *reinterpret_cast<const bf16x8*>(ap + 32 * 256 + kk * 32);
#pragma unroll
                for (int kk = 0; kk < 6; ++kk) A2[kk] = *reinterpret_cast<const bf16x8*>(ap + 64 * 256 + kk * 32);
#pragma unroll
                for (int kk = 0; kk < 8; ++kk) A3[kk] = *reinterpret_cast<const bf16x8*>(ap + 96 * 256 + kk * 32); }
            { const int e8 = (tid & 31) * 8, ch = g * 256 + e8;
                const float4 g0 = *(const float4*)(ln_g + ch), g1 = *(const float4*)(ln_g + ch + 4), b0 = *(const float4*)(ln_b + ch), b1 = *(const float4*)(ln_b + ch + 4);
#pragma unroll
                for (int i = 0; i < 8; ++i) { const int s = (tid >> 5) + 16 * i; const uint4 w = *(const uint4*)(Vb + (row0 + s) * BW + ch); const float2 st = stats[s];
                    const float x0 = (bflo(w.x) - st.x) * st.y * g0.x + b0.x, x1 = (bfhi(w.x) - st.x) * st.y * g0.y + b0.y, x2 = (bflo(w.y) - st.x) * st.y * g0.z + b0.z, x3 = (bfhi(w.y) - st.x) * st.y * g0.w + b0.w;
                    const float x4 = (bflo(w.z) - st.x) * st.y * g1.x + b1.x, x5 = (bfhi(w.z) - st.x) * st.y * g1.y + b1.y, x6 = (bflo(w.w) - st.x) * st.y * g1.z + b1.z, x7 = (bfhi(w.w) - st.x) * st.y * g1.w + b1.w;
                    uint4 o; o.x = att::cvtpk(x0, x1); o.y = att::cvtpk(x2, x3); o.z = att::cvtpk(x4, x5); o.w = att::cvtpk(x6, x7);
                    *(uint4*)(lds + OFF_B + ((s >> 6) * 2 + (e8 >> 7)) * 16384 + att::v_st(s & 63, e8 & 127)) = o; } }
            __syncthreads();
            f32x16 acc[4] = {};
            { const int eh = wid >> 2, d0 = wid & 3;
                const int vb0 = (int)(uintptr_t)(lds + OFF_B) + att::v_rd_base(lane) + eh * 16384 + d0 * 512;
#define TRRD(dst, off) asm volatile("ds_read_b64_tr_b16 %0, %1 offset:%2" : "=&v"(dst) : "v"(vb0), "i"(off) : "memory")
#define BFRAG(dst, sh, ks) do { s16x4 l_, h_; TRRD(l_, (sh) * 32768 + (ks) * 4096); TRRD(h_, (sh) * 32768 + (ks) * 4096 + 2048); asm volatile("s_waitcnt lgkmcnt(0)" ::: "memory"); \
                dst = (bf16x8){l_[0], l_[1], l_[2], l_[3], h_[0], h_[1], h_[2], h_[3]}; } while (0)
                bf16x8 Bf[8];
                BFRAG(Bf[0], 0, 0); BFRAG(Bf[1], 0, 1); BFRAG(Bf[2], 0, 2); BFRAG(Bf[3], 0, 3); BFRAG(Bf[4], 1, 0); BFRAG(Bf[5], 1, 1); BFRAG(Bf[6], 1, 2); BFRAG(Bf[7], 1, 3);
#undef BFRAG
#undef TRRD
#pragma unroll
                for (int kk = 0; kk < 2; ++kk) acc[0] = __builtin_amdgcn_mfma_f32_32x32x16_bf16(A0[kk], Bf[kk], acc[0], 0, 0, 0);
#pragma unroll
                for (int kk = 0; kk < 4; ++kk) acc[1] = __builtin_amdgcn_mfma_f32_32x32x16_bf16(A1[kk], Bf[kk], acc[1], 0, 0, 0);
#pragma unroll
                for (int kk = 0; kk < 6; ++kk) acc[2] = __builtin_amdgcn_mfma_f32_32x32x16_bf16(A2[kk], Bf[kk], acc[2], 0, 0, 0);
#pragma unroll
                for (int kk = 0; kk < 8; ++kk) acc[3] = __builtin_amdgcn_mfma_f32_32x32x16_bf16(A3[kk], Bf[kk], acc[3], 0, 0, 0);
                char* ep = lds + OFF_EP + wid * EP_WAVE;
#pragma unroll
                for (int tb = 0; tb < 4; ++tb)
#pragma unroll
                    for (int r = 0; r < 16; ++r) { const int tl = 32 * tb + (r & 3) + 8 * (r >> 2) + 4 * hi;
                        *(unsigned short*)(ep + tl * EP_PITCH + r32 * 2) = (unsigned short)(cvtpk_s(acc[tb][r], 0.f) & 0xffffu); }
                asm volatile("s_waitcnt lgkmcnt(0)" ::: "memory");
                const int rq = lane >> 2, cq = (lane & 3) * 8;
                const size_t gbase = (row0 * BW + (size_t)(g * 256 + eh * 128 + d0 * 32 + cq)) * 2;
#pragma unroll
                for (int ph = 0; ph < 2; ++ph) {
                    uint4 uu[4], mm[4]; float bs[4];
#pragma unroll
                    for (int p = 0; p < 4; ++p) { const int t = 16 * (ph * 4 + p) + rq; const size_t o = gbase + (size_t)t * (BW * 2);
                        uu[p] = ug[ph * 4 + p]; bs[p] = b_s[g * 128 + t]; mm[p] = *(const uint4*)(ep + t * EP_PITCH + cq * 2); }
#pragma unroll
                    for (int p = 0; p < 4; ++p) { const int t = 16 * (ph * 4 + p) + rq; const size_t o = gbase + (size_t)t * (BW * 2);
                        uint4 y;
                        y.x = att::cvtpk(bflo(uu[p].x) * (bflo(mm[p].x) + bs[p]), bfhi(uu[p].x) * (bfhi(mm[p].x) + bs[p]));
                        y.y = att::cvtpk(bflo(uu[p].y) * (bflo(mm[p].y) + bs[p]), bfhi(uu[p].y) * (bfhi(mm[p].y) + bs[p]));
                        y.z = att::cvtpk(bflo(uu[p].z) * (bflo(mm[p].z) + bs[p]), bfhi(uu[p].z) * (bfhi(mm[p].z) + bs[p]));
                        y.w = att::cvtpk(bflo(uu[p].w) * (bflo(mm[p].w) + bs[p]), bfhi(uu[p].w) * (bfhi(mm[p].w) + bs[p]));
                        if (WRITE || y.x == 0x12345678u) *(uint4*)((char*)U + o) = y; } } }
            __syncthreads();
        }
    }
}
}

constexpr size_t MiB = 1u << 20;
constexpr size_t WS_CTL = 0, CTL_ZERO_BYTES = 64 * 1024;
constexpr size_t WS_WAI = 2 * MiB, WS_WAO = 12 * MiB, WS_WBI = 14 * MiB, WS_WBO = 26 * MiB;
constexpr size_t WS_WS16 = 1 * MiB;
constexpr size_t WS_RS0 = 1 * MiB + 512 * 1024;
constexpr size_t WS_H = 32 * MiB;
constexpr size_t WS_Q = 96 * MiB, WS_K = 160 * MiB, WS_V = 224 * MiB, WS_ZS = 288 * MiB;
constexpr size_t WS_QI = 352 * MiB, WS_KI = 384 * MiB, WS_WI = 388 * MiB;
constexpr size_t WS_MASK = 416 * MiB;
constexpr size_t WS_PS = 30 * MiB;
constexpr size_t WS_XB = 32 * MiB;
constexpr size_t WS_OG = 352 * MiB;
constexpr size_t WS_U = 96 * MiB, WS_VB = 224 * MiB, WS_ZB = 352 * MiB;
constexpr size_t WS_LNP = 352 * MiB;
constexpr size_t WS_TAIL = 480 * MiB;
constexpr size_t WS_END = 512 * MiB;
constexpr int CW_BAR = 1024;
constexpr int LDS_BYTES = 162816;
constexpr int MISC_OFF = 160000;
static_assert(att::ATTN_LDS_BYTES <= MISC_OFF && idx::IDX_LDS_BYTES <= MISC_OFF && sgu::SGU_LDS_BYTES <= MISC_OFF, "LDS map");

#define XB_TMO      128
#define XB_XCNT(j)  (256  + 64 * (j))
#define XB_XSUB(j)  (1280 + 64 * (j))
#define XB_XGEN(j)  (2304 + 64 * (j))
#define XB_TOP      3328
#define XB_TOPGEN   3392
#define XCD_BAR_WORDS 3456
#define XB_SPIN_CAP (1u << 18)
__device__ __forceinline__ unsigned xb_ld(unsigned* p)              { return __hip_atomic_load(p, __ATOMIC_RELAXED, __HIP_MEMORY_SCOPE_AGENT); }
__device__ __forceinline__ unsigned xb_add(unsigned* p, unsigned v) { return __hip_atomic_fetch_add(p, v, __ATOMIC_RELAXED, __HIP_MEMORY_SCOPE_AGENT); }
__device__ __forceinline__ unsigned xb_xcc_id() { return (unsigned)__builtin_amdgcn_s_getreg((3 << 11) | 20) & 0xFu; }
#define XB_SPIN(cond, bar) do { unsigned _sp = 0; while (cond) { __builtin_amdgcn_s_sleep(1); \
    if ((++_sp & 255u) == 0u) { if (xb_ld(&(bar)[XB_TMO])) break; if (_sp > XB_SPIN_CAP) { atomicAdd(&(bar)[XB_TMO], 1u); break; } } } } while (0)
struct XcdBarrier { unsigned* bar; unsigned x; volatile LAS unsigned* st; };
__device__ __forceinline__ XcdBarrier xcd_barrier_post(unsigned* bar, volatile LAS unsigned* st) {
    XcdBarrier b; b.bar = bar; b.x = xb_xcc_id(); b.st = st;
    if (threadIdx.x == 0) (void)xb_add(&bar[XB_XCNT(b.x)], 1u);
    return b;
}
__device__ __forceinline__ void xcd_barrier_complete(unsigned* bar, unsigned x, unsigned& nloc, unsigned& nx) {
    const unsigned G = gridDim.x * gridDim.y * gridDim.z;
    unsigned sum, cnt, mine, sp = 0u;
    for (;;) {
        sum = 0u; cnt = 0u; mine = 0u;
#pragma unroll
        for (unsigned j = 0; j < 16; ++j) { const unsigned c = xb_ld(&bar[XB_XCNT(j)]); sum += c; cnt += (c > 0u) ? 1u : 0u; mine = (j == x) ? c : mine; }
        if (sum == G) break;
        __builtin_amdgcn_s_sleep(1);
        if ((++sp & 255u) == 0u) { if (xb_ld(&bar[XB_TMO])) break; if (sp > XB_SPIN_CAP) { atomicAdd(&bar[XB_TMO], 1u); break; } }
    }
    nloc = mine > 0u ? mine : 1u; nx = cnt > 0u ? cnt : 1u;
}
__device__ __forceinline__ void xcd_barrier(const XcdBarrier& b) {
    asm volatile("s_waitcnt vmcnt(0)" ::: "memory");
    __syncthreads();
    if (threadIdx.x == 0) {
        unsigned* bar = b.bar;
        __builtin_amdgcn_s_waitcnt(0);
        unsigned nloc = b.st[0], nx = b.st[1];
        if (nloc == 0u) { xcd_barrier_complete(bar, b.x, nloc, nx); b.st[0] = nloc; b.st[1] = nx; }
        const unsigned old = xb_add(&bar[XB_XSUB(b.x)], 1u);
        const unsigned gen = old / nloc;
        if (old + 1u == (gen + 1u) * nloc) {
            __builtin_amdgcn_fence(__ATOMIC_RELEASE, "agent");
            asm volatile("s_waitcnt vmcnt(0)" ::: "memory");
            const unsigned og = xb_add(&bar[XB_TOP], 1u);
            const unsigned tg = og / nx;
            if (og + 1u == (tg + 1u) * nx) xb_add(&bar[XB_TOPGEN], 1u);
            else XB_SPIN(xb_ld(&bar[XB_TOPGEN]) == tg, bar);
            __builtin_amdgcn_fence(__ATOMIC_ACQUIRE, "agent");
            xb_add(&bar[XB_XGEN(b.x)], 1u);
            asm volatile("s_waitcnt vmcnt(0)" ::: "memory");
        } else {
            XB_SPIN(xb_ld(&bar[XB_XGEN(b.x)]) == gen, bar);
            __builtin_amdgcn_fence(__ATOMIC_ACQUIRE, "agent");
            asm volatile("s_waitcnt vmcnt(0)" ::: "memory");
        }
    }
    __syncthreads();
}

#ifndef MK_PER_PHASE
#define MK_PER_PHASE 0
#endif
constexpr int NPHASES = 10;
struct Args { const float* in[12]; float* out; unsigned char* ws; int ph_lo, ph_hi; };
__global__ void __launch_bounds__(512, 2) fwd(Args args) {
    extern __shared__ __attribute__((aligned(16))) unsigned char lds[];
    LAS unsigned char* ldsl = (LAS unsigned char*)lds;
    volatile LAS unsigned* MISC = (volatile LAS unsigned*)(ldsl + MISC_OFF);
    const int tid = threadIdx.x, lane = tid & 63, wave = __builtin_amdgcn_readfirstlane(tid >> 6);
    const int G = gridDim.x; const int bx = blockIdx.x; const int vcu = (G % 8 == 0) ? (bx % 8) * (G / 8) + bx / 8 : bx;
    const int gw = vcu * 8 + wave, NGW = G * 8;
    unsigned char* ws = args.ws;
    const float* x = args.in[0]; const float* norm_g = args.in[1]; const float* final_g = args.in[2]; const float* rel_bias = args.in[3];
    const float* a_w_in = args.in[4]; const float* a_w_out = args.in[5]; const float* b_w_in = args.in[6];
    const float* b_ln_g = args.in[7]; const float* b_ln_b = args.in[8]; const float* b_w_s = args.in[9]; const float* b_b_s = args.in[10]; const float* b_w_out = args.in[11];
    float* out = args.out;
    bf16 *WAI = (bf16*)(ws + WS_WAI), *WAO = (bf16*)(ws + WS_WAO), *WBI = (bf16*)(ws + WS_WBI), *WBO = (bf16*)(ws + WS_WBO), *H = (bf16*)(ws + WS_H);
    bf16 *Qb = (bf16*)(ws + WS_Q), *Kb = (bf16*)(ws + WS_K), *Vb = (bf16*)(ws + WS_V), *ZS = (bf16*)(ws + WS_ZS), *QI = (bf16*)(ws + WS_QI), *KI = (bf16*)(ws + WS_KI);
    float* WI = (float*)(ws + WS_WI); bf16* WS16 = (bf16*)(ws + WS_WS16);
    bf16 *U = (bf16*)(ws + WS_U), *V1 = (bf16*)(ws + WS_VB), *Z1 = (bf16*)(ws + WS_ZB), *XB = (bf16*)(ws + WS_XB); float* PS = (float*)(ws + WS_PS);
    if (tid < 32) MISC[tid] = 0u;
    __syncthreads();
    XcdBarrier bar; bar.bar = (unsigned*)(ws + WS_CTL) + CW_BAR; bar.x = 0; bar.st = nullptr;
    if (!MK_PER_PHASE) bar = xcd_barrier_post((unsigned*)(ws + WS_CTL) + CW_BAR, MISC + 8);
    const int lo = args.ph_lo, hi = args.ph_hi;
#ifdef DBG_SKIP
#define IN(k) (((DBG_SKIP >> (k)) & 1) == 0 && lo <= (k) && (k) < hi)
#else
#define IN(k) (lo <= (k) && (k) < hi)
#endif
#ifndef DBG_REPEAT
#define DBG_REPEAT 0
#endif
#define REP(k) _Pragma("unroll 1") for (int rep_ = 0; rep_ < 1 + ((DBG_REPEAT >> (k)) & 1); ++rep_)
#define SEAM(k) do { if (IN(k) && IN((k) + 1)) xcd_barrier(bar); } while (0)

    if (IN(0)) REP(0) {
        LAS float* scr = (LAS float*)ldsl + wave * 64 * 33;
        constexpr int I_AI = 16 * (A_NPAD / 32), I_AO = 16 * 32, I_BI = 16 * (B_COLS / 32), I_BO = 32 * 32;
        for (int it = gw; it < I_AI + I_AO + I_BI + I_BO; it += NGW) {
            int r = it;
            if (r < I_AI) { transpose_item(a_w_in, 1024, A_COLS, A_NPAD, WAI, scr, r, lane, norm_g); continue; } r -= I_AI;
            if (r < I_AO) { transpose_item(a_w_out, 1024, 1024, 1024, WAO, scr, r, lane); continue; } r -= I_AO;
            if (r < I_BI) { transpose_item(b_w_in, 1024, B_COLS, B_COLS, WBI, scr, r, lane, norm_g + DM, true); continue; } r -= I_BI;
            transpose_item(b_w_out, 2048, 1024, 1024, WBO, scr, r, lane);
        }
        for (int i = vcu * 512 + tid; i < 8 * 128 * 128; i += G * 512) WS16[i] = (i & 127) <= ((i >> 7) & 127) ? (bf16)f2bf(b_w_s[i]) : (bf16)0;
        for (int m = gw; m < M; m += NGW) row_to_bf16_rs(x + (size_t)m * DM, H + (size_t)m * DM, (float*)(ws + WS_RS0) + m, lane);
        __syncthreads();
    }
    SEAM(0);
    if (IN(1)) REP(1) {
        pg8::Gemm g{H, WAI, M, A_NPAD, 1024}; pg8::StaticOrder So; So.init(M, A_NPAD, G, bx);
        pg8::EpiA E{Qb, Kb, Vb, ZS, QI, KI, WI, (const float*)(ws + WS_RS0)};
        pg8::gemm_phase<pg8::EpiA, pg8::StaticOrder, true, true>(ldsl, g, So, E);
    }
    SEAM(1);
    if (IN(2)) REP(2) idx::indexer_phase((char*)lds, vcu, G, QI, KI, WI, (idx::u64*)(ws + WS_MASK), (char*)out, (char*)(ws + WS_TAIL), (char*)(ws + WS_WI + 1 * MiB), (char*)(ws + WS_WAI));
    SEAM(2);
    if (IN(3)) REP(3) {
        att::attn_phase((char*)lds, vcu, G, Qb, Kb, Vb, ZS, (bf16*)(ws + WS_OG), (const att::u64*)(ws + WS_MASK), rel_bias); }
    SEAM(3);
    if (IN(4)) REP(4) {
        pg8::Gemm g{(const bf16*)(ws + WS_OG), WAO, M, 1024, 1024}; pg8::StaticOrder So; So.init(M, 1024, G, bx);
        pg8::EpiRes1 E{XB, PS};
        pg8::gemm_phase<pg8::EpiRes1, pg8::StaticOrder, true, true>(ldsl, g, So, E);
    }
    if (IN(4) && IN(6)) xcd_barrier(bar);
    if (IN(6)) REP(6) {
        pg8::Gemm g{XB, WBI, M, B_COLS, 1024}; pg8::StaticOrder So; So.init(M, B_COLS, G, bx);
        pg8::EpiB E{U, V1, PS, (float*)(ws + WS_LNP)};
        pg8::gemm_phase<pg8::EpiB, pg8::StaticOrder, true, true>(ldsl, g, So, E);
    }
    SEAM(6);
#ifdef DBG_SGU2
    if (IN(7)) sgu::sgu_phase<false>((char*)lds, vcu, G, U, V1, (const float*)(ws + WS_LNP), WS16, b_ln_g, b_ln_b, b_b_s);
#endif
    if (IN(7)) sgu::sgu_phase<true>((char*)lds, vcu, G, U, V1, (const float*)(ws + WS_LNP), WS16, b_ln_g, b_ln_b, b_b_s);
    SEAM(7);
    if (IN(8)) REP(8) {
        pg8::Gemm g{U, WBO, M, 1024, 2048}; pg8::StaticOrder So; So.init(M, 1024, G, bx);
        pg8::EpiRes2 E{XB};
        pg8::gemm_phase<pg8::EpiRes2, pg8::StaticOrder, true, true>(ldsl, g, So, E);
    }
    SEAM(8);
    if (IN(9)) REP(9) { for (int m = gw; m < M; m += NGW) rms_row_bf16_to_f32(XB + (size_t)m * DM, final_g, out + (size_t)m * DM, lane); }
#undef IN
#undef SEAM
}

extern "C" void kernel_launch(void* const* d_in, const int* in_sizes, int n_in, void* d_out, int out_size, void* d_ws, size_t ws_size, hipStream_t stream) {
    static int grid = 0;
    if (grid == 0) {
        if (n_in != 12 || in_sizes[0] != M * DM || out_size != M * DM || ws_size < WS_END) { fprintf(stderr, "kernel_launch: unexpected shapes (n_in %d, in0 %d, out %d, ws %zu)\n", n_in, n_in > 0 ? in_sizes[0] : -1, out_size, ws_size); grid = -1; return; }
        int dev = 0, cus = 0, per_cu = 0;
        if (hipGetDevice(&dev) != hipSuccess || hipDeviceGetAttribute(&cus, hipDeviceAttributeMultiprocessorCount, dev) != hipSuccess) { fprintf(stderr, "kernel_launch: device query failed\n"); grid = -1; return; }
        if (hipFuncSetAttribute((const void*)fwd, hipFuncAttributeMaxDynamicSharedMemorySize, LDS_BYTES) != hipSuccess) { fprintf(stderr, "kernel_launch: hipFuncSetAttribute failed\n"); grid = -1; return; }
        if (hipOccupancyMaxActiveBlocksPerMultiprocessor(&per_cu, (const void*)fwd, 512, LDS_BYTES) != hipSuccess || per_cu < 1) { fprintf(stderr, "kernel_launch: occupancy query says %d workgroups per CU\n", per_cu); }
        (void)hipGetLastError();
        grid = cus;
    }
    if (grid < 0) return;
    if (hipMemsetAsync((char*)d_ws + WS_CTL, 0, CTL_ZERO_BYTES, stream) != hipSuccess) { fprintf(stderr, "kernel_launch: memset failed\n"); return; }
    Args a{};
    for (int i = 0; i < 12; ++i) a.in[i] = (const float*)d_in[i];
    a.out = (float*)d_out; a.ws = (unsigned char*)d_ws;
#if MK_PER_PHASE
    for (int p = 0; p < NPHASES; ++p) { a.ph_lo = p; a.ph_hi = p + 1; hipLaunchKernelGGL(fwd, dim3(grid), dim3(512), LDS_BYTES, stream, a); }
#else
    a.ph_lo = 0; a.ph_hi = NPHASES;
    hipLaunchKernelGGL(fwd, dim3(grid), dim3(512), LDS_BYTES, stream, a);
#endif
    const hipError_t le = hipPeekAtLastError();
    if (le != hipSuccess) fprintf(stderr, "kernel_launch: launch failed: %s\n", hipGetErrorName(le));
}
```

```cpp
#include <hip/hip_runtime.h>
#include <cstdio>
#include <cstdint>

constexpr int NB = 2, S = 16384, DM = 1024, M = NB * S;
constexpr int A_COLS = 4680, A_NPAD = 4864;
constexpr int BW = 2048, B_COLS = 3 * BW;
constexpr float RMS_EPS = 1e-6f, LN_EPS = 1e-5f;
constexpr float LOG2E = 1.4426950408889634f;
constexpr float QSCALE = 0.08838834764831845f * LOG2E;
constexpr float WI_SCALE = 0.35355339059327373f;
constexpr float QI_SCALE = 0.125f;
constexpr int TOPK = 256;

namespace pg8 {
#define PG8_LAS __attribute__((address_space(3)))
typedef unsigned short bf16_t;
typedef short bf16x8 __attribute__((ext_vector_type(8)));
typedef float f32x4 __attribute__((ext_vector_type(4)));
typedef unsigned u32x4 __attribute__((ext_vector_type(4)));
constexpr int BM = 256, BK = 64, HALF = 128, HTB = HALF * BK * 2  , STAGE_BYTES = 8 * HTB, NXCD = 8, WGM = 8;

__host__ __device__ __forceinline__ int lds_byte(int r, int c) { const int st = (r >> 4) * 2 + (c >> 5), rr = r & 15, cc = c & 31, ob = rr * 64 + cc * 2; return st * 1024 + (ob ^ (((ob >> 9) & 1) << 5)); }
__host__ __device__ __forceinline__ void stage_rc(int b, int& R, int& C) { const int st = b / 1024, sb = b % 1024, swz = sb ^ (((sb >> 9) & 1) << 5); R = (st >> 1) * 16 + swz / 64; C = (st & 1) * 32 + (swz % 64) / 2; }
__host__ __device__ __forceinline__ int perm32(int rho) { const int n = rho >> 4, i = rho & 15; return 8 * (i >> 2) + 4 * n + (i & 3); }

struct Unit { int pm, pn; };
struct Gemm { const bf16_t* A; const bf16_t* Bt; int M, N, K; };

struct StaticOrder {
    int nM, nN, nwg, G, c;
    __host__ __device__ void init(int M, int N, int G_, int c_) { nM = M / BM; nN = N / BM; nwg = nM * nN; G = G_; c = c_; }
    __host__ __device__ bool next(int i, Unit& u) const {
        const long L = (long)i * G + c; if (L >= nwg) return false;
        int wgid = (int)L; { const int q = nwg / NXCD, r = nwg % NXCD, xcd = wgid % NXCD, off = wgid / NXCD; wgid = (xcd < r ? xcd * (q + 1) : r * (q + 1) + (xcd - r) * q) + off; }
        const int nig = WGM * nN, gid = wgid / nig, fm = gid * WGM, gsz = (nM - fm) < WGM ? (nM - fm) : WGM;
        u.pm = fm + ((wgid % nig) % gsz); u.pn = (wgid % nig) / gsz; return true;
    }
    __device__ __forceinline__ void a_ready(const Unit&) const {}
    __device__ __forceinline__ void done(const Unit&) const {}
};

__device__ __forceinline__ unsigned cvt_pk_bf16(float lo, float hi) { unsigned r; asm volatile("v_cvt_pk_bf16_f32 %0, %1, %2" : "=v"(r) : "v"(lo), "v"(hi)); return r; }
typedef float f32x2 __attribute__((ext_vector_type(2)));
__device__ __forceinline__ float silu_f(float z) { return z * __builtin_amdgcn_rcpf(1.0f + __builtin_amdgcn_exp2f(-z * 1.4426950408889634f)); }

struct EpiA {
    static constexpr bool PERM = true, AFTER_DRAIN = false;
    bf16_t *Q, *K, *V, *ZS, *QI, *KI; float* WI; const float* RS;
    __device__ __forceinline__ void operator()(const f32x4 (&acc)[2][2][4][2], const Unit& u, int wr, int wc, int fr, int fq) const {
        const int pn = u.pn, row0 = u.pm * BM + wr * 64 + fr;
        if (pn < 18) {
            bf16_t* base; int ldc, colt; float sc = 1.f; bool act = false;
            if (pn < 4) { base = Q; ldc = 1024; colt = pn * 256; sc = 0.08838834764831845f * 1.4426950408889634f; }
            else if (pn < 8) { base = K; ldc = 1024; colt = (pn - 4) * 256; }
            else if (pn < 12) { base = V; ldc = 1024; colt = (pn - 8) * 256; }
            else if (pn < 16) { base = ZS; ldc = 1024; colt = (pn - 12) * 256; act = true; }
            else { base = QI; ldc = 512; colt = (pn - 16) * 256; sc = 0.125f; }
            const int col0 = colt + wc * 32 + 8 * fq;
#pragma unroll
            for (int ai = 0; ai < 2; ++ai)
#pragma unroll
                for (int m = 0; m < 4; ++m) { bf16_t* rowp = base + (size_t)(row0 + ai * HALF + m * 16) * ldc + col0; const float rs = RS[row0 + ai * HALF + m * 16] * sc;
#pragma unroll
                    for (int bj = 0; bj < 2; ++bj) { f32x4 v0 = acc[ai][bj][m][0] * rs, v1 = acc[ai][bj][m][1] * rs;
                        if (act) { v0 = (f32x4){silu_f(v0[0]), silu_f(v0[1]), silu_f(v0[2]), silu_f(v0[3])}; v1 = (f32x4){silu_f(v1[0]), silu_f(v1[1]), silu_f(v1[2]), silu_f(v1[3])}; }
                        u32x4 w; w.x = cvt_pk_bf16(v0[0], v0[1]); w.y = cvt_pk_bf16(v0[2], v0[3]); w.z = cvt_pk_bf16(v1[0], v1[1]); w.w = cvt_pk_bf16(v1[2], v1[3]);
                        *(u32x4*)(rowp + bj * HALF) = w; } }
        } else {
#pragma unroll
            for (int ai = 0; ai < 2; ++ai)
#pragma unroll
                for (int m = 0; m < 4; ++m) { const size_t row = (size_t)(row0 + ai * HALF + m * 16);
                    const float rs = RS[row]; const f32x4 v0 = acc[ai][0][m][0] * rs, v1 = acc[ai][0][m][1] * rs;
                    if (wc < 2) { u32x4 w; w.x = cvt_pk_bf16(v0[0], v0[1]); w.y = cvt_pk_bf16(v0[2], v0[3]); w.z = cvt_pk_bf16(v1[0], v1[1]); w.w = cvt_pk_bf16(v1[2], v1[3]);
                        *(u32x4*)(KI + row * 64 + wc * 32 + 8 * fq) = w; }
                    else if (wc == 2 && fq == 0) { const float s = 0.35355339059327373f; *(f32x4*)(WI + row * 8) = v0 * s; *(f32x4*)(WI + row * 8 + 4) = v1 * s; } }
        }
    }
};

struct EpiB {
    static constexpr bool PERM = true, AFTER_DRAIN = false;
    bf16_t* Gt; bf16_t* Vt;
    const float* PS;
    float* LNP;
    __device__ __forceinline__ float rowscale(const float* psrow) const {
        const f32x4* pp = (const f32x4*)psrow; const f32x4 q0 = pp[0], q1 = pp[1], q2 = pp[2], q3 = pp[3];
        const float ss = ((q0[0] + q0[1]) + (q0[2] + q0[3])) + ((q1[0] + q1[1]) + (q1[2] + q1[3])) + ((q2[0] + q2[1]) + (q2[2] + q2[3])) + ((q3[0] + q3[1]) + (q3[2] + q3[3]));
        return 1.0f / sqrtf(ss * (1.f / 1024.f) + 1e-6f); }
    __device__ __forceinline__ void operator()(const f32x4 (&acc)[2][2][4][2], const Unit& u, int wr, int wc, int fr, int fq) const {
        const int pn = u.pn, row0 = u.pm * BM + wr * 64 + fr;
        const float* psrow = PS + (size_t)row0 * 16;
        if (pn < 16) {
            bf16_t* p = Gt + (size_t)row0 * 2048 + pn * 128 + wc * 32 + 8 * fq;
#pragma unroll
            for (int ai = 0; ai < 2; ++ai)
#pragma unroll
                for (int m = 0; m < 4; ++m) { const float rs = rowscale(psrow + (size_t)(ai * HALF + m * 16) * 16);
                    const f32x4 u0 = acc[ai][0][m][0] * rs, u1 = acc[ai][0][m][1] * rs, z0 = acc[ai][1][m][0] * rs, z1 = acc[ai][1][m][1] * rs;
                    u32x4 w; w.x = cvt_pk_bf16(u0[0] * silu_f(z0[0]), u0[1] * silu_f(z0[1])); w.y = cvt_pk_bf16(u0[2] * silu_f(z0[2]), u0[3] * silu_f(z0[3]));
                    w.z = cvt_pk_bf16(u1[0] * silu_f(z1[0]), u1[1] * silu_f(z1[1])); w.w = cvt_pk_bf16(u1[2] * silu_f(z1[2]), u1[3] * silu_f(z1[3]));
                    *(u32x4*)(p + (size_t)(ai * HALF + m * 16) * 2048) = w; }
        } else {
            const int tv = pn - 16; bf16_t* p = Vt + (size_t)row0 * 2048 + tv * 256 + wc * 32 + 8 * fq;
#pragma unroll
            for (int ai = 0; ai < 2; ++ai)
#pragma unroll
                for (int m = 0; m < 4; ++m) { const int ro = ai * HALF + m * 16; const float rs = rowscale(psrow + (size_t)ro * 16); float s1 = 0.f, s2 = 0.f;
#pragma unroll
                    for (int bj = 0; bj < 2; ++bj) { const f32x4 v0 = acc[ai][bj][m][0] * rs, v1 = acc[ai][bj][m][1] * rs;
                        s1 += ((v0[0] + v0[1]) + (v0[2] + v0[3])) + ((v1[0] + v1[1]) + (v1[2] + v1[3]));
                        s2 += ((v0[0] * v0[0] + v0[1] * v0[1]) + (v0[2] * v0[2] + v0[3] * v0[3])) + ((v1[0] * v1[0] + v1[1] * v1[1]) + (v1[2] * v1[2] + v1[3] * v1[3]));
                        u32x4 w; w.x = cvt_pk_bf16(v0[0], v0[1]); w.y = cvt_pk_bf16(v0[2], v0[3]); w.z = cvt_pk_bf16(v1[0], v1[1]); w.w = cvt_pk_bf16(v1[2], v1[3]);
                        *(u32x4*)(p + (size_t)ro * 2048 + bj * HALF) = w; }
                    s1 += __shfl_xor(s1, 16); s1 += __shfl_xor(s1, 32); s2 += __shfl_xor(s2, 16); s2 += __shfl_xor(s2, 32);
                    if (fq == 0) { typedef float f32x2_ __attribute__((ext_vector_type(2))); *(f32x2_*)(LNP + ((size_t)(row0 + ro) * 32 + tv * 4 + wc) * 2) = (f32x2_){s1, s2}; } }
        }
    }
};

struct EpiRes2 {
    static constexpr bool PERM = true, AFTER_DRAIN = false;
    bf16_t* XB;
    __device__ __forceinline__ void operator()(const f32x4 (&acc)[2][2][4][2], const Unit& u, int wr, int wc, int fr, int fq) const {
        const int row0 = u.pm * BM + wr * 64 + fr, col0 = u.pn * BM + wc * 32 + 8 * fq;
#pragma unroll
        for (int ai = 0; ai < 2; ++ai) { u32x4 bb[4][2];
#pragma unroll
            for (int m = 0; m < 4; ++m)
#pragma unroll
                for (int bj = 0; bj < 2; ++bj) bb[m][bj] = *(const u32x4*)(XB + (size_t)(row0 + ai * HALF + m * 16) * 1024 + col0 + bj * HALF);
#pragma unroll
            for (int m = 0; m < 4; ++m)
#pragma unroll
                for (int bj = 0; bj < 2; ++bj) { const u32x4 b = bb[m][bj]; const f32x4 a0 = acc[ai][bj][m][0], a1 = acc[ai][bj][m][1]; u32x4 w;
                    w.x = cvt_pk_bf16(__uint_as_float(b.x << 16) + a0[0], __uint_as_float(b.x & 0xffff0000u) + a0[1]);
                    w.y = cvt_pk_bf16(__uint_as_float(b.y << 16) + a0[2], __uint_as_float(b.y & 0xffff0000u) + a0[3]);
                    w.z = cvt_pk_bf16(__uint_as_float(b.z << 16) + a1[0], __uint_as_float(b.z & 0xffff0000u) + a1[1]);
                    w.w = cvt_pk_bf16(__uint_as_float(b.w << 16) + a1[2], __uint_as_float(b.w & 0xffff0000u) + a1[3]);
                    *(u32x4*)(XB + (size_t)(row0 + ai * HALF + m * 16) * 1024 + col0 + bj * HALF) = w; } }
    }
};

struct EpiRes1 {
    static constexpr bool PERM = true, AFTER_DRAIN = false;
    bf16_t* XB; float* PS;
    __device__ __forceinline__ void operator()(const f32x4 (&acc)[2][2][4][2], const Unit& u, int wr, int wc, int fr, int fq) const {
        const int row0 = u.pm * BM + wr * 64 + fr, col0 = u.pn * BM + wc * 32 + 8 * fq;
#pragma unroll
        for (int ai = 0; ai < 2; ++ai) { u32x4 bb[4][2];
#pragma unroll
            for (int m = 0; m < 4; ++m)
#pragma unroll
                for (int bj = 0; bj < 2; ++bj) bb[m][bj] = *(const u32x4*)(XB + (size_t)(row0 + ai * HALF + m * 16) * 1024 + col0 + bj * HALF);
#pragma unroll
            for (int m = 0; m < 4; ++m) { const size_t row = (size_t)(row0 + ai * HALF + m * 16); float ss = 0.f;
#pragma unroll
                for (int bj = 0; bj < 2; ++bj) { const u32x4 b = bb[m][bj]; const f32x4 a0 = acc[ai][bj][m][0], a1 = acc[ai][bj][m][1];
                    const f32x4 v0 = {__uint_as_float(b.x << 16) + a0[0], __uint_as_float(b.x & 0xffff0000u) + a0[1], __uint_as_float(b.y << 16) + a0[2], __uint_as_float(b.y & 0xffff0000u) + a0[3]};
                    const f32x4 v1 = {__uint_as_float(b.z << 16) + a1[0], __uint_as_float(b.z & 0xffff0000u) + a1[1], __uint_as_float(b.w << 16) + a1[2], __uint_as_float(b.w & 0xffff0000u) + a1[3]};
                    ss += ((v0[0] * v0[0] + v0[1] * v0[1]) + (v0[2] * v0[2] + v0[3] * v0[3])) + ((v1[0] * v1[0] + v1[1] * v1[1]) + (v1[2] * v1[2] + v1[3] * v1[3]));
                    u32x4 w; w.x = cvt_pk_bf16(v0[0], v0[1]); w.y = cvt_pk_bf16(v0[2], v0[3]); w.z = cvt_pk_bf16(v1[0], v1[1]); w.w = cvt_pk_bf16(v1[2], v1[3]);
                    *(u32x4*)(XB + row * 1024 + col0 + bj * HALF) = w; }
                ss += __shfl_xor(ss, 16); ss += __shfl_xor(ss, 32);
                if (fq == 0) PS[row * 16 + u.pn * 4 + wc] = ss; } }
    }
};

template <class Epi, class Sched, bool ALIGN_EPI = false, bool SP2 = false>
__device__ __forceinline__ void gemm_phase(PG8_LAS unsigned char* lds, const Gemm g, const Sched& S, const Epi& E) {
    const int tid = threadIdx.x, wid = __builtin_amdgcn_readfirstlane(tid >> 6), lane = tid & 63, wr = wid >> 2, wc = wid & 3, fr = lane & 15, fq = lane >> 4;
    const int K = g.K, nt = K / BK;
    unsigned voffA[2], voffB[2];
#pragma unroll
    for (int i = 0; i < 2; ++i) { int R, C; stage_rc(tid * 16 + i * 8192, R, C); const int Rb = Epi::PERM ? ((R & ~31) + perm32(R & 31)) : R;
        voffA[i] = (unsigned)(R * K + C) * 2u; voffB[i] = (unsigned)(Rb * K + C) * 2u; }
    const size_t kstep = (size_t)(BK * 2);
    const size_t hstep = (size_t)HALF * K * 2;
    const size_t tstep = 2 * hstep;
    const unsigned ldsw = (unsigned)wid * 1024u;
    const int aoff = lds_byte(wr * 64 + fr, fq * 8), boff = lds_byte(wc * 32 + fr, fq * 8);
#define PG8_SA(b, h) (((b) * 2 + (h)) * HTB)
#define PG8_SB(b, h) ((4 + (b) * 2 + (h)) * HTB)
#define PG8_STAGE(bufoff, gbase, voff) do { _Pragma("unroll") for (int _i = 0; _i < 2; ++_i) \
        __builtin_amdgcn_global_load_lds((const unsigned*)((const char*)(gbase) + (voff)[_i]), (PG8_LAS unsigned*)(lds + (bufoff) + ldsw + _i * 8192), 16, 0, 0); } while (0)
#define PG8_LDA(dst, b, h) do { _Pragma("unroll") for (int m = 0; m < 4; ++m) _Pragma("unroll") for (int k = 0; k < 2; ++k) dst[m][k] = *(const PG8_LAS bf16x8*)(lds + PG8_SA(b, h) + aoff + m * 2048 + k * 1024); } while (0)
#define PG8_LDB(dst, b, h) do { _Pragma("unroll") for (int n = 0; n < 2; ++n) _Pragma("unroll") for (int k = 0; k < 2; ++k) dst[n][k] = *(const PG8_LAS bf16x8*)(lds + PG8_SB(b, h) + boff + n * 2048 + k * 1024); } while (0)
#define PG8_MMA(ai, bj, At, Bt) do { __builtin_amdgcn_s_setprio(1); _Pragma("unroll") for (int m = 0; m < 4; ++m) _Pragma("unroll") for (int n = 0; n < 2; ++n) _Pragma("unroll") for (int k = 0; k < 2; ++k) \
        acc[ai][bj][m][n] = __builtin_amdgcn_mfma_f32_16x16x32_bf16(Bt[n][k], At[m][k], acc[ai][bj][m][n], 0, 0, 0); __builtin_amdgcn_s_setprio(0); } while (0)
#define PG8_WAIT_V(n) asm volatile("s_waitcnt vmcnt(" #n ")" ::: "memory")
#define PG8_WAIT_L(n) asm volatile("s_waitcnt lgkmcnt(" #n ")" ::: "memory")
#define PG8_BAR __builtin_amdgcn_s_barrier()
#define PG8_SCHED __builtin_amdgcn_sched_barrier(0)
    Unit cur, nxt; int ui = 0;
    if (!S.next(0, cur)) return;
    f32x4 acc[2][2][4][2];
#pragma unroll
    for (int a = 0; a < 2; ++a)
#pragma unroll
        for (int b = 0; b < 2; ++b)
#pragma unroll
            for (int m = 0; m < 4; ++m)
#pragma unroll
                for (int n = 0; n < 2; ++n) acc[a][b][m][n] = (f32x4){0.f, 0.f, 0.f, 0.f};
    bf16x8 At[4][2], B0[2][2], B1[2][2];
    const char* cA = (const char*)g.A + (size_t)cur.pm * tstep; const char* cB = (const char*)g.Bt + (size_t)cur.pn * tstep;
    S.a_ready(cur);
    if constexpr (SP2) {
        PG8_STAGE(PG8_SB(0, 0), cB, voffB); PG8_STAGE(PG8_SB(0, 1), cB + hstep, voffB); PG8_STAGE(PG8_SA(0, 0), cA, voffA); PG8_STAGE(PG8_SA(0, 1), cA + hstep, voffA);
        if (wr == 1) PG8_BAR;
        PG8_WAIT_V(2); PG8_BAR;
        PG8_STAGE(PG8_SB(1, 0), cB + kstep, voffB); PG8_STAGE(PG8_SA(1, 0), cA + kstep, voffA); PG8_STAGE(PG8_SB(1, 1), cB + hstep + kstep, voffB);
        PG8_WAIT_V(6); PG8_BAR;
    } else {
        PG8_STAGE(PG8_SB(0, 0), cB, voffB); PG8_STAGE(PG8_SA(0, 0), cA, voffA); PG8_STAGE(PG8_SB(0, 1), cB + hstep, voffB); PG8_STAGE(PG8_SA(0, 1), cA + hstep, voffA);
        if (wr == 1) PG8_BAR;
        PG8_WAIT_V(4); PG8_BAR;
        PG8_STAGE(PG8_SB(1, 0), cB + kstep, voffB); PG8_STAGE(PG8_SA(1, 0), cA + kstep, voffA); PG8_STAGE(PG8_SB(1, 1), cB + hstep + kstep, voffB);
        PG8_WAIT_V(6); PG8_BAR;
    }
    for (;;) {
        const bool has_next = S.next(ui + 1, nxt);
        const char* nA = has_next ? (const char*)g.A + (size_t)nxt.pm * tstep : cA; const char* nB = has_next ? (const char*)g.Bt + (size_t)nxt.pn * tstep : cB;
        for (int t = 0; t < nt; t += 2) {
            const bool last = (t == nt - 2);
            const char* a1 = cA + (size_t)(t + 1) * kstep;
            const char* a2 = last ? nA : cA + (size_t)(t + 2) * kstep; const char* b2 = last ? nB : cB + (size_t)(t + 2) * kstep;
            const char* a3 = a2 + kstep; const char* b3 = b2 + kstep;
            if (last && has_next) S.a_ready(nxt);
            if constexpr (SP2) {
            PG8_LDB(B0, 0, 0); PG8_LDB(B1, 0, 1); PG8_SCHED; PG8_LDA(At, 0, 0); PG8_STAGE(PG8_SA(1, 1), a1 + hstep, voffA);
            PG8_WAIT_V(8); PG8_WAIT_L(0); PG8_BAR; PG8_MMA(0, 0, At, B0); PG8_MMA(0, 1, At, B1); PG8_BAR; PG8_SCHED;
            PG8_LDA(At, 0, 1); PG8_STAGE(PG8_SB(0, 0), b2, voffB); PG8_STAGE(PG8_SB(0, 1), b2 + hstep, voffB); PG8_STAGE(PG8_SA(0, 0), a2, voffA);
            PG8_WAIT_V(8); PG8_WAIT_L(0); PG8_BAR; PG8_MMA(1, 0, At, B0); PG8_MMA(1, 1, At, B1); PG8_BAR; PG8_SCHED;
            PG8_LDB(B0, 1, 0); PG8_LDB(B1, 1, 1); PG8_SCHED; PG8_LDA(At, 1, 0); PG8_STAGE(PG8_SA(0, 1), a2 + hstep, voffA);
            PG8_WAIT_V(8); PG8_WAIT_L(0); PG8_BAR; PG8_MMA(0, 0, At, B0); PG8_MMA(0, 1, At, B1); PG8_BAR; PG8_SCHED;
            PG8_LDA(At, 1, 1); PG8_STAGE(PG8_SB(1, 0), b3, voffB); PG8_STAGE(PG8_SB(1, 1), b3 + hstep, voffB); PG8_STAGE(PG8_SA(1, 0), a3, voffA);
            PG8_WAIT_V(8); PG8_WAIT_L(0); PG8_BAR; PG8_MMA(1, 0, At, B0); PG8_MMA(1, 1, At, B1); PG8_BAR; PG8_SCHED;
            } else {
            PG8_LDB(B0, 0, 0); PG8_SCHED; PG8_LDA(At, 0, 0); PG8_STAGE(PG8_SA(1, 1), a1 + hstep, voffA);
            PG8_WAIT_L(8); PG8_BAR; PG8_WAIT_L(0); PG8_MMA(0, 0, At, B0); PG8_BAR; PG8_SCHED;
            PG8_LDB(B1, 0, 1); PG8_STAGE(PG8_SB(0, 0), b2, voffB);
            PG8_BAR; PG8_WAIT_L(0); PG8_MMA(0, 1, At, B1); PG8_BAR;
            PG8_LDA(At, 0, 1); PG8_STAGE(PG8_SA(0, 0), a2, voffA);
            PG8_BAR; PG8_WAIT_L(0); PG8_MMA(1, 0, At, B0); PG8_BAR; PG8_SCHED;
            PG8_STAGE(PG8_SB(0, 1), b2 + hstep, voffB);
            PG8_WAIT_V(6); PG8_BAR; PG8_MMA(1, 1, At, B1); PG8_BAR;
            PG8_LDB(B0, 1, 0); PG8_SCHED; PG8_LDA(At, 1, 0); PG8_STAGE(PG8_SA(0, 1), a2 + hstep, voffA);
            PG8_WAIT_L(8); PG8_BAR; PG8_WAIT_L(0); PG8_MMA(0, 0, At, B0); PG8_BAR; PG8_SCHED;
            PG8_LDB(B1, 1, 1); PG8_STAGE(PG8_SB(1, 0), b3, voffB);
            PG8_BAR; PG8_WAIT_L(0); PG8_MMA(0, 1, At, B1); PG8_BAR;
            PG8_LDA(At, 1, 1); PG8_STAGE(PG8_SA(1, 0), a3, voffA);
            PG8_BAR; PG8_WAIT_L(0); PG8_MMA(1, 0, At, B0); PG8_BAR; PG8_SCHED;
            PG8_STAGE(PG8_SB(1, 1), b3 + hstep, voffB);
            PG8_WAIT_V(6); PG8_BAR; PG8_MMA(1, 1, At, B1); PG8_BAR;
            }
        }
        if constexpr (ALIGN_EPI) { if (wr == 0) PG8_BAR; }
        if constexpr (!Epi::AFTER_DRAIN) { E(acc, cur, wr, wc, fr, fq); S.done(cur); }
        if (!has_next) break;
#pragma unroll
        for (int a = 0; a < 2; ++a)
#pragma unroll
            for (int b = 0; b < 2; ++b)
#pragma unroll
                for (int m = 0; m < 4; ++m)
#pragma unroll
                    for (int n = 0; n < 2; ++n) acc[a][b][m][n] = (f32x4){0.f, 0.f, 0.f, 0.f};
        cur = nxt; cA = nA; cB = nB; ++ui;
        if constexpr (ALIGN_EPI) { if (wr == 1) PG8_BAR; }
    }
    PG8_WAIT_V(0);
    if constexpr (!ALIGN_EPI) { if (wr == 0) PG8_BAR; }
    PG8_BAR;
    if constexpr (Epi::AFTER_DRAIN) { E.fused(acc, cur, wr, wc, fr, fq, lds, wid, lane); S.done(cur); }
#undef PG8_SA
#undef PG8_SB
#undef PG8_STAGE
#undef PG8_LDA
#undef PG8_LDB
#undef PG8_MMA
#undef PG8_WAIT_V
#undef PG8_WAIT_L
#undef PG8_BAR
#undef PG8_SCHED
}
}
#define LAS __attribute__((address_space(3)))
typedef unsigned short bf16;
typedef float f32x4 __attribute__((ext_vector_type(4)));
typedef unsigned v4u __attribute__((ext_vector_type(4)));
typedef unsigned v2u __attribute__((ext_vector_type(2)));
__device__ __forceinline__ unsigned f2bf(float f) { unsigned u = __builtin_bit_cast(unsigned, f); return (u + 0x7fffu + ((u >> 16) & 1u)) >> 16; }
__device__ __forceinline__ unsigned pk2(float lo, float hi) { return f2bf(lo) | (f2bf(hi) << 16); }
__device__ __forceinline__ float bflo(unsigned w) { return __builtin_bit_cast(float, w << 16); }
__device__ __forceinline__ float bfhi(unsigned w) { return __builtin_bit_cast(float, w & 0xffff0000u); }
__device__ __forceinline__ float wave_sum(float v) {
#pragma unroll
    for (int o = 1; o < 64; o <<= 1) v += __shfl_xor(v, o);
    return v;
}
__device__ __forceinline__ float wave_max(float v) {
#pragma unroll
    for (int o = 1; o < 64; o <<= 1) v = fmaxf(v, __shfl_xor(v, o));
    return v;
}
__device__ __forceinline__ int t5_bucket(int rel) {
    const int ret = rel < 0 ? 16 : 0; const int n = rel < 0 ? -rel : rel;
    int v;
    if (n < 8) v = n; else if (n < 12) v = 8; else if (n < 16) v = 9; else if (n < 23) v = 10; else if (n < 32) v = 11; else if (n < 46) v = 12; else if (n < 64) v = 13; else if (n < 91) v = 14; else v = 15;
    return ret + v;
}

__device__ __forceinline__ void transpose_item(const float* W, int K, int N, int Npad, bf16* WT, LAS float* scr, int item, int lane, const float* gk = nullptr  , bool uzv = false  ) {
    const int nblk = Npad / 32, kb = item / nblk, nb = item % nblk, k0 = 64 * kb, n0 = 32 * nb;
    const int nn = n0 + (lane & 31);
    const int d0 = !uzv ? n0 : n0 < 2048 ? 256 * (n0 >> 7) + (n0 & 127) : n0 < 4096 ? n0 + 2048 : 256 * ((n0 - 4096) >> 7) + 128 + (n0 & 127);
#pragma unroll 8
    for (int i = 0; i < 32; ++i) { const int kk = 2 * i + (lane >> 5); scr[kk * 33 + (lane & 31)] = nn < N ? W[(size_t)(k0 + kk) * N + nn] * (gk ? gk[k0 + kk] : 1.f) : 0.f; }
    asm volatile("s_waitcnt lgkmcnt(0)" ::: "memory");
    const int c = lane & 7;
#pragma unroll
    for (int j = 0; j < 4; ++j) { const int n = (lane >> 3) + 8 * j; const LAS float* s = scr + (8 * c) * 33 + n;
        v4u o; o.x = pk2(s[0 * 33], s[1 * 33]); o.y = pk2(s[2 * 33], s[3 * 33]); o.z = pk2(s[4 * 33], s[5 * 33]); o.w = pk2(s[6 * 33], s[7 * 33]);
        *(v4u*)(WT + (size_t)(d0 + n) * K + k0 + 8 * c) = o; }
    asm volatile("s_waitcnt lgkmcnt(0)" ::: "memory");
}
__device__ __forceinline__ void rms_row_to_bf16(const float* xrow, const float* g, bf16* orow, int lane) {
    const f32x4* xr = (const f32x4*)xrow + lane; const f32x4* gr = (const f32x4*)g + lane;
    f32x4 v[4]; float s = 0.f;
#pragma unroll
    for (int j = 0; j < 4; ++j) { v[j] = xr[64 * j]; s += (v[j].x * v[j].x + v[j].y * v[j].y) + (v[j].z * v[j].z + v[j].w * v[j].w); }
    const float rs = 1.0f / sqrtf(wave_sum(s) * (1.f / 1024.f) + RMS_EPS);
    v2u* o8 = (v2u*)orow + lane;
#pragma unroll
    for (int j = 0; j < 4; ++j) { const f32x4 gg = gr[64 * j]; v2u o; o.x = pk2(v[j].x * rs * gg.x, v[j].y * rs * gg.y); o.y = pk2(v[j].z * rs * gg.z, v[j].w * rs * gg.w); o8[64 * j] = o; }
}
__device__ __forceinline__ void rms_row_f32(const float* xrow, const float* g, float* orow, int lane) {
    const f32x4* xr = (const f32x4*)xrow + lane; const f32x4* gr = (const f32x4*)g + lane;
    f32x4 v[4]; float s = 0.f;
#pragma unroll
    for (int j = 0; j < 4; ++j) { v[j] = xr[64 * j]; s += (v[j].x * v[j].x + v[j].y * v[j].y) + (v[j].z * v[j].z + v[j].w * v[j].w); }
    const float rs = 1.0f / sqrtf(wave_sum(s) * (1.f / 1024.f) + RMS_EPS);
    f32x4* o = (f32x4*)orow + lane;
#pragma unroll
    for (int j = 0; j < 4; ++j) { const f32x4 gg = gr[64 * j]; o[64 * j] = v[j] * rs * gg; }
}


__device__ __forceinline__ void rms_row_bf16_to_f32(const bf16* xrow, const float* g, float* orow, int lane) {
    typedef unsigned u32x4_ __attribute__((ext_vector_type(4)));
    float v[2][8]; float s = 0.f;
#pragma unroll
    for (int j = 0; j < 2; ++j) { const u32x4_ b = *((const u32x4_*)xrow + 64 * j + lane);
        v[j][0] = __uint_as_float(b.x << 16); v[j][1] = __uint_as_float(b.x & 0xffff0000u); v[j][2] = __uint_as_float(b.y << 16); v[j][3] = __uint_as_float(b.y & 0xffff0000u);
        v[j][4] = __uint_as_float(b.z << 16); v[j][5] = __uint_as_float(b.z & 0xffff0000u); v[j][6] = __uint_as_float(b.w << 16); v[j][7] = __uint_as_float(b.w & 0xffff0000u);
#pragma unroll
        for (int e = 0; e < 8; ++e) s += v[j][e] * v[j][e]; }
    const float rs = 1.0f / sqrtf(wave_sum(s) * (1.f / 1024.f) + RMS_EPS);
#pragma unroll
    for (int j = 0; j < 2; ++j) { const f32x4* gr = (const f32x4*)g + 128 * j + 2 * lane; f32x4* o = (f32x4*)orow + 128 * j + 2 * lane; const f32x4 g0 = gr[0], g1 = gr[1];
        o[0] = (f32x4){v[j][0] * rs * g0.x, v[j][1] * rs * g0.y, v[j][2] * rs * g0.z, v[j][3] * rs * g0.w};
        o[1] = (f32x4){v[j][4] * rs * g1.x, v[j][5] * rs * g1.y, v[j][6] * rs * g1.z, v[j][7] * rs * g1.w}; }
}

__device__ __forceinline__ void row_to_bf16_rs(const float* xrow, bf16* orow, float* rs_out, int lane) {
    const f32x4* xr = (const f32x4*)xrow + lane;
    f32x4 v[4]; float s = 0.f;
#pragma unroll
    for (int j = 0; j < 4; ++j) { v[j] = xr[64 * j]; s += (v[j].x * v[j].x + v[j].y * v[j].y) + (v[j].z * v[j].z + v[j].w * v[j].w); }
    v2u* o8 = (v2u*)orow + lane;
#pragma unroll
    for (int j = 0; j < 4; ++j) { v2u o; o.x = pk2(v[j].x, v[j].y); o.y = pk2(v[j].z, v[j].w); o8[64 * j] = o; }
    const float rs = 1.0f / sqrtf(wave_sum(s) * (1.f / 1024.f) + RMS_EPS);
    if (lane == 0) *rs_out = rs;
}
namespace idx {
typedef unsigned short bf16;
typedef short bf16x8 __attribute__((ext_vector_type(8)));
typedef float f32x16 __attribute__((ext_vector_type(16)));
typedef unsigned long long u64;
constexpr int NBINS = 256, HSTR = 257, CAP = 512, FCAP = 2048;
constexpr int OFF_HIST = 0;
constexpr int OFF_QL = 66048;
constexpr int OFF_STAT = 64 * 513 * 4 + 128;
constexpr int OFF_QPAR = OFF_STAT + 2048;
constexpr int OFF_BSTAR = OFF_QPAR + 512, OFF_NEED = OFF_BSTAR + 256, OFF_BCNT = OFF_NEED + 256;
constexpr int OFF_FB = OFF_BCNT + 256;
constexpr int OFF_FBH = OFF_FB + 512;
constexpr int OFF_QF = OFF_FBH + 1024 + 64;
constexpr int OFF_WV = OFF_QF + 2048;
constexpr int OFF_FLAT = OFF_WV + 2048;
constexpr int IDX_LDS_BYTES = OFF_FLAT + 2 * FCAP * 4;
#ifndef IDX_REPS
#define IDX_REPS 1
#endif
#ifndef DBG_FORCE_FB
#define DBG_FORCE_FB 0
#endif

__device__ __forceinline__ int crow(int r, int hi) { return (r & 3) + 8 * (r >> 2) + 4 * hi; }
__device__ __forceinline__ float z_upper(float p) {
    const bool flip = p > 0.5f; const float pp = flip ? 1.f - p : p; const float t = sqrtf(-2.f * logf(pp));
    float num = 2.515517f + t * (0.802853f + t * 0.010328f); asm volatile("" : "+v"(num));
    const float den = 1.f + t * (1.432788f + t * (0.189269f + t * 0.001308f));
    const float z = t - num / den;
    return flip ? -z : z;
}
typedef float f32x4_t __attribute__((ext_vector_type(4)));
__device__ __forceinline__ void load_a16(bf16x8 (&a)[2][2], const char* kib, int j, int l15, int kq) {
    const char* kp = kib + (size_t)(unsigned)((j * 32 + l15) * 128 + kq * 16);
#pragma unroll
    for (int rb = 0; rb < 2; ++rb)
#pragma unroll
        for (int ks = 0; ks < 2; ++ks) a[rb][ks] = *reinterpret_cast<const bf16x8*>(kp + rb * 2048 + ks * 64);
}
template <bool PF>
__device__ __forceinline__ void tile_scores16(bf16x8 (&a)[2][2], const bf16x8 (&qreg)[8][2][2], const char* qlp  , const float* wv0, const float* wv1, float (&sc)[16], const char* kib, int jn, int l15, int kq) {
    f32x4_t dl[2][2]; bf16x8 qL[2][2];
#pragma unroll
    for (int cb = 0; cb < 2; ++cb)
#pragma unroll
        for (int ks = 0; ks < 2; ++ks) qL[cb][ks] = *reinterpret_cast<const bf16x8*>(qlp + (cb * 2 + ks) * 8192);
#pragma unroll
    for (int rb = 0; rb < 2; ++rb)
#pragma unroll
        for (int cb = 0; cb < 2; ++cb) { f32x4_t t = {0.f, 0.f, 0.f, 0.f};
#pragma unroll
            for (int ks = 0; ks < 2; ++ks) t = __builtin_amdgcn_mfma_f32_16x16x32_bf16(a[rb][ks], qL[cb][ks], t, 0, 0, 0);
            dl[rb][cb] = t; }
#pragma unroll
    for (int h = 0; h < 8; ++h) { f32x4_t d[2][2];
#pragma unroll
        for (int rb = 0; rb < 2; ++rb)
#pragma unroll
            for (int cb = 0; cb < 2; ++cb) { f32x4_t t = {0.f, 0.f, 0.f, 0.f};
#pragma unroll
                for (int ks = 0; ks < 2; ++ks) t = __builtin_amdgcn_mfma_f32_16x16x32_bf16(a[rb][ks], qreg[h][cb][ks], t, 0, 0, 0);
                d[rb][cb] = t; }
        asm volatile("" ::: "memory");
        if (PF && h == 7) load_a16(a, kib, jn, l15, kq);
        const float w0 = wv0[h], w1 = wv1[h];
#pragma unroll
        for (int rb = 0; rb < 2; ++rb)
#pragma unroll
            for (int cb = 0; cb < 2; ++cb)
#pragma unroll
                for (int r = 0; r < 4; ++r) { const int i = (2 * rb + cb) * 4 + r; sc[i] = fmaf(cb ? w1 : w0, __builtin_fabsf(d[rb][cb][r]), h == 0 ? dl[rb][cb][r] : sc[i]); } }
}
__device__ __forceinline__ unsigned fkey(float f) { const unsigned u = __builtin_bit_cast(unsigned, f); return (u & 0x80000000u) ? ~u : (u | 0x80000000u); }

__device__ __forceinline__ void mask_or_bit(u64* mwq, int qc, int s) {
    const int kk = s & 31, hk = (kk >> 2) & 1, r = (kk & 3) + 4 * (kk >> 3);
    __hip_atomic_fetch_or(mwq + (size_t)(s >> 5) * 16 + r, 1ull << (qc + 32 * hk), __ATOMIC_RELAXED, __HIP_MEMORY_SCOPE_AGENT);
}

__device__ __forceinline__ void fallback_query(char* lds, int tid, int tg  , int qc, int n, const bf16* QI, const char* kib, const float* WI, u64* mwq) {
    asm volatile("" : "+v"(tid));
    float* sc = (float*)(lds + OFF_HIST); unsigned* hist = (unsigned*)(lds + OFF_FBH); unsigned* misc = hist + 256; float* qf = (float*)(lds + OFF_QF);
    __syncthreads();
    if (tid < 256) { const unsigned w = ((const unsigned*)(QI + (size_t)tg * 512))[tid]; qf[2 * tid] = __builtin_bit_cast(float, w << 16); qf[2 * tid + 1] = __builtin_bit_cast(float, w & 0xffff0000u); }
    __syncthreads();
    for (int s = tid; s < n; s += 1024) {
        const int s2 = s + 512 < n ? s + 512 : s;
        const uint4* kp0 = (const uint4*)(kib + (size_t)s * 128); const uint4* kp1 = (const uint4*)(kib + (size_t)s2 * 128);
        float kf0[64], kf1[64];
#pragma unroll
        for (int c = 0; c < 8; ++c) { const uint4 w = kp0[c], x = kp1[c];
            kf0[8 * c] = __builtin_bit_cast(float, w.x << 16); kf0[8 * c + 1] = __builtin_bit_cast(float, w.x & 0xffff0000u); kf0[8 * c + 2] = __builtin_bit_cast(float, w.y << 16); kf0[8 * c + 3] = __builtin_bit_cast(float, w.y & 0xffff0000u);
            kf0[8 * c + 4] = __builtin_bit_cast(float, w.z << 16); kf0[8 * c + 5] = __builtin_bit_cast(float, w.z & 0xffff0000u); kf0[8 * c + 6] = __builtin_bit_cast(float, w.w << 16); kf0[8 * c + 7] = __builtin_bit_cast(float, w.w & 0xffff0000u);
            kf1[8 * c] = __builtin_bit_cast(float, x.x << 16); kf1[8 * c + 1] = __builtin_bit_cast(float, x.x & 0xffff0000u); kf1[8 * c + 2] = __builtin_bit_cast(float, x.y << 16); kf1[8 * c + 3] = __builtin_bit_cast(float, x.y & 0xffff0000u);
            kf1[8 * c + 4] = __builtin_bit_cast(float, x.z << 16); kf1[8 * c + 5] = __builtin_bit_cast(float, x.z & 0xffff0000u); kf1[8 * c + 6] = __builtin_bit_cast(float, x.w << 16); kf1[8 * c + 7] = __builtin_bit_cast(float, x.w & 0xffff0000u); }
        float sc0 = 0.f, sc1 = 0.f;
#pragma unroll 1
        for (int h = 0; h < 8; ++h) { float d0 = 0.f, d1 = 0.f;
#pragma unroll
            for (int j = 0; j < 64; ++j) { const float qv = qf[h * 64 + j]; d0 = fmaf(qv, kf0[j], d0); d1 = fmaf(qv, kf1[j], d1); }
            const float w = WI[(size_t)tg * 8 + h]; sc0 = fmaf(w, fmaxf(d0, 0.f), sc0); sc1 = fmaf(w, fmaxf(d1, 0.f), sc1); }
        sc[s] = sc0; sc[s2] = sc1;
    }
    __syncthreads();
    unsigned prefix = 0u, need = TOPK, eq_total = 0u;
    for (int pass = 0; pass < 4; ++pass) {
        const int shift = 24 - 8 * pass; const unsigned mask = pass == 0 ? 0u : (0xFFFFFFFFu << (shift + 8));
        if (tid < 256) hist[tid] = 0u;
        __syncthreads();
        for (int s = tid; s < n; s += 512) { const unsigned k = fkey(sc[s]); if ((k & mask) == (prefix & mask)) atomicAdd(&hist[(k >> shift) & 255u], 1u); }
        __syncthreads();
        if (tid == 0) { unsigned c = 0u; int bin = 255; for (; bin > 0; --bin) { if (c + hist[bin] >= need) break; c += hist[bin]; }
            misc[0] = (unsigned)bin; misc[1] = need - c; misc[2] = hist[bin]; }
        __syncthreads();
        prefix |= misc[0] << shift; need = misc[1]; eq_total = misc[2];
        __syncthreads();
    }
    const int nw = (n >> 5) * 16; const u64 clr = ~((1ull << qc) | (1ull << (qc + 32)));
    for (int i = tid; i < nw; i += 512) __hip_atomic_fetch_and(mwq + i, clr, __ATOMIC_RELAXED, __HIP_MEMORY_SCOPE_AGENT);
    asm volatile("s_waitcnt vmcnt(0)" ::: "memory");
    __syncthreads();
    const bool take_all_eq = (eq_total == need);
    for (int s = tid; s < n; s += 512) { const unsigned k = fkey(sc[s]); if (k > prefix || (take_all_eq && k == prefix)) mask_or_bit(mwq, qc, s); }
    if (!take_all_eq) {
        const int per = (n + 511) >> 9, s0 = tid * per, s1 = (s0 + per < n) ? s0 + per : n; unsigned* ce = (unsigned*)qf;
        unsigned mine = 0u; for (int s = s0; s < s1; ++s) mine += fkey(sc[s]) == prefix;
        __syncthreads(); ce[tid] = mine; __syncthreads();
        unsigned before = 0u; for (int t2 = 0; t2 < tid; ++t2) before += ce[t2];
        for (int s = s0; s < s1 && before < need; ++s) if (fkey(sc[s]) == prefix) { mask_or_bit(mwq, qc, s); ++before; }
    }
    __syncthreads();
}

__device__ __forceinline__ void indexer_unit(char* lds, int b, int c, const bf16* QI, const bf16* KI, const float* WI, u64* MASKW, char* codes  ) {
    int tid_ = threadIdx.x; asm volatile("" : "+v"(tid_));
    const int tid = tid_, wid = __builtin_amdgcn_readfirstlane(tid >> 6), lane = tid & 63, r32 = lane & 31, hi = lane >> 5, qg = wid & 1, ks = wid >> 1;
    const int n = 64 * (c + 1), ntile = n >> 5, jend = 2 * ((c | 3) + 1);
    const int row0 = b * S + 64 * c;
    u64* mw = MASKW + ((size_t)(b * (S / 32) + 2 * c + qg) * (S / 32)) * 16;
    const char* kib = (const char*)(KI + (size_t)b * S * 64);
    if (n <= TOPK) {
        for (int j = ks; j < jend; j += 4) if (lane < 16) __hip_atomic_store(mw + (size_t)j * 16 + lane, j < ntile ? ~0ull : 0ull, __ATOMIC_RELAXED, __HIP_MEMORY_SCOPE_AGENT);
        return;
    }
    unsigned* hist = (unsigned*)(lds + OFF_HIST);
    float2* stat = (float2*)(lds + OFF_STAT); float2* qpar = (float2*)(lds + OFF_QPAR);
    int* bstar = (int*)(lds + OFF_BSTAR); int* needv = (int*)(lds + OFF_NEED); unsigned* bcnt = (unsigned*)(lds + OFF_BCNT); unsigned* fb = (unsigned*)(lds + OFF_FB);
    unsigned* fl = (unsigned*)(lds + OFF_FLAT);
    const int ql = qg * 32 + r32;
    {
    int ln_ = lane; asm volatile("" : "+v"(ln_));
    const int l15 = ln_ & 15, kq = ln_ >> 4; const int q0 = qg * 32 + l15, q1 = q0 + 16;
    bf16x8 qreg[8][2][2]; const float* wv0 = (const float*)(lds + OFF_WV) + q0 * 8; const float* wv1 = wv0 + 16 * 8;
    { const char* qp = (const char*)QI + (size_t)(unsigned)(row0 + q0) * 1024 + kq * 16;
#pragma unroll
        for (int h = 0; h < 8; ++h)
#pragma unroll
            for (int cb = 0; cb < 2; ++cb)
#pragma unroll
                for (int ks = 0; ks < 2; ++ks) qreg[h][cb][ks] = *reinterpret_cast<const bf16x8*>(qp + cb * 16 * 1024 + h * 128 + ks * 64);
        { unsigned to_ = (unsigned)tid; asm volatile("" : "+v"(to_)); if (to_ < 128u) { float4 w4 = *(const float4*)((const char*)(WI + (size_t)row0 * 8) + (size_t)(to_ * 16u)); w4.x *= 0.5f; w4.y *= 0.5f; w4.z *= 0.5f; w4.w *= 0.5f; *(float4*)(lds + OFF_WV + to_ * 16u) = w4; } } }
    char* qlp = lds + OFF_QL + tid * 16;
#pragma unroll
    for (int cb = 0; cb < 2; ++cb) { const float* wp = WI + (size_t)(row0 + q0 + 16 * cb) * 8; const float4 w0 = *(const float4*)wp, w1 = *(const float4*)(wp + 4);
        const float wh[8] = {0.5f * w0.x, 0.5f * w0.y, 0.5f * w0.z, 0.5f * w0.w, 0.5f * w1.x, 0.5f * w1.y, 0.5f * w1.z, 0.5f * w1.w};
#pragma unroll
        for (int ks = 0; ks < 2; ++ks) { float acc8[8] = {0.f, 0.f, 0.f, 0.f, 0.f, 0.f, 0.f, 0.f};
#pragma unroll
            for (int h = 0; h < 8; ++h) { const bf16x8 q = qreg[h][cb][ks];
#pragma unroll
                for (int e = 0; e < 8; ++e) acc8[e] = fmaf(wh[h], __builtin_bit_cast(float, (unsigned)(unsigned short)q[e] << 16), acc8[e]); }
            bf16x8 o;
#pragma unroll
            for (int e = 0; e < 8; ++e) { const unsigned u = __builtin_bit_cast(unsigned, acc8[e]); o[e] = (short)((u + 0x7fffu + ((u >> 16) & 1u)) >> 16); }
            *reinterpret_cast<bf16x8*>(qlp + (cb * 2 + ks) * 8192) = o; } }
    float sc[16];
    { unsigned z0; asm volatile("v_mov_b32 %0, 0" : "=v"(z0)); const uint4 z4 = make_uint4(z0, z0, z0, z0);
        unsigned zoff = (unsigned)tid * 16u; asm volatile("" : "+v"(zoff));
#pragma unroll 1
        for (int i = 0; i < 8; ++i) { *(uint4*)((char*)hist + zoff) = z4; zoff += 8192u; }
        if (tid < 16) *(uint4*)((char*)hist + zoff) = z4; }
    __syncthreads();
    { float s1a = 0.f, s2a = 0.f, s1b = 0.f, s2b = 0.f;
#pragma unroll 1
        for (int u = 0; u < 2; ++u) { const int j = ((ks + 4 * u) * ntile) >> 3; bf16x8 a[2][2]; load_a16(a, kib, j, l15, kq); tile_scores16<false>(a, qreg, qlp, wv0, wv1, sc, kib, 0, l15, kq);
#pragma unroll
            for (int i = 0; i < 16; ++i) { if ((i >> 2) & 1) { s1b += sc[i]; s2b = fmaf(sc[i], sc[i], s2b); } else { s1a += sc[i]; s2a = fmaf(sc[i], sc[i], s2a); } } }
        s1a += __shfl_xor(s1a, 16); s2a += __shfl_xor(s2a, 16); s1b += __shfl_xor(s1b, 16); s2b += __shfl_xor(s2b, 16);
        s1a += __shfl_xor(s1a, 32); s2a += __shfl_xor(s2a, 32); s1b += __shfl_xor(s1b, 32); s2b += __shfl_xor(s2b, 32);
        { int qo_ = q0; asm volatile("" : "+v"(qo_)); if (kq == 0) { stat[ks * 64 + qo_] = make_float2(s1a, s2a); stat[ks * 64 + qo_ + 16] = make_float2(s1b, s2b); } } }
    __syncthreads();
    { int tq_ = tid; asm volatile("" : "+v"(tq_));
    if (tq_ < 64) { float s1 = 0.f, s2 = 0.f;
#pragma unroll
        for (int k = 0; k < 4; ++k) { const float2 v = stat[k * 64 + tq_]; s1 += v.x; s2 += v.y; }
        const float mu = s1 * (1.f / 256.f); float var = s2 * (1.f / 256.f) - mu * mu; var = var > 0.f ? var : 0.f;
        const float sg = fmaxf(sqrtf(var), 1e-30f); const float zp = z_upper(256.f / (float)n);
        const float lo = mu + (zp - 2.0f) * sg, a = (float)(NBINS - 2) / (4.0f * sg); float bb = 1.f - lo * a;
        float aa = a; if (!(aa < 3.0e38f) || !(fabsf(bb) < 3.0e38f)) { aa = 0.f; bb = 1.f; }
        qpar[tq_] = make_float2(aa, bb); bcnt[tq_] = 0u; if (tq_ == 0) { fb[0] = 0u; fb[100] = 0u; } } }
    __syncthreads();
    { unsigned* hq0 = hist + q0 * HSTR; unsigned* hq1 = hq0 + 16 * HSTR; bf16x8 aC[2][2]; load_a16(aC, kib, ks, l15, kq);
        unsigned cso = (unsigned)(qg * 1024 + (l15 + 32 * (kq & 1)) * 16 + (kq >> 1) * 4); asm volatile("" : "+v"(cso));
#pragma unroll 1
        for (int j = ks; j < ntile; j += 4) {
            tile_scores16<true>(aC, qreg, qlp, wv0, wv1, sc, kib, j + 4 < ntile ? j + 4 : j, l15, kq);
            const float2 ab0 = qpar[q0], ab1 = qpar[q1];
            char* cp = codes + (size_t)(unsigned)(j * 2048) + cso;
#pragma unroll
            for (int rb = 0; rb < 2; ++rb)
#pragma unroll
                for (int cb = 0; cb < 2; ++cb) { unsigned w = 0u;
#pragma unroll
                    for (int r = 3; r >= 0; --r) { const float v = sc[(2 * rb + cb) * 4 + r];
                        const unsigned bin = (unsigned)__builtin_amdgcn_fmed3f(cb ? fmaf(v, ab1.x, ab1.y) : fmaf(v, ab0.x, ab0.y), 0.f, (float)(NBINS - 1));
                        __hip_atomic_fetch_add((cb ? hq1 : hq0) + bin, 1u, __ATOMIC_RELAXED, __HIP_MEMORY_SCOPE_WORKGROUP); w = (w << 8) | bin; }
                    *(unsigned*)(cp + cb * 256 + rb * 8) = w; } } }
    }
    __syncthreads();
#pragma unroll 1
    for (int qq = 0; qq < 8; ++qq) { const int q = wid * 8 + qq; int lo_ = lane; asm volatile("" : "+v"(lo_)); const unsigned* hp = hist + q * HSTR + 4 * lo_; const unsigned hb[4] = {hp[0], hp[1], hp[2], hp[3]};
        const unsigned ls = (hb[0] + hb[1]) + (hb[2] + hb[3]);
        unsigned T = ls;
#pragma unroll
        for (int o = 1; o < 64; o <<= 1) { const unsigned v = __shfl_down(T, o); if (lane + o < 64) T += v; }
        const u64 bal = __ballot(T >= (unsigned)TOPK); const int lstar = 63 - __builtin_clzll(bal);
        if (lane == lstar) { unsigned acc = T - ls; int bsel = 0;
#pragma unroll
            for (int i = 3; i >= 0; --i) { if (acc + hb[i] >= (unsigned)TOPK) { bsel = i; break; } acc += hb[i]; }
            bstar[q] = 4 * lane + bsel; needv[q] = (int)(TOPK - acc); } }
    __syncthreads();
    { unsigned cso = (unsigned)(qg * 1024 + lane * 16); asm volatile("" : "+v"(cso));
        const unsigned bs = (unsigned)bstar[ql]; const unsigned bsx = bs * 0x01010101u; const unsigned qtag = (unsigned)ql << 14;
#define IDX_LDC(jj) (*(const uint4*)(codes + (size_t)(unsigned)(((jj) < ntile ? (jj) : ks) * 2048) + cso))
#define IDX_SEL(D, K) asm volatile("v_cmp_gt_u32_sdwa vcc, %2, %3 src0_sel:BYTE_" #K " src1_sel:DWORD\n\ts_nop 3\n\tv_writelane_b32 %0, vcc_lo, %4\n\tv_writelane_b32 %1, vcc_hi, %4" \
                : "+v"(mlo), "+v"(mhi) : "v"(cwd[D]), "v"(bs), "n"(4 * (D) + (K)) : "vcc")
#define IDX_PROC(CUR, jj) do { const int j_ = (jj); const unsigned cwd[4] = {CUR.x, CUR.y, CUR.z, CUR.w}; unsigned mlo = 0u, mhi = 0u;                                  \
            IDX_SEL(0, 0); IDX_SEL(0, 1); IDX_SEL(0, 2); IDX_SEL(0, 3); IDX_SEL(1, 0); IDX_SEL(1, 1); IDX_SEL(1, 2); IDX_SEL(1, 3);                                       \
            IDX_SEL(2, 0); IDX_SEL(2, 1); IDX_SEL(2, 2); IDX_SEL(2, 3); IDX_SEL(3, 0); IDX_SEL(3, 1); IDX_SEL(3, 2); IDX_SEL(3, 3);                                       \
            if (lane < 16) mw[(size_t)j_ * 16 + lane] = ((u64)mhi << 32) | mlo;                  \
                                     \
            _Pragma("unroll") for (int d = 0; d < 4; ++d) { const unsigned x = cwd[d] ^ bsx; const unsigned hz = (x - 0x01010101u) & ~x & 0x80808080u;                   \
                if (__ballot(hz != 0u)) {                                                                                                                                \
                    _Pragma("unroll") for (int k = 0; k < 4; ++k) { const bool eq = ((cwd[d] >> (8 * k)) & 255u) == bs;                                                  \
                        if (eq) { const unsigned pos = __hip_atomic_fetch_add(&fb[100], 1u, __ATOMIC_RELAXED, __HIP_MEMORY_SCOPE_WORKGROUP);                             \
                            if (pos < (unsigned)FCAP) fl[pos] = qtag | (unsigned)(j_ * 32 + crow(4 * d + k, hi)); } } } } } while (0)
        uint4 cA = IDX_LDC(ks), cB = IDX_LDC(ks + 4), cC = IDX_LDC(ks + 8), cD = IDX_LDC(ks + 12);
#pragma unroll 1
        for (int j = ks; j < ntile; j += 16) {
            IDX_PROC(cA, j); cA = IDX_LDC(j + 16);
            if (j + 4 < ntile) { IDX_PROC(cB, j + 4); cB = IDX_LDC(j + 20); }
            if (j + 8 < ntile) { IDX_PROC(cC, j + 8); cC = IDX_LDC(j + 24); }
            if (j + 12 < ntile) { IDX_PROC(cD, j + 12); cD = IDX_LDC(j + 28); }
        }
#undef IDX_PROC
#undef IDX_SEL
#undef IDX_LDC
        for (int j = ntile + ks; j < jend; j += 4) if (lane < 16) mw[(size_t)j * 16 + lane] = 0ull; }
    __syncthreads();
    { const unsigned nfl = fb[100] < (unsigned)FCAP ? fb[100] : (unsigned)FCAP; const float* wv = (const float*)(lds + OFF_WV); unsigned* blq = (unsigned*)(lds + OFF_HIST);
        unsigned ti_ = (unsigned)tid; asm volatile("" : "+v"(ti_));
#pragma unroll 1
        for (unsigned i = ti_; i < nfl; i += 512u) { const unsigned e = fl[i]; const int q = (int)(e >> 14), key = (int)(e & 16383u);
            const uint4* kp = (const uint4*)(kib + (size_t)key * 128); float kf[64];
#pragma unroll
            for (int cc = 0; cc < 8; ++cc) { const uint4 w = kp[cc];
                kf[8 * cc] = __builtin_bit_cast(float, w.x << 16); kf[8 * cc + 1] = __builtin_bit_cast(float, w.x & 0xffff0000u); kf[8 * cc + 2] = __builtin_bit_cast(float, w.y << 16); kf[8 * cc + 3] = __builtin_bit_cast(float, w.y & 0xffff0000u);
                kf[8 * cc + 4] = __builtin_bit_cast(float, w.z << 16); kf[8 * cc + 5] = __builtin_bit_cast(float, w.z & 0xffff0000u); kf[8 * cc + 6] = __builtin_bit_cast(float, w.w << 16); kf[8 * cc + 7] = __builtin_bit_cast(float, w.w & 0xffff0000u); }
            const char* qp = (const char*)QI + (size_t)(unsigned)(row0 + q) * 1024; float s = 0.f;
#pragma unroll 4
            for (int h = 0; h < 8; ++h) { float d = 0.f; const uint4* qh = (const uint4*)(qp + h * 128);
#pragma unroll
                for (int cc = 0; cc < 8; ++cc) { const uint4 w = qh[cc];
                    d = fmaf(__builtin_bit_cast(float, w.x << 16), kf[8 * cc], d); d = fmaf(__builtin_bit_cast(float, w.x & 0xffff0000u), kf[8 * cc + 1], d);
                    d = fmaf(__builtin_bit_cast(float, w.y << 16), kf[8 * cc + 2], d); d = fmaf(__builtin_bit_cast(float, w.y & 0xffff0000u), kf[8 * cc + 3], d);
                    d = fmaf(__builtin_bit_cast(float, w.z << 16), kf[8 * cc + 4], d); d = fmaf(__builtin_bit_cast(float, w.z & 0xffff0000u), kf[8 * cc + 5], d);
                    d = fmaf(__builtin_bit_cast(float, w.w << 16), kf[8 * cc + 6], d); d = fmaf(__builtin_bit_cast(float, w.w & 0xffff0000u), kf[8 * cc + 7], d); }
                s = fmaf(2.f * wv[q * 8 + h], fmaxf(d, 0.f), s); }
            const float2 ab = qpar[q]; const float u = fmaf(s, ab.x, ab.y);
            const unsigned fine = (unsigned)__builtin_amdgcn_fmed3f((u - (float)bstar[q]) * 262144.f, 0.f, 262143.f);
            const unsigned pos = __hip_atomic_fetch_add(&bcnt[q], 1u, __ATOMIC_RELAXED, __HIP_MEMORY_SCOPE_WORKGROUP);
            const unsigned word = (fine << 14) | (16383u - (unsigned)key); fl[FCAP + i] = word;
            if (pos < (unsigned)CAP) blq[q * CAP + pos] = word; } }
    asm volatile("s_waitcnt vmcnt(0)" ::: "memory");
    __syncthreads();
    { const bool flat_over = fb[100] > (unsigned)FCAP; const unsigned nfl = flat_over ? (unsigned)FCAP : fb[100]; const unsigned* blq = (const unsigned*)(lds + OFF_HIST);
        unsigned ti_ = (unsigned)tid; asm volatile("" : "+v"(ti_));
        if (ti_ < 64u) { const int q = (int)ti_; if (flat_over || bcnt[q] > (unsigned)CAP || bstar[q] <= 0 || bstar[q] >= NBINS - 1 || (DBG_FORCE_FB && (q & 15) == 3)) {
            const unsigned p = __hip_atomic_fetch_add(&fb[0], 1u, __ATOMIC_RELAXED, __HIP_MEMORY_SCOPE_WORKGROUP); fb[1 + p] = (unsigned)q; } }
        if (!flat_over) {
#pragma unroll 1
        for (unsigned i = ti_; i < nfl; i += 512u) { const unsigned ef = fl[i]; const int q = (int)(ef >> 14); const unsigned cnt = bcnt[q];
            if (cnt > (unsigned)CAP || bstar[q] <= 0 || bstar[q] >= NBINS - 1 || (DBG_FORCE_FB && (q & 15) == 3)) continue;
            const unsigned mine = fl[FCAP + i];
            const unsigned* bl = blq + q * CAP; int rk = 0;
            for (unsigned m = 0; m < cnt; ++m) rk += bl[m] > mine;
            if (rk < needv[q]) mask_or_bit(MASKW + ((size_t)(b * (S / 32) + 2 * c + (q >> 5)) * (S / 32)) * 16, q & 31, (int)(16383u - (mine & 16383u))); } } }
    __syncthreads();
    { const int nfb = (int)fb[0];
        for (int f = 0; f < nfb; ++f) { const int q = (int)fb[1 + f];
            fallback_query(lds, tid, row0 + q, q & 31, n, QI, kib, WI, MASKW + ((size_t)(b * (S / 32) + 2 * c + (q >> 5)) * (S / 32)) * 16); } }
    __syncthreads();
}
__device__ __forceinline__ void indexer_phase(char* lds, int vcu, int G, const bf16* QI, const bf16* KI, const float* WI, u64* MASKW, char* area_out, char* area_tail, char* area_gap, char* area_wai) {
    for (int item = vcu; item < 256; item += G) { const int b = (item >> 7) & 1, x = item & 127;
        const unsigned cum = (unsigned)(256 * x - x * (x - 1) / 2);
        char* codes = b == 0 ? area_out + (size_t)cum * 4096 : x < 33 ? area_out + (size_t)(24640u + cum) * 4096 : x < 73 ? area_tail + (size_t)(cum - 7920u) * 4096 : x < 115 ? area_gap + (size_t)(cum - 16060u) * 4096 : area_wai + (size_t)(cum - 22885u) * 4096;
#pragma unroll 1
        for (int pass = 0; pass < 2; ++pass) indexer_unit(lds, b, pass ? 255 - x : x, QI, KI, WI, MASKW, codes); }
}
}
namespace att {
typedef unsigned short bf16;
typedef short bf16x8 __attribute__((ext_vector_type(8)));
typedef short s16x4 __attribute__((ext_vector_type(4)));
typedef float f32x16 __attribute__((ext_vector_type(16)));
typedef float f32x4 __attribute__((ext_vector_type(4)));
typedef unsigned u32x4 __attribute__((ext_vector_type(4)));
typedef unsigned long long u64;
typedef const __attribute__((address_space(4))) u64* cu64p;
typedef float f32x2_t __attribute__((ext_vector_type(2))); typedef __bf16 bf16x2_t __attribute__((ext_vector_type(2)));
__device__ __forceinline__ unsigned cvtpk_s(float lo, float hi) { f32x2_t v = {lo, hi}; bf16x2_t b = __builtin_convertvector(v, bf16x2_t); return __builtin_bit_cast(unsigned, b); }
constexpr int D = 128, PITCH = 1024, NW = 8, QBLK = 32, KVBLK = 64, QB = NW * QBLK;
constexpr int SHM_V = KVBLK * D * 2, SHM_K = KVBLK * D * 2;
constexpr int NBUF = 4;
constexpr int OFF_WS = NBUF * SHM_V + NBUF * SHM_K;
constexpr int OFF_TAB = OFF_WS + NW * 64 * 4;
constexpr int OFF_EP = 0;
constexpr int EP_PITCH = 272, EP_WAVE = 32 * EP_PITCH;
constexpr int ATTN_LDS_BYTES = OFF_TAB + 448 * 4;
static_assert(NW * EP_WAVE <= OFF_WS, "epilogue staging fits the ring");
constexpr float THR2 = 11.5f;
constexpr int MW_PER_QB = (S / 32) * 16;

#define KSWZ(row, colB) ((row) * 256 + ((colB) ^ (((row) & 7) << 4)))
#define SBAR() __builtin_amdgcn_sched_barrier(0)
__device__ __forceinline__ int v_st(int k, int c) { const int kk = (k & ~0xC) | ((k & 4) << 1) | ((k & 8) >> 1); return ((kk >> 3) * 4 + (c >> 5)) * 512 + ((kk & 7) * 32 + (c & 31)) * 2; }
__device__ __forceinline__ int v_st_nat(int k, int c) { return ((k >> 3) * 4 + (c >> 5)) * 512 + ((k & 7) * 32 + (c & 31)) * 2; }
__device__ __forceinline__ int v_rd_base(int lane) { return ((lane & 3) << 3) | (((lane >> 2) & 3) << 6) | (((lane >> 4) & 1) << 5) | (((lane >> 5) & 1) << 8); }
constexpr int v_rd_off(int d0, int ks, int half) { return d0 * 512 + ks * 4096 + half * 2048; }
__device__ __forceinline__ int crow(int r, int hi) { return (r & 3) + 8 * (r >> 2) + 4 * hi; }
__device__ __forceinline__ unsigned cvtpk(float lo, float hi) { unsigned r; asm volatile("v_cvt_pk_bf16_f32 %0, %1, %2" : "=v"(r) : "v"(lo), "v"(hi)); return r; }

template <bool NEAR>
__device__ __forceinline__ void init_tile(f32x16& p0, f32x16& p1, cu64p w, float cb  , const float* tabp, float mcur) {
    const float NEG = -__builtin_inff();
    u64 m0[16], m1[16];
#pragma unroll
    for (int r = 0; r < 16; ++r) { m0[r] = w[r]; m1[r] = w[16 + r]; }
#pragma unroll
    for (int r = 0; r < 16; ++r) { float bv = cb; if (NEAR) bv = tabp[59 - ((r & 3) + 8 * (r >> 2))] - mcur;
        float o; asm volatile("v_cndmask_b32_e64 %0, %1, %2, %3" : "=v"(o) : "v"(NEG), "v"(bv), "s"(m0[r])); p0[r] = o; }
#pragma unroll
    for (int r = 0; r < 16; ++r) { float bv = cb; if (NEAR) bv = tabp[27 - ((r & 3) + 8 * (r >> 2))] - mcur;
        float o; asm volatile("v_cndmask_b32_e64 %0, %1, %2, %3" : "=v"(o) : "v"(NEG), "v"(bv), "s"(m1[r])); p1[r] = o; }
}
__device__ __forceinline__ void partialSM(f32x16& p0, f32x16& p1, float& m_reg, float& alpha, float l_cur, float pmax_in) {
    float pmax = pmax_in;
    { auto rr = __builtin_amdgcn_permlane32_swap(__float_as_uint(pmax), __float_as_uint(pmax), false, false);
      pmax = fmaxf(__uint_as_float(rr[0]), __uint_as_float(rr[1])); }
    const bool low = pmax < -64.f && pmax > -__builtin_inff();
    alpha = 1.f;
    if (__builtin_expect(__any(pmax > THR2 || low), 0)) {
        float delta = 0.f;
        if (pmax > THR2) { delta = pmax; alpha = __builtin_amdgcn_exp2f(-delta); }
        else if (low && l_cur == 0.f) delta = pmax;
        m_reg += delta;
#pragma unroll
        for (int r = 0; r < 16; ++r) p0[r] = p0[r] - delta;
#pragma unroll
        for (int r = 0; r < 16; ++r) p1[r] = p1[r] - delta; }
#pragma unroll
    for (int r = 0; r < 16; ++r) p0[r] = __builtin_amdgcn_exp2f(p0[r]);
}
__device__ __forceinline__ void finishSM(f32x16& p0, f32x16& p1, float alpha, float& l_reg, bf16x8& pa0, bf16x8& pa1, bf16x8& pa2, bf16x8& pa3) {
#pragma unroll
    for (int r = 0; r < 16; ++r) p1[r] = __builtin_amdgcn_exp2f(p1[r]);
    float ps = 0;
#pragma unroll
    for (int r = 0; r < 16; ++r) ps += p0[r];
#pragma unroll
    for (int r = 0; r < 16; ++r) ps += p1[r];
    { auto rr = __builtin_amdgcn_permlane32_swap(__float_as_uint(ps), __float_as_uint(ps), false, false);
      ps = __uint_as_float(rr[0]) + __uint_as_float(rr[1]); }
    l_reg = l_reg * alpha + ps;
#define PK4(P, B_, OUT) do { u32x4 w = {cvtpk(P[B_+0], P[B_+1]), cvtpk(P[B_+2], P[B_+3]), cvtpk(P[B_+4], P[B_+5]), cvtpk(P[B_+6], P[B_+7])};   \
        OUT = *reinterpret_cast<bf16x8*>(&w); } while (0)
    PK4(p0, 0, pa0); PK4(p0, 8, pa1); PK4(p1, 0, pa2); PK4(p1, 8, pa3);
#undef PK4
}
template <int KB>
__device__ __forceinline__ void qkt(f32x16& p0, f32x16& p1, const char* K_lds, int r32, int hi, const bf16x8* qr) {
    const char* kb[4];
#pragma unroll
    for (int dd = 0; dd < 4; ++dd) kb[dd] = K_lds + KB * SHM_K + KSWZ(r32, (dd * 16 + hi * 8) * 2);
#pragma unroll
    for (int d0 = 0; d0 < 8; ++d0) { const char* a = kb[d0 & 3] + (d0 >> 2) * 128;
        bf16x8 b0 = *reinterpret_cast<const bf16x8*>(a);
        bf16x8 b1 = *reinterpret_cast<const bf16x8*>(a + 32 * 256);
        p0 = __builtin_amdgcn_mfma_f32_32x32x16_bf16(b0, qr[d0], p0, 0, 0, 0);
        p1 = __builtin_amdgcn_mfma_f32_32x32x16_bf16(b1, qr[d0], p1, 0, 0, 0); }
}
template <int VB>
__device__ __forceinline__ void pv_tile(f32x16* o, int vb0, bf16x8 pa0, bf16x8 pa1, bf16x8 pa2, bf16x8 pa3) {
#define TRRD(dst, off) asm volatile("ds_read_b64_tr_b16 %0, %1 offset:%2" : "=&v"(dst) : "v"(vb0), "i"(off) : "memory")
#define PV_D0(d0) do { s16x4 l0, l1, l2, l3, h0, h1, h2, h3; constexpr int b_ = VB * SHM_V + v_rd_off(d0, 0, 0); \
        TRRD(l0, b_); TRRD(h0, b_ + 2048); TRRD(l1, b_ + 4096); TRRD(h1, b_ + 6144); TRRD(l2, b_ + 8192); TRRD(h2, b_ + 10240); TRRD(l3, b_ + 12288); TRRD(h3, b_ + 14336); \
        asm volatile("s_waitcnt lgkmcnt(0)" ::: "memory"); SBAR();   \
        o[d0] = __builtin_amdgcn_mfma_f32_32x32x16_bf16(pa0, (bf16x8){l0[0], l0[1], l0[2], l0[3], h0[0], h0[1], h0[2], h0[3]}, o[d0], 0, 0, 0);   \
        o[d0] = __builtin_amdgcn_mfma_f32_32x32x16_bf16(pa1, (bf16x8){l1[0], l1[1], l1[2], l1[3], h1[0], h1[1], h1[2], h1[3]}, o[d0], 0, 0, 0);   \
        o[d0] = __builtin_amdgcn_mfma_f32_32x32x16_bf16(pa2, (bf16x8){l2[0], l2[1], l2[2], l2[3], h2[0], h2[1], h2[2], h2[3]}, o[d0], 0, 0, 0);   \
        o[d0] = __builtin_amdgcn_mfma_f32_32x32x16_bf16(pa3, (bf16x8){l3[0], l3[1], l3[2], l3[3], h3[0], h3[1], h3[2], h3[3]}, o[d0], 0, 0, 0); } while (0)
    PV_D0(0); PV_D0(1); PV_D0(2); PV_D0(3);
#undef PV_D0
#undef TRRD
}

template <int VB>
__device__ __forceinline__ float pv_tile_max(f32x16* o, int vb0, bf16x8 pa0, bf16x8 pa1, bf16x8 pa2, bf16x8 pa3, const f32x16& p0, const f32x16& p1) {
#define TRRD(dst, off) asm volatile("ds_read_b64_tr_b16 %0, %1 offset:%2" : "=&v"(dst) : "v"(vb0), "i"(off) : "memory")
#define MX3(a, b, c) fmaxf(fmaxf(a, b), c)
#define PV_D0(d0, HOOK) do { s16x4 l0, l1, l2, l3, h0, h1, h2, h3; constexpr int b_ = VB * SHM_V + v_rd_off(d0, 0, 0); \
        TRRD(l0, b_); TRRD(h0, b_ + 2048); TRRD(l1, b_ + 4096); TRRD(h1, b_ + 6144); TRRD(l2, b_ + 8192); TRRD(h2, b_ + 10240); TRRD(l3, b_ + 12288); TRRD(h3, b_ + 14336); \
        HOOK; asm volatile("s_waitcnt lgkmcnt(0)" ::: "memory"); SBAR();   \
        o[d0] = __builtin_amdgcn_mfma_f32_32x32x16_bf16(pa0, (bf16x8){l0[0], l0[1], l0[2], l0[3], h0[0], h0[1], h0[2], h0[3]}, o[d0], 0, 0, 0);   \
        o[d0] = __builtin_amdgcn_mfma_f32_32x32x16_bf16(pa1, (bf16x8){l1[0], l1[1], l1[2], l1[3], h1[0], h1[1], h1[2], h1[3]}, o[d0], 0, 0, 0);   \
        o[d0] = __builtin_amdgcn_mfma_f32_32x32x16_bf16(pa2, (bf16x8){l2[0], l2[1], l2[2], l2[3], h2[0], h2[1], h2[2], h2[3]}, o[d0], 0, 0, 0);   \
        o[d0] = __builtin_amdgcn_mfma_f32_32x32x16_bf16(pa3, (bf16x8){l3[0], l3[1], l3[2], l3[3], h3[0], h3[1], h3[2], h3[3]}, o[d0], 0, 0, 0); } while (0)
    float m;
    PV_D0(0, m = MX3(p0[0], p0[1], p0[2]); m = MX3(m, p0[3], p0[4]); m = MX3(m, p0[5], p0[6]); m = MX3(m, p0[7], p0[8]));
    PV_D0(1, m = MX3(m, p0[9], p0[10]); m = MX3(m, p0[11], p0[12]); m = MX3(m, p0[13], p0[14]); m = MX3(m, p0[15], p1[0]));
    PV_D0(2, m = MX3(m, p1[1], p1[2]); m = MX3(m, p1[3], p1[4]); m = MX3(m, p1[5], p1[6]); m = MX3(m, p1[7], p1[8]));
    PV_D0(3, m = MX3(m, p1[9], p1[10]); m = MX3(m, p1[11], p1[12]); m = MX3(m, p1[13], p1[14]); m = fmaxf(m, p1[15]));
#undef PV_D0
#undef MX3
#undef TRRD
    return m;
}

struct BlockRef { const bf16* Q; const bf16* K; const bf16* V; const bf16* ZS; bf16* O; const u64* MW; const float* bias; int P0; };
struct Seam { bf16x8 qr[8]; bf16x8 st_v0, st_v1, st_k0, st_k1; };
#define ROW(p, k0, rr) ((const bf16*)((const char*)(p) + (size_t)(unsigned)(((k0) + (rr)) * (PITCH * 2) + sc * 2)))
#define VMW() asm volatile("s_waitcnt vmcnt(0)" ::: "memory")
#define VMWN(n) asm volatile("s_waitcnt vmcnt(%0)" :: "i"(n) : "memory")
#define LD8(p) (*reinterpret_cast<const bf16x8*>(p))
#define SLOAD_H(Kp, Vp, k0) do { S.st_v0 = LD8(ROW(Vp, k0, sr)); S.st_v1 = LD8(ROW(Vp, k0, 32 + sr)); S.st_k0 = LD8(ROW(Kp, k0, sr)); S.st_k1 = LD8(ROW(Kp, k0, 32 + sr)); } while (0)
#define SWRITE_HK(bf) do { *(bf16x8*)(K_lds + (bf) * SHM_K + kws) = S.st_k0; *(bf16x8*)(K_lds + (bf) * SHM_K + kws + 32 * 256) = S.st_k1; } while (0)
#define SWRITE_HV(bf) do { *(bf16x8*)(V_lds + (bf) * SHM_V + vst0) = S.st_v0; *(bf16x8*)(V_lds + (bf) * SHM_V + vst1) = S.st_v1; } while (0)
#define SWRITE_H(bf) do { SWRITE_HV(bf); SWRITE_HK(bf); } while (0)
__device__ __forceinline__ void attn_block(const BlockRef& cur, char* lds) {
    Seam S;
    int tid_ = threadIdx.x; asm volatile("" : "+v"(tid_));
    const int tid = tid_, wid = __builtin_amdgcn_readfirstlane(tid >> 6), lane = tid & 63, r32 = lane & 31, hi = lane >> 5;
    int early_i = 0; asm volatile("" : "+s"(early_i)); const bool early_ = early_i != 0;
    const int NT = (cur.P0 + QB) / KVBLK;
    const int qlo = cur.P0 + wid * QBLK;
    char* V_lds = lds; char* K_lds = lds + NBUF * SHM_V;
    float* ws = (float*)(lds + OFF_WS) + wid * 64; float* li_l = ws, * al_l = ws + 32;
    float* tab = (float*)(lds + OFF_TAB);
    float m_reg = 0.f, l_reg = 0; f32x16 o[4] = {};
    const int sr = tid >> 4, sc = (tid & 15) * 8, vst0 = v_st_nat(sr, sc), vst1 = v_st_nat(32 + sr, sc), kws = KSWZ(sr, sc * 2);
    const int vb0 = (int)(uintptr_t)V_lds + v_rd_base(lane);
    const bf16* Kh = cur.K; const bf16* Vh = cur.V;
    { int tq_ = tid; asm volatile("" : "+v"(tq_));
    if (tq_ < 448) { const int rel = tq_ - 256; const int ret = rel < 0 ? 16 : 0; const int n = rel < 0 ? -rel : rel; int v;
        if (n < 8) v = n; else if (n < 12) v = 8; else if (n < 16) v = 9; else if (n < 23) v = 10; else if (n < 32) v = 11; else if (n < 46) v = 12; else if (n < 64) v = 13; else if (n < 91) v = 14; else v = 15;
        tab[tq_] = cur.bias[(ret + v) * 8] * 1.4426950408889634f; } }
    const float cbfar = cur.bias[15 * 8] * 1.4426950408889634f;
    const cu64p mwv = (cu64p)(uintptr_t)(cur.MW + (size_t)wid * MW_PER_QB);
#define RESC(a) do { if (__any((a) < 1.f)) { if (hi == 0) al_l[r32] = (a); asm volatile("s_waitcnt lgkmcnt(0)" ::: "memory");              \
                     for (int d_ = 0; d_ < 4; ++d_) for (int r = 0; r < 16; ++r) o[d_][r] *= al_l[crow(r, hi)]; } } while (0)
#define KBASE(t) ((t) * KVBLK)
#define INIT(P0_, P1_, t) do { const int kb_ = KBASE(t); const cu64p w_ = mwv + (size_t)(t) * 32;                              \
        if (kb_ + 154 <= qlo) init_tile<false>(P0_, P1_, w_, cbfar - m_reg, tab, m_reg);                                        \
        else init_tile<true>(P0_, P1_, w_, cbfar - m_reg, tab + (qlo + r32 - kb_ - 4 * hi + 197), m_reg); } while (0)
    unsigned pm0 = 0u, pm1 = 0u, pm2 = 0u, pm3 = 0u;
#define MPREF(t) do { const __attribute__((address_space(4))) unsigned* w_ = (const __attribute__((address_space(4))) unsigned*)(mwv + (size_t)(t) * 32); pm0 = w_[0]; pm1 = w_[16]; pm2 = w_[32]; pm3 = w_[48]; SBAR(); } while (0)
#define MUSE() asm volatile("" :: "s"(pm0), "s"(pm1), "s"(pm2), "s"(pm3))
    f32x16 pA0, pA1, pB0, pB1; float alA, alB; bf16x8 pa0, pa1, pa2, pa3;
#pragma unroll
    for (int d0 = 0; d0 < 8; ++d0) S.qr[d0] = LD8((const char*)cur.Q + (size_t)(unsigned)((wid * QBLK + r32) * (PITCH * 2) + d0 * 32 + hi * 16));
    SLOAD_H(Kh, Vh, 0); VMW(); SWRITE_H(0); SBAR();
    if (NT > 1) SLOAD_H(Kh, Vh, KBASE(1));
    __syncthreads();
    INIT(pA0, pA1, 0);
    SBAR(); qkt<0>(pA0, pA1, K_lds, r32, hi, S.qr);
    MPREF(1);
    { float pm_ = pA0[0];
#pragma unroll
      for (int r = 1; r < 16; ++r) pm_ = fmaxf(pm_, pA0[r]);
#pragma unroll
      for (int r = 0; r < 16; ++r) pm_ = fmaxf(pm_, pA1[r]);
      partialSM(pA0, pA1, m_reg, alA, l_reg, pm_); }
    if (!early_) { MUSE(); INIT(pB0, pB1, 1); SBAR(); }
    if (NT > 1) { VMW(); SWRITE_H(1); }
    __syncthreads();
#define HALF_STEP(PX0, PX1, alX, PY0, PY1, alY, t, KB, VB, SB) do {                                                           \
        if (early_) { MUSE(); INIT(PX0, PX1, (t)); SBAR(); }                                           \
        qkt<KB>(PX0, PX1, K_lds, r32, hi, S.qr);          \
        finishSM(PY0, PY1, alY, l_reg, pa0, pa1, pa2, pa3); SBAR();                                                           \
        SLOAD_H(Kh, Vh, KBASE((t) + 1)); SBAR();                                                                              \
        { const float pm_ = pv_tile_max<VB>(o, vb0, pa0, pa1, pa2, pa3, PX0, PX1); MPREF((t) + 1); partialSM(PX0, PX1, m_reg, alX, l_reg, pm_); }   \
        VMW(); SWRITE_H(SB);                                                                                                  \
        RESC(alX);                                                                                                            \
        if (!early_) { MUSE(); INIT(PY0, PY1, (t) + 1); SBAR(); }     \
        __syncthreads(); } while (0)
    int t = 1;
    for (; t + 4 < NT; t += 4) {
        HALF_STEP(pB0, pB1, alB, pA0, pA1, alA, t, 1, 0, 2);
        HALF_STEP(pA0, pA1, alA, pB0, pB1, alB, t + 1, 2, 1, 3);
        HALF_STEP(pB0, pB1, alB, pA0, pA1, alA, t + 2, 3, 2, 0);
        HALF_STEP(pA0, pA1, alA, pB0, pB1, alB, t + 3, 0, 3, 1);
    }
    HALF_STEP(pB0, pB1, alB, pA0, pA1, alA, NT - 3, 1, 0, 2);
    HALF_STEP(pA0, pA1, alA, pB0, pB1, alB, NT - 2, 2, 1, 3);
    if (early_) { MUSE(); INIT(pB0, pB1, NT - 1); SBAR(); }
    qkt<3>(pB0, pB1, K_lds, r32, hi, S.qr); SBAR();
    finishSM(pA0, pA1, alA, l_reg, pa0, pa1, pa2, pa3); SBAR();
    { const float pm_ = pv_tile_max<2>(o, vb0, pa0, pa1, pa2, pa3, pB0, pB1); partialSM(pB0, pB1, m_reg, alB, l_reg, pm_); } RESC(alB);
    finishSM(pB0, pB1, alB, l_reg, pa0, pa1, pa2, pa3); SBAR(); pv_tile<3>(o, vb0, pa0, pa1, pa2, pa3);
    SBAR();
    __syncthreads();
    if (hi == 0) li_l[r32] = l_reg; asm volatile("s_waitcnt lgkmcnt(0)" ::: "memory");
    float rli[16];
#pragma unroll
    for (int r = 0; r < 16; ++r) rli[r] = __builtin_amdgcn_rcpf(li_l[crow(r, hi)]);
    {
        char* ep = lds + OFF_EP + wid * EP_WAVE; unsigned ew_off = (unsigned)(4 * hi * EP_PITCH + r32 * 2); asm volatile("" : "+v"(ew_off));
#pragma unroll
        for (int r = 0; r < 16; ++r) { const int rw = (r & 3) + 8 * (r >> 2);
#pragma unroll
            for (int d0 = 0; d0 < 4; ++d0) *(unsigned short*)(ep + ew_off + rw * EP_PITCH + d0 * 64) = (unsigned short)(cvtpk_s(o[d0][r] * rli[r], 0.f) & 0xffffu); }
        asm volatile("s_waitcnt lgkmcnt(0)" ::: "memory");
        unsigned lane_off = (unsigned)((wid * QBLK + (lane >> 4)) * PITCH + (lane & 15) * 8) * 2u;
        asm volatile("" : "+v"(lane_off));
        unsigned er_off = (unsigned)((lane >> 4) * EP_PITCH + (lane & 15) * 16); asm volatile("" : "+v"(er_off));
        char* op = (char*)cur.O + (size_t)lane_off; const char* zp = (const char*)cur.ZS + (size_t)lane_off; const char* er = ep + er_off;
#pragma unroll
        for (int ph = 0; ph < 2; ++ph) {
            asm volatile("" ::: "memory");
            uint4 zz[4];
#pragma unroll
            for (int p4 = 0; p4 < 4; ++p4) zz[p4] = *(const uint4*)(zp + (ph * 4 + p4) * 4 * PITCH * 2);
#pragma unroll
            for (int p4 = 0; p4 < 4; ++p4) { const int p = ph * 4 + p4; const uint4 m = *(const uint4*)(er + p * 4 * EP_PITCH); const uint4 z = zz[p4]; uint4 y;
                y.x = cvtpk_s(__uint_as_float(m.x << 16) * __uint_as_float(z.x << 16), __uint_as_float(m.x & 0xffff0000u) * __uint_as_float(z.x & 0xffff0000u));
                y.y = cvtpk_s(__uint_as_float(m.y << 16) * __uint_as_float(z.y << 16), __uint_as_float(m.y & 0xffff0000u) * __uint_as_float(z.y & 0xffff0000u));
                y.z = cvtpk_s(__uint_as_float(m.z << 16) * __uint_as_float(z.z << 16), __uint_as_float(m.z & 0xffff0000u) * __uint_as_float(z.z & 0xffff0000u));
                y.w = cvtpk_s(__uint_as_float(m.w << 16) * __uint_as_float(z.w << 16), __uint_as_float(m.w & 0xffff0000u) * __uint_as_float(z.w & 0xffff0000u));
                *(uint4*)(op + p * 4 * PITCH * 2) = y; } }
    }
    __syncthreads();
#undef RESC
#undef KBASE
#undef INIT
#undef MPREF
#undef MUSE
#undef HALF_STEP
}
#undef ROW
#undef VMW
#undef VMWN
#undef LD8
#undef SLOAD_H
#undef SWRITE_HK
#undef SWRITE_HV
#undef SWRITE_H

__device__ __forceinline__ BlockRef make_ref(int L, int pass, const bf16* Q, const bf16* K, const bf16* V, const bf16* ZS, bf16* O, const u64* MASKW, const float* rel_bias) {
    const int bh = L >> 5, x = L & 31, b = bh >> 3, h = bh & 7, qb = pass ? 63 - x : x;
    BlockRef r; const size_t row0 = (size_t)b * S + (size_t)qb * QB;
    r.Q = Q + row0 * PITCH + h * D; r.O = O + row0 * PITCH + h * D; r.ZS = ZS + row0 * PITCH + h * D;
    r.K = K + (size_t)b * S * PITCH + h * D; r.V = V + (size_t)b * S * PITCH + h * D;
    r.MW = MASKW + ((size_t)b * (S / 32) + (size_t)qb * 8) * MW_PER_QB; r.bias = rel_bias + h; r.P0 = qb * QB;
    return r;
}
__device__ __forceinline__ void attn_phase(char* lds, int vcu, int G, const bf16* Q, const bf16* K, const bf16* V, const bf16* ZS, bf16* O, const u64* MASKW, const float* rel_bias) {
    constexpr int TOTAL = 512;
    for (int L = vcu; L < TOTAL; L += G)
#pragma unroll 1
        for (int pass = 0; pass < 2; ++pass) { const BlockRef cur = make_ref(L, pass, Q, K, V, ZS, O, MASKW, rel_bias); attn_block(cur, lds); }
}
}

namespace sgu {
typedef unsigned short bf16;
typedef short bf16x8 __attribute__((ext_vector_type(8)));
typedef short s16x4 __attribute__((ext_vector_type(4)));
typedef float f32x16 __attribute__((ext_vector_type(16)));
typedef float f32x2_t __attribute__((ext_vector_type(2))); typedef __bf16 bf16x2_t __attribute__((ext_vector_type(2)));
__device__ __forceinline__ unsigned cvtpk_s(float lo, float hi) { f32x2_t v = {lo, hi}; bf16x2_t b = __builtin_convertvector(v, bf16x2_t); return __builtin_bit_cast(unsigned, b); }
constexpr int OFF_B = 0;
constexpr int OFF_ST = 65536;
constexpr int OFF_EP = 66560;
constexpr int EP_PITCH = 80, EP_WAVE = 128 * EP_PITCH;
constexpr int SGU_LDS_BYTES = OFF_EP + 8 * EP_WAVE;

template <bool WRITE>
__device__ __forceinline__ void sgu_phase(char* lds, int vcu, int G, bf16* U  , const bf16* Vb, const float* LNP, const bf16* WS16, const float* ln_g, const float* ln_b, const float* b_s) {
    const int tid = threadIdx.x, wid = __builtin_amdgcn_readfirstlane(tid >> 6), lane = tid & 63, r32 = lane & 31, hi = lane >> 5;
    float2* stats = (float2*)(lds + OFF_ST);
    for (int chunk = vcu; chunk < M / 128; chunk += G) {
        const size_t row0 = (size_t)chunk * 128;
        { int tq_ = tid; asm volatile("" : "+v"(tq_));
          if (tq_ < 128) { const float4* pp = (const float4*)(LNP + (row0 + tq_) * 64); float s1 = 0.f, s2 = 0.f;
#pragma unroll
            for (int j = 0; j < 16; ++j) { const float4 q = pp[j]; s1 += q.x + q.z; s2 += q.y + q.w; }
            const float mean = s1 * (1.f / BW); const float var = fmaxf(s2 * (1.f / BW) - mean * mean, 0.f);
            stats[tq_] = make_float2(mean, 1.0f / sqrtf(var + LN_EPS)); } }
        __syncthreads();
#pragma unroll 1
        for (int g = 0; g < 8; ++g) {
            bf16x8 A0[2], A1[4], A2[6], A3[8];
            uint4 ug[8];
            { const size_t gb_ = (row0 * BW + (size_t)(g * 256 + (wid >> 2) * 128 + (wid & 3) * 32 + (lane & 3) * 8)) * 2;
#pragma unroll
                for (int p = 0; p < 8; ++p) ug[p] = *(const uint4*)((const char*)U + gb_ + (size_t)(16 * p + (lane >> 2)) * (BW * 2)); }
            { const char* ap = (const char*)WS16 + (size_t)(unsigned)(((g * 128 + r32) * 128 + 8 * hi) * 2);
#pragma unroll
                for (int kk = 0; kk < 2; ++kk) A0[kk] = *reinterpret_cast<const bf16x8*>(ap + kk * 32);
#pragma unroll
                for (int kk = 0; kk < 4; ++kk) A1[kk] = *reinterpret_cast<const bf16x8*>(ap + 32 * 256 + kk * 32);
#pragma unroll
                for (int kk = 0; kk < 6; ++kk) A2[kk] = *reinterpret_cast<const bf16x8*>(ap + 64 * 256 + kk * 32);
#pragma unroll
                for (int kk = 0; kk < 8; ++kk) A3[kk] = *reinterpret_cast<const bf16x8*>(ap + 96 * 256 + kk * 32); }
            { const int e8 = (tid & 31) * 8, ch = g * 256 + e8;
                const float4 g0 = *(const float4*)(ln_g + ch), g1 = *(const float4*)(ln_g + ch + 4), b0 = *(const float4*)(ln_b + ch), b1 = *(const float4*)(ln_b + ch + 4);
#pragma unroll
                for (int i = 0; i < 8; ++i) { const int s = (tid >> 5) + 16 * i; const uint4 w = *(const uint4*)(Vb + (row0 + s) * BW + ch); const float2 st = stats[s];
                    const float x0 = (bflo(w.x) - st.x) * st.y * g0.x + b0.x, x1 = (bfhi(w.x) - st.x) * st.y * g0.y + b0.y, x2 = (bflo(w.y) - st.x) * st.y * g0.z + b0.z, x3 = (bfhi(w.y) - st.x) * st.y * g0.w + b0.w;
                    const float x4 = (bflo(w.z) - st.x) * st.y * g1.x + b1.x, x5 = (bfhi(w.z) - st.x) * st.y * g1.y + b1.y, x6 = (bflo(w.w) - st.x) * st.y * g1.z + b1.z, x7 = (bfhi(w.w) - st.x) * st.y * g1.w + b1.w;
                    uint4 o; o.x = att::cvtpk(x0, x1); o.y = att::cvtpk(x2, x3); o.z = att::cvtpk(x4, x5); o.w = att::cvtpk(x6, x7);
                    *(uint4*)(lds + OFF_B + ((s >> 6) * 2 + (e8 >> 7)) * 16384 + att::v_st(s & 63, e8 & 127)) = o; } }
            __syncthreads();
            f32x16 acc[4] = {};
            { const int eh = wid >> 2, d0 = wid & 3;
                const int vb0 = (int)(uintptr_t)(lds + OFF_B) + att::v_rd_base(lane) + eh * 16384 + d0 * 512;
#define TRRD(dst, off) asm volatile("ds_read_b64_tr_b16 %0, %1 offset:%2" : "=&v"(dst) : "v"(vb0), "i"(off) : "memory")
#define BFRAG(dst, sh, ks) do { s16x4 l_, h_; TRRD(l_, (sh) * 32768 + (ks) * 4096); TRRD(h_, (sh) * 32768 + (ks) * 4096 + 2048); asm volatile("s_waitcnt lgkmcnt(0)" ::: "memory"); \
                dst = (bf16x8){l_[0], l_[1], l_[2], l_[3], h_[0], h_[1], h_[2], h_[3]}; } while (0)
                bf16x8 Bf[8];
                BFRAG(Bf[0], 0, 0); BFRAG(Bf[1], 0, 1); BFRAG(Bf[2], 0, 2); BFRAG(Bf[3], 0, 3); BFRAG(Bf[4], 1, 0); BFRAG(Bf[5], 1, 1); BFRAG(Bf[6], 1, 2); BFRAG(Bf[7], 1, 3);
#undef BFRAG
#undef TRRD
#pragma unroll
                for (int kk = 0; kk < 2; ++kk) acc[0] = __builtin_amdgcn_mfma_f32_32x32x16_bf16(A0[kk], Bf[kk], acc[0], 0, 0, 0);
#pragma unroll
                for (int kk = 0; kk < 4; ++kk) acc[1] = __builtin_amdgcn_mfma_f32_32x32x16_bf16(A1[kk], Bf[kk], acc[1], 0, 0, 0);
#pragma unroll
                for (int kk = 0; kk < 6; ++kk) acc[2] = __builtin_amdgcn_mfma_f32_32x32x16_bf16(A2[kk], Bf[kk], acc[2], 0, 0, 0);
#pragma unroll
                for (int kk = 0; kk < 8; ++kk) acc[3] = __builtin_amdgcn_mfma_f32_32x32x16_bf16(A3[kk], Bf[kk], acc[3], 0, 0, 0);
                char* ep = lds + OFF_EP + wid * EP_WAVE;
#pragma unroll
                for (int tb = 0; tb < 4; ++tb)
#pragma unroll
                    for (int r = 0; r < 16; ++r) { const int tl = 32 * tb + (r & 3) + 8 * (r >> 2) + 4 * hi;
                        *(unsigned short*)(ep + tl * EP_PITCH + r32 * 2) = (unsigned short)(cvtpk_s(acc[tb][r], 0.f) & 0xffffu); }
                asm volatile("s_waitcnt lgkmcnt(0)" ::: "memory");
                const int rq = lane >> 2, cq = (lane & 3) * 8;
                const size_t gbase = (row0 * BW + (size_t)(g * 256 + eh * 128 + d0 * 32 + cq)) * 2;
#pragma unroll
                for (int ph = 0; ph < 2; ++ph) {
                    uint4 uu[4], mm[4]; float bs[4];
#pragma unroll
                    for (int p = 0; p < 4; ++p) { const int t = 16 * (ph * 4 + p) + rq; const size_t o = gbase + (size_t)t * (BW * 2);
                        uu[p] = ug[ph * 4 + p]; bs[p] = b_s[g * 128 + t]; mm[p] = *(const uint4*)(ep + t * EP_PITCH + cq * 2); }
#pragma unroll
                    for (int p = 0; p < 4; ++p) { const int t = 16 * (ph * 4 + p) + rq; const size_t o = gbase + (size_t)t * (BW * 2);
                        uint4 y;
                        y.x = att::cvtpk(bflo(uu[p].x) * (bflo(mm[p].x) + bs[p]), bfhi(uu[p].x) * (bfhi(mm[p].x) + bs[p]));
                        y.y = att::cvtpk(bflo(uu[p].y) * (bflo(mm[p].y) + bs[p]), bfhi(uu[p].y) * (bfhi(mm[p].y) + bs[p]));
                        y.z = att::cvtpk(bflo(uu[p].z) * (bflo(mm[p].z) + bs[p]), bfhi(uu[p].z) * (bfhi(mm[p].z) + bs[p]));
                        y.w = att::cvtpk(bflo(uu[p].w) * (bflo(mm[p].w) + bs[p]), bfhi(uu[p].w) * (bfhi(mm[p].w) + bs[p]));
                        if (WRITE || y.x == 0x12345678u) *(uint4*)((char*)U + o) = y; } } }
            __syncthreads();
        }
    }
}
}

constexpr size_t MiB = 1u << 20;
constexpr size_t WS_CTL = 0, CTL_ZERO_BYTES = 64 * 1024;
constexpr size_t WS_WAI = 2 * MiB, WS_WAO = 12 * MiB, WS_WBI = 14 * MiB, WS_WBO = 26 * MiB;
constexpr size_t WS_WS16 = 1 * MiB;
constexpr size_t WS_RS0 = 1 * MiB + 512 * 1024;
constexpr size_t WS_H = 32 * MiB;
constexpr size_t WS_Q = 96 * MiB, WS_K = 160 * MiB, WS_V = 224 * MiB, WS_ZS = 288 * MiB;
constexpr size_t WS_QI = 352 * MiB, WS_KI = 384 * MiB, WS_WI = 388 * MiB;
constexpr size_t WS_MASK = 416 * MiB;
constexpr size_t WS_PS = 30 * MiB;
constexpr size_t WS_XB = 32 * MiB;
constexpr size_t WS_OG = 352 * MiB;
constexpr size_t WS_U = 96 * MiB, WS_VB = 224 * MiB, WS_ZB = 352 * MiB;
constexpr size_t WS_LNP = 352 * MiB;
constexpr size_t WS_TAIL = 480 * MiB;
constexpr size_t WS_END = 512 * MiB;
constexpr int CW_BAR = 1024;
constexpr int LDS_BYTES = 162816;
constexpr int MISC_OFF = 160000;
static_assert(att::ATTN_LDS_BYTES <= MISC_OFF && idx::IDX_LDS_BYTES <= MISC_OFF && sgu::SGU_LDS_BYTES <= MISC_OFF, "LDS map");

#define XB_TMO      128
#define XB_XCNT(j)  (256  + 64 * (j))
#define XB_XSUB(j)  (1280 + 64 * (j))
#define XB_XGEN(j)  (2304 + 64 * (j))
#define XB_TOP      3328
#define XB_TOPGEN   3392
#define XCD_BAR_WORDS 3456
#define XB_SPIN_CAP (1u << 18)
__device__ __forceinline__ unsigned xb_ld(unsigned* p)              { return __hip_atomic_load(p, __ATOMIC_RELAXED, __HIP_MEMORY_SCOPE_AGENT); }
__device__ __forceinline__ unsigned xb_add(unsigned* p, unsigned v) { return __hip_atomic_fetch_add(p, v, __ATOMIC_RELAXED, __HIP_MEMORY_SCOPE_AGENT); }
__device__ __forceinline__ unsigned xb_xcc_id() { return (unsigned)__builtin_amdgcn_s_getreg((3 << 11) | 20) & 0xFu; }
#define XB_SPIN(cond, bar) do { unsigned _sp = 0; while (cond) { __builtin_amdgcn_s_sleep(1); \
    if ((++_sp & 255u) == 0u) { if (xb_ld(&(bar)[XB_TMO])) break; if (_sp > XB_SPIN_CAP) { atomicAdd(&(bar)[XB_TMO], 1u); break; } } } } while (0)
struct XcdBarrier { unsigned* bar; unsigned x; volatile LAS unsigned* st; };
__device__ __forceinline__ XcdBarrier xcd_barrier_post(unsigned* bar, volatile LAS unsigned* st) {
    XcdBarrier b; b.bar = bar; b.x = xb_xcc_id(); b.st = st;
    if (threadIdx.x == 0) (void)xb_add(&bar[XB_XCNT(b.x)], 1u);
    return b;
}
__device__ __forceinline__ void xcd_barrier_complete(unsigned* bar, unsigned x, unsigned& nloc, unsigned& nx) {
    const unsigned G = gridDim.x * gridDim.y * gridDim.z;
    unsigned sum, cnt, mine, sp = 0u;
    for (;;) {
        sum = 0u; cnt = 0u; mine = 0u;
#pragma unroll
        for (unsigned j = 0; j < 16; ++j) { const unsigned c = xb_ld(&bar[XB_XCNT(j)]); sum += c; cnt += (c > 0u) ? 1u : 0u; mine = (j == x) ? c : mine; }
        if (sum == G) break;
        __builtin_amdgcn_s_sleep(1);
        if ((++sp & 255u) == 0u) { if (xb_ld(&bar[XB_TMO])) break; if (sp > XB_SPIN_CAP) { atomicAdd(&bar[XB_TMO], 1u); break; } }
    }
    nloc = mine > 0u ? mine : 1u; nx = cnt > 0u ? cnt : 1u;
}
__device__ __forceinline__ void xcd_barrier(const XcdBarrier& b) {
    asm volatile("s_waitcnt vmcnt(0)" ::: "memory");
    __syncthreads();
    if (threadIdx.x == 0) {
        unsigned* bar = b.bar;
        __builtin_amdgcn_s_waitcnt(0);
        unsigned nloc = b.st[0], nx = b.st[1];
        if (nloc == 0u) { xcd_barrier_complete(bar, b.x, nloc, nx); b.st[0] = nloc; b.st[1] = nx; }
        const unsigned old = xb_add(&bar[XB_XSUB(b.x)], 1u);
        const unsigned gen = old / nloc;
        if (old + 1u == (gen + 1u) * nloc) {
            __builtin_amdgcn_fence(__ATOMIC_RELEASE, "agent");
            asm volatile("s_waitcnt vmcnt(0)" ::: "memory");
            const unsigned og = xb_add(&bar[XB_TOP], 1u);
            const unsigned tg = og / nx;
            if (og + 1u == (tg + 1u) * nx) xb_add(&bar[XB_TOPGEN], 1u);
            else XB_SPIN(xb_ld(&bar[XB_TOPGEN]) == tg, bar);
            __builtin_amdgcn_fence(__ATOMIC_ACQUIRE, "agent");
            xb_add(&bar[XB_XGEN(b.x)], 1u);
            asm volatile("s_waitcnt vmcnt(0)" ::: "memory");
        } else {
            XB_SPIN(xb_ld(&bar[XB_XGEN(b.x)]) == gen, bar);
            __builtin_amdgcn_fence(__ATOMIC_ACQUIRE, "agent");
            asm volatile("s_waitcnt vmcnt(0)" ::: "memory");
        }
    }
    __syncthreads();
}

#ifndef MK_PER_PHASE
#define MK_PER_PHASE 0
#endif
constexpr int NPHASES = 10;
struct Args { const float* in[12]; float* out; unsigned char* ws; int ph_lo, ph_hi; };
__global__ void __launch_bounds__(512, 2) fwd(Args args) {
    extern __shared__ __attribute__((aligned(16))) unsigned char lds[];
    LAS unsigned char* ldsl = (LAS unsigned char*)lds;
    volatile LAS unsigned* MISC = (volatile LAS unsigned*)(ldsl + MISC_OFF);
    const int tid = threadIdx.x, lane = tid & 63, wave = __builtin_amdgcn_readfirstlane(tid >> 6);
    const int G = gridDim.x; const int bx = blockIdx.x; const int vcu = (G % 8 == 0) ? (bx % 8) * (G / 8) + bx / 8 : bx;
    const int gw = vcu * 8 + wave, NGW = G * 8;
    unsigned char* ws = args.ws;
    const float* x = args.in[0]; const float* norm_g = args.in[1]; const float* final_g = args.in[2]; const float* rel_bias = args.in[3];
    const float* a_w_in = args.in[4]; const float* a_w_out = args.in[5]; const float* b_w_in = args.in[6];
    const float* b_ln_g = args.in[7]; const float* b_ln_b = args.in[8]; const float* b_w_s = args.in[9]; const float* b_b_s = args.in[10]; const float* b_w_out = args.in[11];
    float* out = args.out;
    bf16 *WAI = (bf16*)(ws + WS_WAI), *WAO = (bf16*)(ws + WS_WAO), *WBI = (bf16*)(ws + WS_WBI), *WBO = (bf16*)(ws + WS_WBO), *H = (bf16*)(ws + WS_H);
    bf16 *Qb = (bf16*)(ws + WS_Q), *Kb = (bf16*)(ws + WS_K), *Vb = (bf16*)(ws + WS_V), *ZS = (bf16*)(ws + WS_ZS), *QI = (bf16*)(ws + WS_QI), *KI = (bf16*)(ws + WS_KI);
    float* WI = (float*)(ws + WS_WI); bf16* WS16 = (bf16*)(ws + WS_WS16);
    bf16 *U = (bf16*)(ws + WS_U), *V1 = (bf16*)(ws + WS_VB), *Z1 = (bf16*)(ws + WS_ZB), *XB = (bf16*)(ws + WS_XB); float* PS = (float*)(ws + WS_PS);
    if (tid < 32) MISC[tid] = 0u;
    __syncthreads();
    XcdBarrier bar; bar.bar = (unsigned*)(ws + WS_CTL) + CW_BAR; bar.x = 0; bar.st = nullptr;
    if (!MK_PER_PHASE) bar = xcd_barrier_post((unsigned*)(ws + WS_CTL) + CW_BAR, MISC + 8);
    const int lo = args.ph_lo, hi = args.ph_hi;
#ifdef DBG_SKIP
#define IN(k) (((DBG_SKIP >> (k)) & 1) == 0 && lo <= (k) && (k) < hi)
#else
#define IN(k) (lo <= (k) && (k) < hi)
#endif
#ifndef DBG_REPEAT
#define DBG_REPEAT 0
#endif
#define REP(k) _Pragma("unroll 1") for (int rep_ = 0; rep_ < 1 + ((DBG_REPEAT >> (k)) & 1); ++rep_)
#define SEAM(k) do { if (IN(k) && IN((k) + 1)) xcd_barrier(bar); } while (0)

    if (IN(0)) REP(0) {
        LAS float* scr = (LAS float*)ldsl + wave * 64 * 33;
        constexpr int I_AI = 16 * (A_NPAD / 32), I_AO = 16 * 32, I_BI = 16 * (B_COLS / 32), I_BO = 32 * 32;
        for (int it = gw; it < I_AI + I_AO + I_BI + I_BO; it += NGW) {
            int r = it;
            if (r < I_AI) { transpose_item(a_w_in, 1024, A_COLS, A_NPAD, WAI, scr, r, lane, norm_g); continue; } r -= I_AI;
            if (r < I_AO) { transpose_item(a_w_out, 1024, 1024, 1024, WAO, scr, r, lane); continue; } r -= I_AO;
            if (r < I_BI) { transpose_item(b_w_in, 1024, B_COLS, B_COLS, WBI, scr, r, lane, norm_g + DM, true); continue; } r -= I_BI;
            transpose_item(b_w_out, 2048, 1024, 1024, WBO, scr, r, lane);
        }
        for (int i = vcu * 512 + tid; i < 8 * 128 * 128; i += G * 512) WS16[i] = (i & 127) <= ((i >> 7) & 127) ? (bf16)f2bf(b_w_s[i]) : (bf16)0;
        for (int m = gw; m < M; m += NGW) row_to_bf16_rs(x + (size_t)m * DM, H + (size_t)m * DM, (float*)(ws + WS_RS0) + m, lane);
        __syncthreads();
    }
    SEAM(0);
    if (IN(1)) REP(1) {
        pg8::Gemm g{H, WAI, M, A_NPAD, 1024}; pg8::StaticOrder So; So.init(M, A_NPAD, G, bx);
        pg8::EpiA E{Qb, Kb, Vb, ZS, QI, KI, WI, (const float*)(ws + WS_RS0)};
        pg8::gemm_phase<pg8::EpiA, pg8::StaticOrder, true, true>(ldsl, g, So, E);
    }
    SEAM(1);
    if (IN(2)) REP(2) idx::indexer_phase((char*)lds, vcu, G, QI, KI, WI, (idx::u64*)(ws + WS_MASK), (char*)out, (char*)(ws + WS_TAIL), (char*)(ws + WS_WI + 1 * MiB), (char*)(ws + WS_WAI));
    SEAM(2);
    if (IN(3)) REP(3) {
        att::attn_phase((char*)lds, vcu, G, Qb, Kb, Vb, ZS, (bf16*)(ws + WS_OG), (const att::u64*)(ws + WS_MASK), rel_bias); }
    SEAM(3);
    if (IN(4)) REP(4) {
        pg8::Gemm g{(const bf16*)(ws + WS_OG), WAO, M, 1024, 1024}; pg8::StaticOrder So; So.init(M, 1024, G, bx);
        pg8::EpiRes1 E{XB, PS};
        pg8::gemm_phase<pg8::EpiRes1, pg8::StaticOrder, true, true>(ldsl, g, So, E);
    }
    if (IN(4) && IN(6)) xcd_barrier(bar);
    if (IN(6)) REP(6) {
        pg8::Gemm g{XB, WBI, M, B_COLS, 1024}; pg8::StaticOrder So; So.init(M, B_COLS, G, bx);
        pg8::EpiB E{U, V1, PS, (float*)(ws + WS_LNP)};
        pg8::gemm_phase<pg8::EpiB, pg8::StaticOrder, true, true>(ldsl, g, So, E);
    }
    SEAM(6);
#ifdef DBG_SGU2
    if (IN(7)) sgu::sgu_phase<false>((char*)lds, vcu, G, U, V1, (const float*)(ws + WS_LNP), WS16, b_ln_g, b_ln_b, b_b_s);
#endif
    if (IN(7)) sgu::sgu_phase<true>((char*)lds, vcu, G, U, V1, (const float*)(ws + WS_LNP), WS16, b_ln_g, b_ln_b, b_b_s);
    SEAM(7);
    if (IN(8)) REP(8) {
        pg8::Gemm g{U, WBO, M, 1024, 2048}; pg8::StaticOrder So; So.init(M, 1024, G, bx);
        pg8::EpiRes2 E{XB};
        pg8::gemm_phase<pg8::EpiRes2, pg8::StaticOrder, true, true>(ldsl, g, So, E);
    }
    SEAM(8);
    if (IN(9)) REP(9) { for (int m = gw; m < M; m += NGW) rms_row_bf16_to_f32(XB + (size_t)m * DM, final_g, out + (size_t)m * DM, lane); }
#undef IN
#undef SEAM
}

extern "C" void kernel_launch(void* const* d_in, const int* in_sizes, int n_in, void* d_out, int out_size, void* d_ws, size_t ws_size, hipStream_t stream) {
    static int grid = 0;
    if (grid == 0) {
        if (n_in != 12 || in_sizes[0] != M * DM || out_size != M * DM || ws_size < WS_END) { fprintf(stderr, "kernel_launch: unexpected shapes (n_in %d, in0 %d, out %d, ws %zu)\n", n_in, n_in > 0 ? in_sizes[0] : -1, out_size, ws_size); grid = -1; return; }
        int dev = 0, cus = 0, per_cu = 0;
        if (hipGetDevice(&dev) != hipSuccess || hipDeviceGetAttribute(&cus, hipDeviceAttributeMultiprocessorCount, dev) != hipSuccess) { fprintf(stderr, "kernel_launch: device query failed\n"); grid = -1; return; }
        if (hipFuncSetAttribute((const void*)fwd, hipFuncAttributeMaxDynamicSharedMemorySize, LDS_BYTES) != hipSuccess) { fprintf(stderr, "kernel_launch: hipFuncSetAttribute failed\n"); grid = -1; return; }
        if (hipOccupancyMaxActiveBlocksPerMultiprocessor(&per_cu, (const void*)fwd, 512, LDS_BYTES) != hipSuccess || per_cu < 1) { fprintf(stderr, "kernel_launch: occupancy query says %d workgroups per CU\n", per_cu); }
        (void)hipGetLastError();
        grid = cus;
    }
    if (grid < 0) return;
    if (hipMemsetAsync((char*)d_ws + WS_CTL, 0, CTL_ZERO_BYTES, stream) != hipSuccess) { fprintf(stderr, "kernel_launch: memset failed\n"); return; }
    Args a{};
    for (int i = 0; i < 12; ++i) a.in[i] = (const float*)d_in[i];
    a.out = (float*)d_out; a.ws = (unsigned char*)d_ws;
#if MK_PER_PHASE
    for (int p = 0; p < NPHASES; ++p) { a.ph_lo = p; a.ph_hi = p + 1; hipLaunchKernelGGL(fwd, dim3(grid), dim3(512), LDS_BYTES, stream, a); }
#else
    a.ph_lo = 0; a.ph_hi = NPHASES;
    hipLaunchKernelGGL(fwd, dim3(grid), dim3(512), LDS_BYTES, stream, a);
#endif
    const hipError_t le = hipPeekAtLastError();
    if (le != hipSuccess) fprintf(stderr, "kernel_launch: launch failed: %s\n", hipGetErrorName(le));
}
```
